# Optimizing an MI355X kernel written in HIP

```python
import math
import jax, jax.numpy as jnp
from jax import lax
import numpy as np

D_MODEL = 2048
BATCH = 1
SEQ = 8192
DEPTH = 4

MEM_LEN = 256
DA_HEADS = 8
DA_HEAD_DIM = 64
DA_V_DIM = 2 * DA_HEAD_DIM
DA_WIDTH = DA_HEADS * DA_V_DIM
Q_BLOCK = 128
ROPE_THETA = 10000.0
CV_WIDTH = 512
CONV_TAPS = 31
SSM_WIDTH = 512
SSM_GROUP = 16
SSM_GROUPS = SSM_WIDTH // SSM_GROUP
SSM_STATE = 64
XA_HEADS = 4
XA_HEAD_DIM = 128
XA_WIDTH = XA_HEADS * XA_HEAD_DIM
MOE_GROUPS = 4
MOE_PER_GROUP = 4
MOE_EXPERTS = MOE_GROUPS * MOE_PER_GROUP
MOE_TOPK = 2
MOE_FF = 512
RMS_EPS = 1e-6
HEAD_NORM_EPS = 1e-5
LN_EPS = 1e-5

IN_Q = 2 * DA_HEADS * DA_HEAD_DIM
IN_K = 2 * DA_HEADS * DA_HEAD_DIM
IN_V = DA_WIDTH
IN_CV = 2 * CV_WIDTH
IN_SSM = SSM_WIDTH
IN_GATE = 3 * D_MODEL
IN_TOTAL = IN_Q + IN_K + IN_V + IN_CV + IN_SSM + IN_GATE
IN_SPLITS = (IN_Q, IN_Q + IN_K, IN_Q + IN_K + IN_V, IN_Q + IN_K + IN_V + IN_CV,
             IN_Q + IN_K + IN_V + IN_CV + IN_SSM)

kernel_name = "hybrid_gated_diffattn_conv_s5_hmoe"


def rms_norm(x, g, eps=RMS_EPS):
    xf = x.astype(jnp.float32)
    y = xf * lax.rsqrt(jnp.mean(xf * xf, axis=-1, keepdims=True) + eps)
    return (y * g.astype(jnp.float32)).astype(x.dtype)


def layer_norm(x, g, b, eps=LN_EPS):
    xf = x.astype(jnp.float32)
    mu = jnp.mean(xf, axis=-1, keepdims=True)
    xc = xf - mu
    var = jnp.mean(xc * xc, axis=-1, keepdims=True)
    y = xc * lax.rsqrt(var + eps) * g.astype(jnp.float32) + b.astype(jnp.float32)
    return y.astype(x.dtype)


def rope_tables(positions, dim):
    inv_freq = ROPE_THETA ** (-jnp.arange(0, dim, 2, dtype=jnp.float32) / dim)
    ang = positions.astype(jnp.float32)[..., None] * inv_freq
    return jnp.cos(ang), jnp.sin(ang)


def apply_rope(t, cos, sin):
    half = t.shape[-1] // 2
    t1, t2 = t[..., :half], t[..., half:]
    cos = cos.astype(t.dtype)
    sin = sin.astype(t.dtype)
    return jnp.concatenate([t1 * cos - t2 * sin, t2 * cos + t1 * sin], axis=-1)


def diff_attention(q, k, v, lam):
    bsz, seq = q.shape[0], q.shape[1]
    nblk = seq // Q_BLOCK
    qb = jnp.moveaxis(q.reshape(bsz, nblk, Q_BLOCK, DA_HEADS, 2, DA_HEAD_DIM), 1, 0)
    key_pos = jnp.arange(seq)
    scale = DA_HEAD_DIM ** -0.5

    def block(args):
        q_blk, start = args
        s = jnp.einsum('bqhcd,bkhcd->bhcqk', q_blk, k).astype(jnp.float32) * scale
        q_pos = start + jnp.arange(Q_BLOCK)
        mask = key_pos[None, :] <= q_pos[:, None]
        s = jnp.where(mask, s, -jnp.inf)
        p = jax.nn.softmax(s, axis=-1)
        a = p[:, :, 0] - lam * p[:, :, 1]
        return jnp.einsum('bhqk,bkhe->bqhe', a.astype(v.dtype), v)

    starts = jnp.arange(nblk) * Q_BLOCK
    out = lax.map(block, (qb, starts))
    return jnp.moveaxis(out, 0, 1).reshape(bsz, seq, DA_HEADS, DA_V_DIM)


def conformer_conv(u, dw_w, dw_b, ln_g, ln_b, w_out):
    a, b = jnp.split(u, 2, axis=-1)
    z = a * jax.nn.sigmoid(b)
    z = lax.conv_general_dilated(
        z, dw_w[:, None, :], window_strides=(1,), padding=((CONV_TAPS - 1, 0),),
        dimension_numbers=('NWC', 'WIO', 'NWC'), feature_group_count=CV_WIDTH) + dw_b
    z = jax.nn.silu(layer_norm(z, ln_g, ln_b))
    return z @ w_out


def s5_ssm(u, lam_re, lam_im, log_dt, b_re, b_im, c_re, c_im, d_skip, w_glu, b_glu, w_out):
    bsz, seq, _ = u.shape
    f32 = jnp.float32
    uf = u.astype(f32).reshape(bsz, seq, SSM_GROUPS, SSM_GROUP)
    lr = lam_re.astype(f32)
    li = lam_im.astype(f32)
    dt = jnp.exp(log_dt.astype(f32))[:, None]
    mag = jnp.exp(lr * dt)
    ab_re = mag * jnp.cos(li * dt)
    ab_im = mag * jnp.sin(li * dt)
    den = lr * lr + li * li
    f_re = ((ab_re - 1.0) * lr + ab_im * li) / den
    f_im = (ab_im * lr - (ab_re - 1.0) * li) / den
    br = b_re.astype(f32)
    bi = b_im.astype(f32)
    bb_re = f_re[..., None] * br - f_im[..., None] * bi
    bb_im = f_re[..., None] * bi + f_im[..., None] * br
    bu_re = jnp.einsum('gph,blgh->blgp', bb_re, uf)
    bu_im = jnp.einsum('gph,blgh->blgp', bb_im, uf)
    a_re = jnp.broadcast_to(ab_re, bu_re.shape)
    a_im = jnp.broadcast_to(ab_im, bu_re.shape)

    def combine(e1, e2):
        a1r, a1i, b1r, b1i = e1
        a2r, a2i, b2r, b2i = e2
        return (a2r * a1r - a2i * a1i,
                a2r * a1i + a2i * a1r,
                a2r * b1r - a2i * b1i + b2r,
                a2r * b1i + a2i * b1r + b2i)

    _, _, x_re, x_im = lax.associative_scan(combine, (a_re, a_im, bu_re, bu_im), axis=1)
    y = (jnp.einsum('ghp,blgp->blgh', c_re.astype(f32), x_re)
         - jnp.einsum('ghp,blgp->blgh', c_im.astype(f32), x_im)
         + d_skip.astype(f32) * uf)
    y = y.reshape(bsz, seq, SSM_WIDTH).astype(u.dtype)
    ga, gb = jnp.split(y @ w_glu + b_glu, 2, axis=-1)
    return (ga * jax.nn.sigmoid(gb)) @ w_out


def mem_cross_attention(h, m, w_q, w_kv, w_out):
    bsz, seq, _ = h.shape
    q = (h @ w_q).reshape(bsz, seq, XA_HEADS, XA_HEAD_DIM)
    k, v = jnp.split(m @ w_kv, 2, axis=-1)
    k = k.reshape(bsz, -1, XA_HEADS, XA_HEAD_DIM)
    v = v.reshape(bsz, -1, XA_HEADS, XA_HEAD_DIM)
    s = jnp.einsum('bqhd,bkhd->bhqk', q, k).astype(jnp.float32) * (XA_HEAD_DIM ** -0.5)
    p = jax.nn.softmax(s, axis=-1)
    o = jnp.einsum('bhqk,bkhd->bqhd', p.astype(v.dtype), v).reshape(bsz, seq, XA_WIDTH)
    return o @ w_out


def hier_moe(h, w_rg, b_rg, w_re, b_re, w_gate, w_up, w_down):
    bsz, seq, dm = h.shape
    t = h.reshape(-1, dm)
    g_logits = (t @ w_rg).astype(jnp.float32) + b_rg.astype(jnp.float32)
    g_prob = jax.nn.softmax(g_logits, axis=-1)
    g_idx = jnp.argmax(g_logits, axis=-1)
    g_w = jnp.take_along_axis(g_prob, g_idx[:, None], axis=1)
    e_logits = ((t @ w_re).astype(jnp.float32) + b_re.astype(jnp.float32)).reshape(
        -1, MOE_GROUPS, MOE_PER_GROUP)
    e_sel = jnp.take_along_axis(e_logits, g_idx[:, None, None], axis=1)[:, 0]
    top_v, top_i = lax.top_k(e_sel, MOE_TOPK)
    w = jax.nn.softmax(top_v, axis=-1) * g_w
    e_idx = g_idx[:, None] * MOE_PER_GROUP + top_i
    comb = jnp.sum(jax.nn.one_hot(e_idx, MOE_EXPERTS, dtype=jnp.float32) * w[..., None], axis=1)
    comb = comb.astype(t.dtype)
    out = jnp.zeros_like(t)
    for e in range(MOE_EXPERTS):
        he = jax.nn.silu(t @ w_gate[e]) * (t @ w_up[e])
        out = out + comb[:, e:e + 1] * (he @ w_down[e])
    return out.reshape(bsz, seq, dm)


def setup_inputs(seed: int = 0) -> dict:
    key = jax.random.key(seed)
    ks = iter(jax.random.split(key, 48))
    f32 = jnp.float32

    def nrm(shape, scale):
        return jax.random.normal(next(ks), shape, f32) * scale

    def gain(shape):
        return 1.0 + 0.02 * jax.random.normal(next(ks), shape, f32)

    L = DEPTH
    n = jnp.arange(SSM_STATE, dtype=f32)
    return {
        "x": nrm((BATCH, SEQ, D_MODEL), 1.0),
        "mem": nrm((BATCH, MEM_LEN, D_MODEL), 1.0),
        "positions": jnp.broadcast_to(jnp.arange(SEQ, dtype=jnp.int32), (BATCH, SEQ)),
        "norm_mix": gain((L, D_MODEL)),
        "w_in": nrm((L, D_MODEL, IN_TOTAL), D_MODEL ** -0.5),
        "da_lam_q1": nrm((L, DA_HEAD_DIM), 0.1),
        "da_lam_k1": nrm((L, DA_HEAD_DIM), 0.1),
        "da_lam_q2": nrm((L, DA_HEAD_DIM), 0.1),
        "da_lam_k2": nrm((L, DA_HEAD_DIM), 0.1),
        "da_head_norm": gain((L, DA_V_DIM)),
        "w_da_out": nrm((L, DA_WIDTH, D_MODEL), DA_WIDTH ** -0.5),
        "cv_dw_w": nrm((L, CONV_TAPS, CV_WIDTH), CONV_TAPS ** -0.5),
        "cv_dw_b": nrm((L, CV_WIDTH), 0.02),
        "cv_ln_g": gain((L, CV_WIDTH)),
        "cv_ln_b": nrm((L, CV_WIDTH), 0.02),
        "w_cv_out": nrm((L, CV_WIDTH, D_MODEL), CV_WIDTH ** -0.5),
        "ssm_lam_re": -0.5 + nrm((L, SSM_GROUPS, SSM_STATE), 0.01),
        "ssm_lam_im": math.pi * n + nrm((L, SSM_GROUPS, SSM_STATE), 0.01),
        "ssm_log_dt": jax.random.uniform(next(ks), (L, SSM_GROUPS), f32,
                                         math.log(1e-3), math.log(1e-1)),
        "ssm_b_re": nrm((L, SSM_GROUPS, SSM_STATE, SSM_GROUP), (2 * SSM_GROUP) ** -0.5),
        "ssm_b_im": nrm((L, SSM_GROUPS, SSM_STATE, SSM_GROUP), (2 * SSM_GROUP) ** -0.5),
        "ssm_c_re": nrm((L, SSM_GROUPS, SSM_GROUP, SSM_STATE), (2 * SSM_STATE) ** -0.5),
        "ssm_c_im": nrm((L, SSM_GROUPS, SSM_GROUP, SSM_STATE), (2 * SSM_STATE) ** -0.5),
        "ssm_d": nrm((L, SSM_GROUPS, SSM_GROUP), 1.0),
        "w_ssm_glu": nrm((L, SSM_WIDTH, 2 * SSM_WIDTH), SSM_WIDTH ** -0.5),
        "b_ssm_glu": nrm((L, 2 * SSM_WIDTH), 0.02),
        "w_ssm_out": nrm((L, SSM_WIDTH, D_MODEL), SSM_WIDTH ** -0.5),
        "w_mix_out": nrm((L, D_MODEL, D_MODEL), D_MODEL ** -0.5),
        "norm_xa": gain((L, D_MODEL)),
        "norm_mem": gain((L, D_MODEL)),
        "w_xa_q": nrm((L, D_MODEL, XA_WIDTH), D_MODEL ** -0.5),
        "w_xa_kv": nrm((L, D_MODEL, 2 * XA_WIDTH), D_MODEL ** -0.5),
        "w_xa_out": nrm((L, XA_WIDTH, D_MODEL), XA_WIDTH ** -0.5),
        "norm_ffn": gain((L, D_MODEL)),
        "w_router_group": nrm((L, D_MODEL, MOE_GROUPS), D_MODEL ** -0.5),
        "b_router_group": nrm((L, MOE_GROUPS), 0.01),
        "w_router_expert": nrm((L, D_MODEL, MOE_EXPERTS), D_MODEL ** -0.5),
        "b_router_expert": nrm((L, MOE_EXPERTS), 0.01),
        "w_exp_gate": nrm((L, MOE_EXPERTS, D_MODEL, MOE_FF), D_MODEL ** -0.5),
        "w_exp_up": nrm((L, MOE_EXPERTS, D_MODEL, MOE_FF), D_MODEL ** -0.5),
        "w_exp_down": nrm((L, MOE_EXPERTS, MOE_FF, D_MODEL), MOE_FF ** -0.5),
        "norm_final": gain((D_MODEL,)),
    }


def reference(x, mem, positions, norm_mix, w_in, da_lam_q1, da_lam_k1, da_lam_q2, da_lam_k2,
              da_head_norm, w_da_out, cv_dw_w, cv_dw_b, cv_ln_g, cv_ln_b, w_cv_out,
              ssm_lam_re, ssm_lam_im, ssm_log_dt, ssm_b_re, ssm_b_im, ssm_c_re, ssm_c_im, ssm_d,
              w_ssm_glu, b_ssm_glu, w_ssm_out, w_mix_out, norm_xa, norm_mem, w_xa_q, w_xa_kv,
              w_xa_out, norm_ffn, w_router_group, b_router_group, w_router_expert,
              b_router_expert, w_exp_gate, w_exp_up, w_exp_down, norm_final):
    bsz, seq, _ = x.shape
    cos, sin = rope_tables(positions, DA_HEAD_DIM)
    cos = cos[:, :, None, None, :]
    sin = sin[:, :, None, None, :]
    for l in range(DEPTH):
        lam_init = 0.8 - 0.6 * math.exp(-0.3 * l)
        h = rms_norm(x, norm_mix[l])
        proj = h @ w_in[l]
        q, k, v, u_cv, u_ssm, gates = jnp.split(proj, IN_SPLITS, axis=-1)
        q = apply_rope(q.reshape(bsz, seq, DA_HEADS, 2, DA_HEAD_DIM), cos, sin)
        k = apply_rope(k.reshape(bsz, seq, DA_HEADS, 2, DA_HEAD_DIM), cos, sin)
        v = v.reshape(bsz, seq, DA_HEADS, DA_V_DIM)
        lam = (jnp.exp(jnp.sum(da_lam_q1[l].astype(jnp.float32) * da_lam_k1[l].astype(jnp.float32)))
               - jnp.exp(jnp.sum(da_lam_q2[l].astype(jnp.float32) * da_lam_k2[l].astype(jnp.float32)))
               + lam_init)
        o_a = diff_attention(q, k, v, lam)
        o_a = rms_norm(o_a, da_head_norm[l], HEAD_NORM_EPS) * (1.0 - lam_init)
        y_a = o_a.reshape(bsz, seq, DA_WIDTH) @ w_da_out[l]
        y_b = conformer_conv(u_cv, cv_dw_w[l], cv_dw_b[l], cv_ln_g[l], cv_ln_b[l], w_cv_out[l])
        y_c = s5_ssm(u_ssm, ssm_lam_re[l], ssm_lam_im[l], ssm_log_dt[l], ssm_b_re[l], ssm_b_im[l],
                     ssm_c_re[l], ssm_c_im[l], ssm_d[l], w_ssm_glu[l], b_ssm_glu[l], w_ssm_out[l])
        g_a, g_b, g_c = jnp.split(gates, 3, axis=-1)
        merged = (jax.nn.sigmoid(g_a) * y_a + jax.nn.sigmoid(g_b) * y_b
                  + jax.nn.sigmoid(g_c) * y_c)
        x = x + merged @ w_mix_out[l]
        h = rms_norm(x, norm_xa[l])
        m = rms_norm(mem, norm_mem[l])
        x = x + mem_cross_attention(h, m, w_xa_q[l], w_xa_kv[l], w_xa_out[l])
        h = rms_norm(x, norm_ffn[l])
        x = x + hier_moe(h, w_router_group[l], b_router_group[l], w_router_expert[l],
                         b_router_expert[l], w_exp_gate[l], w_exp_up[l], w_exp_down[l])
    return rms_norm(x, norm_final)
```

```cpp
#include <hip/hip_runtime.h>
#include <cstdio>
#include <cstdint>
#include <cmath>

#ifndef NAIVE_GEMM
#define NAIVE_GEMM 0
#endif
#ifndef NAIVE_ATTN
#define NAIVE_ATTN 0
#endif
#ifndef NAIVE_SSM
#define NAIVE_SSM 0
#endif
#ifndef MK_PER_PHASE
#define MK_PER_PHASE 0
#endif

#define GAS __attribute__((address_space(1)))
#define LAS __attribute__((address_space(3)))
typedef unsigned short bf16_t;
typedef short bf16x8 __attribute__((ext_vector_type(8)));
typedef float f32x4 __attribute__((ext_vector_type(4)));
typedef float f32x2 __attribute__((ext_vector_type(2)));
typedef unsigned u32x4 __attribute__((ext_vector_type(4)));
typedef unsigned u32x2 __attribute__((ext_vector_type(2)));
typedef GAS unsigned gu32;
#define RLX_AGENT __ATOMIC_RELAXED, __HIP_MEMORY_SCOPE_AGENT
#define LDS_WAIT() asm volatile("s_waitcnt lgkmcnt(0)" ::: "memory")
#define VM_WAIT() asm volatile("s_waitcnt vmcnt(0)" ::: "memory")
__device__ __forceinline__ unsigned f2bf(float f) { unsigned u = __builtin_bit_cast(unsigned, f); return (u + 0x7fffu + ((u >> 16) & 1u)) >> 16; }
__device__ __forceinline__ unsigned pk2(float lo, float hi) { return f2bf(lo) | (f2bf(hi) << 16); }
__device__ __forceinline__ float bflo(unsigned w) { return __builtin_bit_cast(float, w << 16); }
__device__ __forceinline__ float bfhi(unsigned w) { return __builtin_bit_cast(float, w & 0xffff0000u); }
__device__ __forceinline__ float bf2f(bf16_t h) { return __builtin_bit_cast(float, (unsigned)h << 16); }
template <int M> __device__ __forceinline__ float xor_lane(float v) {
    if (M < 32) return __builtin_bit_cast(float, __builtin_amdgcn_ds_swizzle(__builtin_bit_cast(int, v), (M << 10) | 0x1f));
    const auto rr = __builtin_amdgcn_permlane32_swap(__builtin_bit_cast(unsigned, v), __builtin_bit_cast(unsigned, v), false, false);
    return __builtin_bit_cast(float, rr[0] ^ rr[1] ^ __builtin_bit_cast(unsigned, v));
}
__device__ __forceinline__ float wave_sum(float v) {
    v += xor_lane<1>(v); v += xor_lane<2>(v); v += xor_lane<4>(v); v += xor_lane<8>(v); v += xor_lane<16>(v); v += xor_lane<32>(v);
    return v;
}
__device__ __forceinline__ float wave_max(float v) {
    v = fmaxf(v, xor_lane<1>(v)); v = fmaxf(v, xor_lane<2>(v)); v = fmaxf(v, xor_lane<4>(v)); v = fmaxf(v, xor_lane<8>(v)); v = fmaxf(v, xor_lane<16>(v)); v = fmaxf(v, xor_lane<32>(v));
    return v;
}
__device__ __forceinline__ int tid_of(int wave_s) { int ln; asm volatile("v_mbcnt_lo_u32_b32 %0, -1, 0\n\tv_mbcnt_hi_u32_b32 %0, -1, %0" : "=v"(ln)); return (wave_s << 6) | ln; }
__device__ __forceinline__ float sigmoidf_(float x) { return __builtin_amdgcn_rcpf(1.f + __expf(-x)); }

constexpr int T = 8192, DM = 2048, NL = 4, MEML = 256, NPROJ = 10752, NEXP = 16, FFE = 512;
constexpr int NWAVES = 8;
constexpr float RMS_EPS = 1e-6f, HEAD_EPS = 1e-5f, LN_EPS = 1e-5f;
constexpr float C2Q = 0.125f * 1.4426950408889634f;
constexpr float GATE_WSCALE = 128.f;
#ifndef S_FP8
#define S_FP8 1
#endif
#ifndef FUSE_N2
#define FUSE_N2 1
#endif
constexpr float SQK_SCALE = S_FP8 ? 64.f : 1.f;
#ifndef XAO_FP8
#define XAO_FP8 1
#endif
constexpr float VW_SCALE = XAO_FP8 ? 64.f : 1.f;
constexpr float C2X = 0.08838834764831845f * 1.4426950408889634f;
constexpr size_t MiB = 1u << 20;
constexpr size_t WS_CTL = 0, CTL_ZERO_BYTES = 64 * 1024;
constexpr size_t LW_WIN = 0;
constexpr size_t LW_WG8 = LW_WIN + (size_t)3584 * DM * 2;
constexpr size_t LW_WCAT = LW_WG8 + (size_t)7680 * DM;
constexpr size_t LW_WGLU = LW_WCAT + (size_t)DM * DM * 2;
constexpr size_t LW_WMIX = LW_WGLU + (size_t)1024 * 512 * 2;
constexpr size_t LW_WQK = LW_WMIX + (size_t)DM * DM * 2;
constexpr size_t LW_VW = LW_WQK + (size_t)1024 * DM * 2;
constexpr size_t LW_WGU = LW_VW + (size_t)DM * 1024 * 2;
constexpr size_t LW_WD = LW_WGU + (size_t)NEXP * 1024 * DM;
constexpr size_t LW_BKE = LW_WD + (size_t)NEXP * DM * FFE;
constexpr size_t LW_F = LW_BKE + (size_t)32 * 512 * 640 * 2;
constexpr size_t LW_RT = LW_F + (size_t)32 * 128 * 512 * 2;
constexpr size_t LW_LAM = LW_RT + (size_t)20 * DM * 4;
constexpr size_t LW_SIZE = ((LW_LAM + (size_t)32 * 64 * 8 + 4095) / 4096) * 4096;
constexpr size_t WS_LW = 1 * MiB;
constexpr size_t WS_ACT = WS_LW + NL * LW_SIZE;
constexpr size_t WS_X = WS_ACT;
constexpr size_t WS_RSTD = WS_X + (size_t)T * DM * 2;
constexpr size_t WS_H = WS_X + (size_t)T * DM * 4;
constexpr size_t WS_Q = WS_H + (size_t)T * DM * 2;
constexpr size_t WS_K = WS_Q + (size_t)T * 1024 * 2;
constexpr size_t WS_V = WS_K + (size_t)T * 1024 * 2;
constexpr size_t WS_O1 = WS_V + (size_t)T * 1024 * 2;
constexpr size_t WS_O2 = WS_O1 + (size_t)T * 1024 * 2;
constexpr size_t WS_OAN = WS_O2 + (size_t)T * 1024 * 2;
constexpr size_t WS_Z = WS_OAN + (size_t)T * 1024 * 2;
constexpr size_t WS_UC = WS_Z + (size_t)T * 512 * 2;
constexpr size_t WS_GATES = WS_UC + (size_t)T * 512 * 2;
constexpr size_t WS_CVO = WS_GATES + (size_t)T * 6144 * 2;
constexpr size_t WS_SS = WS_CVO + (size_t)T * 512 * 2;
constexpr size_t WS_XP = WS_SS + (size_t)256 * 4096 * 4;
constexpr size_t WS_YS = WS_XP + (size_t)32 * 256 * 128 * 2;
constexpr size_t WS_GLUO = WS_YS + (size_t)T * 512 * 2;
constexpr size_t WS_MERGED = WS_GLUO + (size_t)T * 512 * 2;
constexpr size_t WS_P = WS_MERGED + (size_t)T * DM * 2;
constexpr size_t WS_RS = WS_P + (size_t)T * 1024 * 2;
constexpr size_t WS_HE = WS_RS + (size_t)T * 16 * 4;
constexpr size_t WS_Y = WS_HE + (size_t)(2 * T + 256) * 512 * 2;
constexpr size_t WS_LIST = WS_Y + (size_t)2 * T * DM * 2;
constexpr size_t WS_WL = WS_LIST + (size_t)NEXP * T * 4;
constexpr size_t WS_TOK = WS_WL + (size_t)NEXP * T * 4;
constexpr size_t WS_ROPE = WS_TOK + (size_t)T * 16;
constexpr size_t WS_H8 = WS_ROPE + (size_t)T * 64 * 4;
constexpr size_t WS_RSQ = WS_H8 + (size_t)T * DM;
constexpr size_t WS_END = WS_RSQ + (size_t)T * 32 * 4;
constexpr size_t WS_WQB = WS_GATES;
constexpr size_t WS_WKVT = WS_WQB + (size_t)NL * DM * 512 * 2;
constexpr size_t WS_WXOT = WS_WKVT + (size_t)NL * 1024 * DM * 2;
constexpr size_t WS_MNORM = WS_WXOT + (size_t)NL * DM * 512 * 2;
constexpr size_t WS_KVB = WS_MNORM + (size_t)NL * MEML * DM * 2;
static_assert(WS_KVB + (size_t)NL * MEML * 1024 * 2 <= WS_CVO, "prologue temporaries inside GATES");
static_assert(WS_END < (size_t)1350000000, "workspace plan");
constexpr int CW_TMO = 0, CW_CODE = 1;
constexpr int CW_BAR = 4096;
constexpr int CW_CNT = 8192;
constexpr int RING_OFF = 0, RING_BYTES = 131072;
constexpr int LDSCTL_OFF = RING_BYTES, MISC_OFF = LDSCTL_OFF + 320;
constexpr int LDS_BYTES = 147456;
#define XB_TMO      128
#define XB_XCNT(j)  (256  + 64 * (j))
#define XB_XSUB(j)  (1280 + 64 * (j))
#define XB_XGEN(j)  (2304 + 64 * (j))
#define XB_TOP      3328
#define XB_TOPGEN   3392
#define XCD_BAR_WORDS 3456
#define XB_SPIN_CAP (1u << 24)

__device__ __forceinline__ unsigned xb_ld(unsigned* p)              { return __hip_atomic_load(p, __ATOMIC_RELAXED, __HIP_MEMORY_SCOPE_AGENT); }
__device__ __forceinline__ unsigned xb_add(unsigned* p, unsigned v) { return __hip_atomic_fetch_add(p, v, __ATOMIC_RELAXED, __HIP_MEMORY_SCOPE_AGENT); }
__device__ __forceinline__ unsigned xb_xcc_id() { return (unsigned)__builtin_amdgcn_s_getreg((3 << 11) | 20) & 0xFu; }
#define XB_SPIN(cond, bar) do { unsigned _sp = 0; while (cond) { __builtin_amdgcn_s_sleep(1); \
    if ((++_sp & 255u) == 0u) { if (xb_ld(&(bar)[XB_TMO])) break; if (_sp > XB_SPIN_CAP) { atomicAdd(&(bar)[XB_TMO], 1u); break; } } } } while (0)

struct XcdBarrier {
    unsigned* bar; unsigned x;
    volatile LAS unsigned* st;
};

__device__ __forceinline__ XcdBarrier xcd_barrier_post(unsigned* bar, volatile LAS unsigned* st) {
    XcdBarrier b; b.bar = bar; b.x = xb_xcc_id(); b.st = st;
    if (threadIdx.x == 0) (void)xb_add(&bar[XB_XCNT(b.x)], 1u);
    return b;
}
__device__ __forceinline__ void xcd_barrier_complete(unsigned* bar, unsigned x, unsigned& nloc, unsigned& nx) {
    const unsigned G = gridDim.x * gridDim.y * gridDim.z;
    unsigned sum, cnt, mine, sp = 0u;
    for (;;) {
        sum = 0u; cnt = 0u; mine = 0u;
#pragma unroll
        for (unsigned j = 0; j < 16; ++j) { const unsigned c = xb_ld(&bar[XB_XCNT(j)]); sum += c; cnt += (c > 0u) ? 1u : 0u; mine = (j == x) ? c : mine; }
        if (sum == G) break;
        __builtin_amdgcn_s_sleep(1);
        if ((++sp & 255u) == 0u) { if (xb_ld(&bar[XB_TMO])) break; if (sp > XB_SPIN_CAP) { atomicAdd(&bar[XB_TMO], 1u); break; } }
    }
    nloc = mine > 0u ? mine : 1u; nx = cnt > 0u ? cnt : 1u;
}

__device__ __forceinline__ void xcd_barrier(const XcdBarrier& b) {
    asm volatile("s_waitcnt vmcnt(0)" ::: "memory");
    __syncthreads();
    if (threadIdx.x == 0) {
        unsigned* bar = b.bar;
        __builtin_amdgcn_s_waitcnt(0);
        unsigned nloc = b.st[0], nx = b.st[1];
        if (nloc == 0u) { xcd_barrier_complete(bar, b.x, nloc, nx); b.st[0] = nloc; b.st[1] = nx; }
        const unsigned old = xb_add(&bar[XB_XSUB(b.x)], 1u);
        const unsigned gen = old / nloc;
        if (old + 1u == (gen + 1u) * nloc) {
            __builtin_amdgcn_fence(__ATOMIC_RELEASE, "agent");
            asm volatile("s_waitcnt vmcnt(0)" ::: "memory");
            const unsigned og = xb_add(&bar[XB_TOP], 1u);
            const unsigned tg = og / nx;
            if (og + 1u == (tg + 1u) * nx) xb_add(&bar[XB_TOPGEN], 1u);
            else XB_SPIN(xb_ld(&bar[XB_TOPGEN]) == tg, bar);
            __builtin_amdgcn_fence(__ATOMIC_ACQUIRE, "agent");
            xb_add(&bar[XB_XGEN(b.x)], 1u);
            asm volatile("s_waitcnt vmcnt(0)" ::: "memory");
        } else {
            XB_SPIN(xb_ld(&bar[XB_XGEN(b.x)]) == gen, bar);
            __builtin_amdgcn_fence(__ATOMIC_ACQUIRE, "agent");
            asm volatile("s_waitcnt vmcnt(0)" ::: "memory");
        }
    }
    __syncthreads();
}
namespace pg8 {
constexpr int BM = 256, BK = 64, HALF = 128, HTB = HALF * BK * 2  , STAGE_BYTES = 8 * HTB;
__host__ __device__ __forceinline__ int lds_byte(int r, int c) { const int st = (r >> 4) * 2 + (c >> 5), rr = r & 15, cc = c & 31, ob = rr * 64 + cc * 2; return st * 1024 + (ob ^ (((ob >> 9) & 1) << 5)); }
__host__ __device__ __forceinline__ void stage_rc(int b, int& R, int& C) { const int st = b / 1024, sb = b % 1024, swz = sb ^ (((sb >> 9) & 1) << 5); R = (st >> 1) * 16 + swz / 64; C = (st & 1) * 32 + (swz % 64) / 2; }
__host__ __device__ __forceinline__ int perm32(int rho) { const int n = rho >> 4, i = rho & 15; return 8 * (i >> 2) + 4 * n + (i & 3); }

enum { GU_LAST = 1 };
struct GU {
    const char* A;
    const char* B;
    char* C;
    const char* P;
    int lda, ldb;
    int nt;
    int pm, pn;
    int seg;
    int flags;
    int rows;
    int aux;
    int f8;
};
typedef f32x4 Acc[2][2][4][2];
typedef int i32x4 __attribute__((ext_vector_type(4)));
typedef int i32x8 __attribute__((ext_vector_type(8)));

#if !NAIVE_GEMM
template <class Epi, class Sched, bool HAS_F8 = false>
__device__ __forceinline__ void gemm_phase(LAS unsigned char* lds, const Sched& S, const Epi& E, const int tid) {
    const int wid = __builtin_amdgcn_readfirstlane(tid >> 6), lane = tid & 63, wr = wid >> 2, wc = wid & 3, fr = lane & 15, fq = lane >> 4;
    const unsigned ldsw = (unsigned)wid * 1024u;
    const int aoff = lds_byte(wr * 64 + fr, fq * 8), boff = lds_byte(wc * 32 + fr, fq * 8);
#define PG8_SA(b, h) (((b) * 2 + (h)) * HTB)
#define PG8_SB(b, h) ((4 + (b) * 2 + (h)) * HTB)
#define PG8_STAGE(bufoff, gbase, voff) do { _Pragma("unroll") for (int _i = 0; _i < 2; ++_i) { unsigned o_ = (voff)[_i]; asm volatile("" : "+v"(o_));     \
        __builtin_amdgcn_global_load_lds((const unsigned*)((const char*)(gbase) + o_), (LAS unsigned*)(lds + (bufoff) + ldsw + _i * 8192), 16, 0, 0); } } while (0)
#define PG8_LDA(dst, b, h) do { _Pragma("unroll") for (int m = 0; m < 4; ++m) _Pragma("unroll") for (int k = 0; k < 2; ++k) dst[m][k] = *(const LAS bf16x8*)(lds + PG8_SA(b, h) + aoff + m * 2048 + k * 1024); } while (0)
#define PG8_LDB(dst, b, h) do { _Pragma("unroll") for (int n = 0; n < 2; ++n) _Pragma("unroll") for (int k = 0; k < 2; ++k) dst[n][k] = *(const LAS bf16x8*)(lds + PG8_SB(b, h) + boff + n * 2048 + k * 1024); } while (0)
#define PG8_MFMA8(c, a, b) do { const i32x8 a_ = (a), b_ = (b); asm volatile("s_nop 4\n\tv_mfma_scale_f32_16x16x128_f8f6f4 %0, %1, %2, %0, %3, %3 op_sel_hi:[0,0,0]" : "+v"(c) : "v"(a_), "v"(b_), "v"(f8scale)); } while (0)
#define PG8_MFMA_DRAIN() do { if (HAS_F8) asm volatile("s_nop 15\n\ts_nop 15\n\ts_nop 15" ::: "memory"); } while (0)
#define PG8_CAT8(x) __builtin_shufflevector(__builtin_bit_cast(i32x4, (x)[0]), __builtin_bit_cast(i32x4, (x)[1]), 0, 1, 2, 3, 4, 5, 6, 7)
#define PG8_MMA(ai, bj, At, Bt) do { __builtin_amdgcn_s_setprio(1); if (HAS_F8) { _Pragma("unroll") for (int m = 0; m < 4; ++m) _Pragma("unroll") for (int n = 0; n < 2; ++n) \
        PG8_MFMA8(acc[ai][bj][m][n], PG8_CAT8(Bt[n]), PG8_CAT8(At[m])); } \
    else { _Pragma("unroll") for (int m = 0; m < 4; ++m) _Pragma("unroll") for (int n = 0; n < 2; ++n) _Pragma("unroll") for (int k = 0; k < 2; ++k) \
        acc[ai][bj][m][n] = __builtin_amdgcn_mfma_f32_16x16x32_bf16(Bt[n][k], At[m][k], acc[ai][bj][m][n], 0, 0, 0); } __builtin_amdgcn_s_setprio(0); } while (0)
#define PG8_WAIT_V(n) asm volatile("s_waitcnt vmcnt(" #n ")" ::: "memory")
#define PG8_WAIT_L(n) asm volatile("s_waitcnt lgkmcnt(" #n ")" ::: "memory")
#define PG8_BAR __builtin_amdgcn_s_barrier()
#define PG8_SCHED __builtin_amdgcn_sched_barrier(0)
#define PG8_MKV(u, va, vb) do { _Pragma("unroll") for (int _i = 0; _i < 2; ++_i) { int R_, C_; stage_rc(tid * 16 + _i * 8192, R_, C_); const int Rb_ = (R_ & ~31) + perm32(R_ & 31);     \
        vb[_i] = (unsigned)(Rb_ * (u).ldb + C_ * 2); va[0][_i] = S.arow((u), R_) + (unsigned)(C_ * 2); if (Sched::GATHER) va[1][_i] = S.arow((u), 128 + R_) + (unsigned)(C_ * 2); } } while (0)
    GU cur, nxt; int ui = 0;
    if (!S.next(0, cur)) return;
    Acc acc;
#pragma unroll
    for (int a = 0; a < 2; ++a)
#pragma unroll
        for (int b = 0; b < 2; ++b)
#pragma unroll
            for (int m = 0; m < 4; ++m)
#pragma unroll
                for (int n = 0; n < 2; ++n) acc[a][b][m][n] = (f32x4){0.f, 0.f, 0.f, 0.f};
    bf16x8 At[4][2], B0[2][2], B1[2][2];
    int f8scale = 0x7f7f7f7f; asm volatile("" : "+v"(f8scale));
    constexpr int NH = Sched::GATHER ? 2 : 1;
    unsigned vA[NH][2], vB[2], nvA[NH][2], nvB[2];
    PG8_MKV(cur, vA, vB);
    const size_t kstep = (size_t)(BK * 2);
    {
        const char* cA = cur.A; const char* cB = cur.B; const size_t hsB = (size_t)HALF * cur.ldb;
        const char* cBh = cB + hsB; const char* cAk = cA + kstep; const char* cBk = cB + kstep; const char* cBhk = cB + hsB + kstep; const char* cAh = Sched::GATHER ? cA : cA + (size_t)HALF * cur.lda;
        asm volatile("" : "+s"(cA), "+s"(cB), "+s"(cBh), "+s"(cAk), "+s"(cBk), "+s"(cBhk), "+s"(cAh));
        PG8_STAGE(PG8_SB(0, 0), cB, vB); PG8_STAGE(PG8_SB(0, 1), cBh, vB); PG8_STAGE(PG8_SA(0, 0), cA, vA[0]); PG8_STAGE(PG8_SA(0, 1), cAh, vA[NH - 1]);
        if (wr == 1) PG8_BAR;
        PG8_WAIT_V(2); PG8_BAR;
        PG8_STAGE(PG8_SB(1, 0), cBk, vB); PG8_STAGE(PG8_SA(1, 0), cAk, vA[0]); PG8_STAGE(PG8_SB(1, 1), cBhk, vB);
        PG8_WAIT_V(6); PG8_BAR;
    }
    for (;;) {
        const bool has_next = S.next(ui + 1, nxt);
        if (has_next) { PG8_MKV(nxt, nvA, nvB); }
        else {
#pragma unroll
            for (int i = 0; i < 2; ++i) { nvB[i] = vB[i]; nvA[0][i] = vA[0][i]; nvA[NH - 1][i] = vA[NH - 1][i]; }
        }
        const char* cA = cur.A; const char* cB = cur.B; const size_t hsB = (size_t)HALF * cur.ldb;
        const char* nA = has_next ? nxt.A : cA; const char* nB = has_next ? nxt.B : cB; const size_t nhsB = has_next ? (size_t)HALF * nxt.ldb : hsB;
        const size_t hsA = Sched::GATHER ? 0 : (size_t)HALF * cur.lda, nhsA = Sched::GATHER ? 0 : (has_next ? (size_t)HALF * nxt.lda : hsA);
        const int nt = cur.nt;
        for (int t = 0; t < nt; t += 2) {
            const bool last = (t == nt - 2);
            const char* a1 = cA + (size_t)(t + 1) * kstep;
            const char* a2 = last ? nA : cA + (size_t)(t + 2) * kstep; const char* b2 = last ? nB : cB + (size_t)(t + 2) * kstep;
            const char* a3 = a2 + kstep; const char* b3 = b2 + kstep;
            const size_t xhsB = last ? nhsB : hsB, xhsA = last ? nhsA : hsA;
            const char* b2h = b2 + xhsB; const char* b3h = b3 + xhsB; const char* a1h = a1 + hsA; const char* a2h = a2 + xhsA;
            asm volatile("" : "+s"(a1h), "+s"(a2), "+s"(a3), "+s"(b2), "+s"(b3), "+s"(b2h), "+s"(b3h), "+s"(a2h));
            unsigned xA[NH][2], xB[2];
#pragma unroll
            for (int i = 0; i < 2; ++i) { xB[i] = last ? nvB[i] : vB[i]; xA[0][i] = last ? nvA[0][i] : vA[0][i]; xA[NH - 1][i] = last ? nvA[NH - 1][i] : vA[NH - 1][i]; }
            PG8_LDB(B0, 0, 0); PG8_LDB(B1, 0, 1); PG8_SCHED; PG8_LDA(At, 0, 0); PG8_STAGE(PG8_SA(1, 1), a1h, vA[NH - 1]);
            PG8_WAIT_V(8); PG8_WAIT_L(0); PG8_BAR; PG8_MMA(0, 0, At, B0); PG8_MMA(0, 1, At, B1); PG8_BAR; PG8_SCHED;
            PG8_LDA(At, 0, 1); PG8_STAGE(PG8_SB(0, 0), b2, xB); PG8_STAGE(PG8_SB(0, 1), b2h, xB); PG8_STAGE(PG8_SA(0, 0), a2, xA[0]);
            PG8_WAIT_V(8); PG8_WAIT_L(0); PG8_BAR; PG8_MMA(1, 0, At, B0); PG8_MMA(1, 1, At, B1); PG8_BAR; PG8_SCHED;
            PG8_LDB(B0, 1, 0); PG8_LDB(B1, 1, 1); PG8_SCHED; PG8_LDA(At, 1, 0); PG8_STAGE(PG8_SA(0, 1), a2h, xA[NH - 1]);
            PG8_WAIT_V(8); PG8_WAIT_L(0); PG8_BAR; PG8_MMA(0, 0, At, B0); PG8_MMA(0, 1, At, B1); PG8_BAR; PG8_SCHED;
            PG8_LDA(At, 1, 1); PG8_STAGE(PG8_SB(1, 0), b3, xB); PG8_STAGE(PG8_SB(1, 1), b3h, xB); PG8_STAGE(PG8_SA(1, 0), a3, xA[0]);
            PG8_WAIT_V(8); PG8_WAIT_L(0); PG8_BAR; PG8_MMA(1, 0, At, B0); PG8_MMA(1, 1, At, B1); PG8_BAR; PG8_SCHED;
        }
        if (wr == 0) PG8_BAR;
        PG8_MFMA_DRAIN();
        { int fr_e = fr, fq_e = fq; asm volatile("" : "+v"(fr_e), "+v"(fq_e));
          E(acc, cur, wr, wc, fr_e, fq_e); }
        if (!has_next) break;
        if (cur.flags & GU_LAST) {
#pragma unroll
            for (int a = 0; a < 2; ++a)
#pragma unroll
                for (int b = 0; b < 2; ++b)
#pragma unroll
                    for (int m = 0; m < 4; ++m)
#pragma unroll
                        for (int n = 0; n < 2; ++n) acc[a][b][m][n] = (f32x4){0.f, 0.f, 0.f, 0.f};
        }
        cur = nxt; ++ui;
#pragma unroll
        for (int i = 0; i < 2; ++i) { vB[i] = nvB[i]; vA[0][i] = nvA[0][i]; vA[NH - 1][i] = nvA[NH - 1][i]; }
        if (wr == 1) PG8_BAR;
    }
    PG8_WAIT_V(0);
    PG8_BAR;
#undef PG8_SA
#undef PG8_SB
#undef PG8_STAGE
#undef PG8_LDA
#undef PG8_LDB
#undef PG8_MMA
#undef PG8_WAIT_V
#undef PG8_WAIT_L
#undef PG8_BAR
#undef PG8_SCHED
#undef PG8_MKV
#undef PG8_CAT8
}
#else
template <class Epi, class Sched>
__device__ __forceinline__ void gemm_phase(LAS unsigned char* lds, const Sched& S, const Epi& E, const int tid) {
    const int wid = __builtin_amdgcn_readfirstlane(tid >> 6), lane = tid & 63, wr = wid >> 2, wc = wid & 3, fr = lane & 15, fq = lane >> 4;
    GU cur; Acc acc;
#pragma unroll
    for (int a = 0; a < 2; ++a)
#pragma unroll
        for (int b = 0; b < 2; ++b)
#pragma unroll
            for (int m = 0; m < 4; ++m)
#pragma unroll
                for (int n = 0; n < 2; ++n) acc[a][b][m][n] = (f32x4){0.f, 0.f, 0.f, 0.f};
    for (int ui = 0; S.next(ui, cur); ++ui) {
        const int K = cur.nt * 64;
#pragma unroll 1
        for (int ai = 0; ai < 2; ++ai)
#pragma unroll 1
            for (int m = 0; m < 4; ++m) {
                const char* ap = cur.A + S.arow(cur, ai * 128 + wr * 64 + m * 16 + fr);
#pragma unroll 1
                for (int bj = 0; bj < 2; ++bj) {
                    float s[8];
#pragma unroll
                    for (int j = 0; j < 8; ++j) s[j] = 0.f;
                    const char* bp = cur.B + (size_t)(bj * 128 + wc * 32 + 8 * fq) * cur.ldb;
#pragma unroll 1
                    for (int k = 0; k < K; k += 8) {
                        const u32x4 av = *(const u32x4*)(ap + k * 2);
                        const float a0 = bflo(av.x), a1 = bfhi(av.x), a2 = bflo(av.y), a3 = bfhi(av.y), a4 = bflo(av.z), a5 = bfhi(av.z), a6 = bflo(av.w), a7 = bfhi(av.w);
#pragma unroll
                        for (int j = 0; j < 8; ++j) { const u32x4 bv = *(const u32x4*)(bp + (size_t)j * cur.ldb + k * 2);
                            s[j] += a0 * bflo(bv.x) + a1 * bfhi(bv.x) + a2 * bflo(bv.y) + a3 * bfhi(bv.y) + a4 * bflo(bv.z) + a5 * bfhi(bv.z) + a6 * bflo(bv.w) + a7 * bfhi(bv.w); }
                    }
#pragma unroll
                    for (int a_ = 0; a_ < 2; ++a_)
#pragma unroll
                        for (int m_ = 0; m_ < 4; ++m_)
#pragma unroll
                            for (int b_ = 0; b_ < 2; ++b_) if (a_ == ai && m_ == m && b_ == bj) {
                                acc[a_][b_][m_][0] += (f32x4){s[0], s[1], s[2], s[3]}; acc[a_][b_][m_][1] += (f32x4){s[4], s[5], s[6], s[7]}; }
                }
            }
        E(acc, cur, wr, wc, fr, fq);
        if (cur.flags & GU_LAST) {
#pragma unroll
            for (int a = 0; a < 2; ++a)
#pragma unroll
                for (int b = 0; b < 2; ++b)
#pragma unroll
                    for (int m = 0; m < 4; ++m)
#pragma unroll
                        for (int n = 0; n < 2; ++n) acc[a][b][m][n] = (f32x4){0.f, 0.f, 0.f, 0.f};
        }
    }
    __syncthreads();
}
#endif
}
namespace pg8 {
__device__ __forceinline__ unsigned cvt_pk_bf16(float lo, float hi) { unsigned r; asm volatile("v_cvt_pk_bf16_f32 %0, %1, %2" : "=v"(r) : "v"(lo), "v"(hi)); return r; }
__device__ __forceinline__ void st8(char* p, const f32x4 v0, const f32x4 v1) { u32x4 w; w.x = cvt_pk_bf16(v0[0], v0[1]); w.y = cvt_pk_bf16(v0[2], v0[3]); w.z = cvt_pk_bf16(v1[0], v1[1]); w.w = cvt_pk_bf16(v1[2], v1[3]); *(u32x4*)p = w; }
__device__ __forceinline__ void ld8(const char* p, f32x4& v0, f32x4& v1) { const u32x4 w = *(const u32x4*)p; v0 = (f32x4){bflo(w.x), bfhi(w.x), bflo(w.y), bfhi(w.y)}; v1 = (f32x4){bflo(w.z), bfhi(w.z), bflo(w.w), bfhi(w.w)}; }
__device__ __forceinline__ void tile_of(int L, int nM, int nN, int& pm, int& pn) {
    const int nwg = nM * nN; int wgid = L; { const int q = nwg / 8, r = nwg % 8, xcd = wgid % 8, off = wgid / 8; wgid = (xcd < r ? xcd * (q + 1) : r * (q + 1) + (xcd - r) * q) + off; }
    const int nig = 8 * nN, gid = wgid / nig, fm = gid * 8, gsz = (nM - fm) < 8 ? (nM - fm) : 8;
    pm = fm + ((wgid % nig) % gsz); pn = (wgid % nig) / gsz;
}
#define EPI_ROWS(...) _Pragma("unroll") for (int ai = 0; ai < 2; ++ai) _Pragma("unroll") for (int m = 0; m < 4; ++m) { const int lrow = ai * 128 + wr * 64 + m * 16 + fr; __VA_ARGS__ }
#define EPI_COLS(...) _Pragma("unroll") for (int bj = 0; bj < 2; ++bj) { const int lcol = bj * 128 + wc * 32 + 8 * fq; f32x4& v0 = acc[ai][bj][m][0]; f32x4& v1 = acc[ai][bj][m][1]; __VA_ARGS__ }

struct SchedDense {
    const char* A; const char* B; int lda, ldb, nt, nM, nN, G, c;
    static constexpr bool GATHER = false;
    __device__ __forceinline__ bool next(int i, GU& u) const {
        const int L = i * G + c; if (L >= nM * nN) return false;
        int pm, pn; tile_of(L, nM, nN, pm, pn);
        u.A = A + (size_t)pm * 256 * lda; u.B = B + (size_t)pn * 256 * ldb; u.C = nullptr; u.P = nullptr; u.lda = lda; u.ldb = ldb; u.nt = nt; u.pm = pm; u.pn = pn; u.seg = 0; u.flags = GU_LAST; u.rows = 256; u.aux = 0; u.f8 = 0;
        return true;
    }
    __device__ __forceinline__ unsigned arow(const GU& u, int r) const { return (unsigned)(r * u.lda); }
};
template <bool HALF> struct SchedProj {
    unsigned char* ws; unsigned char* lw; int G, c;
    static constexpr bool GATHER = false;
    __device__ __forceinline__ bool next(int i, GU& u) const {
        int id = -1;
        if (G == 256) {
            if (!HALF) { if (i == 0) id = c; else if (i == 1 && c < 192) id = c + 256; }
            else { if (c < 192) { if (i < 3) id = c * 3 + i; } else { if (i < 5) id = 576 + (c - 192) * 5 + i; } } }
        else { const int L = i * G + c; if (L < (HALF ? 896 : 448)) id = L; }
        if (id < 0) return false;
        int pm, pn;
        if (!HALF) { int t14; tile_of(id, 32, 14, pm, t14); u.A = (const char*)ws + WS_X + (size_t)pm * 256 * 4096; u.lda = 4096; u.B = (const char*)lw + LW_WIN + (size_t)t14 * 256 * 4096; u.ldb = 4096; u.nt = 32; u.f8 = 0;
            pn = t14 < 12 ? t14 : 16 + (t14 - 12); }
        else { int t28; tile_of(id, 32, 28, pm, t28); u.A = (const char*)ws + WS_H8 + (size_t)pm * 256 * 2048; u.lda = 2048; u.B = (const char*)lw + LW_WG8 + (size_t)t28 * 256 * 2048; u.ldb = 2048; u.nt = 16; u.f8 = 1;
            pn = t28 < 24 ? 18 + t28 : 12 + (t28 - 24); }
        u.C = nullptr; u.P = nullptr; u.pm = pm; u.pn = pn; u.seg = 0; u.flags = GU_LAST; u.rows = 256; u.aux = 0;
        return true;
    }
    __device__ __forceinline__ unsigned arow(const GU& u, int r) const { return (unsigned)(r * u.lda); }
};
template <int MODE> struct SchedSeg {
    unsigned char* ws; unsigned char* lw; int G, c;
    static constexpr bool GATHER = false; static constexpr int NS = MODE == 0 ? 3 : 4;
    __device__ __forceinline__ bool next(int i, GU& u) const {
        const int ti = i / NS, sg = i % NS; const int L = ti * G + c; if (L >= 256) return false;
        int pm, pn; tile_of(L, 32, 8, pm, pn);
        if (MODE == 0) { const size_t ao = sg == 0 ? WS_OAN : sg == 1 ? WS_CVO : WS_GLUO; const int la = sg == 0 ? 2048 : 1024; const size_t bo = sg == 0 ? 0 : sg == 1 ? 2048 : 3072;
            u.A = (const char*)ws + ao + (size_t)pm * 256 * la; u.lda = la; u.nt = sg == 0 ? 16 : 8; u.B = (const char*)lw + LW_WCAT + bo + (size_t)pn * 256 * 4096; u.ldb = 4096; }
        else if (XAO_FP8) { int two = 2; asm volatile("" : "+s"(two)); u.A = (const char*)ws + WS_P + sg * 256 + (size_t)pm * 256 * 1024; u.lda = 1024; u.nt = two; u.B = (const char*)lw + LW_VW + sg * 256 + (size_t)pn * 256 * 1024; u.ldb = 1024; }
        else { u.A = (const char*)ws + WS_P + sg * 512 + (size_t)pm * 256 * 2048; u.lda = 2048; u.nt = 4; u.B = (const char*)lw + LW_VW + sg * 512 + (size_t)pn * 256 * 2048; u.ldb = 2048; }
        u.C = nullptr; u.P = nullptr; u.pm = pm; u.pn = pn; u.seg = sg; u.flags = (sg == NS - 1) ? GU_LAST : 0; u.rows = 256; u.aux = 0; u.f8 = 0;
        return true;
    }
    __device__ __forceinline__ unsigned arow(const GU& u, int r) const { return (unsigned)(r * u.lda); }
};
struct EpiStore { int ldc; int ncolh;
    __device__ __forceinline__ void operator()(Acc& acc, const GU& u, int wr, int wc, int fr, int fq) const {
        const float sc = __builtin_bit_cast(float, u.aux);
        EPI_ROWS( if (lrow < u.rows) { char* rp = u.C + (unsigned)(lrow * ldc); EPI_COLS( if (bj < ncolh) st8(rp + lcol * 2, v0 * sc, v1 * sc); ) } )
    }
};
struct EpiStoreF32 { int ldc;
    __device__ __forceinline__ void operator()(Acc& acc, const GU& u, int wr, int wc, int fr, int fq) const {
        EPI_ROWS( { char* rp = u.C + (unsigned)(lrow * ldc); const int lcol = wc * 32 + 8 * fq; *(f32x4*)(rp + lcol * 4) = acc[ai][0][m][0]; *(f32x4*)(rp + lcol * 4 + 16) = acc[ai][0][m][1]; } )
    }
};
struct EpiProj { char* ws; const float* ropeC; const float* ropeS; const float* rstd;
    __device__ __forceinline__ void operator()(Acc& acc, const GU& u, int wr, int wc, int fr, int fq) const {
        const int pn = u.pn;
        if (pn < 8) {
            char* dst = ws + (pn < 4 ? WS_Q : WS_K) + (size_t)(pn & 3) * 512; const float sc0 = pn < 4 ? C2Q : 1.f;
            EPI_ROWS( { const int tok = u.pm * 256 + lrow; char* rp = dst + (unsigned)(tok * 2048); const float sc = sc0 * rstd[tok];
                EPI_COLS( { const int i0 = (lcol & 63) >> 1; const f32x4 c4 = *(const f32x4*)(ropeC + tok * 32 + i0), s4 = *(const f32x4*)(ropeS + tok * 32 + i0);
                    const f32x4 o0 = (f32x4){v0[0] * c4[0] - v0[1] * s4[0], v0[1] * c4[0] + v0[0] * s4[0], v0[2] * c4[1] - v0[3] * s4[1], v0[3] * c4[1] + v0[2] * s4[1]};
                    const f32x4 o1 = (f32x4){v1[0] * c4[2] - v1[1] * s4[2], v1[1] * c4[2] + v1[0] * s4[2], v1[2] * c4[3] - v1[3] * s4[3], v1[3] * c4[3] + v1[2] * s4[3]};
                    st8(rp + lcol * 2, o0 * sc, o1 * sc); } ) } )
        } else if (pn < 12) {
            char* dst = ws + WS_V + (size_t)(pn - 8) * 512;
            EPI_ROWS( { const int tok = u.pm * 256 + lrow; char* rp = dst + (unsigned)(tok * 2048); const float rs = rstd[tok]; EPI_COLS( st8(rp + lcol * 2, v0 * rs, v1 * rs); ) } )
        } else if (pn < 16) {
            char* dst = ws + WS_Z + (size_t)(pn - 12) * 256;
            EPI_ROWS( { const int tok = u.pm * 256 + lrow; char* rp = dst + (unsigned)(tok * 1024); const float is = rstd[tok] * (1.f / GATE_WSCALE);
                EPI_COLS( { u32x2 w; w.x = cvt_pk_bf16(v0[0] * is * sigmoidf_(v0[1] * is), v0[2] * is * sigmoidf_(v0[3] * is)); w.y = cvt_pk_bf16(v1[0] * is * sigmoidf_(v1[1] * is), v1[2] * is * sigmoidf_(v1[3] * is)); *(u32x2*)(rp + lcol) = w; } ) } )
        } else if (pn < 18) {
            EPI_ROWS( { const int tok = u.pm * 256 + lrow; const float rs = rstd[tok];
                EPI_COLS( { const int ch = (pn - 16) * 256 + lcol, g = ch >> 4, h = ch & 15; st8((ws + WS_UC) + (unsigned)(((g * 256 + (tok >> 5)) * 512 + (tok & 31) * 16 + h) * 2), v0 * rs, v1 * rs); } ) } )
        } else {
            char* dst = ws + WS_GATES + (size_t)(pn - 18) * 256;
            EPI_ROWS( { const int tok = u.pm * 256 + lrow; char* rp = dst + (unsigned)(tok * 6144); const float is = rstd[tok] * (1.f / GATE_WSCALE);
                EPI_COLS( { unsigned qa[4], qb[4];
                    _Pragma("unroll") for (int j = 0; j < 4; ++j) { qa[j] = (unsigned)fminf(sigmoidf_(v0[j] * is) * 256.f, 255.f); qb[j] = (unsigned)fminf(sigmoidf_(v1[j] * is) * 256.f, 255.f); }
                    u32x2 w; w.x = qa[0] | (qa[1] << 8) | (qa[2] << 16) | (qa[3] << 24); w.y = qb[0] | (qb[1] << 8) | (qb[2] << 16) | (qb[3] << 24);
                    *(u32x2*)(rp + lcol) = w; } ) } )
        }
    }
};
struct EpiSsm3 { char* ys;
    __device__ __forceinline__ void operator()(Acc& acc, const GU& u, int wr, int wc, int fr, int fq) const {
        if (!(u.flags & GU_LAST)) return;
        const int g = u.pm;
        EPI_ROWS( { const int chunk = lrow;
            EPI_COLS( { const int jh = u.pn * 256 + lcol, j = jh >> 4, h = jh & 15; st8(ys + (unsigned)(((chunk * 32 + j) * 512 + g * 16 + h) * 2), v0, v1); } ) } )
    }
};
struct EpiGlu { char* dst; const float* bias;
    __device__ __forceinline__ void operator()(Acc& acc, const GU& u, int wr, int wc, int fr, int fq) const {
        EPI_ROWS( { const int tok = u.pm * 256 + lrow; char* rp = (dst + (size_t)u.pn * 256) + (unsigned)(tok * 1024);
            EPI_COLS( { const int j0 = u.pn * 128 + (lcol >> 1); const f32x4 ba = *(const f32x4*)(bias + j0), bb = *(const f32x4*)(bias + 512 + j0);
                u32x2 w; w.x = cvt_pk_bf16((v0[0] + ba[0]) * sigmoidf_(v0[1] + bb[0]), (v0[2] + ba[1]) * sigmoidf_(v0[3] + bb[1]));
                w.y = cvt_pk_bf16((v1[0] + ba[2]) * sigmoidf_(v1[1] + bb[2]), (v1[2] + ba[3]) * sigmoidf_(v1[3] + bb[3])); *(u32x2*)(rp + lcol) = w; } ) } )
    }
};
struct EpiGated { const char* gates; char* merged;
    __device__ __forceinline__ void operator()(Acc& acc, const GU& u, int wr, int wc, int fr, int fq) const {
        const int sg = u.seg;
        EPI_ROWS( { const int tok = u.pm * 256 + lrow; const char* gp = (gates + (size_t)u.pn * 256) + (unsigned)(tok * 6144); char* mp = (merged + (size_t)u.pn * 512) + (unsigned)(tok * 4096);
            EPI_COLS( { const u32x2 nq = *(const u32x2*)(gp + (size_t)sg * 2048 + lcol);
                if (sg < 2) { const u32x2 dq = *(const u32x2*)(gp + (size_t)(sg + 1) * 2048 + lcol);
                    _Pragma("unroll") for (int j = 0; j < 4; ++j) { v0[j] *= ((float)((nq.x >> (8 * j)) & 255u) + 0.5f) * __builtin_amdgcn_rcpf((float)((dq.x >> (8 * j)) & 255u) + 0.5f); v1[j] *= ((float)((nq.y >> (8 * j)) & 255u) + 0.5f) * __builtin_amdgcn_rcpf((float)((dq.y >> (8 * j)) & 255u) + 0.5f); } }
                else { _Pragma("unroll") for (int j = 0; j < 4; ++j) { v0[j] *= fmaf((float)((nq.x >> (8 * j)) & 255u), 1.f / 256.f, 0.5f / 256.f); v1[j] *= fmaf((float)((nq.y >> (8 * j)) & 255u), 1.f / 256.f, 0.5f / 256.f); }
                    st8(mp + lcol * 2, v0, v1); } } ) } )
    }
};
struct EpiResid { char* x; char* h8; float* rsq;
    __device__ __forceinline__ void operator()(Acc& acc, const GU& u, int wr, int wc, int fr, int fq) const {
        EPI_ROWS( { const int tok = u.pm * 256 + lrow; char* rp = (x + (size_t)u.pn * 512) + (unsigned)(tok * 4096); char* hp = (h8 + (size_t)u.pn * (S_FP8 ? 256 : 512)) + (unsigned)(tok * (S_FP8 ? 2048 : 4096)); float s = 0.f;
            EPI_COLS( { f32x4 a, b; ld8(rp + lcol * 2, a, b); a = a + v0; b = b + v1; st8(rp + lcol * 2, a, b);
                s += (a[0] * a[0] + a[1] * a[1]) + (a[2] * a[2] + a[3] * a[3]) + (b[0] * b[0] + b[1] * b[1]) + (b[2] * b[2] + b[3] * b[3]);
#if S_FP8
                int q0 = __builtin_amdgcn_cvt_pk_fp8_f32(a[0], a[1], 0, false); q0 = __builtin_amdgcn_cvt_pk_fp8_f32(a[2], a[3], q0, true);
                int q1 = __builtin_amdgcn_cvt_pk_fp8_f32(b[0], b[1], 0, false); q1 = __builtin_amdgcn_cvt_pk_fp8_f32(b[2], b[3], q1, true); *(u32x2*)(hp + lcol) = (u32x2){(unsigned)q0, (unsigned)q1};
#elif !defined(DBG_NO_HST)
                st8(hp + lcol * 2, a, b);
#endif
                } )
#ifndef DBG_NO_RSQ
            s += xor_lane<16>(s); s += xor_lane<32>(s);
            if (fq == 0) rsq[(u.pn * T + tok) * 4 + wc] = s;
#endif
            } )
    }
};
struct EpiSexp { char* P; float* rs; const float* rsq;
    __device__ __forceinline__ void operator()(Acc& acc, const GU& u, int wr, int wc, int fr, int fq) const {
        EPI_ROWS( { const int tok = u.pm * 256 + lrow; char* rp = (P + (size_t)u.pn * 512) + (unsigned)(tok * 2048); char* rp8 = (P + (size_t)u.pn * 256) + (unsigned)(tok * 1024); (void)rp; (void)rp8; float s = 0.f;
            float sq = 0.f;
#ifdef DBG_READ_RS
            _Pragma("unroll") for (int q = 0; q < 8; ++q) { const f32x4 t4 = *(const f32x4*)(rs + 262144 + tok * 32 + q * 4); sq += (t4[0] + t4[1]) + (t4[2] + t4[3]); }
#elif defined(DBG_RSQ_ATOMIC_LD)
            _Pragma("unroll") for (int q = 0; q < 32; ++q) sq += __hip_atomic_load(rsq + tok * 32 + q, __ATOMIC_RELAXED, __HIP_MEMORY_SCOPE_AGENT);
#else
            _Pragma("unroll") for (int q = 0; q < 8; ++q) { const f32x4 t4 = *(const f32x4*)(rsq + (q * T + tok) * 4); sq += (t4[0] + t4[1]) + (t4[2] + t4[3]); }
#endif
#ifdef DBG_RN1
            const float rn = 1.f;
#elif defined(DBG_RN1_KEEP)
            asm volatile("" :: "v"(sq)); const float rn = 1.f;
#else
            const float rn = FUSE_N2 ? rsqrtf(sq * (1.f / DM) + RMS_EPS) * (1.f / SQK_SCALE) : 1.f + 0.f * sq;
#endif
#if XAO_FP8
            EPI_COLS( { v0 = v0 * rn - 2.f; v1 = v1 * rn - 2.f;
                const float e0 = __builtin_amdgcn_exp2f(v0[0]), e1 = __builtin_amdgcn_exp2f(v0[1]), e2 = __builtin_amdgcn_exp2f(v0[2]), e3 = __builtin_amdgcn_exp2f(v0[3]);
                const float e4 = __builtin_amdgcn_exp2f(v1[0]), e5 = __builtin_amdgcn_exp2f(v1[1]), e6 = __builtin_amdgcn_exp2f(v1[2]), e7 = __builtin_amdgcn_exp2f(v1[3]);
                int q0 = __builtin_amdgcn_cvt_pk_fp8_f32(e0, e1, 0, false); q0 = __builtin_amdgcn_cvt_pk_fp8_f32(e2, e3, q0, true);
                int q1 = __builtin_amdgcn_cvt_pk_fp8_f32(e4, e5, 0, false); q1 = __builtin_amdgcn_cvt_pk_fp8_f32(e6, e7, q1, true);
                *(u32x2*)(rp8 + lcol) = (u32x2){(unsigned)q0, (unsigned)q1};
                const f32x2 a0 = __builtin_amdgcn_cvt_pk_f32_fp8(q0, false), a1 = __builtin_amdgcn_cvt_pk_f32_fp8(q0, true), a2 = __builtin_amdgcn_cvt_pk_f32_fp8(q1, false), a3 = __builtin_amdgcn_cvt_pk_f32_fp8(q1, true);
                s += ((a0[0] + a0[1]) + (a1[0] + a1[1])) + ((a2[0] + a2[1]) + (a3[0] + a3[1])); } )
#else
            EPI_COLS( { v0 = v0 * rn; v1 = v1 * rn; u32x4 w; w.x = cvt_pk_bf16(__builtin_amdgcn_exp2f(v0[0]), __builtin_amdgcn_exp2f(v0[1])); w.y = cvt_pk_bf16(__builtin_amdgcn_exp2f(v0[2]), __builtin_amdgcn_exp2f(v0[3]));
                w.z = cvt_pk_bf16(__builtin_amdgcn_exp2f(v1[0]), __builtin_amdgcn_exp2f(v1[1])); w.w = cvt_pk_bf16(__builtin_amdgcn_exp2f(v1[2]), __builtin_amdgcn_exp2f(v1[3]));
                *(u32x4*)(rp + lcol * 2) = w; s += ((bflo(w.x) + bfhi(w.x)) + (bflo(w.y) + bfhi(w.y))) + ((bflo(w.z) + bfhi(w.z)) + (bflo(w.w) + bfhi(w.w))); } )
#endif
            s += xor_lane<16>(s); s += xor_lane<32>(s);
            if (fq == 0) rs[(u.pn * T + tok) * 4 + wc] = s; } )
    }
};
#ifdef DBG_NO_XA
#define XA_DBG_COND && false
#else
#define XA_DBG_COND
#endif
struct EpiXao { const float* rs; char* x;
    __device__ __forceinline__ void operator()(Acc& acc, const GU& u, int wr, int wc, int fr, int fq) const {
        const int sg = u.seg;
        EPI_ROWS( { const int tok = u.pm * 256 + lrow; const f32x4 a = *(const f32x4*)(rs + (sg * T + tok) * 4); const float lh = (a[0] + a[1]) + (a[2] + a[3]);
            float f = __builtin_amdgcn_rcpf(lh) * (sg == 3 ? 1.f / VW_SCALE : 1.f);
            if (sg < 3) { const f32x4 b = *(const f32x4*)(rs + ((sg + 1) * T + tok) * 4); f *= (b[0] + b[1]) + (b[2] + b[3]); }
            char* rp = (x + (size_t)u.pn * 512) + (unsigned)(tok * 4096);
            EPI_COLS( { v0 = v0 * f; v1 = v1 * f; if (sg == 3 XA_DBG_COND) { f32x4 a, b; ld8(rp + lcol * 2, a, b); st8(rp + lcol * 2, a + v0, b + v1); } } ) } )
    }
};
template <bool DOWN> struct SchedMoE {
    const volatile LAS int* cnt;
    unsigned char* ws; unsigned char* lw; int G, c;
    static constexpr bool GATHER = !DOWN;
    static constexpr int nN = DOWN ? 8 : 4;
    __device__ __forceinline__ bool next(int i, GU& u) const {
        const int L = i * G + c; const int tile = L / nN, pn = L % nN;
        int e = -1, mt = 0, off = 0, tacc = 0, ce = 0;
#pragma unroll 1
        for (int k = 0; k < NEXP; ++k) { const int ck = __builtin_amdgcn_readfirstlane(cnt[k]); const int tk = (ck + 255) >> 8;
            if (e < 0 && tile < tacc + tk) { e = k; mt = tile - tacc; ce = ck; }
            if (e < 0) { off += ck; tacc += tk; } }
        if (e < 0) return false;
        u.pm = mt; u.pn = pn; u.seg = 0; u.flags = GU_LAST; u.aux = e; u.f8 = 1;
        u.rows = (ce - mt * 256) < 256 ? (ce - mt * 256) : 256;
        int ntd = 4, ntg = 16; asm volatile("" : "+s"(ntd), "+s"(ntg));
        if (DOWN) { u.nt = ntd; u.lda = 512; u.ldb = 512; u.B = (const char*)lw + LW_WD + (size_t)e * DM * FFE + (size_t)pn * 256 * 512;
            u.A = (const char*)ws + WS_HE + (size_t)(off + mt * 256) * 512; u.C = (char*)ws + WS_Y + (size_t)(off + mt * 256) * 2048; u.P = nullptr; }
        else { u.nt = ntg; u.lda = 2048; u.ldb = 2048; u.B = (const char*)lw + LW_WGU + (size_t)e * 1024 * DM + (size_t)pn * 256 * 2048;
            u.A = (const char*)ws + WS_H8; u.C = (char*)ws + WS_HE + (size_t)(off + mt * 256) * 512; u.P = (const char*)ws + WS_WL + ((size_t)e * T + mt * 256) * 4; }
        return true;
    }
    __device__ __forceinline__ unsigned arow(const GU& u, int r) const {
        if (DOWN) return (unsigned)(r * u.lda);
        const int tok = (r < u.rows) ? ((const int*)(ws + WS_LIST))[u.aux * T + u.pm * 256 + r] : 0;
        return (unsigned)tok * (unsigned)u.lda;
    }
};
struct EpiGu {
    __device__ __forceinline__ void operator()(Acc& acc, const GU& u, int wr, int wc, int fr, int fq) const {
        constexpr float is = 1.f / GATE_WSCALE;
        EPI_ROWS( if (lrow < u.rows) { const float w = *(const float*)(u.P + lrow * 4) * is; char* rp = (u.C + (size_t)u.pn * 128) + (unsigned)(lrow * 512);
            EPI_COLS( { const float g0 = v0[0] * is, g1 = v0[2] * is, g2 = v1[0] * is, g3 = v1[2] * is;
                int p8 = __builtin_amdgcn_cvt_pk_fp8_f32(g0 * sigmoidf_(g0) * v0[1] * w, g1 * sigmoidf_(g1) * v0[3] * w, 0, false);
                p8 = __builtin_amdgcn_cvt_pk_fp8_f32(g2 * sigmoidf_(g2) * v1[1] * w, g3 * sigmoidf_(g3) * v1[3] * w, p8, true); *(unsigned*)(rp + (lcol >> 1)) = (unsigned)p8; } ) } )
    }
};
struct EpiDown {
    __device__ __forceinline__ void operator()(Acc& acc, const GU& u, int wr, int wc, int fr, int fq) const {
        constexpr float ys = 16.f / GATE_WSCALE;
        EPI_ROWS( if (lrow < u.rows) { char* rp = (u.C + (size_t)u.pn * 256) + (unsigned)(lrow * 2048);
            EPI_COLS( { int q0 = __builtin_amdgcn_cvt_pk_fp8_f32(v0[0] * ys, v0[1] * ys, 0, false); q0 = __builtin_amdgcn_cvt_pk_fp8_f32(v0[2] * ys, v0[3] * ys, q0, true);
                int q1 = __builtin_amdgcn_cvt_pk_fp8_f32(v1[0] * ys, v1[1] * ys, 0, false); q1 = __builtin_amdgcn_cvt_pk_fp8_f32(v1[2] * ys, v1[3] * ys, q1, true); *(u32x2*)(rp + lcol) = (u32x2){(unsigned)q0, (unsigned)q1}; } ) } )
    }
};
}
#include <hip/hip_bf16.h>
#include <cmath>
namespace attn_body {
using bf16=__hip_bfloat16;
using bf16x8=__attribute__((ext_vector_type(8)))short;
using s16x4=__attribute__((ext_vector_type(4)))short;
using f32x16=__attribute__((ext_vector_type(16)))float;
using u32x4=__attribute__((ext_vector_type(4)))unsigned;
constexpr int BATCH=1,NHEAD=16,SEQ=8192,D=64,DM=NHEAD*D;
constexpr int NW=8,QBLK=32,QB=QBLK*NW,KVBLK=64,NQB=SEQ/QB;
constexpr int ATTN_PITCH=DM, ATTN_UNIT_ROWS=QB;
__device__ __forceinline__ int crow(int r,int hi){return (r&3)+8*(r>>2)+4*hi;}
#define SBAR() __builtin_amdgcn_sched_barrier(0)
__device__ __forceinline__ void cmask(f32x16&p0,f32x16&p1,int jb,int qrel,int hi){
  const float NEG=-INFINITY; int kb=64*jb+4*hi;
  #pragma unroll
  for(int r=0;r<16;++r){int kv=kb+(r&3)+8*(r>>2); if(kv>qrel)p0[r]=NEG; if(kv+32>qrel)p1[r]=NEG;}
}

constexpr int NSLOT=3, SLOTB=8192;
constexpr int LDS_K=0, LDS_V=NSLOT*SLOTB, LDS_WS=2*NSLOT*SLOTB, LDS_OST=LDS_WS+NW*64*4, LDS_BYTES=LDS_OST+NW*4096;
constexpr float C2=0.125f*1.4426950408889634f;
__device__ __forceinline__ void glds16(const void*gsrc,unsigned lds_dst){unsigned keep;
  asm volatile("s_mov_b32 %0, m0\n\ts_mov_b32 m0, %2\n\ts_nop 0\n\tglobal_load_lds_dwordx4 %1, off\n\ts_mov_b32 m0, %0":"=&s"(keep):"v"(gsrc),"s"(lds_dst):"memory");}
__device__ __forceinline__ float max3f(float a,float b,float c){float r;asm("v_max3_f32 %0, %1, %2, %3":"=v"(r):"v"(a),"v"(b),"v"(c));return r;}
__device__ __forceinline__ float max2f(float a,float b){float r;asm("v_max_f32_e32 %0, %1, %2":"=v"(r):"v"(a),"v"(b));return r;}
__device__ __forceinline__ float fadd_s(float a,float b){float r;asm("v_add_f32_e32 %0, %1, %2":"=v"(r):"v"(a),"v"(b));return r;}
__device__ __forceinline__ float fsub_s(float a,float b){float r;asm("v_sub_f32_e32 %0, %1, %2":"=v"(r):"v"(a),"v"(b));return r;}
typedef float f32x2_t __attribute__((ext_vector_type(2))); typedef __bf16 bf16x2_t __attribute__((ext_vector_type(2)));
__device__ __forceinline__ unsigned cvtpk_s(float lo,float hi){f32x2_t v={lo,hi};bf16x2_t b=__builtin_convertvector(v,bf16x2_t);return __builtin_bit_cast(unsigned,b);}
#define WAIT_BAR(N) asm volatile("s_waitcnt vmcnt(" #N ") lgkmcnt(0)\n\ts_barrier":::"memory")

__device__ __forceinline__ void qkt(f32x16&p0,f32x16&p1,const char*Kslot,const bf16x8*qr,const f32x16&negm,int r32,int hi){
  const char*kb=Kslot+hi*1024+r32*16;
  #pragma unroll
  for(int d0=0;d0<4;++d0){
    const bf16x8 b0=*reinterpret_cast<const bf16x8*>(kb+d0*2048);
    const bf16x8 b1=*reinterpret_cast<const bf16x8*>(kb+d0*2048+512);
    if(d0==0){p0=__builtin_amdgcn_mfma_f32_32x32x16_bf16(b0,qr[0],negm,0,0,0);p1=__builtin_amdgcn_mfma_f32_32x32x16_bf16(b1,qr[0],negm,0,0,0);}
    else{p0=__builtin_amdgcn_mfma_f32_32x32x16_bf16(b0,qr[d0],p0,0,0,0);p1=__builtin_amdgcn_mfma_f32_32x32x16_bf16(b1,qr[d0],p1,0,0,0);}}
}
typedef __attribute__((address_space(3))) const char* lds_cptr;
typedef short v4i16_t __attribute__((ext_vector_type(4)));
__device__ __forceinline__ void kload8(bf16x8*kf,lds_cptr kp){
  kf[0]=*(const __attribute__((address_space(3))) bf16x8*)(kp);      kf[1]=*(const __attribute__((address_space(3))) bf16x8*)(kp+512);
  kf[2]=*(const __attribute__((address_space(3))) bf16x8*)(kp+2048); kf[3]=*(const __attribute__((address_space(3))) bf16x8*)(kp+2560);
  kf[4]=*(const __attribute__((address_space(3))) bf16x8*)(kp+4096); kf[5]=*(const __attribute__((address_space(3))) bf16x8*)(kp+4608);
  kf[6]=*(const __attribute__((address_space(3))) bf16x8*)(kp+6144); kf[7]=*(const __attribute__((address_space(3))) bf16x8*)(kp+6656);
}
__device__ __forceinline__ void kload2(bf16x8*kf,lds_cptr kp,int j){ kf[2*j]=*(const __attribute__((address_space(3))) bf16x8*)(kp+j*2048); kf[2*j+1]=*(const __attribute__((address_space(3))) bf16x8*)(kp+j*2048+512); }
__device__ __forceinline__ s16x4 vtr(lds_cptr p){ return __builtin_bit_cast(s16x4,__builtin_amdgcn_ds_read_tr16_b64_v4i16((__attribute__((address_space(3))) v4i16_t*)p)); }
__device__ __forceinline__ float rowmax(const f32x16&p0,const f32x16&p1){
  float a=max3f(p0[0],p0[1],p1[0]),b=max3f(p0[2],p0[3],p1[1]);a=max3f(a,p1[2],p1[3]);
  #pragma unroll
  for(int r=4;r<16;r+=4){a=max3f(a,p0[r],p0[r+1]);b=max3f(b,p0[r+2],p0[r+3]);a=max3f(a,p1[r],p1[r+1]);b=max3f(b,p1[r+2],p1[r+3]);}
  const float m=max2f(a,b);
  auto rr=__builtin_amdgcn_permlane32_swap(__float_as_uint(m),__float_as_uint(m),false,false);
  return max2f(__uint_as_float(rr[0]),__uint_as_float(rr[1]));
}
__device__ __forceinline__ void pv(f32x16*o,int vb,bf16x8 pa0,bf16x8 pa1,bf16x8 pa2,bf16x8 pa3){
  #pragma unroll
  for(int d0=0;d0<2;++d0){s16x4 lo[4],hi[4];
    #pragma unroll
    for(int ks=0;ks<4;++ks){
      asm volatile("ds_read_b64_tr_b16 %0,%1 offset:%c2":"=&v"(lo[ks]):"v"(vb),"i"(d0*4096+ks*1024):"memory");
      asm volatile("ds_read_b64_tr_b16 %0,%1 offset:%c2":"=&v"(hi[ks]):"v"(vb),"i"(d0*4096+ks*1024+512):"memory");}
    asm volatile("s_waitcnt lgkmcnt(0)":::"memory");SBAR();
    #define PK(k) (bf16x8){lo[k][0],lo[k][1],lo[k][2],lo[k][3],hi[k][0],hi[k][1],hi[k][2],hi[k][3]}
    o[d0]=__builtin_amdgcn_mfma_f32_32x32x16_bf16(pa0,PK(0),o[d0],0,0,0);
    o[d0]=__builtin_amdgcn_mfma_f32_32x32x16_bf16(pa1,PK(1),o[d0],0,0,0);
    o[d0]=__builtin_amdgcn_mfma_f32_32x32x16_bf16(pa2,PK(2),o[d0],0,0,0);
    o[d0]=__builtin_amdgcn_mfma_f32_32x32x16_bf16(pa3,PK(3),o[d0],0,0,0);
    #undef PK
  }
}

#ifndef ATTN_STORE16
#define ATTN_STORE16(p,v) (*(u32x4*)(p)=(v))
#endif
template<int THRL> __device__ __forceinline__ void attn_unit(int hq,int hv,int qb,const bf16*Q,const bf16*__restrict__ K,const bf16*__restrict__ V,bf16*O,char*shm,const int tid){
  const int lane=tid&63,r32=lane&31,hi=lane>>5; const int wid=__builtin_amdgcn_readfirstlane(tid>>6);
  const long rowbase=0; const int q0=qb*QB;
  const bf16*Qw=Q+(rowbase+q0+wid*QBLK)*DM+hq*D;
  const bf16*Kh=K+rowbase*DM+hq*D,*Vh=V+rowbase*DM+hv*D;
  const unsigned lds0=(unsigned)(uintptr_t)shm;
  float*wsf=(float*)(shm+LDS_WS)+wid*64;
  const bf16*ksrc=Kh+(long)lane*DM+wid*8;
  const bf16*vsrc=Vh+(long)(16*(wid&3)+(lane>>2))*DM+(wid>>2)*32+(lane&3)*8;
  const unsigned kdst=lds0+LDS_K+wid*1024, vdst=lds0+LDS_V+wid*1024;
  #define DMA_K(t,slot) glds16(ksrc+(long)(t)*KVBLK*DM,(unsigned)__builtin_amdgcn_readfirstlane(kdst+(slot)))
  #define DMA_V(t,slot) glds16(vsrc+(long)(t)*KVBLK*DM,(unsigned)__builtin_amdgcn_readfirstlane(vdst+(slot)))
  const int vb0=(int)(lds0+LDS_V)+((lane>>4)&1)*32+(lane&3)*8+(4*hi+((lane&15)>>2))*64;
  const char*Kbase=shm+LDS_K; bf16x8 kf[8];
  const lds_cptr shm3=(lds_cptr)shm; const lds_cptr kp0=shm3+LDS_K+hi*1024+r32*16; const lds_cptr vp0=shm3+LDS_V+((lane>>4)&1)*32+(lane&3)*8+(4*hi+((lane&15)>>2))*64;
  const int NT=(q0+QB)/KVBLK;
  DMA_K(0,0);DMA_V(0,0);DMA_K(1,SLOTB);
  bf16x8 qr[4];
  #pragma unroll
  for(int d0=0;d0<4;++d0)qr[d0]=*reinterpret_cast<const bf16x8*>(&Qw[(long)r32*DM+d0*16+hi*8]);
  float mhat=0.f,l_reg=0.f;f32x16 o[2];o[0]=f32x16{};o[1]=f32x16{};f32x16 negm=f32x16{};asm volatile("":"+v"(negm));
  const int qrel=wid*QBLK+r32;
  #define CMASK(P0,P1,t) do{int jb_=(t)-(NT-4); if(jb_>=0)cmask(P0,P1,jb_,qrel,hi);}while(0)
  bool resc=false;
  #define START(P0,P1) do{ const float rm=rowmax(P0,P1); resc=false; \
    { const float dl=rm; mhat=fadd_s(mhat,dl); \
      _Pragma("unroll") for(int r=0;r<16;++r){P0[r]=fsub_s(P0[r],dl);P1[r]=fsub_s(P1[r],dl);} \
      _Pragma("unroll") for(int r=0;r<16;++r)negm[r]=-mhat; asm volatile("":"+v"(negm)); } \
    _Pragma("unroll") for(int r=0;r<16;++r)P0[r]=__builtin_amdgcn_exp2f(P0[r]); }while(0)
  #define RESC() do{ if(resc){ asm volatile("s_waitcnt lgkmcnt(0)":::"memory"); \
      _Pragma("unroll") for(int d_=0;d_<2;++d_) _Pragma("unroll") for(int r=0;r<16;++r)o[d_][r]*=wsf[crow(r,hi)]; } }while(0)
  f32x16 pA0,pA1,pB0,pB1;
  int sl_prev=0,sl_cur=0,sl_next=SLOTB;
  #define ROT() do{sl_prev=sl_cur;sl_cur=sl_next;sl_next=(sl_next==(NSLOT-1)*SLOTB)?0:sl_next+SLOTB;}while(0)
  DMA_K(2,2*SLOTB);
  WAIT_BAR(3);
  qkt(pA0,pA1,Kbase,qr,negm,r32,hi);asm volatile("s_nop 15\n\ts_nop 7":"+v"(pA0),"+v"(pA1));CMASK(pA0,pA1,0);
  START(pA0,pA1);
  _Pragma("unroll") for(int r=0;r<16;++r)pA1[r]=__builtin_amdgcn_exp2f(pA1[r]);
  WAIT_BAR(0);
  DMA_K(3,0);DMA_V(1,SLOTB);
  ROT();
  kload8(kf,kp0+sl_cur);
  WAIT_BAR(2);
  s16x4 vlo[8],vhi[8]; u32x4 pw0,pw1,pw2,pw3;
  #define PKW(P,B) cvtpk_s(P[B],P[B+1])
  #define PAF(k) __builtin_bit_cast(bf16x8,pw##k)
  #define VFR(i) (bf16x8){vlo[i][0],vlo[i][1],vlo[i][2],vlo[i][3],vhi[i][0],vhi[i][1],vhi[i][2],vhi[i][3]}
  #define PIN(x) asm volatile("":"+v"(x))
  #define MX3(a,b,c) __builtin_fmaxf(__builtin_fmaxf((a),(b)),(c))
  #define GAPA(MF,A0,A1,A2,A3,W0,W1,PW) do{ MF; sacc+=A0; sacc+=A1; sacc+=A2; sacc+=A3; PIN(sacc); W0; W1; PIN(PW); SBAR(); }while(0)
  #define EX(v) __builtin_amdgcn_exp2f(v)
  #define GAPB(MF,X,B) do{ MF; X[B]=EX(X[B]); X[B+1]=EX(X[B+1]); X[B+2]=EX(X[B+2]); X[B+3]=EX(X[B+3]); PIN(X); SBAR(); }while(0)
  #define VRD(i) do{ vlo[i]=vtr(vp_+(((i)>>2)*4096+((i)&3)*1024)); vhi[i]=vtr(vp_+(((i)>>2)*4096+((i)&3)*1024+512)); }while(0)
  #define KRD(G,j) do{ if(G){ kload2(kf,kp0+sl_next,j); SBAR(); } }while(0)
  #define STEP(C0,C1,P0,P1,t,GK,GV,GL) do{ SBAR(); \
    const lds_cptr vp_=vp0+sl_prev; \
    VRD(0); SBAR(); float sacc=(P0[0]+P0[1]); \
    GAPA(C0=__builtin_amdgcn_mfma_f32_32x32x16_bf16(kf[0],qr[0],negm,0,0,0), P0[2],P0[3],P0[4],P0[5],     pw0[0]=PKW(P0,0), pw0[1]=PKW(P0,2), pw0); \
    VRD(4); SBAR(); GAPA(C1=__builtin_amdgcn_mfma_f32_32x32x16_bf16(kf[1],qr[0],negm,0,0,0), P0[6],P0[7],P0[8],P0[9],     pw0[2]=PKW(P0,4), pw0[3]=PKW(P0,6), pw0); \
    VRD(1); SBAR(); GAPA(C0=__builtin_amdgcn_mfma_f32_32x32x16_bf16(kf[2],qr[1],C0,0,0,0),   P0[10],P0[11],P0[12],P0[13], pw1[0]=PKW(P0,8), pw1[1]=PKW(P0,10), pw1); \
    VRD(5); SBAR(); GAPA(C1=__builtin_amdgcn_mfma_f32_32x32x16_bf16(kf[3],qr[1],C1,0,0,0),   P0[14],P0[15],P1[0],P1[1],   pw1[2]=PKW(P0,12),pw1[3]=PKW(P0,14), pw1); \
    VRD(2); SBAR(); GAPA(C0=__builtin_amdgcn_mfma_f32_32x32x16_bf16(kf[4],qr[2],C0,0,0,0),   P1[2],P1[3],P1[4],P1[5],     pw2[0]=PKW(P1,0), pw2[1]=PKW(P1,2), pw2); \
    VRD(6); SBAR(); GAPA(C1=__builtin_amdgcn_mfma_f32_32x32x16_bf16(kf[5],qr[2],C1,0,0,0),   P1[6],P1[7],P1[8],P1[9],     pw2[2]=PKW(P1,4), pw2[3]=PKW(P1,6), pw2); \
    VRD(3); SBAR(); GAPA(C0=__builtin_amdgcn_mfma_f32_32x32x16_bf16(kf[6],qr[3],C0,0,0,0),   P1[10],P1[11],P1[12],P1[13], pw3[0]=PKW(P1,8), pw3[1]=PKW(P1,10), pw3); \
    VRD(7); SBAR(); GAPA(C1=__builtin_amdgcn_mfma_f32_32x32x16_bf16(kf[7],qr[3],C1,0,0,0),   P1[14],P1[15],0.f,0.f,       pw3[2]=PKW(P1,12),pw3[3]=PKW(P1,14), pw3); \
    l_reg+=sacc; \
    if(GK){DMA_K((t)+3,sl_cur);} if(GV){DMA_V((t)+1,sl_next);} \
    CMASK(C0,C1,t); \
    { float a=MX3(C0[0],C0[1],C1[0]),b=MX3(C0[2],C0[3],C1[1]); a=MX3(a,C1[2],C1[3]); \
      _Pragma("unroll") for(int r=4;r<16;r+=4){a=MX3(a,C0[r],C0[r+1]);b=MX3(b,C0[r+2],C0[r+3]);a=MX3(a,C1[r],C1[r+1]);b=MX3(b,C1[r+2],C1[r+3]);} \
      float rm=__builtin_fmaxf(a,b); { auto rr=__builtin_amdgcn_permlane32_swap(__float_as_uint(rm),__float_as_uint(rm),false,false); rm=__builtin_fmaxf(__uint_as_float(rr[0]),__uint_as_float(rr[1])); } \
      resc=false; \
      if(__builtin_expect(__any(rm>(float)THRL),0)){ const float dl=__builtin_fmaxf(rm,0.f); mhat+=dl; \
        _Pragma("unroll") for(int r=0;r<16;++r){C0[r]-=dl;C1[r]-=dl;} \
        _Pragma("unroll") for(int r=0;r<16;++r)negm[r]=-mhat; asm volatile("":"+v"(negm)); \
        const float f=__builtin_amdgcn_exp2f(-dl); l_reg*=f; if(hi==0)wsf[r32]=f; resc=true; } } \
    SBAR(); \
    GAPB(o[0]=__builtin_amdgcn_mfma_f32_32x32x16_bf16(PAF(0),VFR(0),o[0],0,0,0), C0,0); \
    GAPB(o[1]=__builtin_amdgcn_mfma_f32_32x32x16_bf16(PAF(0),VFR(4),o[1],0,0,0), C0,4); \
    KRD(GL,0); GAPB(o[0]=__builtin_amdgcn_mfma_f32_32x32x16_bf16(PAF(1),VFR(1),o[0],0,0,0), C0,8); \
    KRD(GL,1); GAPB(o[1]=__builtin_amdgcn_mfma_f32_32x32x16_bf16(PAF(1),VFR(5),o[1],0,0,0), C0,12); \
    KRD(GL,2); GAPB(o[0]=__builtin_amdgcn_mfma_f32_32x32x16_bf16(PAF(2),VFR(2),o[0],0,0,0), C1,0); \
    KRD(GL,3); GAPB(o[1]=__builtin_amdgcn_mfma_f32_32x32x16_bf16(PAF(2),VFR(6),o[1],0,0,0), C1,4); \
    GAPB(o[0]=__builtin_amdgcn_mfma_f32_32x32x16_bf16(PAF(3),VFR(3),o[0],0,0,0), C1,8); \
    GAPB(o[1]=__builtin_amdgcn_mfma_f32_32x32x16_bf16(PAF(3),VFR(7),o[1],0,0,0), C1,12); \
    }while(0)
  int t=1;
  #undef CMASK
  #define CMASK(P0,P1,t) do{}while(0)
  for(;t+5<NT;t+=2){
    STEP(pB0,pB1,pA0,pA1,t,true,true,true);     WAIT_BAR(2); RESC(); ROT();
    STEP(pA0,pA1,pB0,pB1,t+1,true,true,true);   WAIT_BAR(2); RESC(); ROT();
  }
  #undef CMASK
  #define CMASK(P0,P1,t) do{int jb_=(t)-(NT-4); if(jb_>=0)cmask(P0,P1,jb_,qrel,hi);}while(0)
  #define ENDW(tt) do{ if((tt)+3<NT){WAIT_BAR(2);} else if((tt)+2<NT){WAIT_BAR(1);} else {WAIT_BAR(0);} }while(0)
  for(;t+1<NT;t+=2){
    STEP(pB0,pB1,pA0,pA1,t,(t+3<NT),(t+1<NT),(t+1<NT));       ENDW(t);   RESC(); ROT();
    STEP(pA0,pA1,pB0,pB1,t+1,(t+4<NT),(t+2<NT),(t+2<NT));     ENDW(t+1); RESC(); ROT();
  }
  STEP(pB0,pB1,pA0,pA1,NT-1,false,false,false); RESC();
  { float sacc=pB0[0]+pB0[1]; _Pragma("unroll") for(int r=2;r<16;++r)sacc+=pB0[r]; _Pragma("unroll") for(int r=0;r<16;++r)sacc+=pB1[r]; l_reg+=sacc;
    pw0=(u32x4){PKW(pB0,0),PKW(pB0,2),PKW(pB0,4),PKW(pB0,6)};pw1=(u32x4){PKW(pB0,8),PKW(pB0,10),PKW(pB0,12),PKW(pB0,14)};pw2=(u32x4){PKW(pB1,0),PKW(pB1,2),PKW(pB1,4),PKW(pB1,6)};pw3=(u32x4){PKW(pB1,8),PKW(pB1,10),PKW(pB1,12),PKW(pB1,14)};
    SBAR(); pv(o,vb0+sl_cur,PAF(0),PAF(1),PAF(2),PAF(3)); }
  #undef PKW
  #undef PAF
  #undef VFR
  #undef PIN
  #undef MX3
  #undef GAPA
  #undef GAPB
  #undef EX
  #undef VRD
  #undef KRD
  #undef STEP
  #undef ENDW
  {auto rr=__builtin_amdgcn_permlane32_swap(__float_as_uint(l_reg),__float_as_uint(l_reg),false,false);l_reg=__uint_as_float(rr[0])+__uint_as_float(rr[1]);}
  if(hi==0)wsf[32+r32]=l_reg;asm volatile("s_waitcnt lgkmcnt(0)":::"memory");
  float rli[16];
  #pragma unroll
  for(int r=0;r<16;++r)rli[r]=__builtin_amdgcn_rcpf(wsf[32+crow(r,hi)]);
  bf16*Ow=O+(rowbase+q0+wid*QBLK)*DM+hv*D;
  { bf16*stg=(bf16*)(shm+LDS_OST)+wid*2048;
    #pragma unroll
    for(int r=0;r<16;++r){const int orow=crow(r,hi);
      #pragma unroll
      for(int d0=0;d0<2;++d0)stg[orow*64+d0*32+r32]=__float2bfloat16(o[d0][r]*rli[r]);}
    asm volatile("s_waitcnt lgkmcnt(0)":::"memory");
    #pragma unroll
    for(int i=0;i<4;++i){const int row=i*8+(lane>>3),ch=lane&7; const u32x4 v=*(const u32x4*)(stg+row*64+ch*8); ATTN_STORE16(Ow+(long)row*DM+ch*8,v);} }
  asm volatile("s_waitcnt lgkmcnt(0)\n\ts_barrier":::"memory");
  #undef DMA_K
  #undef DMA_V
  #undef CMASK
  #undef START
  #undef RESC
  #undef ROT
}

constexpr int ATTN_LDS_BYTES=LDS_BYTES;
#undef SBAR
#undef WAIT_BAR
}
namespace attn_body {
#if NAIVE_ATTN
__device__ __forceinline__ void attn_unit_naive(int hq,int hv,int qb,const bf16_t*Q,const bf16_t*K,const bf16_t*V,bf16_t*O,const int tid_){
  const int lane=tid_&63, wid=tid_>>6;
#pragma unroll 1
  for(int r=0;r<32;++r){ const int row=qb*256+wid*32+r;
    float q[64];
#pragma unroll
    for(int c=0;c<8;++c){ const ::u32x4 w=*(const ::u32x4*)(Q+(size_t)row*1024+hq*64+c*8); q[c*8+0]=bflo(w.x);q[c*8+1]=bfhi(w.x);q[c*8+2]=bflo(w.y);q[c*8+3]=bfhi(w.y);q[c*8+4]=bflo(w.z);q[c*8+5]=bfhi(w.z);q[c*8+6]=bflo(w.w);q[c*8+7]=bfhi(w.w); }
    float m=-INFINITY,l=0.f,o=0.f;
#pragma unroll 1
    for(int j0=0;j0<=row;j0+=64){ const int j=j0+lane; float s=-INFINITY;
      if(j<=row){ float a=0.f;
#pragma unroll
        for(int c=0;c<8;++c){ const ::u32x4 w=*(const ::u32x4*)(K+(size_t)j*1024+hq*64+c*8); a+=q[c*8+0]*bflo(w.x)+q[c*8+1]*bfhi(w.x)+q[c*8+2]*bflo(w.y)+q[c*8+3]*bfhi(w.y)+q[c*8+4]*bflo(w.z)+q[c*8+5]*bfhi(w.z)+q[c*8+6]*bflo(w.w)+q[c*8+7]*bfhi(w.w); }
        s=a; }
      const float mb=wave_max(s);
      const float mn=fmaxf(m,mb), alpha=exp2f(m-mn); const float p=(j<=row)?exp2f(s-mn):0.f;
      l=l*alpha+wave_sum(p); o*=alpha;
      const int nj=(row-j0+1)<64?(row-j0+1):64;
#pragma unroll 1
      for(int jj=0;jj<nj;++jj){ const float pj=__builtin_bit_cast(float,__builtin_amdgcn_readlane(__builtin_bit_cast(int,p),jj)); o+=pj*bf2f(V[(size_t)(j0+jj)*1024+hv*64+lane]); }
      m=mn; }
    O[(size_t)row*1024+hv*64+lane]=(bf16_t)f2bf(o/l);
  }
}
#endif
__device__ __forceinline__ void attn_phase(char* lds, const bf16_t* Q, const bf16_t* K, const bf16_t* V, bf16_t* O1, bf16_t* O2, int vcu, int G, const int tid) {
  const int nu = (G == 256) ? 4 : (1024 - vcu + G - 1) / G;
#pragma unroll 1
  for (int i = 0; i < nu; ++i) {
    int bh, qb;
    if (G == 256) { const int s = vcu & 7; bh = vcu >> 3; qb = (i == 0) ? s : (i == 1) ? 15 - s : (i == 2) ? 16 + s : 31 - s; }
    else { const int L = vcu + i * G; bh = L >> 5; qb = L & 31; }
    const int h = bh >> 2, c = (bh >> 1) & 1, vh = bh & 1;
    int tid_u = tid; asm volatile("" : "+v"(tid_u));
#if NAIVE_ATTN
    attn_unit_naive(h * 2 + c, h * 2 + vh, qb, Q, K, V, c ? O2 : O1, tid_u);
#else
    attn_unit<8>(h * 2 + c, h * 2 + vh, qb, (const bf16*)Q, (const bf16*)K, (const bf16*)V, (bf16*)(c ? O2 : O1), lds, tid_u);
#endif
  }
}
}
namespace attn128 {
using bf16=__hip_bfloat16;
using bf16x8=__attribute__((ext_vector_type(8)))short;
using s16x4=__attribute__((ext_vector_type(4)))short;
using f32x16=__attribute__((ext_vector_type(16)))float;
using u32x4=__attribute__((ext_vector_type(4)))unsigned;
constexpr int BATCH=1,NHEAD=16,SEQ=8192,D=64,DM=NHEAD*D;
constexpr int NW=8,QBLK=32,QB=QBLK*NW,KVBLK=64,NQB=SEQ/QB;
constexpr int ATTN_PITCH=DM, ATTN_UNIT_ROWS=QB;
__device__ __forceinline__ int crow(int r,int hi){return (r&3)+8*(r>>2)+4*hi;}
#define SBAR() __builtin_amdgcn_sched_barrier(0)
__device__ __forceinline__ void cmask(f32x16&p0,f32x16&p1,int jb,int qrel,int hi){
  const float NEG=-INFINITY; int kb=64*jb+4*hi;
  #pragma unroll
  for(int r=0;r<16;++r){int kv=kb+(r&3)+8*(r>>2); if(kv>qrel)p0[r]=NEG; if(kv+32>qrel)p1[r]=NEG;}
}

constexpr int NSLOT=3, SLOTB=8192;
constexpr int VSLOTB=2*SLOTB;
constexpr int LDS_K=0, LDS_V=NSLOT*SLOTB, LDS_WS=LDS_V+NSLOT*VSLOTB, LDS_OST=LDS_WS+NW*64*4, LDS_BYTES=LDS_OST+NW*4096;
constexpr float C2=0.125f*1.4426950408889634f;
__device__ __forceinline__ void glds16(const void*gsrc,unsigned lds_dst){unsigned keep;
  asm volatile("s_mov_b32 %0, m0\n\ts_mov_b32 m0, %2\n\ts_nop 0\n\tglobal_load_lds_dwordx4 %1, off\n\ts_mov_b32 m0, %0":"=&s"(keep):"v"(gsrc),"s"(lds_dst):"memory");}
__device__ __forceinline__ float max3f(float a,float b,float c){float r;asm("v_max3_f32 %0, %1, %2, %3":"=v"(r):"v"(a),"v"(b),"v"(c));return r;}
__device__ __forceinline__ float max2f(float a,float b){float r;asm("v_max_f32_e32 %0, %1, %2":"=v"(r):"v"(a),"v"(b));return r;}
__device__ __forceinline__ float fadd_s(float a,float b){float r;asm("v_add_f32_e32 %0, %1, %2":"=v"(r):"v"(a),"v"(b));return r;}
__device__ __forceinline__ float fsub_s(float a,float b){float r;asm("v_sub_f32_e32 %0, %1, %2":"=v"(r):"v"(a),"v"(b));return r;}
typedef float f32x2_t __attribute__((ext_vector_type(2))); typedef __bf16 bf16x2_t __attribute__((ext_vector_type(2)));
__device__ __forceinline__ unsigned cvtpk_s(float lo,float hi){f32x2_t v={lo,hi};bf16x2_t b=__builtin_convertvector(v,bf16x2_t);return __builtin_bit_cast(unsigned,b);}
#define WAIT_BAR(N) asm volatile("s_waitcnt vmcnt(" #N ") lgkmcnt(0)\n\ts_barrier":::"memory")

__device__ __forceinline__ void qkt(f32x16&p0,f32x16&p1,const char*Kslot,const bf16x8*qr,const f32x16&negm,int r32,int hi){
  const char*kb=Kslot+hi*1024+r32*16;
  #pragma unroll
  for(int d0=0;d0<4;++d0){
    const bf16x8 b0=*reinterpret_cast<const bf16x8*>(kb+d0*2048);
    const bf16x8 b1=*reinterpret_cast<const bf16x8*>(kb+d0*2048+512);
    if(d0==0){p0=__builtin_amdgcn_mfma_f32_32x32x16_bf16(b0,qr[0],negm,0,0,0);p1=__builtin_amdgcn_mfma_f32_32x32x16_bf16(b1,qr[0],negm,0,0,0);}
    else{p0=__builtin_amdgcn_mfma_f32_32x32x16_bf16(b0,qr[d0],p0,0,0,0);p1=__builtin_amdgcn_mfma_f32_32x32x16_bf16(b1,qr[d0],p1,0,0,0);}}
}
typedef __attribute__((address_space(3))) const char* lds_cptr;
typedef short v4i16_t __attribute__((ext_vector_type(4)));
__device__ __forceinline__ void kload8(bf16x8*kf,lds_cptr kp){
  kf[0]=*(const __attribute__((address_space(3))) bf16x8*)(kp);      kf[1]=*(const __attribute__((address_space(3))) bf16x8*)(kp+512);
  kf[2]=*(const __attribute__((address_space(3))) bf16x8*)(kp+2048); kf[3]=*(const __attribute__((address_space(3))) bf16x8*)(kp+2560);
  kf[4]=*(const __attribute__((address_space(3))) bf16x8*)(kp+4096); kf[5]=*(const __attribute__((address_space(3))) bf16x8*)(kp+4608);
  kf[6]=*(const __attribute__((address_space(3))) bf16x8*)(kp+6144); kf[7]=*(const __attribute__((address_space(3))) bf16x8*)(kp+6656);
}
__device__ __forceinline__ void kload2(bf16x8*kf,lds_cptr kp,int j){ kf[2*j]=*(const __attribute__((address_space(3))) bf16x8*)(kp+j*2048); kf[2*j+1]=*(const __attribute__((address_space(3))) bf16x8*)(kp+j*2048+512); }
__device__ __forceinline__ s16x4 vtr(lds_cptr p){ return __builtin_bit_cast(s16x4,__builtin_amdgcn_ds_read_tr16_b64_v4i16((__attribute__((address_space(3))) v4i16_t*)p)); }
__device__ __forceinline__ float rowmax(const f32x16&p0,const f32x16&p1){
  float a=max3f(p0[0],p0[1],p1[0]),b=max3f(p0[2],p0[3],p1[1]);a=max3f(a,p1[2],p1[3]);
  #pragma unroll
  for(int r=4;r<16;r+=4){a=max3f(a,p0[r],p0[r+1]);b=max3f(b,p0[r+2],p0[r+3]);a=max3f(a,p1[r],p1[r+1]);b=max3f(b,p1[r+2],p1[r+3]);}
  const float m=max2f(a,b);
  auto rr=__builtin_amdgcn_permlane32_swap(__float_as_uint(m),__float_as_uint(m),false,false);
  return max2f(__uint_as_float(rr[0]),__uint_as_float(rr[1]));
}
__device__ __forceinline__ void pv(f32x16*o,int vb,bf16x8 pa0,bf16x8 pa1,bf16x8 pa2,bf16x8 pa3){
  #pragma unroll
  for(int d0=0;d0<4;++d0){s16x4 lo[4],hi[4];
    #pragma unroll
    for(int ks=0;ks<4;++ks){
      asm volatile("ds_read_b64_tr_b16 %0,%1 offset:%c2":"=&v"(lo[ks]):"v"(vb),"i"(d0*4096+ks*1024):"memory");
      asm volatile("ds_read_b64_tr_b16 %0,%1 offset:%c2":"=&v"(hi[ks]):"v"(vb),"i"(d0*4096+ks*1024+512):"memory");}
    asm volatile("s_waitcnt lgkmcnt(0)":::"memory");SBAR();
    #define PK(k) (bf16x8){lo[k][0],lo[k][1],lo[k][2],lo[k][3],hi[k][0],hi[k][1],hi[k][2],hi[k][3]}
    o[d0]=__builtin_amdgcn_mfma_f32_32x32x16_bf16(pa0,PK(0),o[d0],0,0,0);
    o[d0]=__builtin_amdgcn_mfma_f32_32x32x16_bf16(pa1,PK(1),o[d0],0,0,0);
    o[d0]=__builtin_amdgcn_mfma_f32_32x32x16_bf16(pa2,PK(2),o[d0],0,0,0);
    o[d0]=__builtin_amdgcn_mfma_f32_32x32x16_bf16(pa3,PK(3),o[d0],0,0,0);
    #undef PK
  }
}

#ifndef ATTN_STORE16
#define ATTN_STORE16(p,v) (*(u32x4*)(p)=(v))
#endif
template<int THRL> __device__ __forceinline__ void attn_unit(int hq,int hv,int qb,const bf16*Q,const bf16*__restrict__ K,const bf16*__restrict__ V,bf16*O,char*shm,const int tid){
  const int lane=tid&63,r32=lane&31,hi=lane>>5; const int wid=__builtin_amdgcn_readfirstlane(tid>>6);
  const long rowbase=0; const int q0=qb*QB;
  const bf16*Qw=Q+(rowbase+q0+wid*QBLK)*DM+hq*D;
  const bf16*Kh=K+rowbase*DM+hq*D,*Vh=V+rowbase*DM+hv*128;
  const unsigned lds0=(unsigned)(uintptr_t)shm;
  float*wsf=(float*)(shm+LDS_WS)+wid*64;
  const bf16*ksrc=Kh+(long)lane*DM+wid*8;
  const bf16*vsrc=Vh+(long)(16*(wid&3)+(lane>>2))*DM+(wid>>2)*32+(lane&3)*8;
  const unsigned kdst=lds0+LDS_K+wid*1024, vdst=lds0+LDS_V+wid*1024;
  #define DMA_K(t,slot) glds16(ksrc+(long)(t)*KVBLK*DM,(unsigned)__builtin_amdgcn_readfirstlane(kdst+(slot)))
  #define DMA_V(t,slot) do{ glds16(vsrc+(long)(t)*KVBLK*DM,(unsigned)__builtin_amdgcn_readfirstlane(vdst+2*(slot))); glds16(vsrc+(long)(t)*KVBLK*DM+64,(unsigned)__builtin_amdgcn_readfirstlane(vdst+2*(slot)+8192)); }while(0)
  const int vb0=(int)(lds0+LDS_V)+((lane>>4)&1)*32+(lane&3)*8+(4*hi+((lane&15)>>2))*64;
  const char*Kbase=shm+LDS_K; bf16x8 kf[8];
  const lds_cptr shm3=(lds_cptr)shm; const lds_cptr kp0=shm3+LDS_K+hi*1024+r32*16; const lds_cptr vp0=shm3+LDS_V+((lane>>4)&1)*32+(lane&3)*8+(4*hi+((lane&15)>>2))*64;
  const int NT=(q0+QB)/KVBLK;
  DMA_K(0,0);DMA_V(0,0);DMA_K(1,SLOTB);
  bf16x8 qr[4];
  #pragma unroll
  for(int d0=0;d0<4;++d0)qr[d0]=*reinterpret_cast<const bf16x8*>(&Qw[(long)r32*DM+d0*16+hi*8]);
  float mhat=0.f,l_reg=0.f;f32x16 o[4];o[0]=f32x16{};o[1]=f32x16{};o[2]=f32x16{};o[3]=f32x16{};
  const int qrel=wid*QBLK+r32;
  #define CMASK(P0,P1,t) do{int jb_=(t)-(NT-4); if(jb_>=0)cmask(P0,P1,jb_,qrel,hi);}while(0)
  bool resc=false;
  #define START(P0,P1) do{ const float rm=rowmax(P0,P1); resc=false; \
    { const float dl=rm; mhat=fadd_s(mhat,dl); \
      _Pragma("unroll") for(int r=0;r<16;++r){P0[r]=fsub_s(P0[r],dl);P1[r]=fsub_s(P1[r],dl);} \
      } \
    _Pragma("unroll") for(int r=0;r<16;++r)P0[r]=__builtin_amdgcn_exp2f(P0[r]); }while(0)
  #define RESC() do{ if(resc){ asm volatile("s_waitcnt lgkmcnt(0)":::"memory"); \
      _Pragma("unroll") for(int d_=0;d_<4;++d_) _Pragma("unroll") for(int r=0;r<16;++r)o[d_][r]*=wsf[crow(r,hi)]; } }while(0)
  f32x16 pA0,pA1,pB0,pB1;
  int sl_prev=0,sl_cur=0,sl_next=SLOTB;
  #define ROT() do{sl_prev=sl_cur;sl_cur=sl_next;sl_next=(sl_next==(NSLOT-1)*SLOTB)?0:sl_next+SLOTB;}while(0)
  DMA_K(2,2*SLOTB);
  WAIT_BAR(4);
  { const f32x16 zero16=f32x16{}; qkt(pA0,pA1,Kbase,qr,zero16,r32,hi); }asm volatile("s_nop 15\n\ts_nop 7":"+v"(pA0),"+v"(pA1));CMASK(pA0,pA1,0);
  START(pA0,pA1);
  _Pragma("unroll") for(int r=0;r<16;++r)pA1[r]=__builtin_amdgcn_exp2f(pA1[r]);
  WAIT_BAR(0);
  DMA_K(3,0);DMA_V(1,SLOTB);
  ROT();
  kload8(kf,kp0+sl_cur);
  WAIT_BAR(3);
  s16x4 vlo[8],vhi[8]; u32x4 pw0,pw1,pw2,pw3;
  #define PKW(P,B) cvtpk_s(P[B],P[B+1])
  #define PAF(k) __builtin_bit_cast(bf16x8,pw##k)
  #define VFR(i) (bf16x8){vlo[i][0],vlo[i][1],vlo[i][2],vlo[i][3],vhi[i][0],vhi[i][1],vhi[i][2],vhi[i][3]}
  #define PIN(x) asm volatile("":"+v"(x))
  #define MX3(a,b,c) __builtin_fmaxf(__builtin_fmaxf((a),(b)),(c))
  #define GAPA(MF,A0,A1,A2,A3,W0,W1,PW) do{ MF; sacc+=A0; sacc+=A1; sacc+=A2; sacc+=A3; PIN(sacc); W0; W1; PIN(PW); SBAR(); }while(0)
  #define EX(v) __builtin_amdgcn_exp2f(v)
  #define GAPB(MF,X,B) do{ MF; X[B]=EX(X[B]); X[B+1]=EX(X[B+1]); X[B+2]=EX(X[B+2]); X[B+3]=EX(X[B+3]); PIN(X); SBAR(); }while(0)
  #define GAPB2(MF,RD,X,B) do{ MF; RD; X[B]=EX(X[B]); X[B+1]=EX(X[B+1]); PIN(X); SBAR(); }while(0)
  #define VRD2(i) do{ vlo[i]=vtr(vp_+((((i)>>2)+2)*4096+((i)&3)*1024)); vhi[i]=vtr(vp_+((((i)>>2)+2)*4096+((i)&3)*1024+512)); }while(0)
  #define VRD(i) do{ vlo[i]=vtr(vp_+(((i)>>2)*4096+((i)&3)*1024)); vhi[i]=vtr(vp_+(((i)>>2)*4096+((i)&3)*1024+512)); }while(0)
  #define KRD(G,j) do{ if(G){ kload2(kf,kp0+sl_next,j); SBAR(); } }while(0)
  #define STEP(C0,C1,P0,P1,t,GK,GV,GL) do{ SBAR(); \
    const lds_cptr vp_=vp0+2*sl_prev; \
    { const float nm_=-mhat; _Pragma("unroll") for(int r=0;r<16;++r){C0[r]=nm_;C1[r]=nm_;} }     \
    VRD(0); SBAR(); float sacc=(P0[0]+P0[1]); \
    GAPA(C0=__builtin_amdgcn_mfma_f32_32x32x16_bf16(kf[0],qr[0],C0,0,0,0), P0[2],P0[3],P0[4],P0[5],     pw0[0]=PKW(P0,0), pw0[1]=PKW(P0,2), pw0); \
    VRD(4); SBAR(); GAPA(C1=__builtin_amdgcn_mfma_f32_32x32x16_bf16(kf[1],qr[0],C1,0,0,0), P0[6],P0[7],P0[8],P0[9],     pw0[2]=PKW(P0,4), pw0[3]=PKW(P0,6), pw0); \
    VRD(1); SBAR(); GAPA(C0=__builtin_amdgcn_mfma_f32_32x32x16_bf16(kf[2],qr[1],C0,0,0,0),   P0[10],P0[11],P0[12],P0[13], pw1[0]=PKW(P0,8), pw1[1]=PKW(P0,10), pw1); \
    VRD(5); SBAR(); GAPA(C1=__builtin_amdgcn_mfma_f32_32x32x16_bf16(kf[3],qr[1],C1,0,0,0),   P0[14],P0[15],P1[0],P1[1],   pw1[2]=PKW(P0,12),pw1[3]=PKW(P0,14), pw1); \
    VRD(2); SBAR(); GAPA(C0=__builtin_amdgcn_mfma_f32_32x32x16_bf16(kf[4],qr[2],C0,0,0,0),   P1[2],P1[3],P1[4],P1[5],     pw2[0]=PKW(P1,0), pw2[1]=PKW(P1,2), pw2); \
    VRD(6); SBAR(); GAPA(C1=__builtin_amdgcn_mfma_f32_32x32x16_bf16(kf[5],qr[2],C1,0,0,0),   P1[6],P1[7],P1[8],P1[9],     pw2[2]=PKW(P1,4), pw2[3]=PKW(P1,6), pw2); \
    VRD(3); SBAR(); GAPA(C0=__builtin_amdgcn_mfma_f32_32x32x16_bf16(kf[6],qr[3],C0,0,0,0),   P1[10],P1[11],P1[12],P1[13], pw3[0]=PKW(P1,8), pw3[1]=PKW(P1,10), pw3); \
    VRD(7); SBAR(); GAPA(C1=__builtin_amdgcn_mfma_f32_32x32x16_bf16(kf[7],qr[3],C1,0,0,0),   P1[14],P1[15],0.f,0.f,       pw3[2]=PKW(P1,12),pw3[3]=PKW(P1,14), pw3); \
    l_reg+=sacc; \
    if(GK){DMA_K((t)+3,sl_cur);} if(GV){DMA_V((t)+1,sl_next);} \
    CMASK(C0,C1,t); \
    { float a=MX3(C0[0],C0[1],C1[0]),b=MX3(C0[2],C0[3],C1[1]); a=MX3(a,C1[2],C1[3]); \
      _Pragma("unroll") for(int r=4;r<16;r+=4){a=MX3(a,C0[r],C0[r+1]);b=MX3(b,C0[r+2],C0[r+3]);a=MX3(a,C1[r],C1[r+1]);b=MX3(b,C1[r+2],C1[r+3]);} \
      float rm=__builtin_fmaxf(a,b); { auto rr=__builtin_amdgcn_permlane32_swap(__float_as_uint(rm),__float_as_uint(rm),false,false); rm=__builtin_fmaxf(__uint_as_float(rr[0]),__uint_as_float(rr[1])); } \
      resc=false; \
      if(__builtin_expect(__any(rm>(float)THRL),0)){ const float dl=__builtin_fmaxf(rm,0.f); mhat+=dl; \
        _Pragma("unroll") for(int r=0;r<16;++r){C0[r]-=dl;C1[r]-=dl;} \
        const float f=__builtin_amdgcn_exp2f(-dl); l_reg*=f; if(hi==0)wsf[r32]=f; resc=true; } } \
    SBAR(); \
    GAPB2(o[0]=__builtin_amdgcn_mfma_f32_32x32x16_bf16(PAF(0),VFR(0),o[0],0,0,0), VRD2(0), C0,0); \
    GAPB2(o[1]=__builtin_amdgcn_mfma_f32_32x32x16_bf16(PAF(0),VFR(4),o[1],0,0,0), VRD2(4), C0,2); \
    GAPB2(o[0]=__builtin_amdgcn_mfma_f32_32x32x16_bf16(PAF(1),VFR(1),o[0],0,0,0), VRD2(1), C0,4); \
    GAPB2(o[1]=__builtin_amdgcn_mfma_f32_32x32x16_bf16(PAF(1),VFR(5),o[1],0,0,0), VRD2(5), C0,6); \
    GAPB2(o[0]=__builtin_amdgcn_mfma_f32_32x32x16_bf16(PAF(2),VFR(2),o[0],0,0,0), VRD2(2), C0,8); \
    GAPB2(o[1]=__builtin_amdgcn_mfma_f32_32x32x16_bf16(PAF(2),VFR(6),o[1],0,0,0), VRD2(6), C0,10); \
    GAPB2(o[0]=__builtin_amdgcn_mfma_f32_32x32x16_bf16(PAF(3),VFR(3),o[0],0,0,0), VRD2(3), C0,12); \
    GAPB2(o[1]=__builtin_amdgcn_mfma_f32_32x32x16_bf16(PAF(3),VFR(7),o[1],0,0,0), VRD2(7), C0,14); \
    KRD(GL,0); GAPB2(o[2]=__builtin_amdgcn_mfma_f32_32x32x16_bf16(PAF(0),VFR(0),o[2],0,0,0), (void)0, C1,0); \
    KRD(GL,1); GAPB2(o[3]=__builtin_amdgcn_mfma_f32_32x32x16_bf16(PAF(0),VFR(4),o[3],0,0,0), (void)0, C1,2); \
    KRD(GL,2); GAPB2(o[2]=__builtin_amdgcn_mfma_f32_32x32x16_bf16(PAF(1),VFR(1),o[2],0,0,0), (void)0, C1,4); \
    KRD(GL,3); GAPB2(o[3]=__builtin_amdgcn_mfma_f32_32x32x16_bf16(PAF(1),VFR(5),o[3],0,0,0), (void)0, C1,6); \
    GAPB2(o[2]=__builtin_amdgcn_mfma_f32_32x32x16_bf16(PAF(2),VFR(2),o[2],0,0,0), (void)0, C1,8); \
    GAPB2(o[3]=__builtin_amdgcn_mfma_f32_32x32x16_bf16(PAF(2),VFR(6),o[3],0,0,0), (void)0, C1,10); \
    GAPB2(o[2]=__builtin_amdgcn_mfma_f32_32x32x16_bf16(PAF(3),VFR(3),o[2],0,0,0), (void)0, C1,12); \
    GAPB2(o[3]=__builtin_amdgcn_mfma_f32_32x32x16_bf16(PAF(3),VFR(7),o[3],0,0,0), (void)0, C1,14); \
    }while(0)
  int t=1;
  #undef CMASK
  #define CMASK(P0,P1,t) do{}while(0)
  for(;t+5<NT;t+=2){
    STEP(pB0,pB1,pA0,pA1,t,true,true,true);     WAIT_BAR(3); RESC(); ROT();
    STEP(pA0,pA1,pB0,pB1,t+1,true,true,true);   WAIT_BAR(3); RESC(); ROT();
  }
  #undef CMASK
  #define CMASK(P0,P1,t) do{int jb_=(t)-(NT-4); if(jb_>=0)cmask(P0,P1,jb_,qrel,hi);}while(0)
  #define ENDW(tt) do{ if((tt)+3<NT){WAIT_BAR(3);} else if((tt)+2<NT){WAIT_BAR(2);} else {WAIT_BAR(0);} }while(0)
  for(;t+1<NT;t+=2){
    STEP(pB0,pB1,pA0,pA1,t,(t+3<NT),(t+1<NT),(t+1<NT));       ENDW(t);   RESC(); ROT();
    STEP(pA0,pA1,pB0,pB1,t+1,(t+4<NT),(t+2<NT),(t+2<NT));     ENDW(t+1); RESC(); ROT();
  }
  STEP(pB0,pB1,pA0,pA1,NT-1,false,false,false); RESC();
  { float sacc=pB0[0]+pB0[1]; _Pragma("unroll") for(int r=2;r<16;++r)sacc+=pB0[r]; _Pragma("unroll") for(int r=0;r<16;++r)sacc+=pB1[r]; l_reg+=sacc;
    pw0=(u32x4){PKW(pB0,0),PKW(pB0,2),PKW(pB0,4),PKW(pB0,6)};pw1=(u32x4){PKW(pB0,8),PKW(pB0,10),PKW(pB0,12),PKW(pB0,14)};pw2=(u32x4){PKW(pB1,0),PKW(pB1,2),PKW(pB1,4),PKW(pB1,6)};pw3=(u32x4){PKW(pB1,8),PKW(pB1,10),PKW(pB1,12),PKW(pB1,14)};
    SBAR(); pv(o,vb0+2*sl_cur,PAF(0),PAF(1),PAF(2),PAF(3)); }
  #undef PKW
  #undef PAF
  #undef VFR
  #undef PIN
  #undef MX3
  #undef GAPA
  #undef GAPB
  #undef GAPB2
  #undef VRD2
  #undef EX
  #undef VRD
  #undef KRD
  #undef STEP
  #undef ENDW
  {auto rr=__builtin_amdgcn_permlane32_swap(__float_as_uint(l_reg),__float_as_uint(l_reg),false,false);l_reg=__uint_as_float(rr[0])+__uint_as_float(rr[1]);}
  if(hi==0)wsf[32+r32]=l_reg;asm volatile("s_waitcnt lgkmcnt(0)":::"memory");
  float rli[16];
  #pragma unroll
  for(int r=0;r<16;++r)rli[r]=__builtin_amdgcn_rcpf(wsf[32+crow(r,hi)]);
  bf16*Ow=O+(rowbase+q0+wid*QBLK)*DM+hv*128;
  { bf16*stg=(bf16*)(shm+LDS_OST)+wid*2048;
    #pragma unroll
    for(int p=0;p<2;++p){
      #pragma unroll
      for(int r=0;r<16;++r){const int orow=crow(r,hi);
        #pragma unroll
        for(int d0=0;d0<2;++d0)stg[orow*64+d0*32+r32]=__float2bfloat16(o[2*p+d0][r]*rli[r]);}
      asm volatile("s_waitcnt lgkmcnt(0)":::"memory");
      #pragma unroll
      for(int i=0;i<4;++i){const int row=i*8+(lane>>3),ch=lane&7; const u32x4 v=*(const u32x4*)(stg+row*64+ch*8); ATTN_STORE16(Ow+(long)row*DM+p*64+ch*8,v);}
      asm volatile("s_waitcnt lgkmcnt(0)":::"memory"); } }
  asm volatile("s_waitcnt lgkmcnt(0)\n\ts_barrier":::"memory");
  #undef DMA_K
  #undef DMA_V
  #undef CMASK
  #undef START
  #undef RESC
  #undef ROT
}

constexpr int ATTN_LDS_BYTES=LDS_BYTES;
#undef SBAR
#undef WAIT_BAR
}

#ifndef ATTN128
#define ATTN128 1
#endif
namespace attn128 {
__device__ __forceinline__ void attn_phase(char* lds, const bf16_t* Q, const bf16_t* K, const bf16_t* V, bf16_t* O1, bf16_t* O2, int vcu, int G, const int tid) {
  const int nu = (G == 256) ? 2 : (512 - vcu + G - 1) / G;
#pragma unroll 1
  for (int i = 0; i < nu; ++i) {
    int hc, qb;
    if (G == 256) { const int s = vcu & 15; hc = vcu >> 4; qb = (i == 0) ? s : 31 - s; }
    else { const int L = vcu + i * G; hc = L >> 5; qb = L & 31; }
    int tid_u = tid; asm volatile("" : "+v"(tid_u));
    attn_unit<8>(hc, hc >> 1, qb, (const bf16*)Q, (const bf16*)K, (const bf16*)V, (bf16*)((hc & 1) ? O2 : O1), lds, tid_u);
  }
}
}
struct Ctx { unsigned char* ws; LAS unsigned char* lds; gu32* ctl; int tid, lane, wave, vcu, G, gw, NGW; };
__device__ __forceinline__ unsigned char* lwp(const Ctx& F, int l, size_t off) { return F.ws + WS_LW + (size_t)l * LW_SIZE + off; }

__device__ __forceinline__ int rowmap(int kind, int n, int H) {
    if (kind == 1) { const int d = n & 63; return (n & ~63) | (d < 32 ? 2 * d : 2 * (d - 32) + 1); }
    if (kind == 2) return n < H ? 2 * n : 2 * (n - H) + 1;
    if (kind == 3) return 2 * n;
    if (kind == 4) return 2 * n + 1;
    return n;
}
__device__ __forceinline__ void xpose_item(const float* W, int N, bf16_t* WT, int dpitch, int koff, int kind, int nbase, int H, int rbase, int k0, int n0, int lane, const float* gk = nullptr) {
    const int q = lane >> 4, c = lane & 15;
    const float* src = W + (size_t)(k0 + 16 * q) * N + n0 + 4 * c;
    f32x4 v[16];
#pragma unroll
    for (int i = 0; i < 16; ++i) v[i] = __builtin_nontemporal_load((const f32x4*)(src + (size_t)i * N));
    if (gk) { const f32x4* g4 = (const f32x4*)(gk + k0 + 16 * q); const f32x4 ga = g4[0], gb = g4[1], gc = g4[2], gd = g4[3];
#pragma unroll
        for (int i = 0; i < 4; ++i) { v[i] = v[i] * ga[i]; v[4 + i] = v[4 + i] * gb[i]; v[8 + i] = v[8 + i] * gc[i]; v[12 + i] = v[12 + i] * gd[i]; } }
#pragma unroll
    for (int j = 0; j < 4; ++j) { const int drow = rbase + rowmap(kind, n0 + 4 * c + j - nbase, H);
        u32x4 o0, o1; o0.x = pk2(v[0][j], v[1][j]); o0.y = pk2(v[2][j], v[3][j]); o0.z = pk2(v[4][j], v[5][j]); o0.w = pk2(v[6][j], v[7][j]);
        o1.x = pk2(v[8][j], v[9][j]); o1.y = pk2(v[10][j], v[11][j]); o1.z = pk2(v[12][j], v[13][j]); o1.w = pk2(v[14][j], v[15][j]);
        u32x4* dp = (u32x4*)(WT + (size_t)drow * dpitch + koff + k0 + 16 * q); dp[0] = o0; dp[1] = o1; }
}
__device__ __forceinline__ void xpose_item8(const float* W, int N, unsigned char* WT, int dpitch, int kind, int nbase, int k0, int n0, int lane, float scale, int H = 0, int rbase = 0, const float* gk = nullptr) {
    const int q = lane >> 4, c = lane & 15;
    const float* src = W + (size_t)(k0 + 16 * q) * N + n0 + 4 * c;
    f32x4 v[16];
#pragma unroll
    for (int i = 0; i < 16; ++i) v[i] = __builtin_nontemporal_load((const f32x4*)(src + (size_t)i * N)) * scale;
    if (gk) { const f32x4* g4 = (const f32x4*)(gk + k0 + 16 * q); const f32x4 ga = g4[0], gb = g4[1], gc = g4[2], gd = g4[3];
#pragma unroll
        for (int i = 0; i < 4; ++i) { v[i] = v[i] * ga[i]; v[4 + i] = v[4 + i] * gb[i]; v[8 + i] = v[8 + i] * gc[i]; v[12 + i] = v[12 + i] * gd[i]; } }
#pragma unroll
    for (int j = 0; j < 4; ++j) { const int drow = rbase + rowmap(kind, n0 + 4 * c + j - nbase, H); int w[4];
#pragma unroll
        for (int t = 0; t < 4; ++t) { int p8 = __builtin_amdgcn_cvt_pk_fp8_f32(v[4 * t][j], v[4 * t + 1][j], 0, false); w[t] = __builtin_amdgcn_cvt_pk_fp8_f32(v[4 * t + 2][j], v[4 * t + 3][j], p8, true); }
        *(u32x4*)(WT + (size_t)drow * dpitch + k0 + 16 * q) = (u32x4){(unsigned)w[0], (unsigned)w[1], (unsigned)w[2], (unsigned)w[3]}; }
}
#define XP_MAT(W_, K_, N_, WT_, DP_, KOFF_, KIND_, NBASE_, H_, RBASE_, NLO_, NHI_) { const int nb_ = ((NHI_) - (NLO_)) / 64, items_ = ((K_) / 64) * nb_; \
    if (r < items_) { xpose_item((W_), (N_), (bf16_t*)(WT_), (DP_), (KOFF_), (KIND_), (NBASE_), (H_), (RBASE_), 64 * (r / nb_), (NLO_) + 64 * (r % nb_), F.lane); continue; } r -= items_; }

#define XP_MATG(W_, K_, N_, WT_, DP_, KOFF_, KIND_, NBASE_, H_, RBASE_, NLO_, NHI_, GK_) { const int nb_ = ((NHI_) - (NLO_)) / 64, items_ = ((K_) / 64) * nb_; \
    if (r < items_) { xpose_item((W_), (N_), (bf16_t*)(WT_), (DP_), (KOFF_), (KIND_), (NBASE_), (H_), (RBASE_), 64 * (r / nb_), (NLO_) + 64 * (r % nb_), F.lane, (GK_)); continue; } r -= items_; }

__device__ __forceinline__ void sincos_d(double a, float& s, float& c) {
    const double k = rint(a * 0.15915494309189535); const double rr = a - k * 6.283185307179586476925; const float rf = (float)rr; s = sinf(rf); c = cosf(rf);
}

struct Inputs { const LAS unsigned* tab;
    __device__ __forceinline__ const float* ptr(int i) const { const unsigned lo = __builtin_amdgcn_readfirstlane(tab[2 * i]), hi = __builtin_amdgcn_readfirstlane(tab[2 * i + 1]);
        return (const float*)(((unsigned long long)hi << 32) | lo); } };

#ifndef DEFER_CONV
#define DEFER_CONV 1
#endif
constexpr int IT_WIN = 32 * (NPROJ / 64), IT_DA = 16 * 32, IT_CV = 8 * 32, IT_SO = 8 * 32, IT_GLU = 8 * 16, IT_MIX = 32 * 32, IT_KV = 32 * 16, IT_XO = 8 * 32, IT_G = 16 * 32 * 8, IT_D = 16 * 8 * 32;
constexpr int IT_BIG = IT_WIN + IT_DA + IT_CV + IT_SO + IT_GLU + IT_MIX + 2 * IT_G + IT_D;
__device__ __forceinline__ void conv_item(const Ctx& F, const Inputs& I, const int l, int r) {
    do {
        const float* win = I.ptr(4) + (size_t)l * DM * NPROJ;
        const float* gmix = I.ptr(3) + (size_t)l * DM;
        XP_MATG(win, DM, NPROJ, lwp(F, l, LW_WIN), DM, 0, 1, 0, 0, 0, 0, 2048, gmix)
        XP_MATG(win, DM, NPROJ, lwp(F, l, LW_WIN), DM, 0, 0, 0, 0, 0, 2048, 3072, gmix)
        { const int nb_ = 1024 / 64, items_ = (DM / 64) * nb_;
            if (r < items_) { xpose_item8(win, NPROJ, lwp(F, l, LW_WG8), DM, 2, 3072, 64 * (r / nb_), 3072 + 64 * (r % nb_), F.lane, GATE_WSCALE, 512, 6144, gmix); continue; } r -= items_; }
        XP_MATG(win, DM, NPROJ, lwp(F, l, LW_WIN), DM, 0, 0, 4096, 0, 3072, 4096, 4608, gmix)
        { const int nb_ = (NPROJ - 4608) / 64, items_ = (DM / 64) * nb_;
            if (r < items_) { xpose_item8(win, NPROJ, lwp(F, l, LW_WG8), DM, 0, 4608, 64 * (r / nb_), 4608 + 64 * (r % nb_), F.lane, GATE_WSCALE, 0, 0, gmix); continue; } r -= items_; }
        XP_MAT(I.ptr(10) + (size_t)l * 1024 * DM, 1024, DM, lwp(F, l, LW_WCAT), DM, 0, 0, 0, 0, 0, 0, DM)
        XP_MAT(I.ptr(15) + (size_t)l * 512 * DM, 512, DM, lwp(F, l, LW_WCAT), DM, 1024, 0, 0, 0, 0, 0, DM)
        XP_MAT(I.ptr(26) + (size_t)l * 512 * DM, 512, DM, lwp(F, l, LW_WCAT), DM, 1536, 0, 0, 0, 0, 0, DM)
        XP_MAT(I.ptr(24) + (size_t)l * 512 * 1024, 512, 1024, lwp(F, l, LW_WGLU), 512, 0, 2, 0, 512, 0, 0, 1024)
        XP_MAT(I.ptr(27) + (size_t)l * DM * DM, DM, DM, lwp(F, l, LW_WMIX), DM, 0, 0, 0, 0, 0, 0, DM)
        if (r < 2 * IT_G) { const int up = r >= IT_G; if (up) r -= IT_G; const int e = r / (32 * 8); r %= (32 * 8);
            const float* w = I.ptr(up ? 39 : 38) + ((size_t)l * NEXP + e) * DM * FFE;
            xpose_item8(w, FFE, lwp(F, l, LW_WGU) + (size_t)e * 1024 * DM, DM, up ? 4 : 3, 0, 64 * (r / 8), 64 * (r % 8), F.lane, GATE_WSCALE); continue; }
        r -= 2 * IT_G;
        { const int e = r / (8 * 32); r %= (8 * 32); const float* w = I.ptr(40) + ((size_t)l * NEXP + e) * FFE * DM;
            xpose_item8(w, DM, lwp(F, l, LW_WD) + (size_t)e * DM * FFE, FFE, 0, 0, 64 * (r / 32), 64 * (r % 32), F.lane, GATE_WSCALE); }
    } while (0);
}
__device__ __forceinline__ void conv_item_xa(const Ctx& F, const Inputs& I, const int l, int r) {
    do {
        XP_MAT(I.ptr(31) + (size_t)l * DM * 1024, DM, 1024, F.ws + WS_WKVT + (size_t)l * 1024 * DM * 2, DM, 0, 0, 0, 0, 0, 0, 1024)
        XP_MAT(I.ptr(32) + (size_t)l * 512 * DM, 512, DM, F.ws + WS_WXOT + (size_t)l * DM * 512 * 2, 512, 0, 0, 0, 0, 0, 0, DM)
    } while (0);
}
__device__ __forceinline__ void conv_window(const Ctx& F, const Inputs& I, const int l, const int base, const int wave_rank, const int nper) {
#pragma unroll 1
    for (int k = 0; k < nper; ++k) { const int r = base + wave_rank * nper + k; if (r < IT_BIG) conv_item(F, I, l, r); }
}
__device__ __forceinline__ void ph_prologue_a(const Ctx& F, const Inputs& I) {
    for (int it = F.gw; it < ((DEFER_CONV && F.G == 256) ? 1 : NL) * IT_BIG; it += F.NGW) conv_item(F, I, it / IT_BIG, it % IT_BIG);
    for (int it = F.gw; it < NL * (IT_KV + IT_XO); it += F.NGW) conv_item_xa(F, I, it / (IT_KV + IT_XO), it % (IT_KV + IT_XO));
    for (size_t i = (size_t)F.gw * 64 + F.lane; i < (size_t)NL * DM * 512 / 8; i += (size_t)F.NGW * 64) {
        const f32x4 a = *(const f32x4*)(I.ptr(30) + i * 8), b = *(const f32x4*)(I.ptr(30) + i * 8 + 4); const float g = FUSE_N2 ? I.ptr(28)[(i * 8) / 512] : 1.f;
        u32x4 o; o.x = pk2(a[0] * g, a[1] * g); o.y = pk2(a[2] * g, a[3] * g); o.z = pk2(b[0] * g, b[1] * g); o.w = pk2(b[2] * g, b[3] * g); *(u32x4*)(F.ws + WS_WQB + i * 16) = o; }
    for (int i = F.gw * 64 + F.lane; i < NL * 20 * DM; i += F.NGW * 64) { const int l = i / (20 * DM), j = (i / DM) % 20, k = i % DM;
        const float g = I.ptr(33)[l * DM + k]; const float w = j < 4 ? I.ptr(34)[((size_t)l * DM + k) * 4 + j] : I.ptr(36)[((size_t)l * DM + k) * 16 + (j - 4)];
        const float p = g * w; const unsigned hb = pk2(p, 0.f) & 0xffffu; const unsigned lb = pk2(p - bflo(hb), 0.f) & 0xffffu;
        ((unsigned short*)lwp(F, l, LW_RT))[j * DM + k] = (unsigned short)hb; ((unsigned short*)lwp(F, l, LW_RT))[(20 + j) * DM + k] = (unsigned short)lb; }
    for (int i = F.gw * 64 + F.lane; i < T * 32; i += F.NGW * 64) { const int t = i >> 5, d = i & 31;
        const double inv = exp(-(double)d * (1.0 / 32.0) * 9.210340371976184); float s, c; sincos_d((double)((const int*)I.ptr(2))[t] * inv, s, c);
        ((float*)(F.ws + WS_ROPE))[i] = c; ((float*)(F.ws + WS_ROPE))[T * 32 + i] = s; }
    for (int rw = F.gw; rw < NL * MEML; rw += F.NGW) { const int l = rw / MEML, m = rw % MEML;
        const f32x4* xr = (const f32x4*)(I.ptr(1) + (size_t)m * DM) + F.lane; f32x4 v[8]; float s = 0.f;
#pragma unroll
        for (int j = 0; j < 8; ++j) { v[j] = xr[64 * j]; s += (v[j][0] * v[j][0] + v[j][1] * v[j][1]) + (v[j][2] * v[j][2] + v[j][3] * v[j][3]); }
        const float rstd = rsqrtf(wave_sum(s) * (1.f / DM) + RMS_EPS);
        const f32x4* gr = (const f32x4*)(I.ptr(29) + (size_t)l * DM) + F.lane; u32x2* o = (u32x2*)(F.ws + WS_MNORM + (size_t)rw * DM * 2) + F.lane;
#pragma unroll
        for (int j = 0; j < 8; ++j) { const f32x4 g = gr[64 * j]; u32x2 w; w.x = pk2(v[j][0] * rstd * g[0], v[j][1] * rstd * g[1]); w.y = pk2(v[j][2] * rstd * g[2], v[j][3] * rstd * g[3]); o[64 * j] = w; } }
    __syncthreads();
    for (int it = F.vcu; it < NL * 32; it += F.G) {
        const int l = it >> 5, g = it & 31;
        LAS f32x2* lamP = (LAS f32x2*)(F.lds + RING_OFF);
        LAS f32x2* Bb = lamP + 33 * 64;
        LAS f32x2* Cc = Bb + 64 * 16;
        LAS float* Kt = (LAS float*)(Cc + 16 * 64);
        LAS f32x2* fz = (LAS f32x2*)(Kt + 32 * 256);
        if (F.tid < 64) { const int p = F.tid; const float lr = I.ptr(16)[(l * 32 + g) * 64 + p], li = I.ptr(17)[(l * 32 + g) * 64 + p]; const float dt = expf(I.ptr(18)[l * 32 + g]);
            for (int tau = 0; tau <= 32; ++tau) { float s, c; sincos_d((double)tau * (double)li * (double)dt, s, c); const float mg = expf((float)tau * lr * dt); lamP[tau * 64 + p] = (f32x2){mg * c, mg * s}; }
            float s1, c1; sincos_d((double)li * (double)dt, s1, c1); const float mg1 = expf(lr * dt), abr = mg1 * c1, abi = mg1 * s1, den = lr * lr + li * li;
            fz[p] = (f32x2){((abr - 1.f) * lr + abi * li) / den, (abi * lr - (abr - 1.f) * li) / den};
            ((f32x2*)lwp(F, l, LW_LAM))[g * 64 + p] = lamP[32 * 64 + p]; }
        __syncthreads();
        for (int i = F.tid; i < 1024; i += 512) { const int p = i >> 4, h = i & 15; const float br = I.ptr(19)[((size_t)(l * 32 + g) * 64 + p) * 16 + h], bi = I.ptr(20)[((size_t)(l * 32 + g) * 64 + p) * 16 + h]; const f32x2 f = fz[p];
            Bb[i] = (f32x2){f[0] * br - f[1] * bi, f[0] * bi + f[1] * br};
            const int hh = i >> 6, pp = i & 63; Cc[i] = (f32x2){I.ptr(21)[((size_t)(l * 32 + g) * 16 + hh) * 64 + pp], I.ptr(22)[((size_t)(l * 32 + g) * 16 + hh) * 64 + pp]}; }
        __syncthreads();
        for (int i = F.tid; i < 32 * 256; i += 512) { const int tau = i >> 8, h = (i >> 4) & 15, h2 = i & 15; float a = 0.f;
            for (int p = 0; p < 64; ++p) { const f32x2 lm = lamP[tau * 64 + p], b = Bb[p * 16 + h2], c = Cc[h * 64 + p]; const float wr_ = lm[0] * b[0] - lm[1] * b[1], wi_ = lm[0] * b[1] + lm[1] * b[0]; a += c[0] * wr_ - c[1] * wi_; }
            if (tau == 0 && h == h2) a += I.ptr(23)[(l * 32 + g) * 16 + h];
            Kt[i] = a; }
        __syncthreads();
        bf16_t* bke = (bf16_t*)(lwp(F, l, LW_BKE) + (size_t)g * 512 * 640 * 2);
        for (int i = F.tid; i < 512 * 80; i += 512) { const int n = i / 80, k8 = i % 80, j = n >> 4, h = n & 15; float v[8];
            if (k8 < 64) { const int ii = k8 >> 1, h0 = (k8 & 1) * 8;
#pragma unroll
                for (int q = 0; q < 8; ++q) v[q] = (ii <= j) ? Kt[(j - ii) * 256 + h * 16 + h0 + q] : 0.f; }
            else { const int p0 = (k8 - 64) * 4;
#pragma unroll
                for (int q = 0; q < 4; ++q) { const f32x2 c = Cc[h * 64 + p0 + q], lm = lamP[(j + 1) * 64 + p0 + q]; v[2 * q] = c[0] * lm[0] - c[1] * lm[1]; v[2 * q + 1] = -(c[0] * lm[1] + c[1] * lm[0]); } }
            u32x4 o; o.x = pk2(v[0], v[1]); o.y = pk2(v[2], v[3]); o.z = pk2(v[4], v[5]); o.w = pk2(v[6], v[7]); *(u32x4*)(bke + (size_t)n * 640 + k8 * 8) = o; }
        bf16_t* fm = (bf16_t*)(lwp(F, l, LW_F) + (size_t)g * 128 * 512 * 2);
        for (int i = F.tid; i < 128 * 64; i += 512) { const int n = i >> 6, k8 = i & 63, p = n >> 1, im = n & 1, ii = k8 >> 1, h0 = (k8 & 1) * 8; float v[8]; const f32x2 lm = lamP[(31 - ii) * 64 + p];
#pragma unroll
            for (int q = 0; q < 8; ++q) { const f32x2 b = Bb[p * 16 + h0 + q]; v[q] = im ? (lm[0] * b[1] + lm[1] * b[0]) : (lm[0] * b[0] - lm[1] * b[1]); }
            u32x4 o; o.x = pk2(v[0], v[1]); o.y = pk2(v[2], v[3]); o.z = pk2(v[4], v[5]); o.w = pk2(v[6], v[7]); *(u32x4*)(fm + (size_t)n * 512 + k8 * 8) = o; }
        __syncthreads();
    }
}

__device__ __forceinline__ void ph_norm1(const Ctx& F, int l, const float* xin, const float* gain, float* fout) {
    char* X = (char*)(F.ws + WS_X);
    for (int rowb = F.gw; rowb < T; rowb += 2 * F.NGW) {
        f32x4 v[2][8];
        if (l == 0) {
#pragma unroll
            for (int r = 0; r < 2; ++r) { const int row = rowb + r * F.NGW; if (row < T) { const f32x4* xr = (const f32x4*)(xin + (size_t)row * DM) + F.lane;
#pragma unroll
                for (int j = 0; j < 8; ++j) v[r][j] = xr[64 * j]; } } }
        else {
            const int cv = (F.lane < 16) ? (int)__hip_atomic_load(F.ctl + CW_CNT + ((l - 1) * 16 + F.lane) * 16, RLX_AGENT) : 0;
            int4 tk[2];
#pragma unroll
            for (int r = 0; r < 2; ++r) { const int row = rowb + r * F.NGW; tk[r] = (row < T) ? *(const int4*)(F.ws + WS_TOK + (size_t)row * 16) : make_int4(0, 0, 0, 0); }
            unsigned ya[2][8], yb[2][8]; u32x2 xq[2][8];
#pragma unroll
            for (int r = 0; r < 2; ++r) { const int row = rowb + r * F.NGW; if (row < T) {
                int o0 = 0, o1 = 0;
#pragma unroll
                for (int k = 0; k < 16; ++k) { const int ck = __builtin_amdgcn_readlane(cv, k); o0 += (k < tk[r].x) ? ck : 0; o1 += (k < tk[r].z) ? ck : 0; }
                const unsigned* y0 = (const unsigned*)(F.ws + WS_Y + (size_t)(o0 + tk[r].y) * 2048) + F.lane; const unsigned* y1 = (const unsigned*)(F.ws + WS_Y + (size_t)(o1 + tk[r].w) * 2048) + F.lane;
                const u32x2* xr = (const u32x2*)(X + (size_t)row * DM * 2) + F.lane;
#pragma unroll
                for (int j = 0; j < 8; ++j) { ya[r][j] = y0[64 * j]; yb[r][j] = y1[64 * j]; xq[r][j] = xr[64 * j]; } } }
#pragma unroll
            for (int r = 0; r < 2; ++r)
#pragma unroll
                for (int j = 0; j < 8; ++j) { const int a = (int)ya[r][j], b = (int)yb[r][j]; const u32x2 xb = xq[r][j]; f32x4 x = (f32x4){bflo(xb.x), bfhi(xb.x), bflo(xb.y), bfhi(xb.y)};
#ifndef DBG_NO_MOE
                    const f32x2 a0 = __builtin_amdgcn_cvt_pk_f32_fp8(a, false), a1 = __builtin_amdgcn_cvt_pk_f32_fp8(a, true), b0 = __builtin_amdgcn_cvt_pk_f32_fp8(b, false), b1 = __builtin_amdgcn_cvt_pk_f32_fp8(b, true);
                    x[0] += (a0[0] + b0[0]) * (1.f / 16.f); x[1] += (a0[1] + b0[1]) * (1.f / 16.f); x[2] += (a1[0] + b1[0]) * (1.f / 16.f); x[3] += (a1[1] + b1[1]) * (1.f / 16.f);
#endif
                    v[r][j] = x; } }
        const f32x4* gr = (const f32x4*)gain + F.lane;
#pragma unroll
        for (int r = 0; r < 2; ++r) { const int row = rowb + r * F.NGW; if (row < T) {
            float s = 0.f;
#pragma unroll
            for (int j = 0; j < 8; ++j) s += (v[r][j][0] * v[r][j][0] + v[r][j][1] * v[r][j][1]) + (v[r][j][2] * v[r][j][2] + v[r][j][3] * v[r][j][3]);
            const float rstd = rsqrtf(wave_sum(s) * (1.f / DM) + RMS_EPS);
            if (fout) { f32x4* o = (f32x4*)(fout + (size_t)row * DM) + F.lane;
#pragma unroll
                for (int j = 0; j < 8; ++j) { const f32x4 g = gr[64 * j]; o[64 * j] = (f32x4){v[r][j][0] * rstd * g[0], v[r][j][1] * rstd * g[1], v[r][j][2] * rstd * g[2], v[r][j][3] * rstd * g[3]}; } }
            else { u32x2* xo = (u32x2*)(X + (size_t)row * DM * 2) + F.lane; unsigned* o8 = (unsigned*)(F.ws + WS_H8 + (size_t)row * DM) + F.lane;
                if (F.lane == 0) ((float*)(F.ws + WS_RSTD))[row] = rstd;
#pragma unroll
                for (int j = 0; j < 8; ++j) { u32x2 xw; xw.x = pk2(v[r][j][0], v[r][j][1]); xw.y = pk2(v[r][j][2], v[r][j][3]); xo[64 * j] = xw;
                    int p8 = __builtin_amdgcn_cvt_pk_fp8_f32(v[r][j][0], v[r][j][1], 0, false); p8 = __builtin_amdgcn_cvt_pk_fp8_f32(v[r][j][2], v[r][j][3], p8, true); o8[64 * j] = (unsigned)p8; } } } }
    }
}
__device__ __forceinline__ void ph_norm2(const Ctx& F, const float* gain) {
    const float* X = (const float*)(F.ws + WS_X);
    for (int row = F.gw; row < T; row += F.NGW) {
        const f32x4* xr = (const f32x4*)(X + (size_t)row * DM) + F.lane; f32x4 v[8]; float s = 0.f;
#pragma unroll
        for (int j = 0; j < 8; ++j) { v[j] = xr[64 * j]; s += (v[j][0] * v[j][0] + v[j][1] * v[j][1]) + (v[j][2] * v[j][2] + v[j][3] * v[j][3]); }
        const float rstd = rsqrtf(wave_sum(s) * (1.f / DM) + RMS_EPS);
        const f32x4* gr = (const f32x4*)gain + F.lane; u32x2* o = (u32x2*)(F.ws + WS_H + (size_t)row * DM * 2) + F.lane;
#pragma unroll
        for (int j = 0; j < 8; ++j) { const f32x4 g = gr[64 * j]; u32x2 w; w.x = pk2(v[j][0] * rstd * g[0], v[j][1] * rstd * g[1]); w.y = pk2(v[j][2] * rstd * g[2], v[j][3] * rstd * g[3]); o[64 * j] = w; }
    }
}
__device__ __forceinline__ void ph_conv(const Ctx& F, const float* dww, const float* dwb, const float* lng, const float* lnb) {
    LAS float* cs = (LAS float*)(F.lds + RING_OFF);
    const bf16_t* Z = (const bf16_t*)(F.ws + WS_Z);
    for (int run = F.vcu; run < T / 32; run += F.G) {
        const int t0 = run * 32, c = F.tid;
        float w[31];
#pragma unroll
        for (int k = 0; k < 31; ++k) w[k] = dww[k * 512 + c];
        const float b = dwb[c];
        float zz[62];
#pragma unroll
        for (int i = 0; i < 62; ++i) { const int t = t0 - 30 + i; zz[i] = (t >= 0) ? bf2f(Z[(size_t)t * 512 + c]) : 0.f; }
#pragma unroll
        for (int j = 0; j < 32; ++j) { float a = b;
#pragma unroll
            for (int k = 0; k < 31; ++k) a += w[k] * zz[j + k];
            cs[j * 512 + c] = a; }
        __syncthreads();
#pragma unroll
        for (int q = 0; q < 4; ++q) { const int j = F.wave * 4 + q; const f32x4 a0 = *(const LAS f32x4*)(cs + j * 512 + F.lane * 8), a1 = *(const LAS f32x4*)(cs + j * 512 + F.lane * 8 + 4);
            const float mu = wave_sum((a0[0] + a0[1]) + (a0[2] + a0[3]) + (a1[0] + a1[1]) + (a1[2] + a1[3])) * (1.f / 512.f);
            const f32x4 d0 = a0 - mu, d1 = a1 - mu;
            const float var = wave_sum((d0[0] * d0[0] + d0[1] * d0[1]) + (d0[2] * d0[2] + d0[3] * d0[3]) + (d1[0] * d1[0] + d1[1] * d1[1]) + (d1[2] * d1[2] + d1[3] * d1[3])) * (1.f / 512.f);
            const float rstd = rsqrtf(var + LN_EPS);
            const f32x4 g0 = *(const f32x4*)(lng + F.lane * 8), g1 = *(const f32x4*)(lng + F.lane * 8 + 4), b0 = *(const f32x4*)(lnb + F.lane * 8), b1 = *(const f32x4*)(lnb + F.lane * 8 + 4);
            f32x4 y0 = d0 * rstd * g0 + b0, y1 = d1 * rstd * g1 + b1;
#pragma unroll
            for (int i = 0; i < 4; ++i) { y0[i] = y0[i] * sigmoidf_(y0[i]); y1[i] = y1[i] * sigmoidf_(y1[i]); }
            u32x4 o; o.x = pk2(y0[0], y0[1]); o.y = pk2(y0[2], y0[3]); o.z = pk2(y1[0], y1[1]); o.w = pk2(y1[2], y1[3]);
            *(u32x4*)(F.ws + WS_CVO + ((size_t)(t0 + j) * 512 + F.lane * 8) * 2) = o; }
        __syncthreads();
    }
}
__device__ __forceinline__ void ph_ssm2(const Ctx& F, int l) {
    if (F.vcu < 64) { const int g = F.vcu >> 1, p = (F.vcu & 1) * 32 + (F.tid & 31), q = F.tid >> 5; const f32x2 lm = ((const f32x2*)lwp(F, l, LW_LAM))[g * 64 + p];
        LAS f32x2* Tq = (LAS f32x2*)(F.lds + RING_OFF);
        const float* S = (const float*)(F.ws + WS_SS) + g * 128 + 2 * p + (size_t)(16 * q) * 4096;
        f32x2 sv[16];
#pragma unroll
        for (int i = 0; i < 16; ++i) sv[i] = *(const f32x2*)(S + (size_t)i * 4096);
        f32x2 loc[16]; float xr = 0.f, xi = 0.f;
#pragma unroll
        for (int i = 0; i < 16; ++i) { const float nr = lm[0] * xr - lm[1] * xi + sv[i][0], ni = lm[0] * xi + lm[1] * xr + sv[i][1]; xr = nr; xi = ni; loc[i] = (f32x2){xr, xi}; }
        Tq[q * 32 + (F.tid & 31)] = loc[15];
        float pr = lm[0], pi = lm[1];
#pragma unroll
        for (int k = 0; k < 4; ++k) { const float nr = pr * pr - pi * pi, ni = 2.f * pr * pi; pr = nr; pi = ni; }
        __syncthreads();
        float cr = 0.f, ci = 0.f;
        for (int qq = 0; qq < q; ++qq) { const f32x2 t = Tq[qq * 32 + (F.tid & 31)]; const float nr = pr * cr - pi * ci + t[0], ni = pr * ci + pi * cr + t[1]; cr = nr; ci = ni; }
        unsigned* xp = (unsigned*)(F.ws + WS_XP) + ((size_t)g * 256 + 16 * q) * 64 + p;
        xp[0] = pk2(cr, ci);
#pragma unroll
        for (int i = 1; i < 16; ++i) { const float nr = lm[0] * cr - lm[1] * ci, ni = lm[0] * ci + lm[1] * cr; cr = nr; ci = ni; xp[i * 64] = pk2(cr + loc[i - 1][0], ci + loc[i - 1][1]); }
    }
    __syncthreads();
}
#if NAIVE_SSM
__device__ __forceinline__ void ph_ssm_naive(const Ctx& F, int l, const Inputs& I) {
    if (F.vcu < 32) { const int g = F.vcu; LAS f32x2* xs = (LAS f32x2*)(F.lds + RING_OFF); LAS float* us = (LAS float*)(xs + 64);
        float br[16], bi[16], abr = 0.f, abi = 0.f, xr = 0.f, xi = 0.f, cr[64], ci[64], dsk = 0.f;
        if (F.tid < 64) { const int p = F.tid; const float lr = I.ptr(16)[(l * 32 + g) * 64 + p], li = I.ptr(17)[(l * 32 + g) * 64 + p]; const float dt = expf(I.ptr(18)[l * 32 + g]);
            float s1, c1; sincos_d((double)li * (double)dt, s1, c1); const float mg1 = expf(lr * dt); abr = mg1 * c1; abi = mg1 * s1; const float den = lr * lr + li * li;
            const float fr_ = ((abr - 1.f) * lr + abi * li) / den, fi_ = (abi * lr - (abr - 1.f) * li) / den;
#pragma unroll
            for (int h = 0; h < 16; ++h) { const float b_r = I.ptr(19)[((size_t)(l * 32 + g) * 64 + p) * 16 + h], b_i = I.ptr(20)[((size_t)(l * 32 + g) * 64 + p) * 16 + h]; br[h] = fr_ * b_r - fi_ * b_i; bi[h] = fr_ * b_i + fi_ * b_r; } }
        if (F.tid < 16) { const int h = F.tid;
#pragma unroll
            for (int p = 0; p < 64; ++p) { cr[p] = I.ptr(21)[((size_t)(l * 32 + g) * 16 + h) * 64 + p]; ci[p] = I.ptr(22)[((size_t)(l * 32 + g) * 16 + h) * 64 + p]; }
            dsk = I.ptr(23)[(l * 32 + g) * 16 + h]; }
        const bf16_t* UC = (const bf16_t*)(F.ws + WS_UC) + (size_t)g * 256 * 512;
#pragma unroll 1
        for (int t = 0; t < T; ++t) {
            if (F.tid < 16) us[F.tid] = bf2f(UC[(size_t)(t >> 5) * 512 + (t & 31) * 16 + F.tid]);
            __syncthreads();
            if (F.tid < 64) { float ar = 0.f, ai = 0.f;
#pragma unroll
                for (int h = 0; h < 16; ++h) { ar += br[h] * us[h]; ai += bi[h] * us[h]; }
                const float nr = abr * xr - abi * xi + ar, ni = abr * xi + abi * xr + ai; xr = nr; xi = ni; xs[F.tid] = (f32x2){xr, xi}; }
            __syncthreads();
            if (F.tid < 16) { float y = dsk * us[F.tid];
#pragma unroll
                for (int p = 0; p < 64; ++p) { const f32x2 x = xs[p]; y += cr[p] * x[0] - ci[p] * x[1]; }
                ((bf16_t*)(F.ws + WS_YS))[(size_t)t * 512 + g * 16 + F.tid] = (bf16_t)f2bf(y); }
        }
        __syncthreads();
    }
}
#endif
__device__ __forceinline__ void ph_diff(const Ctx& F, int l, const Inputs& I) {
    const float lam_init = 0.8f - 0.6f * expf(-0.3f * (float)l);
    const float d1 = wave_sum(I.ptr(5)[l * 64 + F.lane] * I.ptr(6)[l * 64 + F.lane]), d2 = wave_sum(I.ptr(7)[l * 64 + F.lane] * I.ptr(8)[l * 64 + F.lane]);
    const float lam = expf(d1) - expf(d2) + lam_init, post = 1.f - lam_init;
    float hn[16];
#pragma unroll
    for (int i = 0; i < 16; ++i) hn[i] = I.ptr(9)[l * 128 + (F.lane & 7) * 16 + i] * post;
    for (int row = F.gw; row < T; row += F.NGW) {
        const u32x4* a = (const u32x4*)(F.ws + WS_O1 + (size_t)row * 2048) + F.lane * 2; const u32x4* b = (const u32x4*)(F.ws + WS_O2 + (size_t)row * 2048) + F.lane * 2;
        float d[16]; float ss = 0.f;
#pragma unroll
        for (int q = 0; q < 2; ++q) { const u32x4 x = a[q], y = b[q];
            d[q * 8 + 0] = bflo(x.x) - lam * bflo(y.x); d[q * 8 + 1] = bfhi(x.x) - lam * bfhi(y.x); d[q * 8 + 2] = bflo(x.y) - lam * bflo(y.y); d[q * 8 + 3] = bfhi(x.y) - lam * bfhi(y.y);
            d[q * 8 + 4] = bflo(x.z) - lam * bflo(y.z); d[q * 8 + 5] = bfhi(x.z) - lam * bfhi(y.z); d[q * 8 + 6] = bflo(x.w) - lam * bflo(y.w); d[q * 8 + 7] = bfhi(x.w) - lam * bfhi(y.w); }
#pragma unroll
        for (int i = 0; i < 16; ++i) ss += d[i] * d[i];
        ss += xor_lane<1>(ss); ss += xor_lane<2>(ss); ss += xor_lane<4>(ss);
        const float rstd = rsqrtf(ss * (1.f / 128.f) + HEAD_EPS);
        u32x4* o = (u32x4*)(F.ws + WS_OAN + (size_t)row * 2048) + F.lane * 2;
#pragma unroll
        for (int q = 0; q < 2; ++q) { u32x4 w; w.x = pk2(d[q * 8 + 0] * rstd * hn[q * 8 + 0], d[q * 8 + 1] * rstd * hn[q * 8 + 1]); w.y = pk2(d[q * 8 + 2] * rstd * hn[q * 8 + 2], d[q * 8 + 3] * rstd * hn[q * 8 + 3]);
            w.z = pk2(d[q * 8 + 4] * rstd * hn[q * 8 + 4], d[q * 8 + 5] * rstd * hn[q * 8 + 5]); w.w = pk2(d[q * 8 + 6] * rstd * hn[q * 8 + 6], d[q * 8 + 7] * rstd * hn[q * 8 + 7]); o[q] = w; }
    }
}
__device__ __forceinline__ void ph_norm3_router(const Ctx& F, int l, const Inputs& I, const bool commit = true) {
    const char* X = (const char*)(F.ws + WS_X); LAS float* part = (LAS float*)(F.lds + RING_OFF);
    const char* RT = (const char*)lwp(F, l, LW_RT);
    for (int run = F.vcu; run < T / 32; run += F.G) {
        const int r0 = run * 32;
        int ln = F.lane; asm volatile("" : "+v"(ln));
        const int fr = ln & 15, fq = ln >> 4;
        const unsigned lo16 = (unsigned)ln * 16u;
        f32x4 acc[2][2];
#pragma unroll
        for (int m = 0; m < 2; ++m)
#pragma unroll
            for (int n = 0; n < 2; ++n) acc[m][n] = (f32x4){0.f, 0.f, 0.f, 0.f};
        {
            const char* xa = X + (size_t)(r0 + fr) * (DM * 2) + (unsigned)((F.wave * 256 + fq * 8) * 2);
            const char* wa = RT + (size_t)fr * (DM * 2) + (unsigned)((F.wave * 256 + fq * 8) * 2);
            const char* wb = RT + (size_t)(16 + (fr & 3)) * (DM * 2) + (unsigned)((F.wave * 256 + fq * 8) * 2);
#pragma unroll 4
            for (int ks = 0; ks < 8; ++ks) {
                const bf16x8 x0 = *(const bf16x8*)(xa + ks * 64), x1 = *(const bf16x8*)(xa + 16 * DM * 2 + ks * 64);
                const bf16x8 ha = *(const bf16x8*)(wa + ks * 64), la = *(const bf16x8*)(wa + 20 * DM * 2 + ks * 64), hb = *(const bf16x8*)(wb + ks * 64), lb = *(const bf16x8*)(wb + 20 * DM * 2 + ks * 64);
                acc[0][0] = __builtin_amdgcn_mfma_f32_16x16x32_bf16(ha, x0, acc[0][0], 0, 0, 0); acc[1][0] = __builtin_amdgcn_mfma_f32_16x16x32_bf16(ha, x1, acc[1][0], 0, 0, 0);
                acc[0][1] = __builtin_amdgcn_mfma_f32_16x16x32_bf16(hb, x0, acc[0][1], 0, 0, 0); acc[1][1] = __builtin_amdgcn_mfma_f32_16x16x32_bf16(hb, x1, acc[1][1], 0, 0, 0);
                acc[0][0] = __builtin_amdgcn_mfma_f32_16x16x32_bf16(la, x0, acc[0][0], 0, 0, 0); acc[1][0] = __builtin_amdgcn_mfma_f32_16x16x32_bf16(la, x1, acc[1][0], 0, 0, 0);
                acc[0][1] = __builtin_amdgcn_mfma_f32_16x16x32_bf16(lb, x0, acc[0][1], 0, 0, 0); acc[1][1] = __builtin_amdgcn_mfma_f32_16x16x32_bf16(lb, x1, acc[1][1], 0, 0, 0);
            }
        }
        __syncthreads();
#pragma unroll
        for (int m = 0; m < 2; ++m) { LAS float* pw = part + ((F.wave * 32 + 16 * m + fr) * 24);
            *(LAS f32x4*)(pw + 4 * fq) = acc[m][0]; if (fq == 0) *(LAS f32x4*)(pw + 16) = acc[m][1]; }
        __syncthreads();
        u32x2 xb[4][8];
#pragma unroll
        for (int rr = 0; rr < 4; ++rr)
#pragma unroll
            for (int j = 0; j < 8; ++j) xb[rr][j] = *(const u32x2*)(X + (size_t)(r0 + F.wave * 4 + rr) * (DM * 2) + 512 * j + (lo16 >> 1));
#pragma unroll
        for (int rr = 0; rr < 4; ++rr) { const int rl = F.wave * 4 + rr, row = r0 + rl;
            float lgv = 0.f;
            if (ln < 20) {
#pragma unroll
                for (int w = 0; w < 8; ++w) lgv += part[(w * 32 + rl) * 24 + ln]; }
            f32x4 v[8]; float ss = 0.f;
#pragma unroll
            for (int j = 0; j < 8; ++j) { v[j] = (f32x4){bflo(xb[rr][j].x), bfhi(xb[rr][j].x), bflo(xb[rr][j].y), bfhi(xb[rr][j].y)}; ss += (v[j][0] * v[j][0] + v[j][1] * v[j][1]) + (v[j][2] * v[j][2] + v[j][3] * v[j][3]); }
            const float rstd = rsqrtf(wave_sum(ss) * (1.f / DM) + RMS_EPS);
            float lg[20];
#pragma unroll
            for (int j = 0; j < 20; ++j) lg[j] = __builtin_bit_cast(float, __builtin_amdgcn_readlane(__builtin_bit_cast(int, lgv), j));
            float gl[4], el[16];
#pragma unroll
            for (int i = 0; i < 4; ++i) gl[i] = lg[i] * rstd + I.ptr(35)[l * 4 + i];
#pragma unroll
            for (int i = 0; i < 16; ++i) el[i] = lg[4 + i] * rstd + I.ptr(37)[l * 16 + i];
            int gi = 0; float gm = gl[0];
#pragma unroll
            for (int i = 1; i < 4; ++i) if (gl[i] > gm) { gm = gl[i]; gi = i; }
            float gs = 0.f;
#pragma unroll
            for (int i = 0; i < 4; ++i) gs += expf(gl[i] - gm);
            const float gw_ = 1.f / gs;
            float sel[4];
#pragma unroll
            for (int i = 0; i < 4; ++i) sel[i] = gi == 0 ? el[i] : gi == 1 ? el[4 + i] : gi == 2 ? el[8 + i] : el[12 + i];
            int i0 = 0; float v0 = sel[0];
#pragma unroll
            for (int i = 1; i < 4; ++i) if (sel[i] > v0) { v0 = sel[i]; i0 = i; }
            int i1 = -1; float v1 = -INFINITY;
#pragma unroll
            for (int i = 0; i < 4; ++i) if (i != i0 && sel[i] > v1) { v1 = sel[i]; i1 = i; }
            const float w0 = gw_ / (1.f + expf(v1 - v0)), w1 = gw_ - w0;
            const int e0 = gi * 4 + i0, e1 = gi * 4 + i1;
            if (F.lane == 0 && commit) {
                const int s0 = (int)__hip_atomic_fetch_add(F.ctl + CW_CNT + (l * 16 + e0) * 16, 1u, RLX_AGENT), s1 = (int)__hip_atomic_fetch_add(F.ctl + CW_CNT + (l * 16 + e1) * 16, 1u, RLX_AGENT);
                ((int*)(F.ws + WS_LIST))[e0 * T + s0] = row; ((float*)(F.ws + WS_WL))[e0 * T + s0] = w0;
                ((int*)(F.ws + WS_LIST))[e1 * T + s1] = row; ((float*)(F.ws + WS_WL))[e1 * T + s1] = w1;
                *(int4*)(F.ws + WS_TOK + (size_t)row * 16) = make_int4(e0, s0, e1, s1); }
            const char* gr = (const char*)(I.ptr(33) + (size_t)l * DM); char* o = (char*)(F.ws + WS_H8 + (size_t)row * DM);
#pragma unroll
            for (int j = 0; j < 8; ++j) { const f32x4 g = *(const f32x4*)(gr + 1024 * j + lo16);
                int p8 = __builtin_amdgcn_cvt_pk_fp8_f32(v[j][0] * rstd * g[0], v[j][1] * rstd * g[1], 0, false); p8 = __builtin_amdgcn_cvt_pk_fp8_f32(v[j][2] * rstd * g[2], v[j][3] * rstd * g[3], p8, true); *(unsigned*)(o + 256 * j + (lo16 >> 2)) = (unsigned)p8; }
        }
    }
    __syncthreads();
}
namespace pg8 {
struct SchedKV { unsigned char* ws; int G, c; static constexpr bool GATHER = false;
    __device__ __forceinline__ bool next(int i, GU& u) const { const int L = i * G + c; if (L >= 16) return false; const int l = L >> 2, pn = L & 3;
        u.A = (const char*)ws + WS_MNORM + (size_t)l * MEML * DM * 2; u.B = (const char*)ws + WS_WKVT + (size_t)l * 1024 * DM * 2 + (size_t)pn * 256 * 4096; u.C = (char*)ws + WS_KVB + (size_t)l * MEML * 2048 + pn * 512; u.P = nullptr;
        u.lda = 4096; u.ldb = 4096; u.nt = 32; u.pm = 0; u.pn = pn; u.seg = 0; u.flags = GU_LAST; u.rows = 256; u.aux = __builtin_bit_cast(int, 1.0f); u.f8 = 0; return true; }
    __device__ __forceinline__ unsigned arow(const GU& u, int r) const { return (unsigned)(r * u.lda); } };
struct SchedAbsorb { unsigned char* ws; int G, c; static constexpr bool GATHER = false;
    __device__ __forceinline__ bool next(int i, GU& u) const { const int L = i * G + c; if (L >= 256) return false; const int w = L & 127, l = w >> 5, h = (w >> 3) & 3, t = w & 7;
        unsigned char* lw = ws + WS_LW + (size_t)l * LW_SIZE; const char* kvb = (const char*)ws + WS_KVB + (size_t)l * MEML * 2048;
        int two = 2; asm volatile("" : "+s"(two));
        u.P = nullptr; u.nt = two; u.pm = 0; u.pn = 0; u.seg = 0; u.flags = GU_LAST; u.rows = 256;
        if (L < 128) { u.A = kvb + h * 256; u.lda = 2048; u.B = (const char*)ws + WS_WQB + (size_t)l * DM * 1024 + (size_t)t * 256 * 1024 + h * 256; u.ldb = 1024;
            u.C = (char*)lw + LW_WQK + (size_t)(h * 256) * (S_FP8 ? 2048 : 4096) + t * (S_FP8 ? 256 : 512); u.aux = __builtin_bit_cast(int, C2X * SQK_SCALE); u.f8 = 0; u.seg = S_FP8; }
        else { u.A = (const char*)ws + WS_WXOT + (size_t)l * DM * 1024 + (size_t)t * 256 * 1024 + h * 256; u.lda = 1024; u.B = kvb + 1024 + h * 256; u.ldb = 2048;
            u.C = (char*)lw + LW_VW + (size_t)(t * 256) * (XAO_FP8 ? 1024 : 2048) + h * (XAO_FP8 ? 256 : 512); u.aux = __builtin_bit_cast(int, VW_SCALE); u.f8 = 0; u.seg = XAO_FP8; }
        u.pm = (L < 128) ? (S_FP8 ? 2048 : 4096) : (XAO_FP8 ? 1024 : 2048);
        return true; }
    __device__ __forceinline__ unsigned arow(const GU& u, int r) const { return (unsigned)(r * u.lda); } };
struct EpiStoreP {
    __device__ __forceinline__ void operator()(Acc& acc, const GU& u, int wr, int wc, int fr, int fq) const {
        const float sc = __builtin_bit_cast(float, u.aux);
        if (u.seg) { EPI_ROWS( { char* rp = u.C + (unsigned)(lrow * u.pm); EPI_COLS( { int q0 = __builtin_amdgcn_cvt_pk_fp8_f32(v0[0] * sc, v0[1] * sc, 0, false); q0 = __builtin_amdgcn_cvt_pk_fp8_f32(v0[2] * sc, v0[3] * sc, q0, true);
                int q1 = __builtin_amdgcn_cvt_pk_fp8_f32(v1[0] * sc, v1[1] * sc, 0, false); q1 = __builtin_amdgcn_cvt_pk_fp8_f32(v1[2] * sc, v1[3] * sc, q1, true); *(u32x2*)(rp + lcol) = (u32x2){(unsigned)q0, (unsigned)q1}; } ) } ) }
        else { EPI_ROWS( { char* rp = u.C + (unsigned)(lrow * u.pm); EPI_COLS( st8(rp + lcol * 2, v0 * sc, v1 * sc); ) } ) }
    } };
struct SchedSsm1 { unsigned char* ws; unsigned char* lw; int G, c; static constexpr bool GATHER = false;
    __device__ __forceinline__ bool next(int i, GU& u) const { const int g = i * G + c; if (g >= 32) return false;
        u.A = (const char*)ws + WS_UC + (size_t)g * 256 * 1024; u.lda = 1024; u.B = (const char*)lw + LW_F + (size_t)g * 128 * 1024; u.ldb = 1024; u.C = (char*)ws + WS_SS + g * 512; u.P = nullptr;
        u.nt = 8; u.pm = 0; u.pn = g; u.seg = 0; u.flags = GU_LAST; u.rows = 256; u.aux = 0; u.f8 = 0; return true; }
    __device__ __forceinline__ unsigned arow(const GU& u, int r) const { return (unsigned)(r * u.lda); } };
struct SchedSsm3 { unsigned char* ws; unsigned char* lw; int G, c; static constexpr bool GATHER = false;
    __device__ __forceinline__ bool next(int i, GU& u) const { const int ti = i >> 1, sg = i & 1, L = ti * G + c; if (L >= 64) return false; const int g = L >> 1, pn = L & 1;
        const char* b = (const char*)lw + LW_BKE + (size_t)g * 512 * 1280 + (size_t)pn * 256 * 1280;
        if (sg == 0) { u.A = (const char*)ws + WS_UC + (size_t)g * 256 * 1024; u.lda = 1024; u.B = b; u.nt = 8; }
        else { u.A = (const char*)ws + WS_XP + (size_t)g * 256 * 256; u.lda = 256; u.B = b + 1024; u.nt = 2; }
        u.ldb = 1280; u.C = nullptr; u.P = nullptr; u.pm = g; u.pn = pn; u.seg = sg; u.flags = sg ? GU_LAST : 0; u.rows = 256; u.aux = 0; u.f8 = 0; return true; }
    __device__ __forceinline__ unsigned arow(const GU& u, int r) const { return (unsigned)(r * u.lda); } };
}

constexpr int PH_PRO_A = 0, PH_PRO_B = 1, PH_PRO_C = 2, PH_L0 = 3, NPL = 15, PH_FINAL = PH_L0 + NL * NPL, NPHASES = PH_FINAL + 1;
constexpr int INTAB_OFF = LDSCTL_OFF + 1024;
struct Args { const float* in[42]; float* out; unsigned char* ws; int ph_lo, ph_hi; };
#define LAUNDER_S(x) asm volatile("" : "+s"(x))
#define MKCTX() Ctx F; { unsigned char* w_ = args.ws; LAUNDER_S(w_); F.ws = w_; F.lds = (LAS unsigned char*)lds_raw; F.ctl = (gu32*)(w_ + WS_CTL); \
    F.tid = tid_of(wave_s); F.lane = F.tid & 63; F.wave = __builtin_amdgcn_readfirstlane(F.tid >> 6); \
    int g_ = gridDim.x; LAUNDER_S(g_); F.G = g_; { int bx_ = blockIdx.x; LAUNDER_S(bx_); F.vcu = (g_ % 8 == 0) ? (bx_ % 8) * (g_ / 8) + bx_ / 8 : bx_; } \
    F.gw = F.vcu * NWAVES + F.wave; F.NGW = F.G * NWAVES; } \
    unsigned char* const ws = F.ws; (void)ws; const Inputs I{(const LAS unsigned*)(F.lds + INTAB_OFF)}; (void)I; int bx = blockIdx.x; LAUNDER_S(bx);
#if MK_PER_PHASE
#define GRID_BAR() do { } while (0)
#else
#define GRID_BAR() do { unsigned char* w_ = args.ws; LAUNDER_S(w_); XcdBarrier bar_; bar_.bar = (unsigned*)((gu32*)(w_ + WS_CTL) + CW_BAR); bar_.x = xb_xcc_id(); \
        bar_.st = (volatile LAS unsigned*)((LAS unsigned char*)lds_raw + MISC_OFF) + 8; xcd_barrier(bar_); } while (0)
#endif
#define IN(k) (lo <= (k) && (k) < hi)
#define SEAM(k) do { if (IN(k) && IN((k) + 1)) GRID_BAR(); } while (0)
#ifndef ONLY_LPH
#define ONLY_LPH -1
#endif
#define LPH_ON(j) (ONLY_LPH < 0 || ONLY_LPH == (j))
#ifndef DBG_DUP_MASK
#define DBG_DUP_MASK 0
#endif
#define NREP(j) (1 + ((DBG_DUP_MASK >> (j)) & 1))
#define INL(j) (LPH_ON(j) && lo <= (P0 + (j)) && (P0 + (j)) < hi)
#define SEAML(j) do { if ((lo <= (P0 + (j)) && (P0 + (j)) < hi) && (lo <= (P0 + (j) + 1) && (P0 + (j) + 1) < hi)) GRID_BAR(); } while (0)
template <int l> __device__ __forceinline__ void run_layer(const Args& args, unsigned char* lds_raw, const int lo, const int hi, const int wave_s) {
        const int P0 = PH_L0 + l * NPL;
#define LW() (ws + WS_LW + (size_t)l * LW_SIZE)
        if (INL(0)) for (int rep_ = 0; rep_ < NREP(0); ++rep_) { MKCTX(); ph_norm1(F, l, I.ptr(0), I.ptr(3) + (size_t)l * DM, nullptr); } SEAML(0);
        if (INL(1)) for (int rep_ = 0; rep_ < NREP(1); ++rep_) { MKCTX(); pg8::EpiProj E{(char*)ws, (const float*)(ws + WS_ROPE), (const float*)(ws + WS_ROPE) + T * 32, (const float*)(ws + WS_RSTD)};
            { pg8::SchedProj<false> S{ws, LW(), F.G, bx}; pg8::gemm_phase<pg8::EpiProj, pg8::SchedProj<false>, false>(F.lds + RING_OFF, S, E, F.tid); }
            { pg8::SchedProj<true> S{ws, LW(), F.G, bx}; pg8::gemm_phase<pg8::EpiProj, pg8::SchedProj<true>, true>(F.lds + RING_OFF, S, E, F.tid); } } SEAML(1);
#if NAIVE_SSM
        if (INL(2)) for (int rep_ = 0; rep_ < NREP(2); ++rep_) { MKCTX(); ph_conv(F, I.ptr(11) + (size_t)l * 31 * 512, I.ptr(12) + l * 512, I.ptr(13) + l * 512, I.ptr(14) + l * 512); ph_ssm_naive(F, l, I); } SEAML(2);
        SEAML(3); SEAML(4);
#else
        if (INL(2)) for (int rep_ = 0; rep_ < NREP(2); ++rep_) { MKCTX(); ph_conv(F, I.ptr(11) + (size_t)l * 31 * 512, I.ptr(12) + l * 512, I.ptr(13) + l * 512, I.ptr(14) + l * 512);
            pg8::SchedSsm1 S{ws, LW(), F.G, bx}; pg8::EpiStoreF32 E{16384}; pg8::gemm_phase(F.lds + RING_OFF, S, E, F.tid);
            if (DEFER_CONV && l + 1 < NL && F.G == 256 && bx >= 32) conv_window(F, I, l + 1, 0, (bx - 32) * NWAVES + F.wave, 3); } SEAML(2);
        if (INL(3)) for (int rep_ = 0; rep_ < NREP(3); ++rep_) { MKCTX(); ph_ssm2(F, l);
            } SEAML(3);
#endif
        if (INL(5)) for (int rep_ = 0; rep_ < NREP(5); ++rep_) { MKCTX(); { pg8::SchedSsm3 S{ws, LW(), F.G, bx}; pg8::EpiSsm3 E{(char*)ws + WS_YS}; pg8::gemm_phase(F.lds + RING_OFF, S, E, F.tid);
            if (DEFER_CONV && l + 1 < NL && F.G == 256 && bx >= 64) conv_window(F, I, l + 1, 5376, (bx - 64) * NWAVES + F.wave, 3); }
            (ATTN128 && !NAIVE_ATTN ? attn128::attn_phase : attn_body::attn_phase)((char*)lds_raw + RING_OFF, (const bf16_t*)(ws + WS_Q), (const bf16_t*)(ws + WS_K), (const bf16_t*)(ws + WS_V), (bf16_t*)(ws + WS_O1), (bf16_t*)(ws + WS_O2), F.vcu, F.G, F.tid); } SEAML(5);
        if (INL(6)) for (int rep_ = 0; rep_ < NREP(6); ++rep_) { MKCTX(); ph_diff(F, l, I); __syncthreads();
            pg8::SchedDense S{(const char*)ws + WS_YS, (const char*)LW() + LW_WGLU, 1024, 1024, 8, 32, 4, F.G, bx}; pg8::EpiGlu E{(char*)ws + WS_GLUO, I.ptr(25) + (size_t)l * 1024}; pg8::gemm_phase(F.lds + RING_OFF, S, E, F.tid);
            if (DEFER_CONV && l + 1 < NL && F.G == 256 && bx >= 128) conv_window(F, I, l + 1, 9984, (bx - 128) * NWAVES + F.wave, 2); } SEAML(6);
        if (INL(7)) for (int rep_ = 0; rep_ < NREP(7); ++rep_) { MKCTX(); pg8::SchedSeg<0> S{ws, LW(), F.G, bx}; pg8::EpiGated E{(const char*)ws + WS_GATES, (char*)ws + WS_MERGED}; pg8::gemm_phase(F.lds + RING_OFF, S, E, F.tid); } SEAML(7);
        if (INL(8)) for (int rep_ = 0; rep_ < NREP(8); ++rep_) { MKCTX(); pg8::SchedDense S{(const char*)ws + WS_MERGED, (const char*)LW() + LW_WMIX, 4096, 4096, 32, 32, 8, F.G, bx}; pg8::EpiResid E{(char*)ws + WS_X, (char*)ws + ((S_FP8 || !FUSE_N2) ? WS_H8 : WS_H), (float*)(ws + WS_RSQ)}; pg8::gemm_phase(F.lds + RING_OFF, S, E, F.tid); } SEAML(8);
#ifdef DBG_EXTRA_BAR
        if (INL(9)) GRID_BAR();
#endif
#if !FUSE_N2
        if (INL(9)) for (int rep_ = 0; rep_ < NREP(9); ++rep_) { MKCTX(); ph_norm2(F, I.ptr(28) + (size_t)l * DM); } SEAML(9);
#endif
        if (INL(10)) for (int rep_ = 0; rep_ < NREP(10); ++rep_) { MKCTX(); pg8::SchedDense S{(const char*)ws + (S_FP8 ? WS_H8 : WS_H), (const char*)LW() + LW_WQK, S_FP8 ? 2048 : 4096, S_FP8 ? 2048 : 4096, S_FP8 ? 16 : 32, 32, 4, F.G, bx}; pg8::EpiSexp E{(char*)ws + WS_P, (float*)(ws + WS_RS), (const float*)(ws + WS_RSQ)}; pg8::gemm_phase<pg8::EpiSexp, pg8::SchedDense, S_FP8 != 0>(F.lds + RING_OFF, S, E, F.tid);
            if (DEFER_CONV && l + 1 < NL && F.G == 256 && bx >= 128) conv_window(F, I, l + 1, 12032, (bx - 128) * NWAVES + F.wave, 5); } SEAML(10);
        if (INL(11)) for (int rep_ = 0; rep_ < NREP(11); ++rep_) { MKCTX(); pg8::SchedSeg<1> S{ws, LW(), F.G, bx}; pg8::EpiXao E{(const float*)(ws + WS_RS), (char*)ws + WS_X}; pg8::gemm_phase<pg8::EpiXao, pg8::SchedSeg<1>, XAO_FP8 != 0>(F.lds + RING_OFF, S, E, F.tid); } SEAML(11);
        if (INL(12)) for (int rep_ = 0; rep_ < NREP(12); ++rep_) { MKCTX(); ph_norm3_router(F, l, I, rep_ == NREP(12) - 1); } SEAML(12);
        if (INL(13)) for (int rep_ = 0; rep_ < NREP(13); ++rep_) { MKCTX(); volatile LAS unsigned* MISC = (volatile LAS unsigned*)(F.lds + MISC_OFF);
            if (F.tid < 16) MISC[16 + F.tid] = __hip_atomic_load(F.ctl + CW_CNT + (l * 16 + F.tid) * 16, RLX_AGENT);
            __syncthreads();
            pg8::SchedMoE<false> S{(const volatile LAS int*)(MISC + 16), ws, LW(), F.G, bx}; pg8::EpiGu E{}; pg8::gemm_phase<pg8::EpiGu, pg8::SchedMoE<false>, true>(F.lds + RING_OFF, S, E, F.tid);
            if (DEFER_CONV && l + 1 < NL && F.G == 256 && bx >= 64) conv_window(F, I, l + 1, 17152, (bx - 64) * NWAVES + F.wave, 3); } SEAML(13);
        if (INL(14)) for (int rep_ = 0; rep_ < NREP(14); ++rep_) { MKCTX(); volatile LAS unsigned* MISC = (volatile LAS unsigned*)(F.lds + MISC_OFF);
            if (F.tid < 16) MISC[16 + F.tid] = __hip_atomic_load(F.ctl + CW_CNT + (l * 16 + F.tid) * 16, RLX_AGENT);
            __syncthreads();
            pg8::SchedMoE<true> S{(const volatile LAS int*)(MISC + 16), ws, LW(), F.G, bx}; pg8::EpiDown E{}; pg8::gemm_phase<pg8::EpiDown, pg8::SchedMoE<true>, true>(F.lds + RING_OFF, S, E, F.tid); } SEAML(14);
#undef LW
}
__global__ void __launch_bounds__(NWAVES * 64, 2) mk_fwd(Args args) {
    extern __shared__ __attribute__((aligned(16))) unsigned char lds_raw[];
    const int wave_s = __builtin_amdgcn_readfirstlane((int)threadIdx.x >> 6);
    {   LAS unsigned char* l0 = (LAS unsigned char*)lds_raw;
        for (int u = threadIdx.x; u < (LDS_BYTES - LDSCTL_OFF) / 4; u += NWAVES * 64) ((LAS unsigned*)(l0 + LDSCTL_OFF))[u] = 0u;
        __syncthreads();
        if (threadIdx.x < 84) { const unsigned* ka = (const unsigned*)__builtin_amdgcn_kernarg_segment_ptr(); ((LAS unsigned*)(l0 + INTAB_OFF))[threadIdx.x] = ka[threadIdx.x]; }
        __syncthreads(); }
#if !MK_PER_PHASE
    {   unsigned char* w_ = args.ws; LAUNDER_S(w_); (void)xcd_barrier_post((unsigned*)((gu32*)(w_ + WS_CTL) + CW_BAR), (volatile LAS unsigned*)((LAS unsigned char*)lds_raw + MISC_OFF) + 8); }
#endif
    const int lo = args.ph_lo, hi = args.ph_hi;

    if ((ONLY_LPH < 0 || ONLY_LPH == 100) && IN(PH_PRO_A)) for (int rep_ = 0; rep_ < NREP(20); ++rep_) { MKCTX(); ph_prologue_a(F, I); } SEAM(PH_PRO_A);
    if ((ONLY_LPH < 0 || ONLY_LPH == 101) && IN(PH_PRO_B)) { MKCTX(); pg8::SchedKV S{ws, F.G, bx}; pg8::EpiStore E{2048, 2}; pg8::gemm_phase(F.lds + RING_OFF, S, E, F.tid); } SEAM(PH_PRO_B);
    if ((ONLY_LPH < 0 || ONLY_LPH == 102) && IN(PH_PRO_C)) { MKCTX(); pg8::SchedAbsorb S{ws, F.G, bx}; pg8::EpiStoreP E{}; pg8::gemm_phase(F.lds + RING_OFF, S, E, F.tid); } SEAM(PH_PRO_C);

    run_layer<0>(args, lds_raw, lo, hi, wave_s); run_layer<1>(args, lds_raw, lo, hi, wave_s); run_layer<2>(args, lds_raw, lo, hi, wave_s); run_layer<3>(args, lds_raw, lo, hi, wave_s);
    if ((ONLY_LPH < 0 || ONLY_LPH == 103) && IN(PH_FINAL)) { MKCTX(); float* outp = args.out; ph_norm1(F, NL, I.ptr(0), I.ptr(41), outp); }
}

extern "C" void kernel_launch(void* const* d_in, const int* in_sizes, int n_in, void* d_out, int out_size, void* d_ws, size_t ws_size, hipStream_t stream) {
    static int grid = 0;
    if (grid == 0) {
        if (n_in != 42 || out_size != T * DM || ws_size < WS_END) { fprintf(stderr, "kernel_launch: unexpected problem shape / workspace (%d inputs, out %d, ws %zu < %zu); nothing launched\n", n_in, out_size, ws_size, (size_t)WS_END); grid = -1; return; }
        int dev = 0, cus = 0, per_cu = 0;
        if (hipGetDevice(&dev) != hipSuccess || hipDeviceGetAttribute(&cus, hipDeviceAttributeMultiprocessorCount, dev) != hipSuccess) { grid = -1; return; }
        if (hipFuncSetAttribute((const void*)mk_fwd, hipFuncAttributeMaxDynamicSharedMemorySize, LDS_BYTES) != hipSuccess) { fprintf(stderr, "kernel_launch: hipFuncSetAttribute failed\n"); grid = -1; return; }
        if (hipOccupancyMaxActiveBlocksPerMultiprocessor(&per_cu, (const void*)mk_fwd, NWAVES * 64, LDS_BYTES) != hipSuccess || per_cu < 1) { fprintf(stderr, "kernel_launch: occupancy query says %d workgroups per CU\n", per_cu); }
        (void)hipGetLastError();
        grid = cus;
    }
    if (grid < 0) return;
    if (hipMemsetAsync((char*)d_ws + WS_CTL, 0, CTL_ZERO_BYTES, stream) != hipSuccess) return;
    Args a{};
    for (int i = 0; i < 42; ++i) a.in[i] = (const float*)d_in[i];
    a.out = (float*)d_out; a.ws = (unsigned char*)d_ws;
#if MK_PER_PHASE
    for (int ph = 0; ph < NPHASES; ++ph) { a.ph_lo = ph; a.ph_hi = ph + 1; hipLaunchKernelGGL(mk_fwd, dim3(grid), dim3(NWAVES * 64), LDS_BYTES, stream, a); }
#else
    a.ph_lo = 0; a.ph_hi = NPHASES;
    hipLaunchKernelGGL(mk_fwd, dim3(grid), dim3(NWAVES * 64), LDS_BYTES, stream, a);
#endif
}
```

```cpp
#include <hip/hip_runtime.h>
#include <cstdio>
#include <cstdint>
#include <cmath>

#ifndef NAIVE_GEMM
#define NAIVE_GEMM 0
#endif
#ifndef NAIVE_ATTN
#define NAIVE_ATTN 0
#endif
#ifndef NAIVE_SSM
#define NAIVE_SSM 0
#endif
#ifndef MK_PER_PHASE
#define MK_PER_PHASE 0
#endif

#define GAS __attribute__((address_space(1)))
#define LAS __attribute__((address_space(3)))
typedef unsigned short bf16_t;
typedef short bf16x8 __attribute__((ext_vector_type(8)));
typedef float f32x4 __attribute__((ext_vector_type(4)));
typedef float f32x2 __attribute__((ext_vector_type(2)));
typedef unsigned u32x4 __attribute__((ext_vector_type(4)));
typedef unsigned u32x2 __attribute__((ext_vector_type(2)));
typedef GAS unsigned gu32;
#define RLX_AGENT __ATOMIC_RELAXED, __HIP_MEMORY_SCOPE_AGENT
#define LDS_WAIT() asm volatile("s_waitcnt lgkmcnt(0)" ::: "memory")
#define VM_WAIT() asm volatile("s_waitcnt vmcnt(0)" ::: "memory")
__device__ __forceinline__ unsigned f2bf(float f) { unsigned u = __builtin_bit_cast(unsigned, f); return (u + 0x7fffu + ((u >> 16) & 1u)) >> 16; }
__device__ __forceinline__ unsigned pk2(float lo, float hi) { return f2bf(lo) | (f2bf(hi) << 16); }
__device__ __forceinline__ float bflo(unsigned w) { return __builtin_bit_cast(float, w << 16); }
__device__ __forceinline__ float bfhi(unsigned w) { return __builtin_bit_cast(float, w & 0xffff0000u); }
__device__ __forceinline__ float bf2f(bf16_t h) { return __builtin_bit_cast(float, (unsigned)h << 16); }
template <int M> __device__ __forceinline__ float xor_lane(float v) {
    if (M < 32) return __builtin_bit_cast(float, __builtin_amdgcn_ds_swizzle(__builtin_bit_cast(int, v), (M << 10) | 0x1f));
    const auto rr = __builtin_amdgcn_permlane32_swap(__builtin_bit_cast(unsigned, v), __builtin_bit_cast(unsigned, v), false, false);
    return __builtin_bit_cast(float, rr[0] ^ rr[1] ^ __builtin_bit_cast(unsigned, v));
}
__device__ __forceinline__ float wave_sum(float v) {
    v += xor_lane<1>(v); v += xor_lane<2>(v); v += xor_lane<4>(v); v += xor_lane<8>(v); v += xor_lane<16>(v); v += xor_lane<32>(v);
    return v;
}
__device__ __forceinline__ float wave_max(float v) {
    v = fmaxf(v, xor_lane<1>(v)); v = fmaxf(v, xor_lane<2>(v)); v = fmaxf(v, xor_lane<4>(v)); v = fmaxf(v, xor_lane<8>(v)); v = fmaxf(v, xor_lane<16>(v)); v = fmaxf(v, xor_lane<32>(v));
    return v;
}
__device__ __forceinline__ int tid_of(int wave_s) { int ln; asm volatile("v_mbcnt_lo_u32_b32 %0, -1, 0\n\tv_mbcnt_hi_u32_b32 %0, -1, %0" : "=v"(ln)); return (wave_s << 6) | ln; }
__device__ __forceinline__ float sigmoidf_(float x) { return __builtin_amdgcn_rcpf(1.f + __expf(-x)); }

constexpr int T = 8192, DM = 2048, NL = 4, MEML = 256, NPROJ = 10752, NEXP = 16, FFE = 512;
constexpr int NWAVES = 8;
constexpr float RMS_EPS = 1e-6f, HEAD_EPS = 1e-5f, LN_EPS = 1e-5f;
constexpr float C2Q = 0.125f * 1.4426950408889634f;
constexpr float GATE_WSCALE = 128.f;
#ifndef S_FP8
#define S_FP8 1
#endif
#ifndef FUSE_N2
#define FUSE_N2 1
#endif
constexpr float SQK_SCALE = S_FP8 ? 64.f : 1.f;
#ifndef XAO_FP8
#define XAO_FP8 1
#endif
constexpr float VW_SCALE = XAO_FP8 ? 64.f : 1.f;
constexpr float C2X = 0.08838834764831845f * 1.4426950408889634f;
constexpr size_t MiB = 1u << 20;
constexpr size_t WS_CTL = 0, CTL_ZERO_BYTES = 64 * 1024;
constexpr size_t LW_WIN = 0;
constexpr size_t LW_WG8 = LW_WIN + (size_t)3584 * DM * 2;
constexpr size_t LW_WCAT = LW_WG8 + (size_t)7680 * DM;
constexpr size_t LW_WGLU = LW_WCAT + (size_t)DM * DM * 2;
constexpr size_t LW_WMIX = LW_WGLU + (size_t)1024 * 512 * 2;
constexpr size_t LW_WQK = LW_WMIX + (size_t)DM * DM * 2;
constexpr size_t LW_VW = LW_WQK + (size_t)1024 * DM * 2;
constexpr size_t LW_WGU = LW_VW + (size_t)DM * 1024 * 2;
constexpr size_t LW_WD = LW_WGU + (size_t)NEXP * 1024 * DM;
constexpr size_t LW_BKE = LW_WD + (size_t)NEXP * DM * FFE;
constexpr size_t LW_F = LW_BKE + (size_t)32 * 512 * 640 * 2;
constexpr size_t LW_RT = LW_F + (size_t)32 * 128 * 512 * 2;
constexpr size_t LW_LAM = LW_RT + (size_t)20 * DM * 4;
constexpr size_t LW_SIZE = ((LW_LAM + (size_t)32 * 64 * 8 + 4095) / 4096) * 4096;
constexpr size_t WS_LW = 1 * MiB;
constexpr size_t WS_ACT = WS_LW + NL * LW_SIZE;
constexpr size_t WS_X = WS_ACT;
constexpr size_t WS_RSTD = WS_X + (size_t)T * DM * 2;
constexpr size_t WS_H = WS_X + (size_t)T * DM * 4;
constexpr size_t WS_Q = WS_H + (size_t)T * DM * 2;
constexpr size_t WS_K = WS_Q + (size_t)T * 1024 * 2;
constexpr size_t WS_V = WS_K + (size_t)T * 1024 * 2;
constexpr size_t WS_O1 = WS_V + (size_t)T * 1024 * 2;
constexpr size_t WS_O2 = WS_O1 + (size_t)T * 1024 * 2;
constexpr size_t WS_OAN = WS_O2 + (size_t)T * 1024 * 2;
constexpr size_t WS_Z = WS_OAN + (size_t)T * 1024 * 2;
constexpr size_t WS_UC = WS_Z + (size_t)T * 512 * 2;
constexpr size_t WS_GATES = WS_UC + (size_t)T * 512 * 2;
constexpr size_t WS_CVO = WS_GATES + (size_t)T * 6144 * 2;
constexpr size_t WS_SS = WS_CVO + (size_t)T * 512 * 2;
constexpr size_t WS_XP = WS_SS + (size_t)256 * 4096 * 4;
constexpr size_t WS_YS = WS_XP + (size_t)32 * 256 * 128 * 2;
constexpr size_t WS_GLUO = WS_YS + (size_t)T * 512 * 2;
constexpr size_t WS_MERGED = WS_GLUO + (size_t)T * 512 * 2;
constexpr size_t WS_P = WS_MERGED + (size_t)T * DM * 2;
constexpr size_t WS_RS = WS_P + (size_t)T * 1024 * 2;
constexpr size_t WS_HE = WS_RS + (size_t)T * 16 * 4;
constexpr size_t WS_Y = WS_HE + (size_t)(2 * T + 256) * 512 * 2;
constexpr size_t WS_LIST = WS_Y + (size_t)2 * T * DM * 2;
constexpr size_t WS_WL = WS_LIST + (size_t)NEXP * T * 4;
constexpr size_t WS_TOK = WS_WL + (size_t)NEXP * T * 4;
constexpr size_t WS_ROPE = WS_TOK + (size_t)T * 16;
constexpr size_t WS_H8 = WS_ROPE + (size_t)T * 64 * 4;
constexpr size_t WS_RSQ = WS_H8 + (size_t)T * DM;
constexpr size_t WS_END = WS_RSQ + (size_t)T * 32 * 4;
constexpr size_t WS_WQB = WS_GATES;
constexpr size_t WS_WKVT = WS_WQB + (size_t)NL * DM * 512 * 2;
constexpr size_t WS_WXOT = WS_WKVT + (size_t)NL * 1024 * DM * 2;
constexpr size_t WS_MNORM = WS_WXOT + (size_t)NL * DM * 512 * 2;
constexpr size_t WS_KVB = WS_MNORM + (size_t)NL * MEML * DM * 2;
static_assert(WS_KVB + (size_t)NL * MEML * 1024 * 2 <= WS_CVO, "prologue temporaries inside GATES");
static_assert(WS_END < (size_t)1350000000, "workspace plan");
constexpr int CW_TMO = 0, CW_CODE = 1;
constexpr int CW_BAR = 4096;
constexpr int CW_CNT = 8192;
constexpr int RING_OFF = 0, RING_BYTES = 131072;
constexpr int LDSCTL_OFF = RING_BYTES, MISC_OFF = LDSCTL_OFF + 320;
constexpr int LDS_BYTES = 147456;
#define XB_TMO      128
#define XB_XCNT(j)  (256  + 64 * (j))
#define XB_XSUB(j)  (1280 + 64 * (j))
#define XB_XGEN(j)  (2304 + 64 * (j))
#define XB_TOP      3328
#define XB_TOPGEN   3392
#define XCD_BAR_WORDS 3456
#define XB_SPIN_CAP (1u << 24)

__device__ __forceinline__ unsigned xb_ld(unsigned* p)              { return __hip_atomic_load(p, __ATOMIC_RELAXED, __HIP_MEMORY_SCOPE_AGENT); }
__device__ __forceinline__ unsigned xb_add(unsigned* p, unsigned v) { return __hip_atomic_fetch_add(p, v, __ATOMIC_RELAXED, __HIP_MEMORY_SCOPE_AGENT); }
__device__ __forceinline__ unsigned xb_xcc_id() { return (unsigned)__builtin_amdgcn_s_getreg((3 << 11) | 20) & 0xFu; }
#define XB_SPIN(cond, bar) do { unsigned _sp = 0; while (cond) { __builtin_amdgcn_s_sleep(1); \
    if ((++_sp & 255u) == 0u) { if (xb_ld(&(bar)[XB_TMO])) break; if (_sp > XB_SPIN_CAP) { atomicAdd(&(bar)[XB_TMO], 1u); break; } } } } while (0)

struct XcdBarrier {
    unsigned* bar; unsigned x;
    volatile LAS unsigned* st;
};

__device__ __forceinline__ XcdBarrier xcd_barrier_post(unsigned* bar, volatile LAS unsigned* st) {
    XcdBarrier b; b.bar = bar; b.x = xb_xcc_id(); b.st = st;
    if (threadIdx.x == 0) (void)xb_add(&bar[XB_XCNT(b.x)], 1u);
    return b;
}
__device__ __forceinline__ void xcd_barrier_complete(unsigned* bar, unsigned x, unsigned& nloc, unsigned& nx) {
    const unsigned G = gridDim.x * gridDim.y * gridDim.z;
    unsigned sum, cnt, mine, sp = 0u;
    for (;;) {
        sum = 0u; cnt = 0u; mine = 0u;
#pragma unroll
        for (unsigned j = 0; j < 16; ++j) { const unsigned c = xb_ld(&bar[XB_XCNT(j)]); sum += c; cnt += (c > 0u) ? 1u : 0u; mine = (j == x) ? c : mine; }
        if (sum == G) break;
        __builtin_amdgcn_s_sleep(1);
        if ((++sp & 255u) == 0u) { if (xb_ld(&bar[XB_TMO])) break; if (sp > XB_SPIN_CAP) { atomicAdd(&bar[XB_TMO], 1u); break; } }
    }
    nloc = mine > 0u ? mine : 1u; nx = cnt > 0u ? cnt : 1u;
}

__device__ __forceinline__ void xcd_barrier(const XcdBarrier& b) {
    asm volatile("s_waitcnt vmcnt(0)" ::: "memory");
    __syncthreads();
    if (threadIdx.x == 0) {
        unsigned* bar = b.bar;
        __builtin_amdgcn_s_waitcnt(0);
        unsigned nloc = b.st[0], nx = b.st[1];
        if (nloc == 0u) { xcd_barrier_complete(bar, b.x, nloc, nx); b.st[0] = nloc; b.st[1] = nx; }
        const unsigned old = xb_add(&bar[XB_XSUB(b.x)], 1u);
        const unsigned gen = old / nloc;
        if (old + 1u == (gen + 1u) * nloc) {
            __builtin_amdgcn_fence(__ATOMIC_RELEASE, "agent");
            asm volatile("s_waitcnt vmcnt(0)" ::: "memory");
            const unsigned og = xb_add(&bar[XB_TOP], 1u);
            const unsigned tg = og / nx;
            if (og + 1u == (tg + 1u) * nx) xb_add(&bar[XB_TOPGEN], 1u);
            else XB_SPIN(xb_ld(&bar[XB_TOPGEN]) == tg, bar);
            __builtin_amdgcn_fence(__ATOMIC_ACQUIRE, "agent");
            xb_add(&bar[XB_XGEN(b.x)], 1u);
            asm volatile("s_waitcnt vmcnt(0)" ::: "memory");
        } else {
            XB_SPIN(xb_ld(&bar[XB_XGEN(b.x)]) == gen, bar);
            __builtin_amdgcn_fence(__ATOMIC_ACQUIRE, "agent");
            asm volatile("s_waitcnt vmcnt(0)" ::: "memory");
        }
    }
    __syncthreads();
}
namespace pg8 {
constexpr int BM = 256, BK = 64, HALF = 128, HTB = HALF * BK * 2  , STAGE_BYTES = 8 * HTB;
__host__ __device__ __forceinline__ int lds_byte(int r, int c) { const int st = (r >> 4) * 2 + (c >> 5), rr = r & 15, cc = c & 31, ob = rr * 64 + cc * 2; return st * 1024 + (ob ^ (((ob >> 9) & 1) << 5)); }
__host__ __device__ __forceinline__ void stage_rc(int b, int& R, int& C) { const int st = b / 1024, sb = b % 1024, swz = sb ^ (((sb >> 9) & 1) << 5); R = (st >> 1) * 16 + swz / 64; C = (st & 1) * 32 + (swz % 64) / 2; }
__host__ __device__ __forceinline__ int perm32(int rho) { const int n = rho >> 4, i = rho & 15; return 8 * (i >> 2) + 4 * n + (i & 3); }

enum { GU_LAST = 1 };
struct GU {
    const char* A;
    const char* B;
    char* C;
    const char* P;
    int lda, ldb;
    int nt;
    int pm, pn;
    int seg;
    int flags;
    int rows;
    int aux;
    int f8;
};
typedef f32x4 Acc[2][2][4][2];
typedef int i32x4 __attribute__((ext_vector_type(4)));
typedef int i32x8 __attribute__((ext_vector_type(8)));

#if !NAIVE_GEMM
template <class Epi, class Sched, bool HAS_F8 = false>
__device__ __forceinline__ void gemm_phase(LAS unsigned char* lds, const Sched& S, const Epi& E, const int tid) {
    const int wid = __builtin_amdgcn_readfirstlane(tid >> 6), lane = tid & 63, wr = wid >> 2, wc = wid & 3, fr = lane & 15, fq = lane >> 4;
    const unsigned ldsw = (unsigned)wid * 1024u;
    const int aoff = lds_byte(wr * 64 + fr, fq * 8), boff = lds_byte(wc * 32 + fr, fq * 8);
#define PG8_SA(b, h) (((b) * 2 + (h)) * HTB)
#define PG8_SB(b, h) ((4 + (b) * 2 + (h)) * HTB)
#define PG8_STAGE(bufoff, gbase, voff) do { _Pragma("unroll") for (int _i = 0; _i < 2; ++_i) { unsigned o_ = (voff)[_i]; asm volatile("" : "+v"(o_));     \
        __builtin_amdgcn_global_load_lds((const unsigned*)((const char*)(gbase) + o_), (LAS unsigned*)(lds + (bufoff) + ldsw + _i * 8192), 16, 0, 0); } } while (0)
#define PG8_LDA(dst, b, h) do { _Pragma("unroll") for (int m = 0; m < 4; ++m) _Pragma("unroll") for (int k = 0; k < 2; ++k) dst[m][k] = *(const LAS bf16x8*)(lds + PG8_SA(b, h) + aoff + m * 2048 + k * 1024); } while (0)
#define PG8_LDB(dst, b, h) do { _Pragma("unroll") for (int n = 0; n < 2; ++n) _Pragma("unroll") for (int k = 0; k < 2; ++k) dst[n][k] = *(const LAS bf16x8*)(lds + PG8_SB(b, h) + boff + n * 2048 + k * 1024); } while (0)
#define PG8_MFMA8(c, a, b) do { const i32x8 a_ = (a), b_ = (b); asm volatile("s_nop 4\n\tv_mfma_scale_f32_16x16x128_f8f6f4 %0, %1, %2, %0, %3, %3 op_sel_hi:[0,0,0]" : "+v"(c) : "v"(a_), "v"(b_), "v"(f8scale)); } while (0)
#define PG8_MFMA_DRAIN() do { if (HAS_F8) asm volatile("s_nop 15\n\ts_nop 15\n\ts_nop 15" ::: "memory"); } while (0)
#define PG8_CAT8(x) __builtin_shufflevector(__builtin_bit_cast(i32x4, (x)[0]), __builtin_bit_cast(i32x4, (x)[1]), 0, 1, 2, 3, 4, 5, 6, 7)
#define PG8_MMA(ai, bj, At, Bt) do { __builtin_amdgcn_s_setprio(1); if (HAS_F8) { _Pragma("unroll") for (int m = 0; m < 4; ++m) _Pragma("unroll") for (int n = 0; n < 2; ++n) \
        PG8_MFMA8(acc[ai][bj][m][n], PG8_CAT8(Bt[n]), PG8_CAT8(At[m])); } \
    else { _Pragma("unroll") for (int m = 0; m < 4; ++m) _Pragma("unroll") for (int n = 0; n < 2; ++n) _Pragma("unroll") for (int k = 0; k < 2; ++k) \
        acc[ai][bj][m][n] = __builtin_amdgcn_mfma_f32_16x16x32_bf16(Bt[n][k], At[m][k], acc[ai][bj][m][n], 0, 0, 0); } __builtin_amdgcn_s_setprio(0); } while (0)
#define PG8_WAIT_V(n) asm volatile("s_waitcnt vmcnt(" #n ")" ::: "memory")
#define PG8_WAIT_L(n) asm volatile("s_waitcnt lgkmcnt(" #n ")" ::: "memory")
#define PG8_BAR __builtin_amdgcn_s_barrier()
#define PG8_SCHED __builtin_amdgcn_sched_barrier(0)
#define PG8_MKV(u, va, vb) do { _Pragma("unroll") for (int _i = 0; _i < 2; ++_i) { int R_, C_; stage_rc(tid * 16 + _i * 8192, R_, C_); const int Rb_ = (R_ & ~31) + perm32(R_ & 31);     \
        vb[_i] = (unsigned)(Rb_ * (u).ldb + C_ * 2); va[0][_i] = S.arow((u), R_) + (unsigned)(C_ * 2); if (Sched::GATHER) va[1][_i] = S.arow((u), 128 + R_) + (unsigned)(C_ * 2); } } while (0)
    GU cur, nxt; int ui = 0;
    if (!S.next(0, cur)) return;
    Acc acc;
#pragma unroll
    for (int a = 0; a < 2; ++a)
#pragma unroll
        for (int b = 0; b < 2; ++b)
#pragma unroll
            for (int m = 0; m < 4; ++m)
#pragma unroll
                for (int n = 0; n < 2; ++n) acc[a][b][m][n] = (f32x4){0.f, 0.f, 0.f, 0.f};
    bf16x8 At[4][2], B0[2][2], B1[2][2];
    int f8scale = 0x7f7f7f7f; asm volatile("" : "+v"(f8scale));
    constexpr int NH = Sched::GATHER ? 2 : 1;
    unsigned vA[NH][2], vB[2], nvA[NH][2], nvB[2];
    PG8_MKV(cur, vA, vB);
    const size_t kstep = (size_t)(BK * 2);
    {
        const char* cA = cur.A; const char* cB = cur.B; const size_t hsB = (size_t)HALF * cur.ldb;
        const char* cBh = cB + hsB; const char* cAk = cA + kstep; const char* cBk = cB + kstep; const char* cBhk = cB + hsB + kstep; const char* cAh = Sched::GATHER ? cA : cA + (size_t)HALF * cur.lda;
        asm volatile("" : "+s"(cA), "+s"(cB), "+s"(cBh), "+s"(cAk), "+s"(cBk), "+s"(cBhk), "+s"(cAh));
        PG8_STAGE(PG8_SB(0, 0), cB, vB); PG8_STAGE(PG8_SB(0, 1), cBh, vB); PG8_STAGE(PG8_SA(0, 0), cA, vA[0]); PG8_STAGE(PG8_SA(0, 1), cAh, vA[NH - 1]);
        if (wr == 1) PG8_BAR;
        PG8_WAIT_V(2); PG8_BAR;
        PG8_STAGE(PG8_SB(1, 0), cBk, vB); PG8_STAGE(PG8_SA(1, 0), cAk, vA[0]); PG8_STAGE(PG8_SB(1, 1), cBhk, vB);
        PG8_WAIT_V(6); PG8_BAR;
    }
    for (;;) {
        const bool has_next = S.next(ui + 1, nxt);
        if (has_next) { PG8_MKV(nxt, nvA, nvB); }
        else {
#pragma unroll
            for (int i = 0; i < 2; ++i) { nvB[i] = vB[i]; nvA[0][i] = vA[0][i]; nvA[NH - 1][i] = vA[NH - 1][i]; }
        }
        const char* cA = cur.A; const char* cB = cur.B; const size_t hsB = (size_t)HALF * cur.ldb;
        const char* nA = has_next ? nxt.A : cA; const char* nB = has_next ? nxt.B : cB; const size_t nhsB = has_next ? (size_t)HALF * nxt.ldb : hsB;
        const size_t hsA = Sched::GATHER ? 0 : (size_t)HALF * cur.lda, nhsA = Sched::GATHER ? 0 : (has_next ? (size_t)HALF * nxt.lda : hsA);
        const int nt = cur.nt;
        for (int t = 0; t < nt; t += 2) {
            const bool last = (t == nt - 2);
            const char* a1 = cA + (size_t)(t + 1) * kstep;
            const char* a2 = last ? nA : cA + (size_t)(t + 2) * kstep; const char* b2 = last ? nB : cB + (size_t)(t + 2) * kstep;
            const char* a3 = a2 + kstep; const char* b3 = b2 + kstep;
            const size_t xhsB = last ? nhsB : hsB, xhsA = last ? nhsA : hsA;
            const char* b2h = b2 + xhsB; const char* b3h = b3 + xhsB; const char* a1h = a1 + hsA; const char* a2h = a2 + xhsA;
            asm volatile("" : "+s"(a1h), "+s"(a2), "+s"(a3), "+s"(b2), "+s"(b3), "+s"(b2h), "+s"(b3h), "+s"(a2h));
            unsigned xA[NH][2], xB[2];
#pragma unroll
            for (int i = 0; i < 2; ++i) { xB[i] = last ? nvB[i] : vB[i]; xA[0][i] = last ? nvA[0][i] : vA[0][i]; xA[NH - 1][i] = last ? nvA[NH - 1][i] : vA[NH - 1][i]; }
            PG8_LDB(B0, 0, 0); PG8_LDB(B1, 0, 1); PG8_SCHED; PG8_LDA(At, 0, 0); PG8_STAGE(PG8_SA(1, 1), a1h, vA[NH - 1]);
            PG8_WAIT_V(8); PG8_WAIT_L(0); PG8_BAR; PG8_MMA(0, 0, At, B0); PG8_MMA(0, 1, At, B1); PG8_BAR; PG8_SCHED;
            PG8_LDA(At, 0, 1); PG8_STAGE(PG8_SB(0, 0), b2, xB); PG8_STAGE(PG8_SB(0, 1), b2h, xB); PG8_STAGE(PG8_SA(0, 0), a2, xA[0]);
            PG8_WAIT_V(8); PG8_WAIT_L(0); PG8_BAR; PG8_MMA(1, 0, At, B0); PG8_MMA(1, 1, At, B1); PG8_BAR; PG8_SCHED;
            PG8_LDB(B0, 1, 0); PG8_LDB(B1, 1, 1); PG8_SCHED; PG8_LDA(At, 1, 0); PG8_STAGE(PG8_SA(0, 1), a2h, xA[NH - 1]);
            PG8_WAIT_V(8); PG8_WAIT_L(0); PG8_BAR; PG8_MMA(0, 0, At, B0); PG8_MMA(0, 1, At, B1); PG8_BAR; PG8_SCHED;
            PG8_LDA(At, 1, 1); PG8_STAGE(PG8_SB(1, 0), b3, xB); PG8_STAGE(PG8_SB(1, 1), b3h, xB); PG8_STAGE(PG8_SA(1, 0), a3, xA[0]);
            PG8_WAIT_V(8); PG8_WAIT_L(0); PG8_BAR; PG8_MMA(1, 0, At, B0); PG8_MMA(1, 1, At, B1); PG8_BAR; PG8_SCHED;
        }
        if (wr == 0) PG8_BAR;
        PG8_MFMA_DRAIN();
        { int fr_e = fr, fq_e = fq; asm volatile("" : "+v"(fr_e), "+v"(fq_e));
          E(acc, cur, wr, wc, fr_e, fq_e); }
        if (!has_next) break;
        if (cur.flags & GU_LAST) {
#pragma unroll
            for (int a = 0; a < 2; ++a)
#pragma unroll
                for (int b = 0; b < 2; ++b)
#pragma unroll
                    for (int m = 0; m < 4; ++m)
#pragma unroll
                        for (int n = 0; n < 2; ++n) acc[a][b][m][n] = (f32x4){0.f, 0.f, 0.f, 0.f};
        }
        cur = nxt; ++ui;
#pragma unroll
        for (int i = 0; i < 2; ++i) { vB[i] = nvB[i]; vA[0][i] = nvA[0][i]; vA[NH - 1][i] = nvA[NH - 1][i]; }
        if (wr == 1) PG8_BAR;
    }
    PG8_WAIT_V(0);
    PG8_BAR;
#undef PG8_SA
#undef PG8_SB
#undef PG8_STAGE
#undef PG8_LDA
#undef PG8_LDB
#undef PG8_MMA
#undef PG8_WAIT_V
#undef PG8_WAIT_L
#undef PG8_BAR
#undef PG8_SCHED
#undef PG8_MKV
#undef PG8_CAT8
}
#else
template <class Epi, class Sched>
__device__ __forceinline__ void gemm_phase(LAS unsigned char* lds, const Sched& S, const Epi& E, const int tid) {
    const int wid = __builtin_amdgcn_readfirstlane(tid >> 6), lane = tid & 63, wr = wid >> 2, wc = wid & 3, fr = lane & 15, fq = lane >> 4;
    GU cur; Acc acc;
#pragma unroll
    for (int a = 0; a < 2; ++a)
#pragma unroll
        for (int b = 0; b < 2; ++b)
#pragma unroll
            for (int m = 0; m < 4; ++m)
#pragma unroll
                for (int n = 0; n < 2; ++n) acc[a][b][m][n] = (f32x4){0.f, 0.f, 0.f, 0.f};
    for (int ui = 0; S.next(ui, cur); ++ui) {
        const int K = cur.nt * 64;
#pragma unroll 1
        for (int ai = 0; ai < 2; ++ai)
#pragma unroll 1
            for (int m = 0; m < 4; ++m) {
                const char* ap = cur.A + S.arow(cur, ai * 128 + wr * 64 + m * 16 + fr);
#pragma unroll 1
                for (int bj = 0; bj < 2; ++bj) {
                    float s[8];
#pragma unroll
                    for (int j = 0; j < 8; ++j) s[j] = 0.f;
                    const char* bp = cur.B + (size_t)(bj * 128 + wc * 32 + 8 * fq) * cur.ldb;
#pragma unroll 1
                    for (int k = 0; k < K; k += 8) {
                        const u32x4 av = *(const u32x4*)(ap + k * 2);
                        const float a0 = bflo(av.x), a1 = bfhi(av.x), a2 = bflo(av.y), a3 = bfhi(av.y), a4 = bflo(av.z), a5 = bfhi(av.z), a6 = bflo(av.w), a7 = bfhi(av.w);
#pragma unroll
                        for (int j = 0; j < 8; ++j) { const u32x4 bv = *(const u32x4*)(bp + (size_t)j * cur.ldb + k * 2);
                            s[j] += a0 * bflo(bv.x) + a1 * bfhi(bv.x) + a2 * bflo(bv.y) + a3 * bfhi(bv.y) + a4 * bflo(bv.z) + a5 * bfhi(bv.z) + a6 * bflo(bv.w) + a7 * bfhi(bv.w); }
                    }
#pragma unroll
                    for (int a_ = 0; a_ < 2; ++a_)
#pragma unroll
                        for (int m_ = 0; m_ < 4; ++m_)
#pragma unroll
                            for (int b_ = 0; b_ < 2; ++b_) if (a_ == ai && m_ == m && b_ == bj) {
                                acc[a_][b_][m_][0] += (f32x4){s[0], s[1], s[2], s[3]}; acc[a_][b_][m_][1] += (f32x4){s[4], s[5], s[6], s[7]}; }
                }
            }
        E(acc, cur, wr, wc, fr, fq);
        if (cur.flags & GU_LAST) {
#pragma unroll
            for (int a = 0; a < 2; ++a)
#pragma unroll
                for (int b = 0; b < 2; ++b)
#pragma unroll
                    for (int m = 0; m < 4; ++m)
#pragma unroll
                        for (int n = 0; n < 2; ++n) acc[a][b][m][n] = (f32x4){0.f, 0.f, 0.f, 0.f};
        }
    }
    __syncthreads();
}
#endif
}
namespace pg8 {
__device__ __forceinline__ unsigned cvt_pk_bf16(float lo, float hi) { unsigned r; asm volatile("v_cvt_pk_bf16_f32 %0, %1, %2" : "=v"(r) : "v"(lo), "v"(hi)); return r; }
__device__ __forceinline__ void st8(char* p, const f32x4 v0, const f32x4 v1) { u32x4 w; w.x = cvt_pk_bf16(v0[0], v0[1]); w.y = cvt_pk_bf16(v0[2], v0[3]); w.z = cvt_pk_bf16(v1[0], v1[1]); w.w = cvt_pk_bf16(v1[2], v1[3]); *(u32x4*)p = w; }
__device__ __forceinline__ void ld8(const char* p, f32x4& v0, f32x4& v1) { const u32x4 w = *(const u32x4*)p; v0 = (f32x4){bflo(w.x), bfhi(w.x), bflo(w.y), bfhi(w.y)}; v1 = (f32x4){bflo(w.z), bfhi(w.z), bflo(w.w), bfhi(w.w)}; }
__device__ __forceinline__ void tile_of(int L, int nM, int nN, int& pm, int& pn) {
    const int nwg = nM * nN; int wgid = L; { const int q = nwg / 8, r = nwg % 8, xcd = wgid % 8, off = wgid / 8; wgid = (xcd < r ? xcd * (q + 1) : r * (q + 1) + (xcd - r) * q) + off; }
    const int nig = 8 * nN, gid = wgid / nig, fm = gid * 8, gsz = (nM - fm) < 8 ? (nM - fm) : 8;
    pm = fm + ((wgid % nig) % gsz); pn = (wgid % nig) / gsz;
}
#define EPI_ROWS(...) _Pragma("unroll") for (int ai = 0; ai < 2; ++ai) _Pragma("unroll") for (int m = 0; m < 4; ++m) { const int lrow = ai * 128 + wr * 64 + m * 16 + fr; __VA_ARGS__ }
#define EPI_COLS(...) _Pragma("unroll") for (int bj = 0; bj < 2; ++bj) { const int lcol = bj * 128 + wc * 32 + 8 * fq; f32x4& v0 = acc[ai][bj][m][0]; f32x4& v1 = acc[ai][bj][m][1]; __VA_ARGS__ }

struct SchedDense {
    const char* A; const char* B; int lda, ldb, nt, nM, nN, G, c;
    static constexpr bool GATHER = false;
    __device__ __forceinline__ bool next(int i, GU& u) const {
        const int L = i * G + c; if (L >= nM * nN) return false;
        int pm, pn; tile_of(L, nM, nN, pm, pn);
        u.A = A + (size_t)pm * 256 * lda; u.B = B + (size_t)pn * 256 * ldb; u.C = nullptr; u.P = nullptr; u.lda = lda; u.ldb = ldb; u.nt = nt; u.pm = pm; u.pn = pn; u.seg = 0; u.flags = GU_LAST; u.rows = 256; u.aux = 0; u.f8 = 0;
        return true;
    }
    __device__ __forceinline__ unsigned arow(const GU& u, int r) const { return (unsigned)(r * u.lda); }
};
template <bool HALF> struct SchedProj {
    unsigned char* ws; unsigned char* lw; int G, c;
    static constexpr bool GATHER = false;
    __device__ __forceinline__ bool next(int i, GU& u) const {
        int id = -1;
        if (G == 256) {
            if (!HALF) { if (i == 0) id = c; else if (i == 1 && c < 192) id = c + 256; }
            else { if (c < 192) { if (i < 3) id = c * 3 + i; } else { if (i < 5) id = 576 + (c - 192) * 5 + i; } } }
        else { const int L = i * G + c; if (L < (HALF ? 896 : 448)) id = L; }
        if (id < 0) return false;
        int pm, pn;
        if (!HALF) { int t14; tile_of(id, 32, 14, pm, t14); u.A = (const char*)ws + WS_X + (size_t)pm * 256 * 4096; u.lda = 4096; u.B = (const char*)lw + LW_WIN + (size_t)t14 * 256 * 4096; u.ldb = 4096; u.nt = 32; u.f8 = 0;
            pn = t14 < 12 ? t14 : 16 + (t14 - 12); }
        else { int t28; tile_of(id, 32, 28, pm, t28); u.A = (const char*)ws + WS_H8 + (size_t)pm * 256 * 2048; u.lda = 2048; u.B = (const char*)lw + LW_WG8 + (size_t)t28 * 256 * 2048; u.ldb = 2048; u.nt = 16; u.f8 = 1;
            pn = t28 < 24 ? 18 + t28 : 12 + (t28 - 24); }
        u.C = nullptr; u.P = nullptr; u.pm = pm; u.pn = pn; u.seg = 0; u.flags = GU_LAST; u.rows = 256; u.aux = 0;
        return true;
    }
    __device__ __forceinline__ unsigned arow(const GU& u, int r) const { return (unsigned)(r * u.lda); }
};
template <int MODE> struct SchedSeg {
    unsigned char* ws; unsigned char* lw; int G, c;
    static constexpr bool GATHER = false; static constexpr int NS = MODE == 0 ? 3 : 4;
    __device__ __forceinline__ bool next(int i, GU& u) const {
        const int ti = i / NS, sg = i % NS; const int L = ti * G + c; if (L >= 256) return false;
        int pm, pn; tile_of(L, 32, 8, pm, pn);
        if (MODE == 0) { const size_t ao = sg == 0 ? WS_OAN : sg == 1 ? WS_CVO : WS_GLUO; const int la = sg == 0 ? 2048 : 1024; const size_t bo = sg == 0 ? 0 : sg == 1 ? 2048 : 3072;
            u.A = (const char*)ws + ao + (size_t)pm * 256 * la; u.lda = la; u.nt = sg == 0 ? 16 : 8; u.B = (const char*)lw + LW_WCAT + bo + (size_t)pn * 256 * 4096; u.ldb = 4096; }
        else if (XAO_FP8) { int two = 2; asm volatile("" : "+s"(two)); u.A = (const char*)ws + WS_P + sg * 256 + (size_t)pm * 256 * 1024; u.lda = 1024; u.nt = two; u.B = (const char*)lw + LW_VW + sg * 256 + (size_t)pn * 256 * 1024; u.ldb = 1024; }
        else { u.A = (const char*)ws + WS_P + sg * 512 + (size_t)pm * 256 * 2048; u.lda = 2048; u.nt = 4; u.B = (const char*)lw + LW_VW + sg * 512 + (size_t)pn * 256 * 2048; u.ldb = 2048; }
        u.C = nullptr; u.P = nullptr; u.pm = pm; u.pn = pn; u.seg = sg; u.flags = (sg == NS - 1) ? GU_LAST : 0; u.rows = 256; u.aux = 0; u.f8 = 0;
        return true;
    }
    __device__ __forceinline__ unsigned arow(const GU& u, int r) const { return (unsigned)(r * u.lda); }
};
struct EpiStore { int ldc; int ncolh;
    __device__ __forceinline__ void operator()(Acc& acc, const GU& u, int wr, int wc, int fr, int fq) const {
        const float sc = __builtin_bit_cast(float, u.aux);
        EPI_ROWS( if (lrow < u.rows) { char* rp = u.C + (unsigned)(lrow * ldc); EPI_COLS( if (bj < ncolh) st8(rp + lcol * 2, v0 * sc, v1 * sc); ) } )
    }
};
struct EpiStoreF32 { int ldc;
    __device__ __forceinline__ void operator()(Acc& acc, const GU& u, int wr, int wc, int fr, int fq) const {
        EPI_ROWS( { char* rp = u.C + (unsigned)(lrow * ldc); const int lcol = wc * 32 + 8 * fq; *(f32x4*)(rp + lcol * 4) = acc[ai][0][m][0]; *(f32x4*)(rp + lcol * 4 + 16) = acc[ai][0][m][1]; } )
    }
};
struct EpiProj { char* ws; const float* ropeC; const float* ropeS; const float* rstd;
    __device__ __forceinline__ void operator()(Acc& acc, const GU& u, int wr, int wc, int fr, int fq) const {
        const int pn = u.pn;
        if (pn < 8) {
            char* dst = ws + (pn < 4 ? WS_Q : WS_K) + (size_t)(pn & 3) * 512; const float sc0 = pn < 4 ? C2Q : 1.f;
            EPI_ROWS( { const int tok = u.pm * 256 + lrow; char* rp = dst + (unsigned)(tok * 2048); const float sc = sc0 * rstd[tok];
                EPI_COLS( { const int i0 = (lcol & 63) >> 1; const f32x4 c4 = *(const f32x4*)(ropeC + tok * 32 + i0), s4 = *(const f32x4*)(ropeS + tok * 32 + i0);
                    const f32x4 o0 = (f32x4){v0[0] * c4[0] - v0[1] * s4[0], v0[1] * c4[0] + v0[0] * s4[0], v0[2] * c4[1] - v0[3] * s4[1], v0[3] * c4[1] + v0[2] * s4[1]};
                    const f32x4 o1 = (f32x4){v1[0] * c4[2] - v1[1] * s4[2], v1[1] * c4[2] + v1[0] * s4[2], v1[2] * c4[3] - v1[3] * s4[3], v1[3] * c4[3] + v1[2] * s4[3]};
                    st8(rp + lcol * 2, o0 * sc, o1 * sc); } ) } )
        } else if (pn < 12) {
            char* dst = ws + WS_V + (size_t)(pn - 8) * 512;
            EPI_ROWS( { const int tok = u.pm * 256 + lrow; char* rp = dst + (unsigned)(tok * 2048); const float rs = rstd[tok]; EPI_COLS( st8(rp + lcol * 2, v0 * rs, v1 * rs); ) } )
        } else if (pn < 16) {
            char* dst = ws + WS_Z + (size_t)(pn - 12) * 256;
            EPI_ROWS( { const int tok = u.pm * 256 + lrow; char* rp = dst + (unsigned)(tok * 1024); const float is = rstd[tok] * (1.f / GATE_WSCALE);
                EPI_COLS( { u32x2 w; w.x = cvt_pk_bf16(v0[0] * is * sigmoidf_(v0[1] * is), v0[2] * is * sigmoidf_(v0[3] * is)); w.y = cvt_pk_bf16(v1[0] * is * sigmoidf_(v1[1] * is), v1[2] * is * sigmoidf_(v1[3] * is)); *(u32x2*)(rp + lcol) = w; } ) } )
        } else if (pn < 18) {
            EPI_ROWS( { const int tok = u.pm * 256 + lrow; const float rs = rstd[tok];
                EPI_COLS( { const int ch = (pn - 16) * 256 + lcol, g = ch >> 4, h = ch & 15; st8((ws + WS_UC) + (unsigned)(((g * 256 + (tok >> 5)) * 512 + (tok & 31) * 16 + h) * 2), v0 * rs, v1 * rs); } ) } )
        } else {
            char* dst = ws + WS_GATES + (size_t)(pn - 18) * 256;
            EPI_ROWS( { const int tok = u.pm * 256 + lrow; char* rp = dst + (unsigned)(tok * 6144); const float is = rstd[tok] * (1.f / GATE_WSCALE);
                EPI_COLS( { unsigned qa[4], qb[4];
                    _Pragma("unroll") for (int j = 0; j < 4; ++j) { qa[j] = (unsigned)fminf(sigmoidf_(v0[j] * is) * 256.f, 255.f); qb[j] = (unsigned)fminf(sigmoidf_(v1[j] * is) * 256.f, 255.f); }
                    u32x2 w; w.x = qa[0] | (qa[1] << 8) | (qa[2] << 16) | (qa[3] << 24); w.y = qb[0] | (qb[1] << 8) | (qb[2] << 16) | (qb[3] << 24);
                    *(u32x2*)(rp + lcol) = w; } ) } )
        }
    }
};
struct EpiSsm3 { char* ys;
    __device__ __forceinline__ void operator()(Acc& acc, const GU& u, int wr, int wc, int fr, int fq) const {
        if (!(u.flags & GU_LAST)) return;
        const int g = u.pm;
        EPI_ROWS( { const int chunk = lrow;
            EPI_COLS( { const int jh = u.pn * 256 + lcol, j = jh >> 4, h = jh & 15; st8(ys + (unsigned)(((chunk * 32 + j) * 512 + g * 16 + h) * 2), v0, v1); } ) } )
    }
};
struct EpiGlu { char* dst; const float* bias;
    __device__ __forceinline__ void operator()(Acc& acc, const GU& u, int wr, int wc, int fr, int fq) const {
        EPI_ROWS( { const int tok = u.pm * 256 + lrow; char* rp = (dst + (size_t)u.pn * 256) + (unsigned)(tok * 1024);
            EPI_COLS( { const int j0 = u.pn * 128 + (lcol >> 1); const f32x4 ba = *(const f32x4*)(bias + j0), bb = *(const f32x4*)(bias + 512 + j0);
                u32x2 w; w.x = cvt_pk_bf16((v0[0] + ba[0]) * sigmoidf_(v0[1] + bb[0]), (v0[2] + ba[1]) * sigmoidf_(v0[3] + bb[1]));
                w.y = cvt_pk_bf16((v1[0] + ba[2]) * sigmoidf_(v1[1] + bb[2]), (v1[2] + ba[3]) * sigmoidf_(v1[3] + bb[3])); *(u32x2*)(rp + lcol) = w; } ) } )
    }
};
struct EpiGated { const char* gates; char* merged;
    __device__ __forceinline__ void operator()(Acc& acc, const GU& u, int wr, int wc, int fr, int fq) const {
        const int sg = u.seg;
        EPI_ROWS( { const int tok = u.pm * 256 + lrow; const char* gp = (gates + (size_t)u.pn * 256) + (unsigned)(tok * 6144); char* mp = (merged + (size_t)u.pn * 512) + (unsigned)(tok * 4096);
            EPI_COLS( { const u32x2 nq = *(const u32x2*)(gp + (size_t)sg * 2048 + lcol);
                if (sg < 2) { const u32x2 dq = *(const u32x2*)(gp + (size_t)(sg + 1) * 2048 + lcol);
                    _Pragma("unroll") for (int j = 0; j < 4; ++j) { v0[j] *= ((float)((nq.x >> (8 * j)) & 255u) + 0.5f) * __builtin_amdgcn_rcpf((float)((dq.x >> (8 * j)) & 255u) + 0.5f); v1[j] *= ((float)((nq.y >> (8 * j)) & 255u) + 0.5f) * __builtin_amdgcn_rcpf((float)((dq.y >> (8 * j)) & 255u) + 0.5f); } }
                else { _Pragma("unroll") for (int j = 0; j < 4; ++j) { v0[j] *= fmaf((float)((nq.x >> (8 * j)) & 255u), 1.f / 256.f, 0.5f / 256.f); v1[j] *= fmaf((float)((nq.y >> (8 * j)) & 255u), 1.f / 256.f, 0.5f / 256.f); }
                    st8(mp + lcol * 2, v0, v1); } } ) } )
    }
};
struct EpiResid { char* x; char* h8; float* rsq;
    __device__ __forceinline__ void operator()(Acc& acc, const GU& u, int wr, int wc, int fr, int fq) const {
        EPI_ROWS( { const int tok = u.pm * 256 + lrow; char* rp = (x + (size_t)u.pn * 512) + (unsigned)(tok * 4096); char* hp = (h8 + (size_t)u.pn * (S_FP8 ? 256 : 512)) + (unsigned)(tok * (S_FP8 ? 2048 : 4096)); float s = 0.f;
            EPI_COLS( { f32x4 a, b; ld8(rp + lcol * 2, a, b); a = a + v0; b = b + v1; st8(rp + lcol * 2, a, b);
                s += (a[0] * a[0] + a[1] * a[1]) + (a[2] * a[2] + a[3] * a[3]) + (b[0] * b[0] + b[1] * b[1]) + (b[2] * b[2] + b[3] * b[3]);
#if S_FP8
                int q0 = __builtin_amdgcn_cvt_pk_fp8_f32(a[0], a[1], 0, false); q0 = __builtin_amdgcn_cvt_pk_fp8_f32(a[2], a[3], q0, true);
                int q1 = __builtin_amdgcn_cvt_pk_fp8_f32(b[0], b[1], 0, false); q1 = __builtin_amdgcn_cvt_pk_fp8_f32(b[2], b[3], q1, true); *(u32x2*)(hp + lcol) = (u32x2){(unsigned)q0, (unsigned)q1};
#elif !defined(DBG_NO_HST)
                st8(hp + lcol * 2, a, b);
#endif
                } )
#ifndef DBG_NO_RSQ
            s += xor_lane<16>(s); s += xor_lane<32>(s);
            if (fq == 0) rsq[(u.pn * T + tok) * 4 + wc] = s;
#endif
            } )
    }
};
struct EpiSexp { char* P; float* rs; const float* rsq;
    __device__ __forceinline__ void operator()(Acc& acc, const GU& u, int wr, int wc, int fr, int fq) const {
        EPI_ROWS( { const int tok = u.pm * 256 + lrow; char* rp = (P + (size_t)u.pn * 512) + (unsigned)(tok * 2048); char* rp8 = (P + (size_t)u.pn * 256) + (unsigned)(tok * 1024); (void)rp; (void)rp8; float s = 0.f;
            float sq = 0.f;
#ifdef DBG_READ_RS
            _Pragma("unroll") for (int q = 0; q < 8; ++q) { const f32x4 t4 = *(const f32x4*)(rs + 262144 + tok * 32 + q * 4); sq += (t4[0] + t4[1]) + (t4[2] + t4[3]); }
#elif defined(DBG_RSQ_ATOMIC_LD)
            _Pragma("unroll") for (int q = 0; q < 32; ++q) sq += __hip_atomic_load(rsq + tok * 32 + q, __ATOMIC_RELAXED, __HIP_MEMORY_SCOPE_AGENT);
#else
            _Pragma("unroll") for (int q = 0; q < 8; ++q) { const f32x4 t4 = *(const f32x4*)(rsq + (q * T + tok) * 4); sq += (t4[0] + t4[1]) + (t4[2] + t4[3]); }
#endif
#ifdef DBG_RN1
            const float rn = 1.f;
#elif defined(DBG_RN1_KEEP)
            asm volatile("" :: "v"(sq)); const float rn = 1.f;
#else
            const float rn = FUSE_N2 ? rsqrtf(sq * (1.f / DM) + RMS_EPS) * (1.f / SQK_SCALE) : 1.f + 0.f * sq;
#endif
#if XAO_FP8
            EPI_COLS( { v0 = v0 * rn - 2.f; v1 = v1 * rn - 2.f;
                const float e0 = __builtin_amdgcn_exp2f(v0[0]), e1 = __builtin_amdgcn_exp2f(v0[1]), e2 = __builtin_amdgcn_exp2f(v0[2]), e3 = __builtin_amdgcn_exp2f(v0[3]);
                const float e4 = __builtin_amdgcn_exp2f(v1[0]), e5 = __builtin_amdgcn_exp2f(v1[1]), e6 = __builtin_amdgcn_exp2f(v1[2]), e7 = __builtin_amdgcn_exp2f(v1[3]);
                int q0 = __builtin_amdgcn_cvt_pk_fp8_f32(e0, e1, 0, false); q0 = __builtin_amdgcn_cvt_pk_fp8_f32(e2, e3, q0, true);
                int q1 = __builtin_amdgcn_cvt_pk_fp8_f32(e4, e5, 0, false); q1 = __builtin_amdgcn_cvt_pk_fp8_f32(e6, e7, q1, true);
                *(u32x2*)(rp8 + lcol) = (u32x2){(unsigned)q0, (unsigned)q1};
                const f32x2 a0 = __builtin_amdgcn_cvt_pk_f32_fp8(q0, false), a1 = __builtin_amdgcn_cvt_pk_f32_fp8(q0, true), a2 = __builtin_amdgcn_cvt_pk_f32_fp8(q1, false), a3 = __builtin_amdgcn_cvt_pk_f32_fp8(q1, true);
                s += ((a0[0] + a0[1]) + (a1[0] + a1[1])) + ((a2[0] + a2[1]) + (a3[0] + a3[1])); } )
#else
            EPI_COLS( { v0 = v0 * rn; v1 = v1 * rn; u32x4 w; w.x = cvt_pk_bf16(__builtin_amdgcn_exp2f(v0[0]), __builtin_amdgcn_exp2f(v0[1])); w.y = cvt_pk_bf16(__builtin_amdgcn_exp2f(v0[2]), __builtin_amdgcn_exp2f(v0[3]));
                w.z = cvt_pk_bf16(__builtin_amdgcn_exp2f(v1[0]), __builtin_amdgcn_exp2f(v1[1])); w.w = cvt_pk_bf16(__builtin_amdgcn_exp2f(v1[2]), __builtin_amdgcn_exp2f(v1[3]));
                *(u32x4*)(rp + lcol * 2) = w; s += ((bflo(w.x) + bfhi(w.x)) + (bflo(w.y) + bfhi(w.y))) + ((bflo(w.z) + bfhi(w.z)) + (bflo(w.w) + bfhi(w.w))); } )
#endif
            s += xor_lane<16>(s); s += xor_lane<32>(s);
            if (fq == 0) rs[(u.pn * T + tok) * 4 + wc] = s; } )
    }
};
#ifdef DBG_NO_XA
#define XA_DBG_COND && false
#else
#define XA_DBG_COND
#endif
struct EpiXao { const float* rs; char* x;
    __device__ __forceinline__ void operator()(Acc& acc, const GU& u, int wr, int wc, int fr, int fq) const {
        const int sg = u.seg;
        EPI_ROWS( { const int tok = u.pm * 256 + lrow; const f32x4 a = *(const f32x4*)(rs + (sg * T + tok) * 4); const float lh = (a[0] + a[1]) + (a[2] + a[3]);
            float f = __builtin_amdgcn_rcpf(lh) * (sg == 3 ? 1.f / VW_SCALE : 1.f);
            if (sg < 3) { const f32x4 b = *(const f32x4*)(rs + ((sg + 1) * T + tok) * 4); f *= (b[0] + b[1]) + (b[2] + b[3]); }
            char* rp = (x + (size_t)u.pn * 512) + (unsigned)(tok * 4096);
            EPI_COLS( { v0 = v0 * f; v1 = v1 * f; if (sg == 3 XA_DBG_COND) { f32x4 a, b; ld8(rp + lcol * 2, a, b); st8(rp + lcol * 2, a + v0, b + v1); } } ) } )
    }
};
template <bool DOWN> struct SchedMoE {
    const volatile LAS int* cnt;
    unsigned char* ws; unsigned char* lw; int G, c;
    static constexpr bool GATHER = !DOWN;
    static constexpr int nN = DOWN ? 8 : 4;
    __device__ __forceinline__ bool next(int i, GU& u) const {
        const int L = i * G + c; const int tile = L / nN, pn = L % nN;
        int e = -1, mt = 0, off = 0, tacc = 0, ce = 0;
#pragma unroll 1
        for (int k = 0; k < NEXP; ++k) { const int ck = __builtin_amdgcn_readfirstlane(cnt[k]); const int tk = (ck + 255) >> 8;
            if (e < 0 && tile < tacc + tk) { e = k; mt = tile - tacc; ce = ck; }
            if (e < 0) { off += ck; tacc += tk; } }
        if (e < 0) return false;
        u.pm = mt; u.pn = pn; u.seg = 0; u.flags = GU_LAST; u.aux = e; u.f8 = 1;
        u.rows = (ce - mt * 256) < 256 ? (ce - mt * 256) : 256;
        int ntd = 4, ntg = 16; asm volatile("" : "+s"(ntd), "+s"(ntg));
        if (DOWN) { u.nt = ntd; u.lda = 512; u.ldb = 512; u.B = (const char*)lw + LW_WD + (size_t)e * DM * FFE + (size_t)pn * 256 * 512;
            u.A = (const char*)ws + WS_HE + (size_t)(off + mt * 256) * 512; u.C = (char*)ws + WS_Y + (size_t)(off + mt * 256) * 2048; u.P = nullptr; }
        else { u.nt = ntg; u.lda = 2048; u.ldb = 2048; u.B = (const char*)lw + LW_WGU + (size_t)e * 1024 * DM + (size_t)pn * 256 * 2048;
            u.A = (const char*)ws + WS_H8; u.C = (char*)ws + WS_HE + (size_t)(off + mt * 256) * 512; u.P = (const char*)ws + WS_WL + ((size_t)e * T + mt * 256) * 4; }
        return true;
    }
    __device__ __forceinline__ unsigned arow(const GU& u, int r) const {
        if (DOWN) return (unsigned)(r * u.lda);
        const int tok = (r < u.rows) ? ((const int*)(ws + WS_LIST))[u.aux * T + u.pm * 256 + r] : 0;
        return (unsigned)tok * (unsigned)u.lda;
    }
};
struct EpiGu {
    __device__ __forceinline__ void operator()(Acc& acc, const GU& u, int wr, int wc, int fr, int fq) const {
        constexpr float is = 1.f / GATE_WSCALE;
        EPI_ROWS( if (lrow < u.rows) { const float w = *(const float*)(u.P + lrow * 4) * is; char* rp = (u.C + (size_t)u.pn * 128) + (unsigned)(lrow * 512);
            EPI_COLS( { const float g0 = v0[0] * is, g1 = v0[2] * is, g2 = v1[0] * is, g3 = v1[2] * is;
                int p8 = __builtin_amdgcn_cvt_pk_fp8_f32(g0 * sigmoidf_(g0) * v0[1] * w, g1 * sigmoidf_(g1) * v0[3] * w, 0, false);
                p8 = __builtin_amdgcn_cvt_pk_fp8_f32(g2 * sigmoidf_(g2) * v1[1] * w, g3 * sigmoidf_(g3) * v1[3] * w, p8, true); *(unsigned*)(rp + (lcol >> 1)) = (unsigned)p8; } ) } )
    }
};
struct EpiDown {
    __device__ __forceinline__ void operator()(Acc& acc, const GU& u, int wr, int wc, int fr, int fq) const {
        constexpr float ys = 16.f / GATE_WSCALE;
        EPI_ROWS( if (lrow < u.rows) { char* rp = (u.C + (size_t)u.pn * 256) + (unsigned)(lrow * 2048);
            EPI_COLS( { int q0 = __builtin_amdgcn_cvt_pk_fp8_f32(v0[0] * ys, v0[1] * ys, 0, false); q0 = __builtin_amdgcn_cvt_pk_fp8_f32(v0[2] * ys, v0[3] * ys, q0, true);
                int q1 = __builtin_amdgcn_cvt_pk_fp8_f32(v1[0] * ys, v1[1] * ys, 0, false); q1 = __builtin_amdgcn_cvt_pk_fp8_f32(v1[2] * ys, v1[3] * ys, q1, true); *(u32x2*)(rp + lcol) = (u32x2){(unsigned)q0, (unsigned)q1}; } ) } )
    }
};
}
#include <hip/hip_bf16.h>
#include <cmath>
namespace attn_body {
using bf16=__hip_bfloat16;
using bf16x8=__attribute__((ext_vector_type(8)))short;
using s16x4=__attribute__((ext_vector_type(4)))short;
using f32x16=__attribute__((ext_vector_type(16)))float;
using u32x4=__attribute__((ext_vector_type(4)))unsigned;
constexpr int BATCH=1,NHEAD=16,SEQ=8192,D=64,DM=NHEAD*D;
constexpr int NW=8,QBLK=32,QB=QBLK*NW,KVBLK=64,NQB=SEQ/QB;
constexpr int ATTN_PITCH=DM, ATTN_UNIT_ROWS=QB;
__device__ __forceinline__ int crow(int r,int hi){return (r&3)+8*(r>>2)+4*hi;}
#define SBAR() __builtin_amdgcn_sched_barrier(0)
__device__ __forceinline__ void cmask(f32x16&p0,f32x16&p1,int jb,int qrel,int hi){
  const float NEG=-INFINITY; int kb=64*jb+4*hi;
  #pragma unroll
  for(int r=0;r<16;++r){int kv=kb+(r&3)+8*(r>>2); if(kv>qrel)p0[r]=NEG; if(kv+32>qrel)p1[r]=NEG;}
}

constexpr int NSLOT=3, SLOTB=8192;
constexpr int LDS_K=0, LDS_V=NSLOT*SLOTB, LDS_WS=2*NSLOT*SLOTB, LDS_OST=LDS_WS+NW*64*4, LDS_BYTES=LDS_OST+NW*4096;
constexpr float C2=0.125f*1.4426950408889634f;
__device__ __forceinline__ void glds16(const void*gsrc,unsigned lds_dst){unsigned keep;
  asm volatile("s_mov_b32 %0, m0\n\ts_mov_b32 m0, %2\n\ts_nop 0\n\tglobal_load_lds_dwordx4 %1, off\n\ts_mov_b32 m0, %0":"=&s"(keep):"v"(gsrc),"s"(lds_dst):"memory");}
__device__ __forceinline__ float max3f(float a,float b,float c){float r;asm("v_max3_f32 %0, %1, %2, %3":"=v"(r):"v"(a),"v"(b),"v"(c));return r;}
__device__ __forceinline__ float max2f(float a,float b){float r;asm("v_max_f32_e32 %0, %1, %2":"=v"(r):"v"(a),"v"(b));return r;}
__device__ __forceinline__ float fadd_s(float a,float b){float r;asm("v_add_f32_e32 %0, %1, %2":"=v"(r):"v"(a),"v"(b));return r;}
__device__ __forceinline__ float fsub_s(float a,float b){float r;asm("v_sub_f32_e32 %0, %1, %2":"=v"(r):"v"(a),"v"(b));return r;}
typedef float f32x2_t __attribute__((ext_vector_type(2))); typedef __bf16 bf16x2_t __attribute__((ext_vector_type(2)));
__device__ __forceinline__ unsigned cvtpk_s(float lo,float hi){f32x2_t v={lo,hi};bf16x2_t b=__builtin_convertvector(v,bf16x2_t);return __builtin_bit_cast(unsigned,b);}
#define WAIT_BAR(N) asm volatile("s_waitcnt vmcnt(" #N ") lgkmcnt(0)\n\ts_barrier":::"memory")

__device__ __forceinline__ void qkt(f32x16&p0,f32x16&p1,const char*Kslot,const bf16x8*qr,const f32x16&negm,int r32,int hi){
  const char*kb=Kslot+hi*1024+r32*16;
  #pragma unroll
  for(int d0=0;d0<4;++d0){
    const bf16x8 b0=*reinterpret_cast<const bf16x8*>(kb+d0*2048);
    const bf16x8 b1=*reinterpret_cast<const bf16x8*>(kb+d0*2048+512);
    if(d0==0){p0=__builtin_amdgcn_mfma_f32_32x32x16_bf16(b0,qr[0],negm,0,0,0);p1=__builtin_amdgcn_mfma_f32_32x32x16_bf16(b1,qr[0],negm,0,0,0);}
    else{p0=__builtin_amdgcn_mfma_f32_32x32x16_bf16(b0,qr[d0],p0,0,0,0);p1=__builtin_amdgcn_mfma_f32_32x32x16_bf16(b1,qr[d0],p1,0,0,0);}}
}
typedef __attribute__((address_space(3))) const char* lds_cptr;
typedef short v4i16_t __attribute__((ext_vector_type(4)));
__device__ __forceinline__ void kload8(bf16x8*kf,lds_cptr kp){
  kf[0]=*(const __attribute__((address_space(3))) bf16x8*)(kp);      kf[1]=*(const __attribute__((address_space(3))) bf16x8*)(kp+512);
  kf[2]=*(const __attribute__((address_space(3))) bf16x8*)(kp+2048); kf[3]=*(const __attribute__((address_space(3))) bf16x8*)(kp+2560);
  kf[4]=*(const __attribute__((address_space(3))) bf16x8*)(kp+4096); kf[5]=*(const __attribute__((address_space(3))) bf16x8*)(kp+4608);
  kf[6]=*(const __attribute__((address_space(3))) bf16x8*)(kp+6144); kf[7]=*(const __attribute__((address_space(3))) bf16x8*)(kp+6656);
}
__device__ __forceinline__ void kload2(bf16x8*kf,lds_cptr kp,int j){ kf[2*j]=*(const __attribute__((address_space(3))) bf16x8*)(kp+j*2048); kf[2*j+1]=*(const __attribute__((address_space(3))) bf16x8*)(kp+j*2048+512); }
__device__ __forceinline__ s16x4 vtr(lds_cptr p){ return __builtin_bit_cast(s16x4,__builtin_amdgcn_ds_read_tr16_b64_v4i16((__attribute__((address_space(3))) v4i16_t*)p)); }
__device__ __forceinline__ float rowmax(const f32x16&p0,const f32x16&p1){
  float a=max3f(p0[0],p0[1],p1[0]),b=max3f(p0[2],p0[3],p1[1]);a=max3f(a,p1[2],p1[3]);
  #pragma unroll
  for(int r=4;r<16;r+=4){a=max3f(a,p0[r],p0[r+1]);b=max3f(b,p0[r+2],p0[r+3]);a=max3f(a,p1[r],p1[r+1]);b=max3f(b,p1[r+2],p1[r+3]);}
  const float m=max2f(a,b);
  auto rr=__builtin_amdgcn_permlane32_swap(__float_as_uint(m),__float_as_uint(m),false,false);
  return max2f(__uint_as_float(rr[0]),__uint_as_float(rr[1]));
}
__device__ __forceinline__ void pv(f32x16*o,int vb,bf16x8 pa0,bf16x8 pa1,bf16x8 pa2,bf16x8 pa3){
  #pragma unroll
  for(int d0=0;d0<2;++d0){s16x4 lo[4],hi[4];
    #pragma unroll
    for(int ks=0;ks<4;++ks){
      asm volatile("ds_read_b64_tr_b16 %0,%1 offset:%c2":"=&v"(lo[ks]):"v"(vb),"i"(d0*4096+ks*1024):"memory");
      asm volatile("ds_read_b64_tr_b16 %0,%1 offset:%c2":"=&v"(hi[ks]):"v"(vb),"i"(d0*4096+ks*1024+512):"memory");}
    asm volatile("s_waitcnt lgkmcnt(0)":::"memory");SBAR();
    #define PK(k) (bf16x8){lo[k][0],lo[k][1],lo[k][2],lo[k][3],hi[k][0],hi[k][1],hi[k][2],hi[k][3]}
    o[d0]=__builtin_amdgcn_mfma_f32_32x32x16_bf16(pa0,PK(0),o[d0],0,0,0);
    o[d0]=__builtin_amdgcn_mfma_f32_32x32x16_bf16(pa1,PK(1),o[d0],0,0,0);
    o[d0]=__builtin_amdgcn_mfma_f32_32x32x16_bf16(pa2,PK(2),o[d0],0,0,0);
    o[d0]=__builtin_amdgcn_mfma_f32_32x32x16_bf16(pa3,PK(3),o[d0],0,0,0);
    #undef PK
  }
}

#ifndef ATTN_STORE16
#define ATTN_STORE16(p,v) (*(u32x4*)(p)=(v))
#endif
template<int THRL> __device__ __forceinline__ void attn_unit(int hq,int hv,int qb,const bf16*Q,const bf16*__restrict__ K,const bf16*__restrict__ V,bf16*O,char*shm,const int tid){
  const int lane=tid&63,r32=lane&31,hi=lane>>5; const int wid=__builtin_amdgcn_readfirstlane(tid>>6);
  const long rowbase=0; const int q0=qb*QB;
  const bf16*Qw=Q+(rowbase+q0+wid*QBLK)*DM+hq*D;
  const bf16*Kh=K+rowbase*DM+hq*D,*Vh=V+rowbase*DM+hv*D;
  const unsigned lds0=(unsigned)(uintptr_t)shm;
  float*wsf=(float*)(shm+LDS_WS)+wid*64;
  const bf16*ksrc=Kh+(long)lane*DM+wid*8;
  const bf16*vsrc=Vh+(long)(16*(wid&3)+(lane>>2))*DM+(wid>>2)*32+(lane&3)*8;
  const unsigned kdst=lds0+LDS_K+wid*1024, vdst=lds0+LDS_V+wid*1024;
  #define DMA_K(t,slot) glds16(ksrc+(long)(t)*KVBLK*DM,(unsigned)__builtin_amdgcn_readfirstlane(kdst+(slot)))
  #define DMA_V(t,slot) glds16(vsrc+(long)(t)*KVBLK*DM,(unsigned)__builtin_amdgcn_readfirstlane(vdst+(slot)))
  const int vb0=(int)(lds0+LDS_V)+((lane>>4)&1)*32+(lane&3)*8+(4*hi+((lane&15)>>2))*64;
  const char*Kbase=shm+LDS_K; bf16x8 kf[8];
  const lds_cptr shm3=(lds_cptr)shm; const lds_cptr kp0=shm3+LDS_K+hi*1024+r32*16; const lds_cptr vp0=shm3+LDS_V+((lane>>4)&1)*32+(lane&3)*8+(4*hi+((lane&15)>>2))*64;
  const int NT=(q0+QB)/KVBLK;
  DMA_K(0,0);DMA_V(0,0);DMA_K(1,SLOTB);
  bf16x8 qr[4];
  #pragma unroll
  for(int d0=0;d0<4;++d0)qr[d0]=*reinterpret_cast<const bf16x8*>(&Qw[(long)r32*DM+d0*16+hi*8]);
  float mhat=0.f,l_reg=0.f;f32x16 o[2];o[0]=f32x16{};o[1]=f32x16{};f32x16 negm=f32x16{};asm volatile("":"+v"(negm));
  const int qrel=wid*QBLK+r32;
  #define CMASK(P0,P1,t) do{int jb_=(t)-(NT-4); if(jb_>=0)cmask(P0,P1,jb_,qrel,hi);}while(0)
  bool resc=false;
  #define START(P0,P1) do{ const float rm=rowmax(P0,P1); resc=false; \
    { const float dl=rm; mhat=fadd_s(mhat,dl); \
      _Pragma("unroll") for(int r=0;r<16;++r){P0[r]=fsub_s(P0[r],dl);P1[r]=fsub_s(P1[r],dl);} \
      _Pragma("unroll") for(int r=0;r<16;++r)negm[r]=-mhat; asm volatile("":"+v"(negm)); } \
    _Pragma("unroll") for(int r=0;r<16;++r)P0[r]=__builtin_amdgcn_exp2f(P0[r]); }while(0)
  #define RESC() do{ if(resc){ asm volatile("s_waitcnt lgkmcnt(0)":::"memory"); \
      _Pragma("unroll") for(int d_=0;d_<2;++d_) _Pragma("unroll") for(int r=0;r<16;++r)o[d_][r]*=wsf[crow(r,hi)]; } }while(0)
  f32x16 pA0,pA1,pB0,pB1;
  int sl_prev=0,sl_cur=0,sl_next=SLOTB;
  #define ROT() do{sl_prev=sl_cur;sl_cur=sl_next;sl_next=(sl_next==(NSLOT-1)*SLOTB)?0:sl_next+SLOTB;}while(0)
  DMA_K(2,2*SLOTB);
  WAIT_BAR(3);
  qkt(pA0,pA1,Kbase,qr,negm,r32,hi);asm volatile("s_nop 15\n\ts_nop 7":"+v"(pA0),"+v"(pA1));CMASK(pA0,pA1,0);
  START(pA0,pA1);
  _Pragma("unroll") for(int r=0;r<16;++r)pA1[r]=__builtin_amdgcn_exp2f(pA1[r]);
  WAIT_BAR(0);
  DMA_K(3,0);DMA_V(1,SLOTB);
  ROT();
  kload8(kf,kp0+sl_cur);
  WAIT_BAR(2);
  s16x4 vlo[8],vhi[8]; u32x4 pw0,pw1,pw2,pw3;
  #define PKW(P,B) cvtpk_s(P[B],P[B+1])
  #define PAF(k) __builtin_bit_cast(bf16x8,pw##k)
  #define VFR(i) (bf16x8){vlo[i][0],vlo[i][1],vlo[i][2],vlo[i][3],vhi[i][0],vhi[i][1],vhi[i][2],vhi[i][3]}
  #define PIN(x) asm volatile("":"+v"(x))
  #define MX3(a,b,c) __builtin_fmaxf(__builtin_fmaxf((a),(b)),(c))
  #define GAPA(MF,A0,A1,A2,A3,W0,W1,PW) do{ MF; sacc+=A0; sacc+=A1; sacc+=A2; sacc+=A3; PIN(sacc); W0; W1; PIN(PW); SBAR(); }while(0)
  #define EX(v) __builtin_amdgcn_exp2f(v)
  #define GAPB(MF,X,B) do{ MF; X[B]=EX(X[B]); X[B+1]=EX(X[B+1]); X[B+2]=EX(X[B+2]); X[B+3]=EX(X[B+3]); PIN(X); SBAR(); }while(0)
  #define VRD(i) do{ vlo[i]=vtr(vp_+(((i)>>2)*4096+((i)&3)*1024)); vhi[i]=vtr(vp_+(((i)>>2)*4096+((i)&3)*1024+512)); }while(0)
  #define KRD(G,j) do{ if(G){ kload2(kf,kp0+sl_next,j); SBAR(); } }while(0)
  #define STEP(C0,C1,P0,P1,t,GK,GV,GL) do{ SBAR(); \
    const lds_cptr vp_=vp0+sl_prev; \
    VRD(0); SBAR(); float sacc=(P0[0]+P0[1]); \
    GAPA(C0=__builtin_amdgcn_mfma_f32_32x32x16_bf16(kf[0],qr[0],negm,0,0,0), P0[2],P0[3],P0[4],P0[5],     pw0[0]=PKW(P0,0), pw0[1]=PKW(P0,2), pw0); \
    VRD(4); SBAR(); GAPA(C1=__builtin_amdgcn_mfma_f32_32x32x16_bf16(kf[1],qr[0],negm,0,0,0), P0[6],P0[7],P0[8],P0[9],     pw0[2]=PKW(P0,4), pw0[3]=PKW(P0,6), pw0); \
    VRD(1); SBAR(); GAPA(C0=__builtin_amdgcn_mfma_f32_32x32x16_bf16(kf[2],qr[1],C0,0,0,0),   P0[10],P0[11],P0[12],P0[13], pw1[0]=PKW(P0,8), pw1[1]=PKW(P0,10), pw1); \
    VRD(5); SBAR(); GAPA(C1=__builtin_amdgcn_mfma_f32_32x32x16_bf16(kf[3],qr[1],C1,0,0,0),   P0[14],P0[15],P1[0],P1[1],   pw1[2]=PKW(P0,12),pw1[3]=PKW(P0,14), pw1); \
    VRD(2); SBAR(); GAPA(C0=__builtin_amdgcn_mfma_f32_32x32x16_bf16(kf[4],qr[2],C0,0,0,0),   P1[2],P1[3],P1[4],P1[5],     pw2[0]=PKW(P1,0), pw2[1]=PKW(P1,2), pw2); \
    VRD(6); SBAR(); GAPA(C1=__builtin_amdgcn_mfma_f32_32x32x16_bf16(kf[5],qr[2],C1,0,0,0),   P1[6],P1[7],P1[8],P1[9],     pw2[2]=PKW(P1,4), pw2[3]=PKW(P1,6), pw2); \
    VRD(3); SBAR(); GAPA(C0=__builtin_amdgcn_mfma_f32_32x32x16_bf16(kf[6],qr[3],C0,0,0,0),   P1[10],P1[11],P1[12],P1[13], pw3[0]=PKW(P1,8), pw3[1]=PKW(P1,10), pw3); \
    VRD(7); SBAR(); GAPA(C1=__builtin_amdgcn_mfma_f32_32x32x16_bf16(kf[7],qr[3],C1,0,0,0),   P1[14],P1[15],0.f,0.f,       pw3[2]=PKW(P1,12),pw3[3]=PKW(P1,14), pw3); \
    l_reg+=sacc; \
    if(GK){DMA_K((t)+3,sl_cur);} if(GV){DMA_V((t)+1,sl_next);} \
    CMASK(C0,C1,t); \
    { float a=MX3(C0[0],C0[1],C1[0]),b=MX3(C0[2],C0[3],C1[1]); a=MX3(a,C1[2],C1[3]); \
      _Pragma("unroll") for(int r=4;r<16;r+=4){a=MX3(a,C0[r],C0[r+1]);b=MX3(b,C0[r+2],C0[r+3]);a=MX3(a,C1[r],C1[r+1]);b=MX3(b,C1[r+2],C1[r+3]);} \
      float rm=__builtin_fmaxf(a,b); { auto rr=__builtin_amdgcn_permlane32_swap(__float_as_uint(rm),__float_as_uint(rm),false,false); rm=__builtin_fmaxf(__uint_as_float(rr[0]),__uint_as_float(rr[1])); } \
      resc=false; \
      if(__builtin_expect(__any(rm>(float)THRL),0)){ const float dl=__builtin_fmaxf(rm,0.f); mhat+=dl; \
        _Pragma("unroll") for(int r=0;r<16;++r){C0[r]-=dl;C1[r]-=dl;} \
        _Pragma("unroll") for(int r=0;r<16;++r)negm[r]=-mhat; asm volatile("":"+v"(negm)); \
        const float f=__builtin_amdgcn_exp2f(-dl); l_reg*=f; if(hi==0)wsf[r32]=f; resc=true; } } \
    SBAR(); \
    GAPB(o[0]=__builtin_amdgcn_mfma_f32_32x32x16_bf16(PAF(0),VFR(0),o[0],0,0,0), C0,0); \
    GAPB(o[1]=__builtin_amdgcn_mfma_f32_32x32x16_bf16(PAF(0),VFR(4),o[1],0,0,0), C0,4); \
    KRD(GL,0); GAPB(o[0]=__builtin_amdgcn_mfma_f32_32x32x16_bf16(PAF(1),VFR(1),o[0],0,0,0), C0,8); \
    KRD(GL,1); GAPB(o[1]=__builtin_amdgcn_mfma_f32_32x32x16_bf16(PAF(1),VFR(5),o[1],0,0,0), C0,12); \
    KRD(GL,2); GAPB(o[0]=__builtin_amdgcn_mfma_f32_32x32x16_bf16(PAF(2),VFR(2),o[0],0,0,0), C1,0); \
    KRD(GL,3); GAPB(o[1]=__builtin_amdgcn_mfma_f32_32x32x16_bf16(PAF(2),VFR(6),o[1],0,0,0), C1,4); \
    GAPB(o[0]=__builtin_amdgcn_mfma_f32_32x32x16_bf16(PAF(3),VFR(3),o[0],0,0,0), C1,8); \
    GAPB(o[1]=__builtin_amdgcn_mfma_f32_32x32x16_bf16(PAF(3),VFR(7),o[1],0,0,0), C1,12); \
    }while(0)
  int t=1;
  #undef CMASK
  #define CMASK(P0,P1,t) do{}while(0)
  for(;t+5<NT;t+=2){
    STEP(pB0,pB1,pA0,pA1,t,true,true,true);     WAIT_BAR(2); RESC(); ROT();
    STEP(pA0,pA1,pB0,pB1,t+1,true,true,true);   WAIT_BAR(2); RESC(); ROT();
  }
  #undef CMASK
  #define CMASK(P0,P1,t) do{int jb_=(t)-(NT-4); if(jb_>=0)cmask(P0,P1,jb_,qrel,hi);}while(0)
  #define ENDW(tt) do{ if((tt)+3<NT){WAIT_BAR(2);} else if((tt)+2<NT){WAIT_BAR(1);} else {WAIT_BAR(0);} }while(0)
  for(;t+1<NT;t+=2){
    STEP(pB0,pB1,pA0,pA1,t,(t+3<NT),(t+1<NT),(t+1<NT));       ENDW(t);   RESC(); ROT();
    STEP(pA0,pA1,pB0,pB1,t+1,(t+4<NT),(t+2<NT),(t+2<NT));     ENDW(t+1); RESC(); ROT();
  }
  STEP(pB0,pB1,pA0,pA1,NT-1,false,false,false); RESC();
  { float sacc=pB0[0]+pB0[1]; _Pragma("unroll") for(int r=2;r<16;++r)sacc+=pB0[r]; _Pragma("unroll") for(int r=0;r<16;++r)sacc+=pB1[r]; l_reg+=sacc;
    pw0=(u32x4){PKW(pB0,0),PKW(pB0,2),PKW(pB0,4),PKW(pB0,6)};pw1=(u32x4){PKW(pB0,8),PKW(pB0,10),PKW(pB0,12),PKW(pB0,14)};pw2=(u32x4){PKW(pB1,0),PKW(pB1,2),PKW(pB1,4),PKW(pB1,6)};pw3=(u32x4){PKW(pB1,8),PKW(pB1,10),PKW(pB1,12),PKW(pB1,14)};
    SBAR(); pv(o,vb0+sl_cur,PAF(0),PAF(1),PAF(2),PAF(3)); }
  #undef PKW
  #undef PAF
  #undef VFR
  #undef PIN
  #undef MX3
  #undef GAPA
  #undef GAPB
  #undef EX
  #undef VRD
  #undef KRD
  #undef STEP
  #undef ENDW
  {auto rr=__builtin_amdgcn_permlane32_swap(__float_as_uint(l_reg),__float_as_uint(l_reg),false,false);l_reg=__uint_as_float(rr[0])+__uint_as_float(rr[1]);}
  if(hi==0)wsf[32+r32]=l_reg;asm volatile("s_waitcnt lgkmcnt(0)":::"memory");
  float rli[16];
  #pragma unroll
  for(int r=0;r<16;++r)rli[r]=__builtin_amdgcn_rcpf(wsf[32+crow(r,hi)]);
  bf16*Ow=O+(rowbase+q0+wid*QBLK)*DM+hv*D;
  { bf16*stg=(bf16*)(shm+LDS_OST)+wid*2048;
    #pragma unroll
    for(int r=0;r<16;++r){const int orow=crow(r,hi);
      #pragma unroll
      for(int d0=0;d0<2;++d0)stg[orow*64+d0*32+r32]=__float2bfloat16(o[d0][r]*rli[r]);}
    asm volatile("s_waitcnt lgkmcnt(0)":::"memory");
    #pragma unroll
    for(int i=0;i<4;++i){const int row=i*8+(lane>>3),ch=lane&7; const u32x4 v=*(const u32x4*)(stg+row*64+ch*8); ATTN_STORE16(Ow+(long)row*DM+ch*8,v);} }
  asm volatile("s_waitcnt lgkmcnt(0)\n\ts_barrier":::"memory");
  #undef DMA_K
  #undef DMA_V
  #undef CMASK
  #undef START
  #undef RESC
  #undef ROT
}

constexpr int ATTN_LDS_BYTES=LDS_BYTES;
#undef SBAR
#undef WAIT_BAR
}
namespace attn_body {
#if NAIVE_ATTN
__device__ __forceinline__ void attn_unit_naive(int hq,int hv,int qb,const bf16_t*Q,const bf16_t*K,const bf16_t*V,bf16_t*O,const int tid_){
  const int lane=tid_&63, wid=tid_>>6;
#pragma unroll 1
  for(int r=0;r<32;++r){ const int row=qb*256+wid*32+r;
    float q[64];
#pragma unroll
    for(int c=0;c<8;++c){ const ::u32x4 w=*(const ::u32x4*)(Q+(size_t)row*1024+hq*64+c*8); q[c*8+0]=bflo(w.x);q[c*8+1]=bfhi(w.x);q[c*8+2]=bflo(w.y);q[c*8+3]=bfhi(w.y);q[c*8+4]=bflo(w.z);q[c*8+5]=bfhi(w.z);q[c*8+6]=bflo(w.w);q[c*8+7]=bfhi(w.w); }
    float m=-INFINITY,l=0.f,o=0.f;
#pragma unroll 1
    for(int j0=0;j0<=row;j0+=64){ const int j=j0+lane; float s=-INFINITY;
      if(j<=row){ float a=0.f;
#pragma unroll
        for(int c=0;c<8;++c){ const ::u32x4 w=*(const ::u32x4*)(K+(size_t)j*1024+hq*64+c*8); a+=q[c*8+0]*bflo(w.x)+q[c*8+1]*bfhi(w.x)+q[c*8+2]*bflo(w.y)+q[c*8+3]*bfhi(w.y)+q[c*8+4]*bflo(w.z)+q[c*8+5]*bfhi(w.z)+q[c*8+6]*bflo(w.w)+q[c*8+7]*bfhi(w.w); }
        s=a; }
      const float mb=wave_max(s);
      const float mn=fmaxf(m,mb), alpha=exp2f(m-mn); const float p=(j<=row)?exp2f(s-mn):0.f;
      l=l*alpha+wave_sum(p); o*=alpha;
      const int nj=(row-j0+1)<64?(row-j0+1):64;
#pragma unroll 1
      for(int jj=0;jj<nj;++jj){ const float pj=__builtin_bit_cast(float,__builtin_amdgcn_readlane(__builtin_bit_cast(int,p),jj)); o+=pj*bf2f(V[(size_t)(j0+jj)*1024+hv*64+lane]); }
      m=mn; }
    O[(size_t)row*1024+hv*64+lane]=(bf16_t)f2bf(o/l);
  }
}
#endif
__device__ __forceinline__ void attn_phase(char* lds, const bf16_t* Q, const bf16_t* K, const bf16_t* V, bf16_t* O1, bf16_t* O2, int vcu, int G, const int tid) {
  const int nu = (G == 256) ? 4 : (1024 - vcu + G - 1) / G;
#pragma unroll 1
  for (int i = 0; i < nu; ++i) {
    int bh, qb;
    if (G == 256) { const int s = vcu & 7; bh = vcu >> 3; qb = (i == 0) ? s : (i == 1) ? 15 - s : (i == 2) ? 16 + s : 31 - s; }
    else { const int L = vcu + i * G; bh = L >> 5; qb = L & 31; }
    const int h = bh >> 2, c = (bh >> 1) & 1, vh = bh & 1;
    int tid_u = tid; asm volatile("" : "+v"(tid_u));
#if NAIVE_ATTN
    attn_unit_naive(h * 2 + c, h * 2 + vh, qb, Q, K, V, c ? O2 : O1, tid_u);
#else
    attn_unit<8>(h * 2 + c, h * 2 + vh, qb, (const bf16*)Q, (const bf16*)K, (const bf16*)V, (bf16*)(c ? O2 : O1), lds, tid_u);
#endif
  }
}
}
namespace attn128 {
using bf16=__hip_bfloat16;
using bf16x8=__attribute__((ext_vector_type(8)))short;
using s16x4=__attribute__((ext_vector_type(4)))short;
using f32x16=__attribute__((ext_vector_type(16)))float;
using u32x4=__attribute__((ext_vector_type(4)))unsigned;
constexpr int BATCH=1,NHEAD=16,SEQ=8192,D=64,DM=NHEAD*D;
constexpr int NW=8,QBLK=32,QB=QBLK*NW,KVBLK=64,NQB=SEQ/QB;
constexpr int ATTN_PITCH=DM, ATTN_UNIT_ROWS=QB;
__device__ __forceinline__ int crow(int r,int hi){return (r&3)+8*(r>>2)+4*hi;}
#define SBAR() __builtin_amdgcn_sched_barrier(0)
__device__ __forceinline__ void cmask(f32x16&p0,f32x16&p1,int jb,int qrel,int hi){
  const float NEG=-INFINITY; int kb=64*jb+4*hi;
  #pragma unroll
  for(int r=0;r<16;++r){int kv=kb+(r&3)+8*(r>>2); if(kv>qrel)p0[r]=NEG; if(kv+32>qrel)p1[r]=NEG;}
}

constexpr int NSLOT=3, SLOTB=8192;
constexpr int VSLOTB=2*SLOTB;
constexpr int LDS_K=0, LDS_V=NSLOT*SLOTB, LDS_WS=LDS_V+NSLOT*VSLOTB, LDS_OST=LDS_WS+NW*64*4, LDS_BYTES=LDS_OST+NW*4096;
constexpr float C2=0.125f*1.4426950408889634f;
__device__ __forceinline__ void glds16(const void*gsrc,unsigned lds_dst){unsigned keep;
  asm volatile("s_mov_b32 %0, m0\n\ts_mov_b32 m0, %2\n\ts_nop 0\n\tglobal_load_lds_dwordx4 %1, off\n\ts_mov_b32 m0, %0":"=&s"(keep):"v"(gsrc),"s"(lds_dst):"memory");}
__device__ __forceinline__ float max3f(float a,float b,float c){float r;asm("v_max3_f32 %0, %1, %2, %3":"=v"(r):"v"(a),"v"(b),"v"(c));return r;}
__device__ __forceinline__ float max2f(float a,float b){float r;asm("v_max_f32_e32 %0, %1, %2":"=v"(r):"v"(a),"v"(b));return r;}
__device__ __forceinline__ float fadd_s(float a,float b){float r;asm("v_add_f32_e32 %0, %1, %2":"=v"(r):"v"(a),"v"(b));return r;}
__device__ __forceinline__ float fsub_s(float a,float b){float r;asm("v_sub_f32_e32 %0, %1, %2":"=v"(r):"v"(a),"v"(b));return r;}
typedef float f32x2_t __attribute__((ext_vector_type(2))); typedef __bf16 bf16x2_t __attribute__((ext_vector_type(2)));
__device__ __forceinline__ unsigned cvtpk_s(float lo,float hi){f32x2_t v={lo,hi};bf16x2_t b=__builtin_convertvector(v,bf16x2_t);return __builtin_bit_cast(unsigned,b);}
#define WAIT_BAR(N) asm volatile("s_waitcnt vmcnt(" #N ") lgkmcnt(0)\n\ts_barrier":::"memory")

__device__ __forceinline__ void qkt(f32x16&p0,f32x16&p1,const char*Kslot,const bf16x8*qr,const f32x16&negm,int r32,int hi){
  const char*kb=Kslot+hi*1024+r32*16;
  #pragma unroll
  for(int d0=0;d0<4;++d0){
    const bf16x8 b0=*reinterpret_cast<const bf16x8*>(kb+d0*2048);
    const bf16x8 b1=*reinterpret_cast<const bf16x8*>(kb+d0*2048+512);
    if(d0==0){p0=__builtin_amdgcn_mfma_f32_32x32x16_bf16(b0,qr[0],negm,0,0,0);p1=__builtin_amdgcn_mfma_f32_32x32x16_bf16(b1,qr[0],negm,0,0,0);}
    else{p0=__builtin_amdgcn_mfma_f32_32x32x16_bf16(b0,qr[d0],p0,0,0,0);p1=__builtin_amdgcn_mfma_f32_32x32x16_bf16(b1,qr[d0],p1,0,0,0);}}
}
typedef __attribute__((address_space(3))) const char* lds_cptr;
typedef short v4i16_t __attribute__((ext_vector_type(4)));
__device__ __forceinline__ void kload8(bf16x8*kf,lds_cptr kp){
  kf[0]=*(const __attribute__((address_space(3))) bf16x8*)(kp);      kf[1]=*(const __attribute__((address_space(3))) bf16x8*)(kp+512);
  kf[2]=*(const __attribute__((address_space(3))) bf16x8*)(kp+2048); kf[3]=*(const __attribute__((address_space(3))) bf16x8*)(kp+2560);
  kf[4]=*(const __attribute__((address_space(3))) bf16x8*)(kp+4096); kf[5]=*(const __attribute__((address_space(3))) bf16x8*)(kp+4608);
  kf[6]=*(const __attribute__((address_space(3))) bf16x8*)(kp+6144); kf[7]=*(const __attribute__((address_space(3))) bf16x8*)(kp+6656);
}
__device__ __forceinline__ void kload2(bf16x8*kf,lds_cptr kp,int j){ kf[2*j]=*(const __attribute__((address_space(3))) bf16x8*)(kp+j*2048); kf[2*j+1]=*(const __attribute__((address_space(3))) bf16x8*)(kp+j*2048+512); }
__device__ __forceinline__ s16x4 vtr(lds_cptr p){ return __builtin_bit_cast(s16x4,__builtin_amdgcn_ds_read_tr16_b64_v4i16((__attribute__((address_space(3))) v4i16_t*)p)); }
__device__ __forceinline__ float rowmax(const f32x16&p0,const f32x16&p1){
  float a=max3f(p0[0],p0[1],p1[0]),b=max3f(p0[2],p0[3],p1[1]);a=max3f(a,p1[2],p1[3]);
  #pragma unroll
  for(int r=4;r<16;r+=4){a=max3f(a,p0[r],p0[r+1]);b=max3f(b,p0[r+2],p0[r+3]);a=max3f(a,p1[r],p1[r+1]);b=max3f(b,p1[r+2],p1[r+3]);}
  const float m=max2f(a,b);
  auto rr=__builtin_amdgcn_permlane32_swap(__float_as_uint(m),__float_as_uint(m),false,false);
  return max2f(__uint_as_float(rr[0]),__uint_as_float(rr[1]));
}
__device__ __forceinline__ void pv(f32x16*o,int vb,bf16x8 pa0,bf16x8 pa1,bf16x8 pa2,bf16x8 pa3){
  #pragma unroll
  for(int d0=0;d0<4;++d0){s16x4 lo[4],hi[4];
    #pragma unroll
    for(int ks=0;ks<4;++ks){
      asm volatile("ds_read_b64_tr_b16 %0,%1 offset:%c2":"=&v"(lo[ks]):"v"(vb),"i"(d0*4096+ks*1024):"memory");
      asm volatile("ds_read_b64_tr_b16 %0,%1 offset:%c2":"=&v"(hi[ks]):"v"(vb),"i"(d0*4096+ks*1024+512):"memory");}
    asm volatile("s_waitcnt lgkmcnt(0)":::"memory");SBAR();
    #define PK(k) (bf16x8){lo[k][0],lo[k][1],lo[k][2],lo[k][3],hi[k][0],hi[k][1],hi[k][2],hi[k][3]}
    o[d0]=__builtin_amdgcn_mfma_f32_32x32x16_bf16(pa0,PK(0),o[d0],0,0,0);
    o[d0]=__builtin_amdgcn_mfma_f32_32x32x16_bf16(pa1,PK(1),o[d0],0,0,0);
    o[d0]=__builtin_amdgcn_mfma_f32_32x32x16_bf16(pa2,PK(2),o[d0],0,0,0);
    o[d0]=__builtin_amdgcn_mfma_f32_32x32x16_bf16(pa3,PK(3),o[d0],0,0,0);
    #undef PK
  }
}

#ifndef ATTN_STORE16
#define ATTN_STORE16(p,v) (*(u32x4*)(p)=(v))
#endif
template<int THRL> __device__ __forceinline__ void attn_unit(int hq,int hv,int qb,const bf16*Q,const bf16*__restrict__ K,const bf16*__restrict__ V,bf16*O,char*shm,const int tid){
  const int lane=tid&63,r32=lane&31,hi=lane>>5; const int wid=__builtin_amdgcn_readfirstlane(tid>>6);
  const long rowbase=0; const int q0=qb*QB;
  const bf16*Qw=Q+(rowbase+q0+wid*QBLK)*DM+hq*D;
  const bf16*Kh=K+rowbase*DM+hq*D,*Vh=V+rowbase*DM+hv*128;
  const unsigned lds0=(unsigned)(uintptr_t)shm;
  float*wsf=(float*)(shm+LDS_WS)+wid*64;
  const bf16*ksrc=Kh+(long)lane*DM+wid*8;
  const bf16*vsrc=Vh+(long)(16*(wid&3)+(lane>>2))*DM+(wid>>2)*32+(lane&3)*8;
  const unsigned kdst=lds0+LDS_K+wid*1024, vdst=lds0+LDS_V+wid*1024;
  #define DMA_K(t,slot) glds16(ksrc+(long)(t)*KVBLK*DM,(unsigned)__builtin_amdgcn_readfirstlane(kdst+(slot)))
  #define DMA_V(t,slot) do{ glds16(vsrc+(long)(t)*KVBLK*DM,(unsigned)__builtin_amdgcn_readfirstlane(vdst+2*(slot))); glds16(vsrc+(long)(t)*KVBLK*DM+64,(unsigned)__builtin_amdgcn_readfirstlane(vdst+2*(slot)+8192)); }while(0)
  const int vb0=(int)(lds0+LDS_V)+((lane>>4)&1)*32+(lane&3)*8+(4*hi+((lane&15)>>2))*64;
  const char*Kbase=shm+LDS_K; bf16x8 kf[8];
  const lds_cptr shm3=(lds_cptr)shm; const lds_cptr kp0=shm3+LDS_K+hi*1024+r32*16; const lds_cptr vp0=shm3+LDS_V+((lane>>4)&1)*32+(lane&3)*8+(4*hi+((lane&15)>>2))*64;
  const int NT=(q0+QB)/KVBLK;
  DMA_K(0,0);DMA_V(0,0);DMA_K(1,SLOTB);
  bf16x8 qr[4];
  #pragma unroll
  for(int d0=0;d0<4;++d0)qr[d0]=*reinterpret_cast<const bf16x8*>(&Qw[(long)r32*DM+d0*16+hi*8]);
  float mhat=0.f,l_reg=0.f;f32x16 o[4];o[0]=f32x16{};o[1]=f32x16{};o[2]=f32x16{};o[3]=f32x16{};
  const int qrel=wid*QBLK+r32;
  #define CMASK(P0,P1,t) do{int jb_=(t)-(NT-4); if(jb_>=0)cmask(P0,P1,jb_,qrel,hi);}while(0)
  bool resc=false;
  #define START(P0,P1) do{ const float rm=rowmax(P0,P1); resc=false; \
    { const float dl=rm; mhat=fadd_s(mhat,dl); \
      _Pragma("unroll") for(int r=0;r<16;++r){P0[r]=fsub_s(P0[r],dl);P1[r]=fsub_s(P1[r],dl);} \
      } \
    _Pragma("unroll") for(int r=0;r<16;++r)P0[r]=__builtin_amdgcn_exp2f(P0[r]); }while(0)
  #define RESC() do{ if(resc){ asm volatile("s_waitcnt lgkmcnt(0)":::"memory"); \
      _Pragma("unroll") for(int d_=0;d_<4;++d_) _Pragma("unroll") for(int r=0;r<16;++r)o[d_][r]*=wsf[crow(r,hi)]; } }while(0)
  f32x16 pA0,pA1,pB0,pB1;
  int sl_prev=0,sl_cur=0,sl_next=SLOTB;
  #define ROT() do{sl_prev=sl_cur;sl_cur=sl_next;sl_next=(sl_next==(NSLOT-1)*SLOTB)?0:sl_next+SLOTB;}while(0)
  DMA_K(2,2*SLOTB);
  WAIT_BAR(4);
  { const f32x16 zero16=f32x16{}; qkt(pA0,pA1,Kbase,qr,zero16,r32,hi); }asm volatile("s_nop 15\n\ts_nop 7":"+v"(pA0),"+v"(pA1));CMASK(pA0,pA1,0);
  START(pA0,pA1);
  _Pragma("unroll") for(int r=0;r<16;++r)pA1[r]=__builtin_amdgcn_exp2f(pA1[r]);
  WAIT_BAR(0);
  DMA_K(3,0);DMA_V(1,SLOTB);
  ROT();
  kload8(kf,kp0+sl_cur);
  WAIT_BAR(3);
  s16x4 vlo[8],vhi[8]; u32x4 pw0,pw1,pw2,pw3;
  #define PKW(P,B) cvtpk_s(P[B],P[B+1])
  #define PAF(k) __builtin_bit_cast(bf16x8,pw##k)
  #define VFR(i) (bf16x8){vlo[i][0],vlo[i][1],vlo[i][2],vlo[i][3],vhi[i][0],vhi[i][1],vhi[i][2],vhi[i][3]}
  #define PIN(x) asm volatile("":"+v"(x))
  #define MX3(a,b,c) __builtin_fmaxf(__builtin_fmaxf((a),(b)),(c))
  #define GAPA(MF,A0,A1,A2,A3,W0,W1,PW) do{ MF; sacc+=A0; sacc+=A1; sacc+=A2; sacc+=A3; PIN(sacc); W0; W1; PIN(PW); SBAR(); }while(0)
  #define EX(v) __builtin_amdgcn_exp2f(v)
  #define GAPB(MF,X,B) do{ MF; X[B]=EX(X[B]); X[B+1]=EX(X[B+1]); X[B+2]=EX(X[B+2]); X[B+3]=EX(X[B+3]); PIN(X); SBAR(); }while(0)
  #define GAPB2(MF,RD,X,B) do{ MF; RD; X[B]=EX(X[B]); X[B+1]=EX(X[B+1]); PIN(X); SBAR(); }while(0)
  #define VRD2(i) do{ vlo[i]=vtr(vp_+((((i)>>2)+2)*4096+((i)&3)*1024)); vhi[i]=vtr(vp_+((((i)>>2)+2)*4096+((i)&3)*1024+512)); }while(0)
  #define VRD(i) do{ vlo[i]=vtr(vp_+(((i)>>2)*4096+((i)&3)*1024)); vhi[i]=vtr(vp_+(((i)>>2)*4096+((i)&3)*1024+512)); }while(0)
  #define KRD(G,j) do{ if(G){ kload2(kf,kp0+sl_next,j); SBAR(); } }while(0)
  #define STEP(C0,C1,P0,P1,t,GK,GV,GL) do{ SBAR(); \
    const lds_cptr vp_=vp0+2*sl_prev; \
    { const float nm_=-mhat; _Pragma("unroll") for(int r=0;r<16;++r){C0[r]=nm_;C1[r]=nm_;} }     \
    VRD(0); SBAR(); float sacc=(P0[0]+P0[1]); \
    GAPA(C0=__builtin_amdgcn_mfma_f32_32x32x16_bf16(kf[0],qr[0],C0,0,0,0), P0[2],P0[3],P0[4],P0[5],     pw0[0]=PKW(P0,0), pw0[1]=PKW(P0,2), pw0); \
    VRD(4); SBAR(); GAPA(C1=__builtin_amdgcn_mfma_f32_32x32x16_bf16(kf[1],qr[0],C1,0,0,0), P0[6],P0[7],P0[8],P0[9],     pw0[2]=PKW(P0,4), pw0[3]=PKW(P0,6), pw0); \
    VRD(1); SBAR(); GAPA(C0=__builtin_amdgcn_mfma_f32_32x32x16_bf16(kf[2],qr[1],C0,0,0,0),   P0[10],P0[11],P0[12],P0[13], pw1[0]=PKW(P0,8), pw1[1]=PKW(P0,10), pw1); \
    VRD(5); SBAR(); GAPA(C1=__builtin_amdgcn_mfma_f32_32x32x16_bf16(kf[3],qr[1],C1,0,0,0),   P0[14],P0[15],P1[0],P1[1],   pw1[2]=PKW(P0,12),pw1[3]=PKW(P0,14), pw1); \
    VRD(2); SBAR(); GAPA(C0=__builtin_amdgcn_mfma_f32_32x32x16_bf16(kf[4],qr[2],C0,0,0,0),   P1[2],P1[3],P1[4],P1[5],     pw2[0]=PKW(P1,0), pw2[1]=PKW(P1,2), pw2); \
    VRD(6); SBAR(); GAPA(C1=__builtin_amdgcn_mfma_f32_32x32x16_bf16(kf[5],qr[2],C1,0,0,0),   P1[6],P1[7],P1[8],P1[9],     pw2[2]=PKW(P1,4), pw2[3]=PKW(P1,6), pw2); \
    VRD(3); SBAR(); GAPA(C0=__builtin_amdgcn_mfma_f32_32x32x16_bf16(kf[6],qr[3],C0,0,0,0),   P1[10],P1[11],P1[12],P1[13], pw3[0]=PKW(P1,8), pw3[1]=PKW(P1,10), pw3); \
    VRD(7); SBAR(); GAPA(C1=__builtin_amdgcn_mfma_f32_32x32x16_bf16(kf[7],qr[3],C1,0,0,0),   P1[14],P1[15],0.f,0.f,       pw3[2]=PKW(P1,12),pw3[3]=PKW(P1,14), pw3); \
    l_reg+=sacc; \
    if(GK){DMA_K((t)+3,sl_cur);} if(GV){DMA_V((t)+1,sl_next);} \
    CMASK(C0,C1,t); \
    { float a=MX3(C0[0],C0[1],C1[0]),b=MX3(C0[2],C0[3],C1[1]); a=MX3(a,C1[2],C1[3]); \
      _Pragma("unroll") for(int r=4;r<16;r+=4){a=MX3(a,C0[r],C0[r+1]);b=MX3(b,C0[r+2],C0[r+3]);a=MX3(a,C1[r],C1[r+1]);b=MX3(b,C1[r+2],C1[r+3]);} \
      float rm=__builtin_fmaxf(a,b); { auto rr=__builtin_amdgcn_permlane32_swap(__float_as_uint(rm),__float_as_uint(rm),false,false); rm=__builtin_fmaxf(__uint_as_float(rr[0]),__uint_as_float(rr[1])); } \
      resc=false; \
      if(__builtin_expect(__any(rm>(float)THRL),0)){ const float dl=__builtin_fmaxf(rm,0.f); mhat+=dl; \
        _Pragma("unroll") for(int r=0;r<16;++r){C0[r]-=dl;C1[r]-=dl;} \
        const float f=__builtin_amdgcn_exp2f(-dl); l_reg*=f; if(hi==0)wsf[r32]=f; resc=true; } } \
    SBAR(); \
    GAPB2(o[0]=__builtin_amdgcn_mfma_f32_32x32x16_bf16(PAF(0),VFR(0),o[0],0,0,0), VRD2(0), C0,0); \
    GAPB2(o[1]=__builtin_amdgcn_mfma_f32_32x32x16_bf16(PAF(0),VFR(4),o[1],0,0,0), VRD2(4), C0,2); \
    GAPB2(o[0]=__builtin_amdgcn_mfma_f32_32x32x16_bf16(PAF(1),VFR(1),o[0],0,0,0), VRD2(1), C0,4); \
    GAPB2(o[1]=__builtin_amdgcn_mfma_f32_32x32x16_bf16(PAF(1),VFR(5),o[1],0,0,0), VRD2(5), C0,6); \
    GAPB2(o[0]=__builtin_amdgcn_mfma_f32_32x32x16_bf16(PAF(2),VFR(2),o[0],0,0,0), VRD2(2), C0,8); \
    GAPB2(o[1]=__builtin_amdgcn_mfma_f32_32x32x16_bf16(PAF(2),VFR(6),o[1],0,0,0), VRD2(6), C0,10); \
    GAPB2(o[0]=__builtin_amdgcn_mfma_f32_32x32x16_bf16(PAF(3),VFR(3),o[0],0,0,0), VRD2(3), C0,12); \
    GAPB2(o[1]=__builtin_amdgcn_mfma_f32_32x32x16_bf16(PAF(3),VFR(7),o[1],0,0,0), VRD2(7), C0,14); \
    KRD(GL,0); GAPB2(o[2]=__builtin_amdgcn_mfma_f32_32x32x16_bf16(PAF(0),VFR(0),o[2],0,0,0), (void)0, C1,0); \
    KRD(GL,1); GAPB2(o[3]=__builtin_amdgcn_mfma_f32_32x32x16_bf16(PAF(0),VFR(4),o[3],0,0,0), (void)0, C1,2); \
    KRD(GL,2); GAPB2(o[2]=__builtin_amdgcn_mfma_f32_32x32x16_bf16(PAF(1),VFR(1),o[2],0,0,0), (void)0, C1,4); \
    KRD(GL,3); GAPB2(o[3]=__builtin_amdgcn_mfma_f32_32x32x16_bf16(PAF(1),VFR(5),o[3],0,0,0), (void)0, C1,6); \
    GAPB2(o[2]=__builtin_amdgcn_mfma_f32_32x32x16_bf16(PAF(2),VFR(2),o[2],0,0,0), (void)0, C1,8); \
    GAPB2(o[3]=__builtin_amdgcn_mfma_f32_32x32x16_bf16(PAF(2),VFR(6),o[3],0,0,0), (void)0, C1,10); \
    GAPB2(o[2]=__builtin_amdgcn_mfma_f32_32x32x16_bf16(PAF(3),VFR(3),o[2],0,0,0), (void)0, C1,12); \
    GAPB2(o[3]=__builtin_amdgcn_mfma_f32_32x32x16_bf16(PAF(3),VFR(7),o[3],0,0,0), (void)0, C1,14); \
    }while(0)
  int t=1;
  #undef CMASK
  #define CMASK(P0,P1,t) do{}while(0)
  for(;t+5<NT;t+=2){
    STEP(pB0,pB1,pA0,pA1,t,true,true,true);     WAIT_BAR(3); RESC(); ROT();
    STEP(pA0,pA1,pB0,pB1,t+1,true,true,true);   WAIT_BAR(3); RESC(); ROT();
  }
  #undef CMASK
  #define CMASK(P0,P1,t) do{int jb_=(t)-(NT-4); if(jb_>=0)cmask(P0,P1,jb_,qrel,hi);}while(0)
  #define ENDW(tt) do{ if((tt)+3<NT){WAIT_BAR(3);} else if((tt)+2<NT){WAIT_BAR(2);} else {WAIT_BAR(0);} }while(0)
  for(;t+1<NT;t+=2){
    STEP(pB0,pB1,pA0,pA1,t,(t+3<NT),(t+1<NT),(t+1<NT));       ENDW(t);   RESC(); ROT();
    STEP(pA0,pA1,pB0,pB1,t+1,(t+4<NT),(t+2<NT),(t+2<NT));     ENDW(t+1); RESC(); ROT();
  }
  STEP(pB0,pB1,pA0,pA1,NT-1,false,false,false); RESC();
  { float sacc=pB0[0]+pB0[1]; _Pragma("unroll") for(int r=2;r<16;++r)sacc+=pB0[r]; _Pragma("unroll") for(int r=0;r<16;++r)sacc+=pB1[r]; l_reg+=sacc;
    pw0=(u32x4){PKW(pB0,0),PKW(pB0,2),PKW(pB0,4),PKW(pB0,6)};pw1=(u32x4){PKW(pB0,8),PKW(pB0,10),PKW(pB0,12),PKW(pB0,14)};pw2=(u32x4){PKW(pB1,0),PKW(pB1,2),PKW(pB1,4),PKW(pB1,6)};pw3=(u32x4){PKW(pB1,8),PKW(pB1,10),PKW(pB1,12),PKW(pB1,14)};
    SBAR(); pv(o,vb0+2*sl_cur,PAF(0),PAF(1),PAF(2),PAF(3)); }
  #undef PKW
  #undef PAF
  #undef VFR
  #undef PIN
  #undef MX3
  #undef GAPA
  #undef GAPB
  #undef GAPB2
  #undef VRD2
  #undef EX
  #undef VRD
  #undef KRD
  #undef STEP
  #undef ENDW
  {auto rr=__builtin_amdgcn_permlane32_swap(__float_as_uint(l_reg),__float_as_uint(l_reg),false,false);l_reg=__uint_as_float(rr[0])+__uint_as_float(rr[1]);}
  if(hi==0)wsf[32+r32]=l_reg;asm volatile("s_waitcnt lgkmcnt(0)":::"memory");
  float rli[16];
  #pragma unroll
  for(int r=0;r<16;++r)rli[r]=__builtin_amdgcn_rcpf(wsf[32+crow(r,hi)]);
  bf16*Ow=O+(rowbase+q0+wid*QBLK)*DM+hv*128;
  { bf16*stg=(bf16*)(shm+LDS_OST)+wid*2048;
    #pragma unroll
    for(int p=0;p<2;++p){
      #pragma unroll
      for(int r=0;r<16;++r){const int orow=crow(r,hi);
        #pragma unroll
        for(int d0=0;d0<2;++d0)stg[orow*64+d0*32+r32]=__float2bfloat16(o[2*p+d0][r]*rli[r]);}
      asm volatile("s_waitcnt lgkmcnt(0)":::"memory");
      #pragma unroll
      for(int i=0;i<4;++i){const int row=i*8+(lane>>3),ch=lane&7; const u32x4 v=*(const u32x4*)(stg+row*64+ch*8); ATTN_STORE16(Ow+(long)row*DM+p*64+ch*8,v);}
      asm volatile("s_waitcnt lgkmcnt(0)":::"memory"); } }
  asm volatile("s_waitcnt lgkmcnt(0)\n\ts_barrier":::"memory");
  #undef DMA_K
  #undef DMA_V
  #undef CMASK
  #undef START
  #undef RESC
  #undef ROT
}

constexpr int ATTN_LDS_BYTES=LDS_BYTES;
#undef SBAR
#undef WAIT_BAR
}

#ifndef ATTN128
#define ATTN128 1
#endif
namespace attn128 {
__device__ __forceinline__ void attn_phase(char* lds, const bf16_t* Q, const bf16_t* K, const bf16_t* V, bf16_t* O1, bf16_t* O2, int vcu, int G, const int tid) {
  const int nu = (G == 256) ? 2 : (512 - vcu + G - 1) / G;
#pragma unroll 1
  for (int i = 0; i < nu; ++i) {
    int hc, qb;
    if (G == 256) { const int s = vcu & 15; hc = vcu >> 4; qb = (i == 0) ? s : 31 - s; }
    else { const int L = vcu + i * G; hc = L >> 5; qb = L & 31; }
    int tid_u = tid; asm volatile("" : "+v"(tid_u));
    attn_unit<8>(hc, hc >> 1, qb, (const bf16*)Q, (const bf16*)K, (const bf16*)V, (bf16*)((hc & 1) ? O2 : O1), lds, tid_u);
  }
}
}
struct Ctx { unsigned char* ws; LAS unsigned char* lds; gu32* ctl; int tid, lane, wave, vcu, G, gw, NGW; };
__device__ __forceinline__ unsigned char* lwp(const Ctx& F, int l, size_t off) { return F.ws + WS_LW + (size_t)l * LW_SIZE + off; }

__device__ __forceinline__ int rowmap(int kind, int n, int H) {
    if (kind == 1) { const int d = n & 63; return (n & ~63) | (d < 32 ? 2 * d : 2 * (d - 32) + 1); }
    if (kind == 2) return n < H ? 2 * n : 2 * (n - H) + 1;
    if (kind == 3) return 2 * n;
    if (kind == 4) return 2 * n + 1;
    return n;
}
__device__ __forceinline__ void xpose_item(const float* W, int N, bf16_t* WT, int dpitch, int koff, int kind, int nbase, int H, int rbase, int k0, int n0, int lane, const float* gk = nullptr) {
    const int q = lane >> 4, c = lane & 15;
    const float* src = W + (size_t)(k0 + 16 * q) * N + n0 + 4 * c;
    f32x4 v[16];
#pragma unroll
    for (int i = 0; i < 16; ++i) v[i] = __builtin_nontemporal_load((const f32x4*)(src + (size_t)i * N));
    if (gk) { const f32x4* g4 = (const f32x4*)(gk + k0 + 16 * q); const f32x4 ga = g4[0], gb = g4[1], gc = g4[2], gd = g4[3];
#pragma unroll
        for (int i = 0; i < 4; ++i) { v[i] = v[i] * ga[i]; v[4 + i] = v[4 + i] * gb[i]; v[8 + i] = v[8 + i] * gc[i]; v[12 + i] = v[12 + i] * gd[i]; } }
#pragma unroll
    for (int j = 0; j < 4; ++j) { const int drow = rbase + rowmap(kind, n0 + 4 * c + j - nbase, H);
        u32x4 o0, o1; o0.x = pk2(v[0][j], v[1][j]); o0.y = pk2(v[2][j], v[3][j]); o0.z = pk2(v[4][j], v[5][j]); o0.w = pk2(v[6][j], v[7][j]);
        o1.x = pk2(v[8][j], v[9][j]); o1.y = pk2(v[10][j], v[11][j]); o1.z = pk2(v[12][j], v[13][j]); o1.w = pk2(v[14][j], v[15][j]);
        u32x4* dp = (u32x4*)(WT + (size_t)drow * dpitch + koff + k0 + 16 * q); dp[0] = o0; dp[1] = o1; }
}
__device__ __forceinline__ void xpose_item8(const float* W, int N, unsigned char* WT, int dpitch, int kind, int nbase, int k0, int n0, int lane, float scale, int H = 0, int rbase = 0, const float* gk = nullptr) {
    const int q = lane >> 4, c = lane & 15;
    const float* src = W + (size_t)(k0 + 16 * q) * N + n0 + 4 * c;
    f32x4 v[16];
#pragma unroll
    for (int i = 0; i < 16; ++i) v[i] = __builtin_nontemporal_load((const f32x4*)(src + (size_t)i * N)) * scale;
    if (gk) { const f32x4* g4 = (const f32x4*)(gk + k0 + 16 * q); const f32x4 ga = g4[0], gb = g4[1], gc = g4[2], gd = g4[3];
#pragma unroll
        for (int i = 0; i < 4; ++i) { v[i] = v[i] * ga[i]; v[4 + i] = v[4 + i] * gb[i]; v[8 + i] = v[8 + i] * gc[i]; v[12 + i] = v[12 + i] * gd[i]; } }
#pragma unroll
    for (int j = 0; j < 4; ++j) { const int drow = rbase + rowmap(kind, n0 + 4 * c + j - nbase, H); int w[4];
#pragma unroll
        for (int t = 0; t < 4; ++t) { int p8 = __builtin_amdgcn_cvt_pk_fp8_f32(v[4 * t][j], v[4 * t + 1][j], 0, false); w[t] = __builtin_amdgcn_cvt_pk_fp8_f32(v[4 * t + 2][j], v[4 * t + 3][j], p8, true); }
        *(u32x4*)(WT + (size_t)drow * dpitch + k0 + 16 * q) = (u32x4){(unsigned)w[0], (unsigned)w[1], (unsigned)w[2], (unsigned)w[3]}; }
}
#define XP_MAT(W_, K_, N_, WT_, DP_, KOFF_, KIND_, NBASE_, H_, RBASE_, NLO_, NHI_) { const int nb_ = ((NHI_) - (NLO_)) / 64, items_ = ((K_) / 64) * nb_; \
    if (r < items_) { xpose_item((W_), (N_), (bf16_t*)(WT_), (DP_), (KOFF_), (KIND_), (NBASE_), (H_), (RBASE_), 64 * (r / nb_), (NLO_) + 64 * (r % nb_), F.lane); continue; } r -= items_; }

#define XP_MATG(W_, K_, N_, WT_, DP_, KOFF_, KIND_, NBASE_, H_, RBASE_, NLO_, NHI_, GK_) { const int nb_ = ((NHI_) - (NLO_)) / 64, items_ = ((K_) / 64) * nb_; \
    if (r < items_) { xpose_item((W_), (N_), (bf16_t*)(WT_), (DP_), (KOFF_), (KIND_), (NBASE_), (H_), (RBASE_), 64 * (r / nb_), (NLO_) + 64 * (r % nb_), F.lane, (GK_)); continue; } r -= items_; }

__device__ __forceinline__ void sincos_d(double a, float& s, float& c) {
    const double k = rint(a * 0.15915494309189535); const double rr = a - k * 6.283185307179586476925; const float rf = (float)rr; s = sinf(rf); c = cosf(rf);
}

struct Inputs { const LAS unsigned* tab;
    __device__ __forceinline__ const float* ptr(int i) const { const unsigned lo = __builtin_amdgcn_readfirstlane(tab[2 * i]), hi = __builtin_amdgcn_readfirstlane(tab[2 * i + 1]);
        return (const float*)(((unsigned long long)hi << 32) | lo); } };

#ifndef DEFER_CONV
#define DEFER_CONV 1
#endif
constexpr int IT_WIN = 32 * (NPROJ / 64), IT_DA = 16 * 32, IT_CV = 8 * 32, IT_SO = 8 * 32, IT_GLU = 8 * 16, IT_MIX = 32 * 32, IT_KV = 32 * 16, IT_XO = 8 * 32, IT_G = 16 * 32 * 8, IT_D = 16 * 8 * 32;
constexpr int IT_BIG = IT_WIN + IT_DA + IT_CV + IT_SO + IT_GLU + IT_MIX + 2 * IT_G + IT_D;
__device__ __forceinline__ void conv_item(const Ctx& F, const Inputs& I, const int l, int r) {
    do {
        const float* win = I.ptr(4) + (size_t)l * DM * NPROJ;
        const float* gmix = I.ptr(3) + (size_t)l * DM;
        XP_MATG(win, DM, NPROJ, lwp(F, l, LW_WIN), DM, 0, 1, 0, 0, 0, 0, 2048, gmix)
        XP_MATG(win, DM, NPROJ, lwp(F, l, LW_WIN), DM, 0, 0, 0, 0, 0, 2048, 3072, gmix)
        { const int nb_ = 1024 / 64, items_ = (DM / 64) * nb_;
            if (r < items_) { xpose_item8(win, NPROJ, lwp(F, l, LW_WG8), DM, 2, 3072, 64 * (r / nb_), 3072 + 64 * (r % nb_), F.lane, GATE_WSCALE, 512, 6144, gmix); continue; } r -= items_; }
        XP_MATG(win, DM, NPROJ, lwp(F, l, LW_WIN), DM, 0, 0, 4096, 0, 3072, 4096, 4608, gmix)
        { const int nb_ = (NPROJ - 4608) / 64, items_ = (DM / 64) * nb_;
            if (r < items_) { xpose_item8(win, NPROJ, lwp(F, l, LW_WG8), DM, 0, 4608, 64 * (r / nb_), 4608 + 64 * (r % nb_), F.lane, GATE_WSCALE, 0, 0, gmix); continue; } r -= items_; }
        XP_MAT(I.ptr(10) + (size_t)l * 1024 * DM, 1024, DM, lwp(F, l, LW_WCAT), DM, 0, 0, 0, 0, 0, 0, DM)
        XP_MAT(I.ptr(15) + (size_t)l * 512 * DM, 512, DM, lwp(F, l, LW_WCAT), DM, 1024, 0, 0, 0, 0, 0, DM)
        XP_MAT(I.ptr(26) + (size_t)l * 512 * DM, 512, DM, lwp(F, l, LW_WCAT), DM, 1536, 0, 0, 0, 0, 0, DM)
        XP_MAT(I.ptr(24) + (size_t)l * 512 * 1024, 512, 1024, lwp(F, l, LW_WGLU), 512, 0, 2, 0, 512, 0, 0, 1024)
        XP_MAT(I.ptr(27) + (size_t)l * DM * DM, DM, DM, lwp(F, l, LW_WMIX), DM, 0, 0, 0, 0, 0, 0, DM)
        if (r < 2 * IT_G) { const int up = r >= IT_G; if (up) r -= IT_G; const int e = r / (32 * 8); r %= (32 * 8);
            const float* w = I.ptr(up ? 39 : 38) + ((size_t)l * NEXP + e) * DM * FFE;
            xpose_item8(w, FFE, lwp(F, l, LW_WGU) + (size_t)e * 1024 * DM, DM, up ? 4 : 3, 0, 64 * (r / 8), 64 * (r % 8), F.lane, GATE_WSCALE); continue; }
        r -= 2 * IT_G;
        { const int e = r / (8 * 32); r %= (8 * 32); const float* w = I.ptr(40) + ((size_t)l * NEXP + e) * FFE * DM;
            xpose_item8(w, DM, lwp(F, l, LW_WD) + (size_t)e * DM * FFE, FFE, 0, 0, 64 * (r / 32), 64 * (r % 32), F.lane, GATE_WSCALE); }
    } while (0);
}
__device__ __forceinline__ void conv_item_xa(const Ctx& F, const Inputs& I, const int l, int r) {
    do {
        XP_MAT(I.ptr(31) + (size_t)l * DM * 1024, DM, 1024, F.ws + WS_WKVT + (size_t)l * 1024 * DM * 2, DM, 0, 0, 0, 0, 0, 0, 1024)
        XP_MAT(I.ptr(32) + (size_t)l * 512 * DM, 512, DM, F.ws + WS_WXOT + (size_t)l * DM * 512 * 2, 512, 0, 0, 0, 0, 0, 0, DM)
    } while (0);
}
constexpr int IT_EXP = 2 * IT_G + IT_D, IT_EARLY = IT_BIG - IT_EXP;
__device__ __forceinline__ void conv_window(const Ctx& F, const Inputs& I, const int l, const int base, const int wave_rank, const int nper) {
#pragma unroll 1
    for (int k = 0; k < nper; ++k) { const int w = base + wave_rank * nper + k; const bool own = w < IT_EXP; const int ll = own ? l : l + 1, rr = own ? IT_EARLY + w : w - IT_EXP;
        if (w < IT_BIG && ll < NL) conv_item(F, I, ll, rr); }
}
__device__ __forceinline__ void ph_prologue_a(const Ctx& F, const Inputs& I) {
    if (DEFER_CONV && F.G == 256) { for (int it = F.gw; it < IT_EARLY; it += F.NGW) conv_item(F, I, 0, it); }
    else for (int it = F.gw; it < NL * IT_BIG; it += F.NGW) conv_item(F, I, it / IT_BIG, it % IT_BIG);
    for (int it = F.gw; it < NL * (IT_KV + IT_XO); it += F.NGW) conv_item_xa(F, I, it / (IT_KV + IT_XO), it % (IT_KV + IT_XO));
    for (size_t i = (size_t)F.gw * 64 + F.lane; i < (size_t)NL * DM * 512 / 8; i += (size_t)F.NGW * 64) {
        const f32x4 a = *(const f32x4*)(I.ptr(30) + i * 8), b = *(const f32x4*)(I.ptr(30) + i * 8 + 4); const float g = FUSE_N2 ? I.ptr(28)[(i * 8) / 512] : 1.f;
        u32x4 o; o.x = pk2(a[0] * g, a[1] * g); o.y = pk2(a[2] * g, a[3] * g); o.z = pk2(b[0] * g, b[1] * g); o.w = pk2(b[2] * g, b[3] * g); *(u32x4*)(F.ws + WS_WQB + i * 16) = o; }
    for (int i = F.gw * 64 + F.lane; i < NL * 20 * DM; i += F.NGW * 64) { const int l = i / (20 * DM), j = (i / DM) % 20, k = i % DM;
        const float g = I.ptr(33)[l * DM + k]; const float w = j < 4 ? I.ptr(34)[((size_t)l * DM + k) * 4 + j] : I.ptr(36)[((size_t)l * DM + k) * 16 + (j - 4)];
        const float p = g * w; const unsigned hb = pk2(p, 0.f) & 0xffffu; const unsigned lb = pk2(p - bflo(hb), 0.f) & 0xffffu;
        ((unsigned short*)lwp(F, l, LW_RT))[j * DM + k] = (unsigned short)hb; ((unsigned short*)lwp(F, l, LW_RT))[(20 + j) * DM + k] = (unsigned short)lb; }
    for (int i = F.gw * 64 + F.lane; i < T * 32; i += F.NGW * 64) { const int t = i >> 5, d = i & 31;
        const double inv = exp(-(double)d * (1.0 / 32.0) * 9.210340371976184); float s, c; sincos_d((double)((const int*)I.ptr(2))[t] * inv, s, c);
        ((float*)(F.ws + WS_ROPE))[i] = c; ((float*)(F.ws + WS_ROPE))[T * 32 + i] = s; }
    for (int rw = F.gw; rw < NL * MEML; rw += F.NGW) { const int l = rw / MEML, m = rw % MEML;
        const f32x4* xr = (const f32x4*)(I.ptr(1) + (size_t)m * DM) + F.lane; f32x4 v[8]; float s = 0.f;
#pragma unroll
        for (int j = 0; j < 8; ++j) { v[j] = xr[64 * j]; s += (v[j][0] * v[j][0] + v[j][1] * v[j][1]) + (v[j][2] * v[j][2] + v[j][3] * v[j][3]); }
        const float rstd = rsqrtf(wave_sum(s) * (1.f / DM) + RMS_EPS);
        const f32x4* gr = (const f32x4*)(I.ptr(29) + (size_t)l * DM) + F.lane; u32x2* o = (u32x2*)(F.ws + WS_MNORM + (size_t)rw * DM * 2) + F.lane;
#pragma unroll
        for (int j = 0; j < 8; ++j) { const f32x4 g = gr[64 * j]; u32x2 w; w.x = pk2(v[j][0] * rstd * g[0], v[j][1] * rstd * g[1]); w.y = pk2(v[j][2] * rstd * g[2], v[j][3] * rstd * g[3]); o[64 * j] = w; } }
    __syncthreads();
    for (int it = F.vcu; it < NL * 32; it += F.G) {
        const int l = it >> 5, g = it & 31;
        LAS f32x2* lamP = (LAS f32x2*)(F.lds + RING_OFF);
        LAS f32x2* Bb = lamP + 33 * 64;
        LAS f32x2* Cc = Bb + 64 * 16;
        LAS float* Kt = (LAS float*)(Cc + 16 * 64);
        LAS f32x2* fz = (LAS f32x2*)(Kt + 32 * 256);
        if (F.tid < 64) { const int p = F.tid; const float lr = I.ptr(16)[(l * 32 + g) * 64 + p], li = I.ptr(17)[(l * 32 + g) * 64 + p]; const float dt = expf(I.ptr(18)[l * 32 + g]);
            for (int tau = 0; tau <= 32; ++tau) { float s, c; sincos_d((double)tau * (double)li * (double)dt, s, c); const float mg = expf((float)tau * lr * dt); lamP[tau * 64 + p] = (f32x2){mg * c, mg * s}; }
            float s1, c1; sincos_d((double)li * (double)dt, s1, c1); const float mg1 = expf(lr * dt), abr = mg1 * c1, abi = mg1 * s1, den = lr * lr + li * li;
            fz[p] = (f32x2){((abr - 1.f) * lr + abi * li) / den, (abi * lr - (abr - 1.f) * li) / den};
            ((f32x2*)lwp(F, l, LW_LAM))[g * 64 + p] = lamP[32 * 64 + p]; }
        __syncthreads();
        for (int i = F.tid; i < 1024; i += 512) { const int p = i >> 4, h = i & 15; const float br = I.ptr(19)[((size_t)(l * 32 + g) * 64 + p) * 16 + h], bi = I.ptr(20)[((size_t)(l * 32 + g) * 64 + p) * 16 + h]; const f32x2 f = fz[p];
            Bb[i] = (f32x2){f[0] * br - f[1] * bi, f[0] * bi + f[1] * br};
            const int hh = i >> 6, pp = i & 63; Cc[i] = (f32x2){I.ptr(21)[((size_t)(l * 32 + g) * 16 + hh) * 64 + pp], I.ptr(22)[((size_t)(l * 32 + g) * 16 + hh) * 64 + pp]}; }
        __syncthreads();
        for (int i = F.tid; i < 32 * 256; i += 512) { const int tau = i >> 8, h = (i >> 4) & 15, h2 = i & 15; float a = 0.f;
            for (int p = 0; p < 64; ++p) { const f32x2 lm = lamP[tau * 64 + p], b = Bb[p * 16 + h2], c = Cc[h * 64 + p]; const float wr_ = lm[0] * b[0] - lm[1] * b[1], wi_ = lm[0] * b[1] + lm[1] * b[0]; a += c[0] * wr_ - c[1] * wi_; }
            if (tau == 0 && h == h2) a += I.ptr(23)[(l * 32 + g) * 16 + h];
            Kt[i] = a; }
        __syncthreads();
        bf16_t* bke = (bf16_t*)(lwp(F, l, LW_BKE) + (size_t)g * 512 * 640 * 2);
        for (int i = F.tid; i < 512 * 80; i += 512) { const int n = i / 80, k8 = i % 80, j = n >> 4, h = n & 15; float v[8];
            if (k8 < 64) { const int ii = k8 >> 1, h0 = (k8 & 1) * 8;
#pragma unroll
                for (int q = 0; q < 8; ++q) v[q] = (ii <= j) ? Kt[(j - ii) * 256 + h * 16 + h0 + q] : 0.f; }
            else { const int p0 = (k8 - 64) * 4;
#pragma unroll
                for (int q = 0; q < 4; ++q) { const f32x2 c = Cc[h * 64 + p0 + q], lm = lamP[(j + 1) * 64 + p0 + q]; v[2 * q] = c[0] * lm[0] - c[1] * lm[1]; v[2 * q + 1] = -(c[0] * lm[1] + c[1] * lm[0]); } }
            u32x4 o; o.x = pk2(v[0], v[1]); o.y = pk2(v[2], v[3]); o.z = pk2(v[4], v[5]); o.w = pk2(v[6], v[7]); *(u32x4*)(bke + (size_t)n * 640 + k8 * 8) = o; }
        bf16_t* fm = (bf16_t*)(lwp(F, l, LW_F) + (size_t)g * 128 * 512 * 2);
        for (int i = F.tid; i < 128 * 64; i += 512) { const int n = i >> 6, k8 = i & 63, p = n >> 1, im = n & 1, ii = k8 >> 1, h0 = (k8 & 1) * 8; float v[8]; const f32x2 lm = lamP[(31 - ii) * 64 + p];
#pragma unroll
            for (int q = 0; q < 8; ++q) { const f32x2 b = Bb[p * 16 + h0 + q]; v[q] = im ? (lm[0] * b[1] + lm[1] * b[0]) : (lm[0] * b[0] - lm[1] * b[1]); }
            u32x4 o; o.x = pk2(v[0], v[1]); o.y = pk2(v[2], v[3]); o.z = pk2(v[4], v[5]); o.w = pk2(v[6], v[7]); *(u32x4*)(fm + (size_t)n * 512 + k8 * 8) = o; }
        __syncthreads();
    }
}

__device__ __forceinline__ void ph_norm1(const Ctx& F, int l, const float* xin, const float* gain, float* fout) {
    char* X = (char*)(F.ws + WS_X);
    for (int rowb = F.gw; rowb < T; rowb += 2 * F.NGW) {
        f32x4 v[2][8];
        if (l == 0) {
#pragma unroll
            for (int r = 0; r < 2; ++r) { const int row = rowb + r * F.NGW; if (row < T) { const f32x4* xr = (const f32x4*)(xin + (size_t)row * DM) + F.lane;
#pragma unroll
                for (int j = 0; j < 8; ++j) v[r][j] = xr[64 * j]; } } }
        else {
            const int cv = (F.lane < 16) ? (int)__hip_atomic_load(F.ctl + CW_CNT + ((l - 1) * 16 + F.lane) * 16, RLX_AGENT) : 0;
            int4 tk[2];
#pragma unroll
            for (int r = 0; r < 2; ++r) { const int row = rowb + r * F.NGW; tk[r] = (row < T) ? *(const int4*)(F.ws + WS_TOK + (size_t)row * 16) : make_int4(0, 0, 0, 0); }
            unsigned ya[2][8], yb[2][8]; u32x2 xq[2][8];
#pragma unroll
            for (int r = 0; r < 2; ++r) { const int row = rowb + r * F.NGW; if (row < T) {
                int o0 = 0, o1 = 0;
#pragma unroll
                for (int k = 0; k < 16; ++k) { const int ck = __builtin_amdgcn_readlane(cv, k); o0 += (k < tk[r].x) ? ck : 0; o1 += (k < tk[r].z) ? ck : 0; }
                const unsigned* y0 = (const unsigned*)(F.ws + WS_Y + (size_t)(o0 + tk[r].y) * 2048) + F.lane; const unsigned* y1 = (const unsigned*)(F.ws + WS_Y + (size_t)(o1 + tk[r].w) * 2048) + F.lane;
                const u32x2* xr = (const u32x2*)(X + (size_t)row * DM * 2) + F.lane;
#pragma unroll
                for (int j = 0; j < 8; ++j) { ya[r][j] = y0[64 * j]; yb[r][j] = y1[64 * j]; xq[r][j] = xr[64 * j]; } } }
#pragma unroll
            for (int r = 0; r < 2; ++r)
#pragma unroll
                for (int j = 0; j < 8; ++j) { const int a = (int)ya[r][j], b = (int)yb[r][j]; const u32x2 xb = xq[r][j]; f32x4 x = (f32x4){bflo(xb.x), bfhi(xb.x), bflo(xb.y), bfhi(xb.y)};
#ifndef DBG_NO_MOE
                    const f32x2 a0 = __builtin_amdgcn_cvt_pk_f32_fp8(a, false), a1 = __builtin_amdgcn_cvt_pk_f32_fp8(a, true), b0 = __builtin_amdgcn_cvt_pk_f32_fp8(b, false), b1 = __builtin_amdgcn_cvt_pk_f32_fp8(b, true);
                    x[0] += (a0[0] + b0[0]) * (1.f / 16.f); x[1] += (a0[1] + b0[1]) * (1.f / 16.f); x[2] += (a1[0] + b1[0]) * (1.f / 16.f); x[3] += (a1[1] + b1[1]) * (1.f / 16.f);
#endif
                    v[r][j] = x; } }
        const f32x4* gr = (const f32x4*)gain + F.lane;
#pragma unroll
        for (int r = 0; r < 2; ++r) { const int row = rowb + r * F.NGW; if (row < T) {
            float s = 0.f;
#pragma unroll
            for (int j = 0; j < 8; ++j) s += (v[r][j][0] * v[r][j][0] + v[r][j][1] * v[r][j][1]) + (v[r][j][2] * v[r][j][2] + v[r][j][3] * v[r][j][3]);
            const float rstd = rsqrtf(wave_sum(s) * (1.f / DM) + RMS_EPS);
            if (fout) { f32x4* o = (f32x4*)(fout + (size_t)row * DM) + F.lane;
#pragma unroll
                for (int j = 0; j < 8; ++j) { const f32x4 g = gr[64 * j]; o[64 * j] = (f32x4){v[r][j][0] * rstd * g[0], v[r][j][1] * rstd * g[1], v[r][j][2] * rstd * g[2], v[r][j][3] * rstd * g[3]}; } }
            else { u32x2* xo = (u32x2*)(X + (size_t)row * DM * 2) + F.lane; unsigned* o8 = (unsigned*)(F.ws + WS_H8 + (size_t)row * DM) + F.lane;
                if (F.lane == 0) ((float*)(F.ws + WS_RSTD))[row] = rstd;
#pragma unroll
                for (int j = 0; j < 8; ++j) { u32x2 xw; xw.x = pk2(v[r][j][0], v[r][j][1]); xw.y = pk2(v[r][j][2], v[r][j][3]); xo[64 * j] = xw;
                    int p8 = __builtin_amdgcn_cvt_pk_fp8_f32(v[r][j][0], v[r][j][1], 0, false); p8 = __builtin_amdgcn_cvt_pk_fp8_f32(v[r][j][2], v[r][j][3], p8, true); o8[64 * j] = (unsigned)p8; } } } }
    }
}
__device__ __forceinline__ void ph_norm2(const Ctx& F, const float* gain) {
    const float* X = (const float*)(F.ws + WS_X);
    for (int row = F.gw; row < T; row += F.NGW) {
        const f32x4* xr = (const f32x4*)(X + (size_t)row * DM) + F.lane; f32x4 v[8]; float s = 0.f;
#pragma unroll
        for (int j = 0; j < 8; ++j) { v[j] = xr[64 * j]; s += (v[j][0] * v[j][0] + v[j][1] * v[j][1]) + (v[j][2] * v[j][2] + v[j][3] * v[j][3]); }
        const float rstd = rsqrtf(wave_sum(s) * (1.f / DM) + RMS_EPS);
        const f32x4* gr = (const f32x4*)gain + F.lane; u32x2* o = (u32x2*)(F.ws + WS_H + (size_t)row * DM * 2) + F.lane;
#pragma unroll
        for (int j = 0; j < 8; ++j) { const f32x4 g = gr[64 * j]; u32x2 w; w.x = pk2(v[j][0] * rstd * g[0], v[j][1] * rstd * g[1]); w.y = pk2(v[j][2] * rstd * g[2], v[j][3] * rstd * g[3]); o[64 * j] = w; }
    }
}
__device__ __forceinline__ void ph_conv(const Ctx& F, const float* dww, const float* dwb, const float* lng, const float* lnb) {
    LAS float* cs = (LAS float*)(F.lds + RING_OFF);
    const bf16_t* Z = (const bf16_t*)(F.ws + WS_Z);
    for (int run = F.vcu; run < T / 32; run += F.G) {
        const int t0 = run * 32, c = F.tid;
        float w[31];
#pragma unroll
        for (int k = 0; k < 31; ++k) w[k] = dww[k * 512 + c];
        const float b = dwb[c];
        float zz[62];
#pragma unroll
        for (int i = 0; i < 62; ++i) { const int t = t0 - 30 + i; zz[i] = (t >= 0) ? bf2f(Z[(size_t)t * 512 + c]) : 0.f; }
#pragma unroll
        for (int j = 0; j < 32; ++j) { float a = b;
#pragma unroll
            for (int k = 0; k < 31; ++k) a += w[k] * zz[j + k];
            cs[j * 512 + c] = a; }
        __syncthreads();
#pragma unroll
        for (int q = 0; q < 4; ++q) { const int j = F.wave * 4 + q; const f32x4 a0 = *(const LAS f32x4*)(cs + j * 512 + F.lane * 8), a1 = *(const LAS f32x4*)(cs + j * 512 + F.lane * 8 + 4);
            const float mu = wave_sum((a0[0] + a0[1]) + (a0[2] + a0[3]) + (a1[0] + a1[1]) + (a1[2] + a1[3])) * (1.f / 512.f);
            const f32x4 d0 = a0 - mu, d1 = a1 - mu;
            const float var = wave_sum((d0[0] * d0[0] + d0[1] * d0[1]) + (d0[2] * d0[2] + d0[3] * d0[3]) + (d1[0] * d1[0] + d1[1] * d1[1]) + (d1[2] * d1[2] + d1[3] * d1[3])) * (1.f / 512.f);
            const float rstd = rsqrtf(var + LN_EPS);
            const f32x4 g0 = *(const f32x4*)(lng + F.lane * 8), g1 = *(const f32x4*)(lng + F.lane * 8 + 4), b0 = *(const f32x4*)(lnb + F.lane * 8), b1 = *(const f32x4*)(lnb + F.lane * 8 + 4);
            f32x4 y0 = d0 * rstd * g0 + b0, y1 = d1 * rstd * g1 + b1;
#pragma unroll
            for (int i = 0; i < 4; ++i) { y0[i] = y0[i] * sigmoidf_(y0[i]); y1[i] = y1[i] * sigmoidf_(y1[i]); }
            u32x4 o; o.x = pk2(y0[0], y0[1]); o.y = pk2(y0[2], y0[3]); o.z = pk2(y1[0], y1[1]); o.w = pk2(y1[2], y1[3]);
            *(u32x4*)(F.ws + WS_CVO + ((size_t)(t0 + j) * 512 + F.lane * 8) * 2) = o; }
        __syncthreads();
    }
}
__device__ __forceinline__ void ph_ssm2(const Ctx& F, int l) {
    if (F.vcu < 64) { const int g = F.vcu >> 1, p = (F.vcu & 1) * 32 + (F.tid & 31), q = F.tid >> 5; const f32x2 lm = ((const f32x2*)lwp(F, l, LW_LAM))[g * 64 + p];
        LAS f32x2* Tq = (LAS f32x2*)(F.lds + RING_OFF);
        const float* S = (const float*)(F.ws + WS_SS) + g * 128 + 2 * p + (size_t)(16 * q) * 4096;
        f32x2 sv[16];
#pragma unroll
        for (int i = 0; i < 16; ++i) sv[i] = *(const f32x2*)(S + (size_t)i * 4096);
        f32x2 loc[16]; float xr = 0.f, xi = 0.f;
#pragma unroll
        for (int i = 0; i < 16; ++i) { const float nr = lm[0] * xr - lm[1] * xi + sv[i][0], ni = lm[0] * xi + lm[1] * xr + sv[i][1]; xr = nr; xi = ni; loc[i] = (f32x2){xr, xi}; }
        Tq[q * 32 + (F.tid & 31)] = loc[15];
        float pr = lm[0], pi = lm[1];
#pragma unroll
        for (int k = 0; k < 4; ++k) { const float nr = pr * pr - pi * pi, ni = 2.f * pr * pi; pr = nr; pi = ni; }
        __syncthreads();
        float cr = 0.f, ci = 0.f;
        for (int qq = 0; qq < q; ++qq) { const f32x2 t = Tq[qq * 32 + (F.tid & 31)]; const float nr = pr * cr - pi * ci + t[0], ni = pr * ci + pi * cr + t[1]; cr = nr; ci = ni; }
        unsigned* xp = (unsigned*)(F.ws + WS_XP) + ((size_t)g * 256 + 16 * q) * 64 + p;
        xp[0] = pk2(cr, ci);
#pragma unroll
        for (int i = 1; i < 16; ++i) { const float nr = lm[0] * cr - lm[1] * ci, ni = lm[0] * ci + lm[1] * cr; cr = nr; ci = ni; xp[i * 64] = pk2(cr + loc[i - 1][0], ci + loc[i - 1][1]); }
    }
    __syncthreads();
}
#if NAIVE_SSM
__device__ __forceinline__ void ph_ssm_naive(const Ctx& F, int l, const Inputs& I) {
    if (F.vcu < 32) { const int g = F.vcu; LAS f32x2* xs = (LAS f32x2*)(F.lds + RING_OFF); LAS float* us = (LAS float*)(xs + 64);
        float br[16], bi[16], abr = 0.f, abi = 0.f, xr = 0.f, xi = 0.f, cr[64], ci[64], dsk = 0.f;
        if (F.tid < 64) { const int p = F.tid; const float lr = I.ptr(16)[(l * 32 + g) * 64 + p], li = I.ptr(17)[(l * 32 + g) * 64 + p]; const float dt = expf(I.ptr(18)[l * 32 + g]);
            float s1, c1; sincos_d((double)li * (double)dt, s1, c1); const float mg1 = expf(lr * dt); abr = mg1 * c1; abi = mg1 * s1; const float den = lr * lr + li * li;
            const float fr_ = ((abr - 1.f) * lr + abi * li) / den, fi_ = (abi * lr - (abr - 1.f) * li) / den;
#pragma unroll
            for (int h = 0; h < 16; ++h) { const float b_r = I.ptr(19)[((size_t)(l * 32 + g) * 64 + p) * 16 + h], b_i = I.ptr(20)[((size_t)(l * 32 + g) * 64 + p) * 16 + h]; br[h] = fr_ * b_r - fi_ * b_i; bi[h] = fr_ * b_i + fi_ * b_r; } }
        if (F.tid < 16) { const int h = F.tid;
#pragma unroll
            for (int p = 0; p < 64; ++p) { cr[p] = I.ptr(21)[((size_t)(l * 32 + g) * 16 + h) * 64 + p]; ci[p] = I.ptr(22)[((size_t)(l * 32 + g) * 16 + h) * 64 + p]; }
            dsk = I.ptr(23)[(l * 32 + g) * 16 + h]; }
        const bf16_t* UC = (const bf16_t*)(F.ws + WS_UC) + (size_t)g * 256 * 512;
#pragma unroll 1
        for (int t = 0; t < T; ++t) {
            if (F.tid < 16) us[F.tid] = bf2f(UC[(size_t)(t >> 5) * 512 + (t & 31) * 16 + F.tid]);
            __syncthreads();
            if (F.tid < 64) { float ar = 0.f, ai = 0.f;
#pragma unroll
                for (int h = 0; h < 16; ++h) { ar += br[h] * us[h]; ai += bi[h] * us[h]; }
                const float nr = abr * xr - abi * xi + ar, ni = abr * xi + abi * xr + ai; xr = nr; xi = ni; xs[F.tid] = (f32x2){xr, xi}; }
            __syncthreads();
            if (F.tid < 16) { float y = dsk * us[F.tid];
#pragma unroll
                for (int p = 0; p < 64; ++p) { const f32x2 x = xs[p]; y += cr[p] * x[0] - ci[p] * x[1]; }
                ((bf16_t*)(F.ws + WS_YS))[(size_t)t * 512 + g * 16 + F.tid] = (bf16_t)f2bf(y); }
        }
        __syncthreads();
    }
}
#endif
__device__ __forceinline__ void ph_diff(const Ctx& F, int l, const Inputs& I) {
    const float lam_init = 0.8f - 0.6f * expf(-0.3f * (float)l);
    const float d1 = wave_sum(I.ptr(5)[l * 64 + F.lane] * I.ptr(6)[l * 64 + F.lane]), d2 = wave_sum(I.ptr(7)[l * 64 + F.lane] * I.ptr(8)[l * 64 + F.lane]);
    const float lam = expf(d1) - expf(d2) + lam_init, post = 1.f - lam_init;
    float hn[16];
#pragma unroll
    for (int i = 0; i < 16; ++i) hn[i] = I.ptr(9)[l * 128 + (F.lane & 7) * 16 + i] * post;
    for (int row = F.gw; row < T; row += F.NGW) {
        const u32x4* a = (const u32x4*)(F.ws + WS_O1 + (size_t)row * 2048) + F.lane * 2; const u32x4* b = (const u32x4*)(F.ws + WS_O2 + (size_t)row * 2048) + F.lane * 2;
        float d[16]; float ss = 0.f;
#pragma unroll
        for (int q = 0; q < 2; ++q) { const u32x4 x = a[q], y = b[q];
            d[q * 8 + 0] = bflo(x.x) - lam * bflo(y.x); d[q * 8 + 1] = bfhi(x.x) - lam * bfhi(y.x); d[q * 8 + 2] = bflo(x.y) - lam * bflo(y.y); d[q * 8 + 3] = bfhi(x.y) - lam * bfhi(y.y);
            d[q * 8 + 4] = bflo(x.z) - lam * bflo(y.z); d[q * 8 + 5] = bfhi(x.z) - lam * bfhi(y.z); d[q * 8 + 6] = bflo(x.w) - lam * bflo(y.w); d[q * 8 + 7] = bfhi(x.w) - lam * bfhi(y.w); }
#pragma unroll
        for (int i = 0; i < 16; ++i) ss += d[i] * d[i];
        ss += xor_lane<1>(ss); ss += xor_lane<2>(ss); ss += xor_lane<4>(ss);
        const float rstd = rsqrtf(ss * (1.f / 128.f) + HEAD_EPS);
        u32x4* o = (u32x4*)(F.ws + WS_OAN + (size_t)row * 2048) + F.lane * 2;
#pragma unroll
        for (int q = 0; q < 2; ++q) { u32x4 w; w.x = pk2(d[q * 8 + 0] * rstd * hn[q * 8 + 0], d[q * 8 + 1] * rstd * hn[q * 8 + 1]); w.y = pk2(d[q * 8 + 2] * rstd * hn[q * 8 + 2], d[q * 8 + 3] * rstd * hn[q * 8 + 3]);
            w.z = pk2(d[q * 8 + 4] * rstd * hn[q * 8 + 4], d[q * 8 + 5] * rstd * hn[q * 8 + 5]); w.w = pk2(d[q * 8 + 6] * rstd * hn[q * 8 + 6], d[q * 8 + 7] * rstd * hn[q * 8 + 7]); o[q] = w; }
    }
}
__device__ __forceinline__ void ph_norm3_router(const Ctx& F, int l, const Inputs& I, const bool commit = true) {
    const char* X = (const char*)(F.ws + WS_X); LAS float* part = (LAS float*)(F.lds + RING_OFF);
    const char* RT = (const char*)lwp(F, l, LW_RT);
    for (int run = F.vcu; run < T / 32; run += F.G) {
        const int r0 = run * 32;
        int ln = F.lane; asm volatile("" : "+v"(ln));
        const int fr = ln & 15, fq = ln >> 4;
        const unsigned lo16 = (unsigned)ln * 16u;
        f32x4 acc[2][2];
#pragma unroll
        for (int m = 0; m < 2; ++m)
#pragma unroll
            for (int n = 0; n < 2; ++n) acc[m][n] = (f32x4){0.f, 0.f, 0.f, 0.f};
        {
            const char* xa = X + (size_t)(r0 + fr) * (DM * 2) + (unsigned)((F.wave * 256 + fq * 8) * 2);
            const char* wa = RT + (size_t)fr * (DM * 2) + (unsigned)((F.wave * 256 + fq * 8) * 2);
            const char* wb = RT + (size_t)(16 + (fr & 3)) * (DM * 2) + (unsigned)((F.wave * 256 + fq * 8) * 2);
#pragma unroll 4
            for (int ks = 0; ks < 8; ++ks) {
                const bf16x8 x0 = *(const bf16x8*)(xa + ks * 64), x1 = *(const bf16x8*)(xa + 16 * DM * 2 + ks * 64);
                const bf16x8 ha = *(const bf16x8*)(wa + ks * 64), la = *(const bf16x8*)(wa + 20 * DM * 2 + ks * 64), hb = *(const bf16x8*)(wb + ks * 64), lb = *(const bf16x8*)(wb + 20 * DM * 2 + ks * 64);
                acc[0][0] = __builtin_amdgcn_mfma_f32_16x16x32_bf16(ha, x0, acc[0][0], 0, 0, 0); acc[1][0] = __builtin_amdgcn_mfma_f32_16x16x32_bf16(ha, x1, acc[1][0], 0, 0, 0);
                acc[0][1] = __builtin_amdgcn_mfma_f32_16x16x32_bf16(hb, x0, acc[0][1], 0, 0, 0); acc[1][1] = __builtin_amdgcn_mfma_f32_16x16x32_bf16(hb, x1, acc[1][1], 0, 0, 0);
                acc[0][0] = __builtin_amdgcn_mfma_f32_16x16x32_bf16(la, x0, acc[0][0], 0, 0, 0); acc[1][0] = __builtin_amdgcn_mfma_f32_16x16x32_bf16(la, x1, acc[1][0], 0, 0, 0);
                acc[0][1] = __builtin_amdgcn_mfma_f32_16x16x32_bf16(lb, x0, acc[0][1], 0, 0, 0); acc[1][1] = __builtin_amdgcn_mfma_f32_16x16x32_bf16(lb, x1, acc[1][1], 0, 0, 0);
            }
        }
        __syncthreads();
#pragma unroll
        for (int m = 0; m < 2; ++m) { LAS float* pw = part + ((F.wave * 32 + 16 * m + fr) * 24);
            *(LAS f32x4*)(pw + 4 * fq) = acc[m][0]; if (fq == 0) *(LAS f32x4*)(pw + 16) = acc[m][1]; }
        __syncthreads();
        u32x2 xb[4][8];
#pragma unroll
        for (int rr = 0; rr < 4; ++rr)
#pragma unroll
            for (int j = 0; j < 8; ++j) xb[rr][j] = *(const u32x2*)(X + (size_t)(r0 + F.wave * 4 + rr) * (DM * 2) + 512 * j + (lo16 >> 1));
#pragma unroll
        for (int rr = 0; rr < 4; ++rr) { const int rl = F.wave * 4 + rr, row = r0 + rl;
            float lgv = 0.f;
            if (ln < 20) {
#pragma unroll
                for (int w = 0; w < 8; ++w) lgv += part[(w * 32 + rl) * 24 + ln]; }
            f32x4 v[8]; float ss = 0.f;
#pragma unroll
            for (int j = 0; j < 8; ++j) { v[j] = (f32x4){bflo(xb[rr][j].x), bfhi(xb[rr][j].x), bflo(xb[rr][j].y), bfhi(xb[rr][j].y)}; ss += (v[j][0] * v[j][0] + v[j][1] * v[j][1]) + (v[j][2] * v[j][2] + v[j][3] * v[j][3]); }
            const float rstd = rsqrtf(wave_sum(ss) * (1.f / DM) + RMS_EPS);
            float lg[20];
#pragma unroll
            for (int j = 0; j < 20; ++j) lg[j] = __builtin_bit_cast(float, __builtin_amdgcn_readlane(__builtin_bit_cast(int, lgv), j));
            float gl[4], el[16];
#pragma unroll
            for (int i = 0; i < 4; ++i) gl[i] = lg[i] * rstd + I.ptr(35)[l * 4 + i];
#pragma unroll
            for (int i = 0; i < 16; ++i) el[i] = lg[4 + i] * rstd + I.ptr(37)[l * 16 + i];
            int gi = 0; float gm = gl[0];
#pragma unroll
            for (int i = 1; i < 4; ++i) if (gl[i] > gm) { gm = gl[i]; gi = i; }
            float gs = 0.f;
#pragma unroll
            for (int i = 0; i < 4; ++i) gs += expf(gl[i] - gm);
            const float gw_ = 1.f / gs;
            float sel[4];
#pragma unroll
            for (int i = 0; i < 4; ++i) sel[i] = gi == 0 ? el[i] : gi == 1 ? el[4 + i] : gi == 2 ? el[8 + i] : el[12 + i];
            int i0 = 0; float v0 = sel[0];
#pragma unroll
            for (int i = 1; i < 4; ++i) if (sel[i] > v0) { v0 = sel[i]; i0 = i; }
            int i1 = -1; float v1 = -INFINITY;
#pragma unroll
            for (int i = 0; i < 4; ++i) if (i != i0 && sel[i] > v1) { v1 = sel[i]; i1 = i; }
            const float w0 = gw_ / (1.f + expf(v1 - v0)), w1 = gw_ - w0;
            const int e0 = gi * 4 + i0, e1 = gi * 4 + i1;
            if (F.lane == 0 && commit) {
                const int s0 = (int)__hip_atomic_fetch_add(F.ctl + CW_CNT + (l * 16 + e0) * 16, 1u, RLX_AGENT), s1 = (int)__hip_atomic_fetch_add(F.ctl + CW_CNT + (l * 16 + e1) * 16, 1u, RLX_AGENT);
                ((int*)(F.ws + WS_LIST))[e0 * T + s0] = row; ((float*)(F.ws + WS_WL))[e0 * T + s0] = w0;
                ((int*)(F.ws + WS_LIST))[e1 * T + s1] = row; ((float*)(F.ws + WS_WL))[e1 * T + s1] = w1;
                *(int4*)(F.ws + WS_TOK + (size_t)row * 16) = make_int4(e0, s0, e1, s1); }
            const char* gr = (const char*)(I.ptr(33) + (size_t)l * DM); char* o = (char*)(F.ws + WS_H8 + (size_t)row * DM);
#pragma unroll
            for (int j = 0; j < 8; ++j) { const f32x4 g = *(const f32x4*)(gr + 1024 * j + lo16);
                int p8 = __builtin_amdgcn_cvt_pk_fp8_f32(v[j][0] * rstd * g[0], v[j][1] * rstd * g[1], 0, false); p8 = __builtin_amdgcn_cvt_pk_fp8_f32(v[j][2] * rstd * g[2], v[j][3] * rstd * g[3], p8, true); *(unsigned*)(o + 256 * j + (lo16 >> 2)) = (unsigned)p8; }
        }
    }
    __syncthreads();
}
namespace pg8 {
struct SchedKV { unsigned char* ws; int G, c; static constexpr bool GATHER = false;
    __device__ __forceinline__ bool next(int i, GU& u) const { const int L = i * G + c; if (L >= 16) return false; const int l = L >> 2, pn = L & 3;
        u.A = (const char*)ws + WS_MNORM + (size_t)l * MEML * DM * 2; u.B = (const char*)ws + WS_WKVT + (size_t)l * 1024 * DM * 2 + (size_t)pn * 256 * 4096; u.C = (char*)ws + WS_KVB + (size_t)l * MEML * 2048 + pn * 512; u.P = nullptr;
        u.lda = 4096; u.ldb = 4096; u.nt = 32; u.pm = 0; u.pn = pn; u.seg = 0; u.flags = GU_LAST; u.rows = 256; u.aux = __builtin_bit_cast(int, 1.0f); u.f8 = 0; return true; }
    __device__ __forceinline__ unsigned arow(const GU& u, int r) const { return (unsigned)(r * u.lda); } };
struct SchedAbsorb { unsigned char* ws; int G, c; static constexpr bool GATHER = false;
    __device__ __forceinline__ bool next(int i, GU& u) const { const int L = i * G + c; if (L >= 256) return false; const int w = L & 127, l = w >> 5, h = (w >> 3) & 3, t = w & 7;
        unsigned char* lw = ws + WS_LW + (size_t)l * LW_SIZE; const char* kvb = (const char*)ws + WS_KVB + (size_t)l * MEML * 2048;
        int two = 2; asm volatile("" : "+s"(two));
        u.P = nullptr; u.nt = two; u.pm = 0; u.pn = 0; u.seg = 0; u.flags = GU_LAST; u.rows = 256;
        if (L < 128) { u.A = kvb + h * 256; u.lda = 2048; u.B = (const char*)ws + WS_WQB + (size_t)l * DM * 1024 + (size_t)t * 256 * 1024 + h * 256; u.ldb = 1024;
            u.C = (char*)lw + LW_WQK + (size_t)(h * 256) * (S_FP8 ? 2048 : 4096) + t * (S_FP8 ? 256 : 512); u.aux = __builtin_bit_cast(int, C2X * SQK_SCALE); u.f8 = 0; u.seg = S_FP8; }
        else { u.A = (const char*)ws + WS_WXOT + (size_t)l * DM * 1024 + (size_t)t * 256 * 1024 + h * 256; u.lda = 1024; u.B = kvb + 1024 + h * 256; u.ldb = 2048;
            u.C = (char*)lw + LW_VW + (size_t)(t * 256) * (XAO_FP8 ? 1024 : 2048) + h * (XAO_FP8 ? 256 : 512); u.aux = __builtin_bit_cast(int, VW_SCALE); u.f8 = 0; u.seg = XAO_FP8; }
        u.pm = (L < 128) ? (S_FP8 ? 2048 : 4096) : (XAO_FP8 ? 1024 : 2048);
        return true; }
    __device__ __forceinline__ unsigned arow(const GU& u, int r) const { return (unsigned)(r * u.lda); } };
struct EpiStoreP {
    __device__ __forceinline__ void operator()(Acc& acc, const GU& u, int wr, int wc, int fr, int fq) const {
        const float sc = __builtin_bit_cast(float, u.aux);
        if (u.seg) { EPI_ROWS( { char* rp = u.C + (unsigned)(lrow * u.pm); EPI_COLS( { int q0 = __builtin_amdgcn_cvt_pk_fp8_f32(v0[0] * sc, v0[1] * sc, 0, false); q0 = __builtin_amdgcn_cvt_pk_fp8_f32(v0[2] * sc, v0[3] * sc, q0, true);
                int q1 = __builtin_amdgcn_cvt_pk_fp8_f32(v1[0] * sc, v1[1] * sc, 0, false); q1 = __builtin_amdgcn_cvt_pk_fp8_f32(v1[2] * sc, v1[3] * sc, q1, true); *(u32x2*)(rp + lcol) = (u32x2){(unsigned)q0, (unsigned)q1}; } ) } ) }
        else { EPI_ROWS( { char* rp = u.C + (unsigned)(lrow * u.pm); EPI_COLS( st8(rp + lcol * 2, v0 * sc, v1 * sc); ) } ) }
    } };
struct SchedSsm1 { unsigned char* ws; unsigned char* lw; int G, c; static constexpr bool GATHER = false;
    __device__ __forceinline__ bool next(int i, GU& u) const { const int g = i * G + c; if (g >= 32) return false;
        u.A = (const char*)ws + WS_UC + (size_t)g * 256 * 1024; u.lda = 1024; u.B = (const char*)lw + LW_F + (size_t)g * 128 * 1024; u.ldb = 1024; u.C = (char*)ws + WS_SS + g * 512; u.P = nullptr;
        u.nt = 8; u.pm = 0; u.pn = g; u.seg = 0; u.flags = GU_LAST; u.rows = 256; u.aux = 0; u.f8 = 0; return true; }
    __device__ __forceinline__ unsigned arow(const GU& u, int r) const { return (unsigned)(r * u.lda); } };
struct SchedSsm3 { unsigned char* ws; unsigned char* lw; int G, c; static constexpr bool GATHER = false;
    __device__ __forceinline__ bool next(int i, GU& u) const { const int ti = i >> 1, sg = i & 1, L = ti * G + c; if (L >= 64) return false; const int g = L >> 1, pn = L & 1;
        const char* b = (const char*)lw + LW_BKE + (size_t)g * 512 * 1280 + (size_t)pn * 256 * 1280;
        if (sg == 0) { u.A = (const char*)ws + WS_UC + (size_t)g * 256 * 1024; u.lda = 1024; u.B = b; u.nt = 8; }
        else { u.A = (const char*)ws + WS_XP + (size_t)g * 256 * 256; u.lda = 256; u.B = b + 1024; u.nt = 2; }
        u.ldb = 1280; u.C = nullptr; u.P = nullptr; u.pm = g; u.pn = pn; u.seg = sg; u.flags = sg ? GU_LAST : 0; u.rows = 256; u.aux = 0; u.f8 = 0; return true; }
    __device__ __forceinline__ unsigned arow(const GU& u, int r) const { return (unsigned)(r * u.lda); } };
}

constexpr int PH_PRO_A = 0, PH_PRO_B = 1, PH_PRO_C = 2, PH_L0 = 3, NPL = 15, PH_FINAL = PH_L0 + NL * NPL, NPHASES = PH_FINAL + 1;
constexpr int INTAB_OFF = LDSCTL_OFF + 1024;
struct Args { const float* in[42]; float* out; unsigned char* ws; int ph_lo, ph_hi; };
#define LAUNDER_S(x) asm volatile("" : "+s"(x))
#define MKCTX() Ctx F; { unsigned char* w_ = args.ws; LAUNDER_S(w_); F.ws = w_; F.lds = (LAS unsigned char*)lds_raw; F.ctl = (gu32*)(w_ + WS_CTL); \
    F.tid = tid_of(wave_s); F.lane = F.tid & 63; F.wave = __builtin_amdgcn_readfirstlane(F.tid >> 6); \
    int g_ = gridDim.x; LAUNDER_S(g_); F.G = g_; { int bx_ = blockIdx.x; LAUNDER_S(bx_); F.vcu = (g_ % 8 == 0) ? (bx_ % 8) * (g_ / 8) + bx_ / 8 : bx_; } \
    F.gw = F.vcu * NWAVES + F.wave; F.NGW = F.G * NWAVES; } \
    unsigned char* const ws = F.ws; (void)ws; const Inputs I{(const LAS unsigned*)(F.lds + INTAB_OFF)}; (void)I; int bx = blockIdx.x; LAUNDER_S(bx);
#if MK_PER_PHASE
#define GRID_BAR() do { } while (0)
#else
#define GRID_BAR() do { unsigned char* w_ = args.ws; LAUNDER_S(w_); XcdBarrier bar_; bar_.bar = (unsigned*)((gu32*)(w_ + WS_CTL) + CW_BAR); bar_.x = xb_xcc_id(); \
        bar_.st = (volatile LAS unsigned*)((LAS unsigned char*)lds_raw + MISC_OFF) + 8; xcd_barrier(bar_); } while (0)
#endif
#define IN(k) (lo <= (k) && (k) < hi)
#define SEAM(k) do { if (IN(k) && IN((k) + 1)) GRID_BAR(); } while (0)
#ifndef ONLY_LPH
#define ONLY_LPH -1
#endif
#define LPH_ON(j) (ONLY_LPH < 0 || ONLY_LPH == (j))
#ifndef DBG_DUP_MASK
#define DBG_DUP_MASK 0
#endif
#define NREP(j) (1 + ((DBG_DUP_MASK >> (j)) & 1))
#define INL(j) (LPH_ON(j) && lo <= (P0 + (j)) && (P0 + (j)) < hi)
#define SEAML(j) do { if ((lo <= (P0 + (j)) && (P0 + (j)) < hi) && (lo <= (P0 + (j) + 1) && (P0 + (j) + 1) < hi)) GRID_BAR(); } while (0)
template <int l> __device__ __forceinline__ void run_layer(const Args& args, unsigned char* lds_raw, const int lo, const int hi, const int wave_s) {
        const int P0 = PH_L0 + l * NPL;
#define LW() (ws + WS_LW + (size_t)l * LW_SIZE)
        if (INL(0)) for (int rep_ = 0; rep_ < NREP(0); ++rep_) { MKCTX(); ph_norm1(F, l, I.ptr(0), I.ptr(3) + (size_t)l * DM, nullptr); } SEAML(0);
        if (INL(1)) for (int rep_ = 0; rep_ < NREP(1); ++rep_) { MKCTX(); pg8::EpiProj E{(char*)ws, (const float*)(ws + WS_ROPE), (const float*)(ws + WS_ROPE) + T * 32, (const float*)(ws + WS_RSTD)};
            { pg8::SchedProj<false> S{ws, LW(), F.G, bx}; pg8::gemm_phase<pg8::EpiProj, pg8::SchedProj<false>, false>(F.lds + RING_OFF, S, E, F.tid); }
            { pg8::SchedProj<true> S{ws, LW(), F.G, bx}; pg8::gemm_phase<pg8::EpiProj, pg8::SchedProj<true>, true>(F.lds + RING_OFF, S, E, F.tid); } } SEAML(1);
#if NAIVE_SSM
        if (INL(2)) for (int rep_ = 0; rep_ < NREP(2); ++rep_) { MKCTX(); ph_conv(F, I.ptr(11) + (size_t)l * 31 * 512, I.ptr(12) + l * 512, I.ptr(13) + l * 512, I.ptr(14) + l * 512); ph_ssm_naive(F, l, I); } SEAML(2);
        SEAML(3); SEAML(4);
#else
        if (INL(2)) for (int rep_ = 0; rep_ < NREP(2); ++rep_) { MKCTX(); ph_conv(F, I.ptr(11) + (size_t)l * 31 * 512, I.ptr(12) + l * 512, I.ptr(13) + l * 512, I.ptr(14) + l * 512);
            pg8::SchedSsm1 S{ws, LW(), F.G, bx}; pg8::EpiStoreF32 E{16384}; pg8::gemm_phase(F.lds + RING_OFF, S, E, F.tid);
            if (DEFER_CONV && F.G == 256 && bx >= 32) conv_window(F, I, l, 0, (bx - 32) * NWAVES + F.wave, 2); } SEAML(2);
        if (INL(3)) for (int rep_ = 0; rep_ < NREP(3); ++rep_) { MKCTX(); ph_ssm2(F, l);
            if (DEFER_CONV && F.G == 256 && F.vcu >= 64) conv_window(F, I, l, 3584, (F.vcu - 64) * NWAVES + F.wave, 1); } SEAML(3);
#endif
        if (INL(5)) for (int rep_ = 0; rep_ < NREP(5); ++rep_) { MKCTX(); { pg8::SchedSsm3 S{ws, LW(), F.G, bx}; pg8::EpiSsm3 E{(char*)ws + WS_YS}; pg8::gemm_phase(F.lds + RING_OFF, S, E, F.tid);
            if (DEFER_CONV && F.G == 256 && bx >= 64) conv_window(F, I, l, 5120, (bx - 64) * NWAVES + F.wave, 2); }
            (ATTN128 && !NAIVE_ATTN ? attn128::attn_phase : attn_body::attn_phase)((char*)lds_raw + RING_OFF, (const bf16_t*)(ws + WS_Q), (const bf16_t*)(ws + WS_K), (const bf16_t*)(ws + WS_V), (bf16_t*)(ws + WS_O1), (bf16_t*)(ws + WS_O2), F.vcu, F.G, F.tid); } SEAML(5);
        if (INL(6)) for (int rep_ = 0; rep_ < NREP(6); ++rep_) { MKCTX(); ph_diff(F, l, I); __syncthreads();
            pg8::SchedDense S{(const char*)ws + WS_YS, (const char*)LW() + LW_WGLU, 1024, 1024, 8, 32, 4, F.G, bx}; pg8::EpiGlu E{(char*)ws + WS_GLUO, I.ptr(25) + (size_t)l * 1024}; pg8::gemm_phase(F.lds + RING_OFF, S, E, F.tid);
            if (DEFER_CONV && F.G == 256 && bx >= 128) conv_window(F, I, l, 8192, (bx - 128) * NWAVES + F.wave, 2); } SEAML(6);
        if (INL(7)) for (int rep_ = 0; rep_ < NREP(7); ++rep_) { MKCTX(); pg8::SchedSeg<0> S{ws, LW(), F.G, bx}; pg8::EpiGated E{(const char*)ws + WS_GATES, (char*)ws + WS_MERGED}; pg8::gemm_phase(F.lds + RING_OFF, S, E, F.tid); } SEAML(7);
        if (INL(8)) for (int rep_ = 0; rep_ < NREP(8); ++rep_) { MKCTX(); pg8::SchedDense S{(const char*)ws + WS_MERGED, (const char*)LW() + LW_WMIX, 4096, 4096, 32, 32, 8, F.G, bx}; pg8::EpiResid E{(char*)ws + WS_X, (char*)ws + ((S_FP8 || !FUSE_N2) ? WS_H8 : WS_H), (float*)(ws + WS_RSQ)}; pg8::gemm_phase(F.lds + RING_OFF, S, E, F.tid); } SEAML(8);
#ifdef DBG_EXTRA_BAR
        if (INL(9)) GRID_BAR();
#endif
#if !FUSE_N2
        if (INL(9)) for (int rep_ = 0; rep_ < NREP(9); ++rep_) { MKCTX(); ph_norm2(F, I.ptr(28) + (size_t)l * DM); } SEAML(9);
#endif
        if (INL(10)) for (int rep_ = 0; rep_ < NREP(10); ++rep_) { MKCTX(); pg8::SchedDense S{(const char*)ws + (S_FP8 ? WS_H8 : WS_H), (const char*)LW() + LW_WQK, S_FP8 ? 2048 : 4096, S_FP8 ? 2048 : 4096, S_FP8 ? 16 : 32, 32, 4, F.G, bx}; pg8::EpiSexp E{(char*)ws + WS_P, (float*)(ws + WS_RS), (const float*)(ws + WS_RSQ)}; pg8::gemm_phase<pg8::EpiSexp, pg8::SchedDense, S_FP8 != 0>(F.lds + RING_OFF, S, E, F.tid);
            if (DEFER_CONV && F.G == 256 && bx >= 128) conv_window(F, I, l, 10240, (bx - 128) * NWAVES + F.wave, 6); } SEAML(10);
        if (INL(11)) for (int rep_ = 0; rep_ < NREP(11); ++rep_) { MKCTX(); pg8::SchedSeg<1> S{ws, LW(), F.G, bx}; pg8::EpiXao E{(const float*)(ws + WS_RS), (char*)ws + WS_X}; pg8::gemm_phase<pg8::EpiXao, pg8::SchedSeg<1>, XAO_FP8 != 0>(F.lds + RING_OFF, S, E, F.tid); } SEAML(11);
        if (INL(12)) for (int rep_ = 0; rep_ < NREP(12); ++rep_) { MKCTX(); ph_norm3_router(F, l, I, rep_ == NREP(12) - 1); } SEAML(12);
        if (INL(13)) for (int rep_ = 0; rep_ < NREP(13); ++rep_) { MKCTX(); volatile LAS unsigned* MISC = (volatile LAS unsigned*)(F.lds + MISC_OFF);
            if (F.tid < 16) MISC[16 + F.tid] = __hip_atomic_load(F.ctl + CW_CNT + (l * 16 + F.tid) * 16, RLX_AGENT);
            __syncthreads();
            pg8::SchedMoE<false> S{(const volatile LAS int*)(MISC + 16), ws, LW(), F.G, bx}; pg8::EpiGu E{}; pg8::gemm_phase<pg8::EpiGu, pg8::SchedMoE<false>, true>(F.lds + RING_OFF, S, E, F.tid);
            if (DEFER_CONV && F.G == 256 && bx >= 64) conv_window(F, I, l, 16384, (bx - 64) * NWAVES + F.wave, 3); } SEAML(13);
        if (INL(14)) for (int rep_ = 0; rep_ < NREP(14); ++rep_) { MKCTX(); volatile LAS unsigned* MISC = (volatile LAS unsigned*)(F.lds + MISC_OFF);
            if (F.tid < 16) MISC[16 + F.tid] = __hip_atomic_load(F.ctl + CW_CNT + (l * 16 + F.tid) * 16, RLX_AGENT);
            __syncthreads();
            pg8::SchedMoE<true> S{(const volatile LAS int*)(MISC + 16), ws, LW(), F.G, bx}; pg8::EpiDown E{}; pg8::gemm_phase<pg8::EpiDown, pg8::SchedMoE<true>, true>(F.lds + RING_OFF, S, E, F.tid); } SEAML(14);
#undef LW
}
__global__ void __launch_bounds__(NWAVES * 64, 2) mk_fwd(Args args) {
    extern __shared__ __attribute__((aligned(16))) unsigned char lds_raw[];
    const int wave_s = __builtin_amdgcn_readfirstlane((int)threadIdx.x >> 6);
    {   LAS unsigned char* l0 = (LAS unsigned char*)lds_raw;
        for (int u = threadIdx.x; u < (LDS_BYTES - LDSCTL_OFF) / 4; u += NWAVES * 64) ((LAS unsigned*)(l0 + LDSCTL_OFF))[u] = 0u;
        __syncthreads();
        if (threadIdx.x < 84) { const unsigned* ka = (const unsigned*)__builtin_amdgcn_kernarg_segment_ptr(); ((LAS unsigned*)(l0 + INTAB_OFF))[threadIdx.x] = ka[threadIdx.x]; }
        __syncthreads(); }
#if !MK_PER_PHASE
    {   unsigned char* w_ = args.ws; LAUNDER_S(w_); (void)xcd_barrier_post((unsigned*)((gu32*)(w_ + WS_CTL) + CW_BAR), (volatile LAS unsigned*)((LAS unsigned char*)lds_raw + MISC_OFF) + 8); }
#endif
    const int lo = args.ph_lo, hi = args.ph_hi;

    if ((ONLY_LPH < 0 || ONLY_LPH == 100) && IN(PH_PRO_A)) for (int rep_ = 0; rep_ < NREP(20); ++rep_) { MKCTX(); ph_prologue_a(F, I); } SEAM(PH_PRO_A);
    if ((ONLY_LPH < 0 || ONLY_LPH == 101) && IN(PH_PRO_B)) { MKCTX(); pg8::SchedKV S{ws, F.G, bx}; pg8::EpiStore E{2048, 2}; pg8::gemm_phase(F.lds + RING_OFF, S, E, F.tid); } SEAM(PH_PRO_B);
    if ((ONLY_LPH < 0 || ONLY_LPH == 102) && IN(PH_PRO_C)) { MKCTX(); pg8::SchedAbsorb S{ws, F.G, bx}; pg8::EpiStoreP E{}; pg8::gemm_phase(F.lds + RING_OFF, S, E, F.tid); } SEAM(PH_PRO_C);

    run_layer<0>(args, lds_raw, lo, hi, wave_s); run_layer<1>(args, lds_raw, lo, hi, wave_s); run_layer<2>(args, lds_raw, lo, hi, wave_s); run_layer<3>(args, lds_raw, lo, hi, wave_s);
    if ((ONLY_LPH < 0 || ONLY_LPH == 103) && IN(PH_FINAL)) { MKCTX(); float* outp = args.out; ph_norm1(F, NL, I.ptr(0), I.ptr(41), outp); }
}

extern "C" void kernel_launch(void* const* d_in, const int* in_sizes, int n_in, void* d_out, int out_size, void* d_ws, size_t ws_size, hipStream_t stream) {
    static int grid = 0;
    if (grid == 0) {
        if (n_in != 42 || out_size != T * DM || ws_size < WS_END) { fprintf(stderr, "kernel_launch: unexpected problem shape / workspace (%d inputs, out %d, ws %zu < %zu); nothing launched\n", n_in, out_size, ws_size, (size_t)WS_END); grid = -1; return; }
        int dev = 0, cus = 0, per_cu = 0;
        if (hipGetDevice(&dev) != hipSuccess || hipDeviceGetAttribute(&cus, hipDeviceAttributeMultiprocessorCount, dev) != hipSuccess) { grid = -1; return; }
        if (hipFuncSetAttribute((const void*)mk_fwd, hipFuncAttributeMaxDynamicSharedMemorySize, LDS_BYTES) != hipSuccess) { fprintf(stderr, "kernel_launch: hipFuncSetAttribute failed\n"); grid = -1; return; }
        if (hipOccupancyMaxActiveBlocksPerMultiprocessor(&per_cu, (const void*)mk_fwd, NWAVES * 64, LDS_BYTES) != hipSuccess || per_cu < 1) { fprintf(stderr, "kernel_launch: occupancy query says %d workgroups per CU\n", per_cu); }
        (void)hipGetLastError();
        grid = cus;
    }
    if (grid < 0) return;
    if (hipMemsetAsync((char*)d_ws + WS_CTL, 0, CTL_ZERO_BYTES, stream) != hipSuccess) return;
    Args a{};
    for (int i = 0; i < 42; ++i) a.in[i] = (const float*)d_in[i];
    a.out = (float*)d_out; a.ws = (unsigned char*)d_ws;
#if MK_PER_PHASE
    for (int ph = 0; ph < NPHASES; ++ph) { a.ph_lo = ph; a.ph_hi = ph + 1; hipLaunchKernelGGL(mk_fwd, dim3(grid), dim3(NWAVES * 64), LDS_BYTES, stream, a); }
#else
    a.ph_lo = 0; a.ph_hi = NPHASES;
    hipLaunchKernelGGL(mk_fwd, dim3(grid), dim3(NWAVES * 64), LDS_BYTES, stream, a);
#endif
}
```

```cpp
#include <hip/hip_runtime.h>
#include <cstdio>
#include <cstdint>
#include <cmath>

#ifndef NAIVE_GEMM
#define NAIVE_GEMM 0
#endif
#ifndef NAIVE_ATTN
#define NAIVE_ATTN 0
#endif
#ifndef NAIVE_SSM
#define NAIVE_SSM 0
#endif
#ifndef MK_PER_PHASE
#define MK_PER_PHASE 0
#endif

#define GAS __attribute__((address_space(1)))
#define LAS __attribute__((address_space(3)))
typedef unsigned short bf16_t;
typedef short bf16x8 __attribute__((ext_vector_type(8)));
typedef float f32x4 __attribute__((ext_vector_type(4)));
typedef float f32x2 __attribute__((ext_vector_type(2)));
typedef unsigned u32x4 __attribute__((ext_vector_type(4)));
typedef unsigned u32x2 __attribute__((ext_vector_type(2)));
typedef GAS unsigned gu32;
#define RLX_AGENT __ATOMIC_RELAXED, __HIP_MEMORY_SCOPE_AGENT
#define LDS_WAIT() asm volatile("s_waitcnt lgkmcnt(0)" ::: "memory")
#define VM_WAIT() asm volatile("s_waitcnt vmcnt(0)" ::: "memory")
__device__ __forceinline__ unsigned f2bf(float f) { unsigned u = __builtin_bit_cast(unsigned, f); return (u + 0x7fffu + ((u >> 16) & 1u)) >> 16; }
__device__ __forceinline__ unsigned pk2(float lo, float hi) { return f2bf(lo) | (f2bf(hi) << 16); }
__device__ __forceinline__ float bflo(unsigned w) { return __builtin_bit_cast(float, w << 16); }
__device__ __forceinline__ float bfhi(unsigned w) { return __builtin_bit_cast(float, w & 0xffff0000u); }
__device__ __forceinline__ float bf2f(bf16_t h) { return __builtin_bit_cast(float, (unsigned)h << 16); }
template <int M> __device__ __forceinline__ float xor_lane(float v) {
    if (M < 32) return __builtin_bit_cast(float, __builtin_amdgcn_ds_swizzle(__builtin_bit_cast(int, v), (M << 10) | 0x1f));
    const auto rr = __builtin_amdgcn_permlane32_swap(__builtin_bit_cast(unsigned, v), __builtin_bit_cast(unsigned, v), false, false);
    return __builtin_bit_cast(float, rr[0] ^ rr[1] ^ __builtin_bit_cast(unsigned, v));
}
__device__ __forceinline__ float wave_sum(float v) {
    v += xor_lane<1>(v); v += xor_lane<2>(v); v += xor_lane<4>(v); v += xor_lane<8>(v); v += xor_lane<16>(v); v += xor_lane<32>(v);
    return v;
}
__device__ __forceinline__ float wave_max(float v) {
    v = fmaxf(v, xor_lane<1>(v)); v = fmaxf(v, xor_lane<2>(v)); v = fmaxf(v, xor_lane<4>(v)); v = fmaxf(v, xor_lane<8>(v)); v = fmaxf(v, xor_lane<16>(v)); v = fmaxf(v, xor_lane<32>(v));
    return v;
}
__device__ __forceinline__ int tid_of(int wave_s) { int ln; asm volatile("v_mbcnt_lo_u32_b32 %0, -1, 0\n\tv_mbcnt_hi_u32_b32 %0, -1, %0" : "=v"(ln)); return (wave_s << 6) | ln; }
__device__ __forceinline__ float sigmoidf_(float x) { return __builtin_amdgcn_rcpf(1.f + __expf(-x)); }

constexpr int T = 8192, DM = 2048, NL = 4, MEML = 256, NPROJ = 10752, NEXP = 16, FFE = 512;
constexpr int NWAVES = 8;
constexpr float RMS_EPS = 1e-6f, HEAD_EPS = 1e-5f, LN_EPS = 1e-5f;
constexpr float C2Q = 0.125f * 1.4426950408889634f;
constexpr float GATE_WSCALE = 128.f;
#ifndef S_FP8
#define S_FP8 1
#endif
#ifndef FUSE_N2
#define FUSE_N2 1
#endif
constexpr float SQK_SCALE = S_FP8 ? 64.f : 1.f;
#ifndef XAO_FP8
#define XAO_FP8 1
#endif
constexpr float VW_SCALE = XAO_FP8 ? 64.f : 1.f;
constexpr float C2X = 0.08838834764831845f * 1.4426950408889634f;
constexpr size_t MiB = 1u << 20;
constexpr size_t WS_CTL = 0, CTL_ZERO_BYTES = 64 * 1024;
constexpr size_t LW_WIN = 0;
constexpr size_t LW_WG8 = LW_WIN + (size_t)3584 * DM * 2;
constexpr size_t LW_WCAT = LW_WG8 + (size_t)7680 * DM;
constexpr size_t LW_WGLU = LW_WCAT + (size_t)DM * DM * 2;
constexpr size_t LW_WMIX = LW_WGLU + (size_t)1024 * 512 * 2;
constexpr size_t LW_WQK = LW_WMIX + (size_t)DM * DM * 2;
constexpr size_t LW_VW = LW_WQK + (size_t)1024 * DM * 2;
constexpr size_t LW_WGU = LW_VW + (size_t)DM * 1024 * 2;
constexpr size_t LW_WD = LW_WGU + (size_t)NEXP * 1024 * DM;
constexpr size_t LW_BKE = LW_WD + (size_t)NEXP * DM * FFE;
constexpr size_t LW_F = LW_BKE + (size_t)32 * 512 * 640 * 2;
constexpr size_t LW_RT = LW_F + (size_t)32 * 128 * 512 * 2;
constexpr size_t LW_LAM = LW_RT + (size_t)20 * DM * 4;
constexpr size_t LW_SIZE = ((LW_LAM + (size_t)32 * 64 * 8 + 4095) / 4096) * 4096;
constexpr size_t WS_LW = 1 * MiB;
constexpr size_t WS_ACT = WS_LW + NL * LW_SIZE;
constexpr size_t WS_X = WS_ACT;
constexpr size_t WS_RSTD = WS_X + (size_t)T * DM * 2;
constexpr size_t WS_H = WS_X + (size_t)T * DM * 4;
constexpr size_t WS_Q = WS_H + (size_t)T * DM * 2;
constexpr size_t WS_K = WS_Q + (size_t)T * 1024 * 2;
constexpr size_t WS_V = WS_K + (size_t)T * 1024 * 2;
constexpr size_t WS_O1 = WS_V + (size_t)T * 1024 * 2;
constexpr size_t WS_O2 = WS_O1 + (size_t)T * 1024 * 2;
constexpr size_t WS_OAN = WS_O2 + (size_t)T * 1024 * 2;
constexpr size_t WS_Z = WS_OAN + (size_t)T * 1024 * 2;
constexpr size_t WS_UC = WS_Z + (size_t)T * 512 * 2;
constexpr size_t WS_GATES = WS_UC + (size_t)T * 512 * 2;
constexpr size_t WS_CVO = WS_GATES + (size_t)T * 6144 * 2;
constexpr size_t WS_SS = WS_CVO + (size_t)T * 512 * 2;
constexpr size_t WS_XP = WS_SS + (size_t)256 * 4096 * 4;
constexpr size_t WS_YS = WS_XP + (size_t)32 * 256 * 128 * 2;
constexpr size_t WS_GLUO = WS_YS + (size_t)T * 512 * 2;
constexpr size_t WS_MERGED = WS_GLUO + (size_t)T * 512 * 2;
constexpr size_t WS_P = WS_MERGED + (size_t)T * DM * 2;
constexpr size_t WS_RS = WS_P + (size_t)T * 1024 * 2;
constexpr size_t WS_HE = WS_RS + (size_t)T * 16 * 4;
constexpr size_t WS_Y = WS_HE + (size_t)(2 * T + 256) * 512 * 2;
constexpr size_t WS_LIST = WS_Y + (size_t)2 * T * DM * 2;
constexpr size_t WS_WL = WS_LIST + (size_t)NEXP * T * 4;
constexpr size_t WS_TOK = WS_WL + (size_t)NEXP * T * 4;
constexpr size_t WS_ROPE = WS_TOK + (size_t)T * 16;
constexpr size_t WS_H8 = WS_ROPE + (size_t)T * 64 * 4;
constexpr size_t WS_RSQ = WS_H8 + (size_t)T * DM;
constexpr size_t WS_END = WS_RSQ + (size_t)T * 32 * 4;
constexpr size_t WS_WQB = WS_GATES;
constexpr size_t WS_WKVT = WS_WQB + (size_t)NL * DM * 512 * 2;
constexpr size_t WS_WXOT = WS_WKVT + (size_t)NL * 1024 * DM * 2;
constexpr size_t WS_MNORM = WS_WXOT + (size_t)NL * DM * 512 * 2;
constexpr size_t WS_KVB = WS_MNORM + (size_t)NL * MEML * DM * 2;
static_assert(WS_KVB + (size_t)NL * MEML * 1024 * 2 <= WS_CVO, "prologue temporaries inside GATES");
static_assert(WS_END < (size_t)1350000000, "workspace plan");
constexpr int CW_TMO = 0, CW_CODE = 1;
constexpr int CW_BAR = 4096;
constexpr int CW_CNT = 8192;
constexpr int RING_OFF = 0, RING_BYTES = 131072;
constexpr int LDSCTL_OFF = RING_BYTES, MISC_OFF = LDSCTL_OFF + 320;
constexpr int LDS_BYTES = 147456;
#define XB_TMO      128
#define XB_XCNT(j)  (256  + 64 * (j))
#define XB_XSUB(j)  (1280 + 64 * (j))
#define XB_XGEN(j)  (2304 + 64 * (j))
#define XB_TOP      3328
#define XB_TOPGEN   3392
#define XCD_BAR_WORDS 3456
#define XB_SPIN_CAP (1u << 24)

__device__ __forceinline__ unsigned xb_ld(unsigned* p)              { return __hip_atomic_load(p, __ATOMIC_RELAXED, __HIP_MEMORY_SCOPE_AGENT); }
__device__ __forceinline__ unsigned xb_add(unsigned* p, unsigned v) { return __hip_atomic_fetch_add(p, v, __ATOMIC_RELAXED, __HIP_MEMORY_SCOPE_AGENT); }
__device__ __forceinline__ unsigned xb_xcc_id() { return (unsigned)__builtin_amdgcn_s_getreg((3 << 11) | 20) & 0xFu; }
#define XB_SPIN(cond, bar) do { unsigned _sp = 0; while (cond) { __builtin_amdgcn_s_sleep(1); \
    if ((++_sp & 255u) == 0u) { if (xb_ld(&(bar)[XB_TMO])) break; if (_sp > XB_SPIN_CAP) { atomicAdd(&(bar)[XB_TMO], 1u); break; } } } } while (0)

struct XcdBarrier {
    unsigned* bar; unsigned x;
    volatile LAS unsigned* st;
};

__device__ __forceinline__ XcdBarrier xcd_barrier_post(unsigned* bar, volatile LAS unsigned* st) {
    XcdBarrier b; b.bar = bar; b.x = xb_xcc_id(); b.st = st;
    if (threadIdx.x == 0) (void)xb_add(&bar[XB_XCNT(b.x)], 1u);
    return b;
}
__device__ __forceinline__ void xcd_barrier_complete(unsigned* bar, unsigned x, unsigned& nloc, unsigned& nx) {
    const unsigned G = gridDim.x * gridDim.y * gridDim.z;
    unsigned sum, cnt, mine, sp = 0u;
    for (;;) {
        sum = 0u; cnt = 0u; mine = 0u;
#pragma unroll
        for (unsigned j = 0; j < 16; ++j) { const unsigned c = xb_ld(&bar[XB_XCNT(j)]); sum += c; cnt += (c > 0u) ? 1u : 0u; mine = (j == x) ? c : mine; }
        if (sum == G) break;
        __builtin_amdgcn_s_sleep(1);
        if ((++sp & 255u) == 0u) { if (xb_ld(&bar[XB_TMO])) break; if (sp > XB_SPIN_CAP) { atomicAdd(&bar[XB_TMO], 1u); break; } }
    }
    nloc = mine > 0u ? mine : 1u; nx = cnt > 0u ? cnt : 1u;
}

__device__ __forceinline__ void xcd_barrier(const XcdBarrier& b) {
    asm volatile("s_waitcnt vmcnt(0)" ::: "memory");
    __syncthreads();
    if (threadIdx.x == 0) {
        unsigned* bar = b.bar;
        __builtin_amdgcn_s_waitcnt(0);
        unsigned nloc = b.st[0], nx = b.st[1];
        if (nloc == 0u) { xcd_barrier_complete(bar, b.x, nloc, nx); b.st[0] = nloc; b.st[1] = nx; }
        const unsigned old = xb_add(&bar[XB_XSUB(b.x)], 1u);
        const unsigned gen = old / nloc;
        if (old + 1u == (gen + 1u) * nloc) {
            __builtin_amdgcn_fence(__ATOMIC_RELEASE, "agent");
            asm volatile("s_waitcnt vmcnt(0)" ::: "memory");
            const unsigned og = xb_add(&bar[XB_TOP], 1u);
            const unsigned tg = og / nx;
            if (og + 1u == (tg + 1u) * nx) xb_add(&bar[XB_TOPGEN], 1u);
            else XB_SPIN(xb_ld(&bar[XB_TOPGEN]) == tg, bar);
            __builtin_amdgcn_fence(__ATOMIC_ACQUIRE, "agent");
            xb_add(&bar[XB_XGEN(b.x)], 1u);
            asm volatile("s_waitcnt vmcnt(0)" ::: "memory");
        } else {
            XB_SPIN(xb_ld(&bar[XB_XGEN(b.x)]) == gen, bar);
            __builtin_amdgcn_fence(__ATOMIC_ACQUIRE, "agent");
            asm volatile("s_waitcnt vmcnt(0)" ::: "memory");
        }
    }
    __syncthreads();
}
namespace pg8 {
constexpr int BM = 256, BK = 64, HALF = 128, HTB = HALF * BK * 2  , STAGE_BYTES = 8 * HTB;
__host__ __device__ __forceinline__ int lds_byte(int r, int c) { const int st = (r >> 4) * 2 + (c >> 5), rr = r & 15, cc = c & 31, ob = rr * 64 + cc * 2; return st * 1024 + (ob ^ (((ob >> 9) & 1) << 5)); }
__host__ __device__ __forceinline__ void stage_rc(int b, int& R, int& C) { const int st = b / 1024, sb = b % 1024, swz = sb ^ (((sb >> 9) & 1) << 5); R = (st >> 1) * 16 + swz / 64; C = (st & 1) * 32 + (swz % 64) / 2; }
__host__ __device__ __forceinline__ int perm32(int rho) { const int n = rho >> 4, i = rho & 15; return 8 * (i >> 2) + 4 * n + (i & 3); }

enum { GU_LAST = 1 };
struct GU {
    const char* A;
    const char* B;
    char* C;
    const char* P;
    int lda, ldb;
    int nt;
    int pm, pn;
    int seg;
    int flags;
    int rows;
    int aux;
    int f8;
};
typedef f32x4 Acc[2][2][4][2];
typedef int i32x4 __attribute__((ext_vector_type(4)));
typedef int i32x8 __attribute__((ext_vector_type(8)));

#if !NAIVE_GEMM
template <class Epi, class Sched, bool HAS_F8 = false>
__device__ __forceinline__ void gemm_phase(LAS unsigned char* lds, const Sched& S, const Epi& E, const int tid) {
    const int wid = __builtin_amdgcn_readfirstlane(tid >> 6), lane = tid & 63, wr = wid >> 2, wc = wid & 3, fr = lane & 15, fq = lane >> 4;
    const unsigned ldsw = (unsigned)wid * 1024u;
    const int aoff = lds_byte(wr * 64 + fr, fq * 8), boff = lds_byte(wc * 32 + fr, fq * 8);
#define PG8_SA(b, h) (((b) * 2 + (h)) * HTB)
#define PG8_SB(b, h) ((4 + (b) * 2 + (h)) * HTB)
#define PG8_STAGE(bufoff, gbase, voff) do { _Pragma("unroll") for (int _i = 0; _i < 2; ++_i) { unsigned o_ = (voff)[_i]; asm volatile("" : "+v"(o_));     \
        __builtin_amdgcn_global_load_lds((const unsigned*)((const char*)(gbase) + o_), (LAS unsigned*)(lds + (bufoff) + ldsw + _i * 8192), 16, 0, 0); } } while (0)
#define PG8_LDA(dst, b, h) do { _Pragma("unroll") for (int m = 0; m < 4; ++m) _Pragma("unroll") for (int k = 0; k < 2; ++k) dst[m][k] = *(const LAS bf16x8*)(lds + PG8_SA(b, h) + aoff + m * 2048 + k * 1024); } while (0)
#define PG8_LDB(dst, b, h) do { _Pragma("unroll") for (int n = 0; n < 2; ++n) _Pragma("unroll") for (int k = 0; k < 2; ++k) dst[n][k] = *(const LAS bf16x8*)(lds + PG8_SB(b, h) + boff + n * 2048 + k * 1024); } while (0)
#define PG8_MFMA8(c, a, b) do { const i32x8 a_ = (a), b_ = (b); asm volatile("s_nop 4\n\tv_mfma_scale_f32_16x16x128_f8f6f4 %0, %1, %2, %0, %3, %3 op_sel_hi:[0,0,0]" : "+v"(c) : "v"(a_), "v"(b_), "v"(f8scale)); } while (0)
#define PG8_MFMA_DRAIN() do { if (HAS_F8) asm volatile("s_nop 15\n\ts_nop 15\n\ts_nop 15" ::: "memory"); } while (0)
#define PG8_CAT8(x) __builtin_shufflevector(__builtin_bit_cast(i32x4, (x)[0]), __builtin_bit_cast(i32x4, (x)[1]), 0, 1, 2, 3, 4, 5, 6, 7)
#define PG8_MMA(ai, bj, At, Bt) do { __builtin_amdgcn_s_setprio(1); if (HAS_F8) { _Pragma("unroll") for (int m = 0; m < 4; ++m) _Pragma("unroll") for (int n = 0; n < 2; ++n) \
        PG8_MFMA8(acc[ai][bj][m][n], PG8_CAT8(Bt[n]), PG8_CAT8(At[m])); } \
    else { _Pragma("unroll") for (int m = 0; m < 4; ++m) _Pragma("unroll") for (int n = 0; n < 2; ++n) _Pragma("unroll") for (int k = 0; k < 2; ++k) \
        acc[ai][bj][m][n] = __builtin_amdgcn_mfma_f32_16x16x32_bf16(Bt[n][k], At[m][k], acc[ai][bj][m][n], 0, 0, 0); } __builtin_amdgcn_s_setprio(0); } while (0)
#define PG8_WAIT_V(n) asm volatile("s_waitcnt vmcnt(" #n ")" ::: "memory")
#define PG8_WAIT_L(n) asm volatile("s_waitcnt lgkmcnt(" #n ")" ::: "memory")
#define PG8_BAR __builtin_amdgcn_s_barrier()
#define PG8_SCHED __builtin_amdgcn_sched_barrier(0)
#define PG8_MKV(u, va, vb) do { _Pragma("unroll") for (int _i = 0; _i < 2; ++_i) { int R_, C_; stage_rc(tid * 16 + _i * 8192, R_, C_); const int Rb_ = (R_ & ~31) + perm32(R_ & 31);     \
        vb[_i] = (unsigned)(Rb_ * (u).ldb + C_ * 2); va[0][_i] = S.arow((u), R_) + (unsigned)(C_ * 2); if (Sched::GATHER) va[1][_i] = S.arow((u), 128 + R_) + (unsigned)(C_ * 2); } } while (0)
    GU cur, nxt; int ui = 0;
    if (!S.next(0, cur)) return;
    Acc acc;
#pragma unroll
    for (int a = 0; a < 2; ++a)
#pragma unroll
        for (int b = 0; b < 2; ++b)
#pragma unroll
            for (int m = 0; m < 4; ++m)
#pragma unroll
                for (int n = 0; n < 2; ++n) acc[a][b][m][n] = (f32x4){0.f, 0.f, 0.f, 0.f};
    bf16x8 At[4][2], B0[2][2], B1[2][2];
    int f8scale = 0x7f7f7f7f; asm volatile("" : "+v"(f8scale));
    constexpr int NH = Sched::GATHER ? 2 : 1;
    unsigned vA[NH][2], vB[2], nvA[NH][2], nvB[2];
    PG8_MKV(cur, vA, vB);
    const size_t kstep = (size_t)(BK * 2);
    {
        const char* cA = cur.A; const char* cB = cur.B; const size_t hsB = (size_t)HALF * cur.ldb;
        const char* cBh = cB + hsB; const char* cAk = cA + kstep; const char* cBk = cB + kstep; const char* cBhk = cB + hsB + kstep; const char* cAh = Sched::GATHER ? cA : cA + (size_t)HALF * cur.lda;
        asm volatile("" : "+s"(cA), "+s"(cB), "+s"(cBh), "+s"(cAk), "+s"(cBk), "+s"(cBhk), "+s"(cAh));
        PG8_STAGE(PG8_SB(0, 0), cB, vB); PG8_STAGE(PG8_SB(0, 1), cBh, vB); PG8_STAGE(PG8_SA(0, 0), cA, vA[0]); PG8_STAGE(PG8_SA(0, 1), cAh, vA[NH - 1]);
        if (wr == 1) PG8_BAR;
        PG8_WAIT_V(2); PG8_BAR;
        PG8_STAGE(PG8_SB(1, 0), cBk, vB); PG8_STAGE(PG8_SA(1, 0), cAk, vA[0]); PG8_STAGE(PG8_SB(1, 1), cBhk, vB);
        PG8_WAIT_V(6); PG8_BAR;
    }
    for (;;) {
        const bool has_next = S.next(ui + 1, nxt);
        if (has_next) { PG8_MKV(nxt, nvA, nvB); }
        else {
#pragma unroll
            for (int i = 0; i < 2; ++i) { nvB[i] = vB[i]; nvA[0][i] = vA[0][i]; nvA[NH - 1][i] = vA[NH - 1][i]; }
        }
        const char* cA = cur.A; const char* cB = cur.B; const size_t hsB = (size_t)HALF * cur.ldb;
        const char* nA = has_next ? nxt.A : cA; const char* nB = has_next ? nxt.B : cB; const size_t nhsB = has_next ? (size_t)HALF * nxt.ldb : hsB;
        const size_t hsA = Sched::GATHER ? 0 : (size_t)HALF * cur.lda, nhsA = Sched::GATHER ? 0 : (has_next ? (size_t)HALF * nxt.lda : hsA);
        const int nt = cur.nt;
        for (int t = 0; t < nt; t += 2) {
            const bool last = (t == nt - 2);
            const char* a1 = cA + (size_t)(t + 1) * kstep;
            const char* a2 = last ? nA : cA + (size_t)(t + 2) * kstep; const char* b2 = last ? nB : cB + (size_t)(t + 2) * kstep;
            const char* a3 = a2 + kstep; const char* b3 = b2 + kstep;
            const size_t xhsB = last ? nhsB : hsB, xhsA = last ? nhsA : hsA;
            const char* b2h = b2 + xhsB; const char* b3h = b3 + xhsB; const char* a1h = a1 + hsA; const char* a2h = a2 + xhsA;
            asm volatile("" : "+s"(a1h), "+s"(a2), "+s"(a3), "+s"(b2), "+s"(b3), "+s"(b2h), "+s"(b3h), "+s"(a2h));
            unsigned xA[NH][2], xB[2];
#pragma unroll
            for (int i = 0; i < 2; ++i) { xB[i] = last ? nvB[i] : vB[i]; xA[0][i] = last ? nvA[0][i] : vA[0][i]; xA[NH - 1][i] = last ? nvA[NH - 1][i] : vA[NH - 1][i]; }
            PG8_LDB(B0, 0, 0); PG8_LDB(B1, 0, 1); PG8_SCHED; PG8_LDA(At, 0, 0); PG8_STAGE(PG8_SA(1, 1), a1h, vA[NH - 1]);
            PG8_WAIT_V(8); PG8_WAIT_L(0); PG8_BAR; PG8_MMA(0, 0, At, B0); PG8_MMA(0, 1, At, B1); PG8_BAR; PG8_SCHED;
            PG8_LDA(At, 0, 1); PG8_STAGE(PG8_SB(0, 0), b2, xB); PG8_STAGE(PG8_SB(0, 1), b2h, xB); PG8_STAGE(PG8_SA(0, 0), a2, xA[0]);
            PG8_WAIT_V(8); PG8_WAIT_L(0); PG8_BAR; PG8_MMA(1, 0, At, B0); PG8_MMA(1, 1, At, B1); PG8_BAR; PG8_SCHED;
            PG8_LDB(B0, 1, 0); PG8_LDB(B1, 1, 1); PG8_SCHED; PG8_LDA(At, 1, 0); PG8_STAGE(PG8_SA(0, 1), a2h, xA[NH - 1]);
            PG8_WAIT_V(8); PG8_WAIT_L(0); PG8_BAR; PG8_MMA(0, 0, At, B0); PG8_MMA(0, 1, At, B1); PG8_BAR; PG8_SCHED;
            PG8_LDA(At, 1, 1); PG8_STAGE(PG8_SB(1, 0), b3, xB); PG8_STAGE(PG8_SB(1, 1), b3h, xB); PG8_STAGE(PG8_SA(1, 0), a3, xA[0]);
            PG8_WAIT_V(8); PG8_WAIT_L(0); PG8_BAR; PG8_MMA(1, 0, At, B0); PG8_MMA(1, 1, At, B1); PG8_BAR; PG8_SCHED;
        }
        if (wr == 0) PG8_BAR;
        PG8_MFMA_DRAIN();
        { int fr_e = fr, fq_e = fq; asm volatile("" : "+v"(fr_e), "+v"(fq_e));
          E(acc, cur, wr, wc, fr_e, fq_e); }
        if (!has_next) break;
        if (cur.flags & GU_LAST) {
#pragma unroll
            for (int a = 0; a < 2; ++a)
#pragma unroll
                for (int b = 0; b < 2; ++b)
#pragma unroll
                    for (int m = 0; m < 4; ++m)
#pragma unroll
                        for (int n = 0; n < 2; ++n) acc[a][b][m][n] = (f32x4){0.f, 0.f, 0.f, 0.f};
        }
        cur = nxt; ++ui;
#pragma unroll
        for (int i = 0; i < 2; ++i) { vB[i] = nvB[i]; vA[0][i] = nvA[0][i]; vA[NH - 1][i] = nvA[NH - 1][i]; }
        if (wr == 1) PG8_BAR;
    }
    PG8_WAIT_V(0);
    PG8_BAR;
#undef PG8_SA
#undef PG8_SB
#undef PG8_STAGE
#undef PG8_LDA
#undef PG8_LDB
#undef PG8_MMA
#undef PG8_WAIT_V
#undef PG8_WAIT_L
#undef PG8_BAR
#undef PG8_SCHED
#undef PG8_MKV
#undef PG8_CAT8
}
#else
template <class Epi, class Sched>
__device__ __forceinline__ void gemm_phase(LAS unsigned char* lds, const Sched& S, const Epi& E, const int tid) {
    const int wid = __builtin_amdgcn_readfirstlane(tid >> 6), lane = tid & 63, wr = wid >> 2, wc = wid & 3, fr = lane & 15, fq = lane >> 4;
    GU cur; Acc acc;
#pragma unroll
    for (int a = 0; a < 2; ++a)
#pragma unroll
        for (int b = 0; b < 2; ++b)
#pragma unroll
            for (int m = 0; m < 4; ++m)
#pragma unroll
                for (int n = 0; n < 2; ++n) acc[a][b][m][n] = (f32x4){0.f, 0.f, 0.f, 0.f};
    for (int ui = 0; S.next(ui, cur); ++ui) {
        const int K = cur.nt * 64;
#pragma unroll 1
        for (int ai = 0; ai < 2; ++ai)
#pragma unroll 1
            for (int m = 0; m < 4; ++m) {
                const char* ap = cur.A + S.arow(cur, ai * 128 + wr * 64 + m * 16 + fr);
#pragma unroll 1
                for (int bj = 0; bj < 2; ++bj) {
                    float s[8];
#pragma unroll
                    for (int j = 0; j < 8; ++j) s[j] = 0.f;
                    const char* bp = cur.B + (size_t)(bj * 128 + wc * 32 + 8 * fq) * cur.ldb;
#pragma unroll 1
                    for (int k = 0; k < K; k += 8) {
                        const u32x4 av = *(const u32x4*)(ap + k * 2);
                        const float a0 = bflo(av.x), a1 = bfhi(av.x), a2 = bflo(av.y), a3 = bfhi(av.y), a4 = bflo(av.z), a5 = bfhi(av.z), a6 = bflo(av.w), a7 = bfhi(av.w);
#pragma unroll
                        for (int j = 0; j < 8; ++j) { const u32x4 bv = *(const u32x4*)(bp + (size_t)j * cur.ldb + k * 2);
                            s[j] += a0 * bflo(bv.x) + a1 * bfhi(bv.x) + a2 * bflo(bv.y) + a3 * bfhi(bv.y) + a4 * bflo(bv.z) + a5 * bfhi(bv.z) + a6 * bflo(bv.w) + a7 * bfhi(bv.w); }
                    }
#pragma unroll
                    for (int a_ = 0; a_ < 2; ++a_)
#pragma unroll
                        for (int m_ = 0; m_ < 4; ++m_)
#pragma unroll
                            for (int b_ = 0; b_ < 2; ++b_) if (a_ == ai && m_ == m && b_ == bj) {
                                acc[a_][b_][m_][0] += (f32x4){s[0], s[1], s[2], s[3]}; acc[a_][b_][m_][1] += (f32x4){s[4], s[5], s[6], s[7]}; }
                }
            }
        E(acc, cur, wr, wc, fr, fq);
        if (cur.flags & GU_LAST) {
#pragma unroll
            for (int a = 0; a < 2; ++a)
#pragma unroll
                for (int b = 0; b < 2; ++b)
#pragma unroll
                    for (int m = 0; m < 4; ++m)
#pragma unroll
                        for (int n = 0; n < 2; ++n) acc[a][b][m][n] = (f32x4){0.f, 0.f, 0.f, 0.f};
        }
    }
    __syncthreads();
}
#endif
}
namespace pg8 {
__device__ __forceinline__ unsigned cvt_pk_bf16(float lo, float hi) { unsigned r; asm volatile("v_cvt_pk_bf16_f32 %0, %1, %2" : "=v"(r) : "v"(lo), "v"(hi)); return r; }
__device__ __forceinline__ void st8(char* p, const f32x4 v0, const f32x4 v1) { u32x4 w; w.x = cvt_pk_bf16(v0[0], v0[1]); w.y = cvt_pk_bf16(v0[2], v0[3]); w.z = cvt_pk_bf16(v1[0], v1[1]); w.w = cvt_pk_bf16(v1[2], v1[3]); *(u32x4*)p = w; }
__device__ __forceinline__ void ld8(const char* p, f32x4& v0, f32x4& v1) { const u32x4 w = *(const u32x4*)p; v0 = (f32x4){bflo(w.x), bfhi(w.x), bflo(w.y), bfhi(w.y)}; v1 = (f32x4){bflo(w.z), bfhi(w.z), bflo(w.w), bfhi(w.w)}; }
__device__ __forceinline__ void tile_of(int L, int nM, int nN, int& pm, int& pn) {
    const int nwg = nM * nN; int wgid = L; { const int q = nwg / 8, r = nwg % 8, xcd = wgid % 8, off = wgid / 8; wgid = (xcd < r ? xcd * (q + 1) : r * (q + 1) + (xcd - r) * q) + off; }
    const int nig = 8 * nN, gid = wgid / nig, fm = gid * 8, gsz = (nM - fm) < 8 ? (nM - fm) : 8;
    pm = fm + ((wgid % nig) % gsz); pn = (wgid % nig) / gsz;
}
#define EPI_ROWS(...) _Pragma("unroll") for (int ai = 0; ai < 2; ++ai) _Pragma("unroll") for (int m = 0; m < 4; ++m) { const int lrow = ai * 128 + wr * 64 + m * 16 + fr; __VA_ARGS__ }
#define EPI_COLS(...) _Pragma("unroll") for (int bj = 0; bj < 2; ++bj) { const int lcol = bj * 128 + wc * 32 + 8 * fq; f32x4& v0 = acc[ai][bj][m][0]; f32x4& v1 = acc[ai][bj][m][1]; __VA_ARGS__ }

struct SchedDense {
    const char* A; const char* B; int lda, ldb, nt, nM, nN, G, c;
    static constexpr bool GATHER = false;
    __device__ __forceinline__ bool next(int i, GU& u) const {
        const int L = i * G + c; if (L >= nM * nN) return false;
        int pm, pn; tile_of(L, nM, nN, pm, pn);
        u.A = A + (size_t)pm * 256 * lda; u.B = B + (size_t)pn * 256 * ldb; u.C = nullptr; u.P = nullptr; u.lda = lda; u.ldb = ldb; u.nt = nt; u.pm = pm; u.pn = pn; u.seg = 0; u.flags = GU_LAST; u.rows = 256; u.aux = 0; u.f8 = 0;
        return true;
    }
    __device__ __forceinline__ unsigned arow(const GU& u, int r) const { return (unsigned)(r * u.lda); }
};
template <bool HALF> struct SchedProj {
    unsigned char* ws; unsigned char* lw; int G, c;
    static constexpr bool GATHER = false;
    __device__ __forceinline__ bool next(int i, GU& u) const {
        int id = -1;
        if (G == 256) {
            if (!HALF) { if (i == 0) id = c; else if (i == 1 && c < 192) id = c + 256; }
            else { if (c < 192) { if (i < 3) id = c * 3 + i; } else { if (i < 5) id = 576 + (c - 192) * 5 + i; } } }
        else { const int L = i * G + c; if (L < (HALF ? 896 : 448)) id = L; }
        if (id < 0) return false;
        int pm, pn;
        if (!HALF) { int t14; tile_of(id, 32, 14, pm, t14); u.A = (const char*)ws + WS_X + (size_t)pm * 256 * 4096; u.lda = 4096; u.B = (const char*)lw + LW_WIN + (size_t)t14 * 256 * 4096; u.ldb = 4096; u.nt = 32; u.f8 = 0;
            pn = t14 < 12 ? t14 : 16 + (t14 - 12); }
        else { int t28; tile_of(id, 32, 28, pm, t28); u.A = (const char*)ws + WS_H8 + (size_t)pm * 256 * 2048; u.lda = 2048; u.B = (const char*)lw + LW_WG8 + (size_t)t28 * 256 * 2048; u.ldb = 2048; u.nt = 16; u.f8 = 1;
            pn = t28 < 24 ? 18 + t28 : 12 + (t28 - 24); }
        u.C = nullptr; u.P = nullptr; u.pm = pm; u.pn = pn; u.seg = 0; u.flags = GU_LAST; u.rows = 256; u.aux = 0;
        return true;
    }
    __device__ __forceinline__ unsigned arow(const GU& u, int r) const { return (unsigned)(r * u.lda); }
};
template <int MODE> struct SchedSeg {
    unsigned char* ws; unsigned char* lw; int G, c;
    static constexpr bool GATHER = false; static constexpr int NS = MODE == 0 ? 3 : 4;
    __device__ __forceinline__ bool next(int i, GU& u) const {
        const int ti = i / NS, sg = i % NS; const int L = ti * G + c; if (L >= 256) return false;
        int pm, pn; tile_of(L, 32, 8, pm, pn);
        if (MODE == 0) { const size_t ao = sg == 0 ? WS_OAN : sg == 1 ? WS_CVO : WS_GLUO; const int la = sg == 0 ? 2048 : 1024; const size_t bo = sg == 0 ? 0 : sg == 1 ? 2048 : 3072;
            u.A = (const char*)ws + ao + (size_t)pm * 256 * la; u.lda = la; u.nt = sg == 0 ? 16 : 8; u.B = (const char*)lw + LW_WCAT + bo + (size_t)pn * 256 * 4096; u.ldb = 4096; }
        else if (XAO_FP8) { int two = 2; asm volatile("" : "+s"(two)); u.A = (const char*)ws + WS_P + sg * 256 + (size_t)pm * 256 * 1024; u.lda = 1024; u.nt = two; u.B = (const char*)lw + LW_VW + sg * 256 + (size_t)pn * 256 * 1024; u.ldb = 1024; }
        else { u.A = (const char*)ws + WS_P + sg * 512 + (size_t)pm * 256 * 2048; u.lda = 2048; u.nt = 4; u.B = (const char*)lw + LW_VW + sg * 512 + (size_t)pn * 256 * 2048; u.ldb = 2048; }
        u.C = nullptr; u.P = nullptr; u.pm = pm; u.pn = pn; u.seg = sg; u.flags = (sg == NS - 1) ? GU_LAST : 0; u.rows = 256; u.aux = 0; u.f8 = 0;
        return true;
    }
    __device__ __forceinline__ unsigned arow(const GU& u, int r) const { return (unsigned)(r * u.lda); }
};
struct EpiStore { int ldc; int ncolh;
    __device__ __forceinline__ void operator()(Acc& acc, const GU& u, int wr, int wc, int fr, int fq) const {
        const float sc = __builtin_bit_cast(float, u.aux);
        EPI_ROWS( if (lrow < u.rows) { char* rp = u.C + (unsigned)(lrow * ldc); EPI_COLS( if (bj < ncolh) st8(rp + lcol * 2, v0 * sc, v1 * sc); ) } )
    }
};
struct EpiStoreF32 { int ldc;
    __device__ __forceinline__ void operator()(Acc& acc, const GU& u, int wr, int wc, int fr, int fq) const {
        EPI_ROWS( { char* rp = u.C + (unsigned)(lrow * ldc); const int lcol = wc * 32 + 8 * fq; *(f32x4*)(rp + lcol * 4) = acc[ai][0][m][0]; *(f32x4*)(rp + lcol * 4 + 16) = acc[ai][0][m][1]; } )
    }
};
struct EpiProj { char* ws; const float* ropeC; const float* ropeS; const float* rstd;
    __device__ __forceinline__ void operator()(Acc& acc, const GU& u, int wr, int wc, int fr, int fq) const {
        const int pn = u.pn;
        if (pn < 8) {
            char* dst = ws + (pn < 4 ? WS_Q : WS_K) + (size_t)(pn & 3) * 512; const float sc0 = pn < 4 ? C2Q : 1.f;
            EPI_ROWS( { const int tok = u.pm * 256 + lrow; char* rp = dst + (unsigned)(tok * 2048); const float sc = sc0 * rstd[tok];
                EPI_COLS( { const int i0 = (lcol & 63) >> 1; const f32x4 c4 = *(const f32x4*)(ropeC + tok * 32 + i0), s4 = *(const f32x4*)(ropeS + tok * 32 + i0);
                    const f32x4 o0 = (f32x4){v0[0] * c4[0] - v0[1] * s4[0], v0[1] * c4[0] + v0[0] * s4[0], v0[2] * c4[1] - v0[3] * s4[1], v0[3] * c4[1] + v0[2] * s4[1]};
                    const f32x4 o1 = (f32x4){v1[0] * c4[2] - v1[1] * s4[2], v1[1] * c4[2] + v1[0] * s4[2], v1[2] * c4[3] - v1[3] * s4[3], v1[3] * c4[3] + v1[2] * s4[3]};
                    st8(rp + lcol * 2, o0 * sc, o1 * sc); } ) } )
        } else if (pn < 12) {
            char* dst = ws + WS_V + (size_t)(pn - 8) * 512;
            EPI_ROWS( { const int tok = u.pm * 256 + lrow; char* rp = dst + (unsigned)(tok * 2048); const float rs = rstd[tok]; EPI_COLS( st8(rp + lcol * 2, v0 * rs, v1 * rs); ) } )
        } else if (pn < 16) {
            char* dst = ws + WS_Z + (size_t)(pn - 12) * 256;
            EPI_ROWS( { const int tok = u.pm * 256 + lrow; char* rp = dst + (unsigned)(tok * 1024); const float is = rstd[tok] * (1.f / GATE_WSCALE);
                EPI_COLS( { u32x2 w; w.x = cvt_pk_bf16(v0[0] * is * sigmoidf_(v0[1] * is), v0[2] * is * sigmoidf_(v0[3] * is)); w.y = cvt_pk_bf16(v1[0] * is * sigmoidf_(v1[1] * is), v1[2] * is * sigmoidf_(v1[3] * is)); *(u32x2*)(rp + lcol) = w; } ) } )
        } else if (pn < 18) {
            EPI_ROWS( { const int tok = u.pm * 256 + lrow; const float rs = rstd[tok];
                EPI_COLS( { const int ch = (pn - 16) * 256 + lcol, g = ch >> 4, h = ch & 15; st8((ws + WS_UC) + (unsigned)(((g * 256 + (tok >> 5)) * 512 + (tok & 31) * 16 + h) * 2), v0 * rs, v1 * rs); } ) } )
        } else {
            char* dst = ws + WS_GATES + (size_t)(pn - 18) * 256;
            EPI_ROWS( { const int tok = u.pm * 256 + lrow; char* rp = dst + (unsigned)(tok * 6144); const float is = rstd[tok] * (1.f / GATE_WSCALE);
                EPI_COLS( { unsigned qa[4], qb[4];
                    _Pragma("unroll") for (int j = 0; j < 4; ++j) { qa[j] = (unsigned)fminf(sigmoidf_(v0[j] * is) * 256.f, 255.f); qb[j] = (unsigned)fminf(sigmoidf_(v1[j] * is) * 256.f, 255.f); }
                    u32x2 w; w.x = qa[0] | (qa[1] << 8) | (qa[2] << 16) | (qa[3] << 24); w.y = qb[0] | (qb[1] << 8) | (qb[2] << 16) | (qb[3] << 24);
                    *(u32x2*)(rp + lcol) = w; } ) } )
        }
    }
};
struct EpiSsm3 { char* ys;
    __device__ __forceinline__ void operator()(Acc& acc, const GU& u, int wr, int wc, int fr, int fq) const {
        if (!(u.flags & GU_LAST)) return;
        const int g = u.pm;
        EPI_ROWS( { const int chunk = lrow;
            EPI_COLS( { const int jh = u.pn * 256 + lcol, j = jh >> 4, h = jh & 15; st8(ys + (unsigned)(((chunk * 32 + j) * 512 + g * 16 + h) * 2), v0, v1); } ) } )
    }
};
struct EpiGlu { char* dst; const float* bias;
    __device__ __forceinline__ void operator()(Acc& acc, const GU& u, int wr, int wc, int fr, int fq) const {
        EPI_ROWS( { const int tok = u.pm * 256 + lrow; char* rp = (dst + (size_t)u.pn * 256) + (unsigned)(tok * 1024);
            EPI_COLS( { const int j0 = u.pn * 128 + (lcol >> 1); const f32x4 ba = *(const f32x4*)(bias + j0), bb = *(const f32x4*)(bias + 512 + j0);
                u32x2 w; w.x = cvt_pk_bf16((v0[0] + ba[0]) * sigmoidf_(v0[1] + bb[0]), (v0[2] + ba[1]) * sigmoidf_(v0[3] + bb[1]));
                w.y = cvt_pk_bf16((v1[0] + ba[2]) * sigmoidf_(v1[1] + bb[2]), (v1[2] + ba[3]) * sigmoidf_(v1[3] + bb[3])); *(u32x2*)(rp + lcol) = w; } ) } )
    }
};
struct EpiGated { const char* gates; char* merged;
    __device__ __forceinline__ void operator()(Acc& acc, const GU& u, int wr, int wc, int fr, int fq) const {
        const int sg = u.seg;
        EPI_ROWS( { const int tok = u.pm * 256 + lrow; const char* gp = (gates + (size_t)u.pn * 256) + (unsigned)(tok * 6144); char* mp = (merged + (size_t)u.pn * 512) + (unsigned)(tok * 4096);
            EPI_COLS( { const u32x2 nq = *(const u32x2*)(gp + (size_t)sg * 2048 + lcol);
                if (sg < 2) { const u32x2 dq = *(const u32x2*)(gp + (size_t)(sg + 1) * 2048 + lcol);
                    _Pragma("unroll") for (int j = 0; j < 4; ++j) { v0[j] *= ((float)((nq.x >> (8 * j)) & 255u) + 0.5f) * __builtin_amdgcn_rcpf((float)((dq.x >> (8 * j)) & 255u) + 0.5f); v1[j] *= ((float)((nq.y >> (8 * j)) & 255u) + 0.5f) * __builtin_amdgcn_rcpf((float)((dq.y >> (8 * j)) & 255u) + 0.5f); } }
                else { _Pragma("unroll") for (int j = 0; j < 4; ++j) { v0[j] *= fmaf((float)((nq.x >> (8 * j)) & 255u), 1.f / 256.f, 0.5f / 256.f); v1[j] *= fmaf((float)((nq.y >> (8 * j)) & 255u), 1.f / 256.f, 0.5f / 256.f); }
                    st8(mp + lcol * 2, v0, v1); } } ) } )
    }
};
struct EpiResid { char* x; char* h8; float* rsq;
    __device__ __forceinline__ void operator()(Acc& acc, const GU& u, int wr, int wc, int fr, int fq) const {
        EPI_ROWS( { const int tok = u.pm * 256 + lrow; char* rp = (x + (size_t)u.pn * 512) + (unsigned)(tok * 4096); char* hp = (h8 + (size_t)u.pn * (S_FP8 ? 256 : 512)) + (unsigned)(tok * (S_FP8 ? 2048 : 4096)); float s = 0.f;
            EPI_COLS( { f32x4 a, b; ld8(rp + lcol * 2, a, b); a = a + v0; b = b + v1; st8(rp + lcol * 2, a, b);
                s += (a[0] * a[0] + a[1] * a[1]) + (a[2] * a[2] + a[3] * a[3]) + (b[0] * b[0] + b[1] * b[1]) + (b[2] * b[2] + b[3] * b[3]);
#if S_FP8
                int q0 = __builtin_amdgcn_cvt_pk_fp8_f32(a[0], a[1], 0, false); q0 = __builtin_amdgcn_cvt_pk_fp8_f32(a[2], a[3], q0, true);
                int q1 = __builtin_amdgcn_cvt_pk_fp8_f32(b[0], b[1], 0, false); q1 = __builtin_amdgcn_cvt_pk_fp8_f32(b[2], b[3], q1, true); *(u32x2*)(hp + lcol) = (u32x2){(unsigned)q0, (unsigned)q1};
#elif !defined(DBG_NO_HST)
                st8(hp + lcol * 2, a, b);
#endif
                } )
#ifndef DBG_NO_RSQ
            s += xor_lane<16>(s); s += xor_lane<32>(s);
            if (fq == 0) rsq[(u.pn * T + tok) * 4 + wc] = s;
#endif
            } )
    }
};
struct EpiSexp { char* P; float* rs; const float* rsq;
    __device__ __forceinline__ void operator()(Acc& acc, const GU& u, int wr, int wc, int fr, int fq) const {
        EPI_ROWS( { const int tok = u.pm * 256 + lrow; char* rp = (P + (size_t)u.pn * 512) + (unsigned)(tok * 2048); char* rp8 = (P + (size_t)u.pn * 256) + (unsigned)(tok * 1024); (void)rp; (void)rp8; float s = 0.f;
            float sq = 0.f;
#ifdef DBG_READ_RS
            _Pragma("unroll") for (int q = 0; q < 8; ++q) { const f32x4 t4 = *(const f32x4*)(rs + 262144 + tok * 32 + q * 4); sq += (t4[0] + t4[1]) + (t4[2] + t4[3]); }
#elif defined(DBG_RSQ_ATOMIC_LD)
            _Pragma("unroll") for (int q = 0; q < 32; ++q) sq += __hip_atomic_load(rsq + tok * 32 + q, __ATOMIC_RELAXED, __HIP_MEMORY_SCOPE_AGENT);
#else
            _Pragma("unroll") for (int q = 0; q < 8; ++q) { const f32x4 t4 = *(const f32x4*)(rsq + (q * T + tok) * 4); sq += (t4[0] + t4[1]) + (t4[2] + t4[3]); }
#endif
#ifdef DBG_RN1
            const float rn = 1.f;
#elif defined(DBG_RN1_KEEP)
            asm volatile("" :: "v"(sq)); const float rn = 1.f;
#else
            const float rn = FUSE_N2 ? rsqrtf(sq * (1.f / DM) + RMS_EPS) * (1.f / SQK_SCALE) : 1.f + 0.f * sq;
#endif
#if XAO_FP8
            EPI_COLS( { v0 = v0 * rn - 2.f; v1 = v1 * rn - 2.f;
                const float e0 = __builtin_amdgcn_exp2f(v0[0]), e1 = __builtin_amdgcn_exp2f(v0[1]), e2 = __builtin_amdgcn_exp2f(v0[2]), e3 = __builtin_amdgcn_exp2f(v0[3]);
                const float e4 = __builtin_amdgcn_exp2f(v1[0]), e5 = __builtin_amdgcn_exp2f(v1[1]), e6 = __builtin_amdgcn_exp2f(v1[2]), e7 = __builtin_amdgcn_exp2f(v1[3]);
                int q0 = __builtin_amdgcn_cvt_pk_fp8_f32(e0, e1, 0, false); q0 = __builtin_amdgcn_cvt_pk_fp8_f32(e2, e3, q0, true);
                int q1 = __builtin_amdgcn_cvt_pk_fp8_f32(e4, e5, 0, false); q1 = __builtin_amdgcn_cvt_pk_fp8_f32(e6, e7, q1, true);
                *(u32x2*)(rp8 + lcol) = (u32x2){(unsigned)q0, (unsigned)q1};
                const f32x2 a0 = __builtin_amdgcn_cvt_pk_f32_fp8(q0, false), a1 = __builtin_amdgcn_cvt_pk_f32_fp8(q0, true), a2 = __builtin_amdgcn_cvt_pk_f32_fp8(q1, false), a3 = __builtin_amdgcn_cvt_pk_f32_fp8(q1, true);
                s += ((a0[0] + a0[1]) + (a1[0] + a1[1])) + ((a2[0] + a2[1]) + (a3[0] + a3[1])); } )
#else
            EPI_COLS( { v0 = v0 * rn; v1 = v1 * rn; u32x4 w; w.x = cvt_pk_bf16(__builtin_amdgcn_exp2f(v0[0]), __builtin_amdgcn_exp2f(v0[1])); w.y = cvt_pk_bf16(__builtin_amdgcn_exp2f(v0[2]), __builtin_amdgcn_exp2f(v0[3]));
                w.z = cvt_pk_bf16(__builtin_amdgcn_exp2f(v1[0]), __builtin_amdgcn_exp2f(v1[1])); w.w = cvt_pk_bf16(__builtin_amdgcn_exp2f(v1[2]), __builtin_amdgcn_exp2f(v1[3]));
                *(u32x4*)(rp + lcol * 2) = w; s += ((bflo(w.x) + bfhi(w.x)) + (bflo(w.y) + bfhi(w.y))) + ((bflo(w.z) + bfhi(w.z)) + (bflo(w.w) + bfhi(w.w))); } )
#endif
            s += xor_lane<16>(s); s += xor_lane<32>(s);
            if (fq == 0) rs[(u.pn * T + tok) * 4 + wc] = s; } )
    }
};
#ifdef DBG_NO_XA
#define XA_DBG_COND && false
#else
#define XA_DBG_COND
#endif
struct EpiXao { const float* rs; char* x;
    __device__ __forceinline__ void operator()(Acc& acc, const GU& u, int wr, int wc, int fr, int fq) const {
        const int sg = u.seg;
        EPI_ROWS( { const int tok = u.pm * 256 + lrow; const f32x4 a = *(const f32x4*)(rs + (sg * T + tok) * 4); const float lh = (a[0] + a[1]) + (a[2] + a[3]);
            float f = __builtin_amdgcn_rcpf(lh) * (sg == 3 ? 1.f / VW_SCALE : 1.f);
            if (sg < 3) { const f32x4 b = *(const f32x4*)(rs + ((sg + 1) * T + tok) * 4); f *= (b[0] + b[1]) + (b[2] + b[3]); }
            char* rp = (x + (size_t)u.pn * 512) + (unsigned)(tok * 4096);
            EPI_COLS( { v0 = v0 * f; v1 = v1 * f; if (sg == 3 XA_DBG_COND) { f32x4 a, b; ld8(rp + lcol * 2, a, b); st8(rp + lcol * 2, a + v0, b + v1); } } ) } )
    }
};
template <bool DOWN> struct SchedMoE {
    const volatile LAS int* cnt;
    unsigned char* ws; unsigned char* lw; int G, c;
    static constexpr bool GATHER = !DOWN;
    static constexpr int nN = DOWN ? 8 : 4;
    __device__ __forceinline__ bool next(int i, GU& u) const {
        const int L = i * G + c; const int tile = L / nN, pn = L % nN;
        int e = -1, mt = 0, off = 0, tacc = 0, ce = 0;
#pragma unroll 1
        for (int k = 0; k < NEXP; ++k) { const int ck = __builtin_amdgcn_readfirstlane(cnt[k]); const int tk = (ck + 255) >> 8;
            if (e < 0 && tile < tacc + tk) { e = k; mt = tile - tacc; ce = ck; }
            if (e < 0) { off += ck; tacc += tk; } }
        if (e < 0) return false;
        u.pm = mt; u.pn = pn; u.seg = 0; u.flags = GU_LAST; u.aux = e; u.f8 = 1;
        u.rows = (ce - mt * 256) < 256 ? (ce - mt * 256) : 256;
        int ntd = 4, ntg = 16; asm volatile("" : "+s"(ntd), "+s"(ntg));
        if (DOWN) { u.nt = ntd; u.lda = 512; u.ldb = 512; u.B = (const char*)lw + LW_WD + (size_t)e * DM * FFE + (size_t)pn * 256 * 512;
            u.A = (const char*)ws + WS_HE + (size_t)(off + mt * 256) * 512; u.C = (char*)ws + WS_Y + (size_t)(off + mt * 256) * 2048; u.P = nullptr; }
        else { u.nt = ntg; u.lda = 2048; u.ldb = 2048; u.B = (const char*)lw + LW_WGU + (size_t)e * 1024 * DM + (size_t)pn * 256 * 2048;
            u.A = (const char*)ws + WS_H8; u.C = (char*)ws + WS_HE + (size_t)(off + mt * 256) * 512; u.P = (const char*)ws + WS_WL + ((size_t)e * T + mt * 256) * 4; }
        return true;
    }
    __device__ __forceinline__ unsigned arow(const GU& u, int r) const {
        if (DOWN) return (unsigned)(r * u.lda);
        const int tok = (r < u.rows) ? ((const int*)(ws + WS_LIST))[u.aux * T + u.pm * 256 + r] : 0;
        return (unsigned)tok * (unsigned)u.lda;
    }
};
struct EpiGu {
    __device__ __forceinline__ void operator()(Acc& acc, const GU& u, int wr, int wc, int fr, int fq) const {
        constexpr float is = 1.f / GATE_WSCALE;
        EPI_ROWS( if (lrow < u.rows) { const float w = *(const float*)(u.P + lrow * 4) * is; char* rp = (u.C + (size_t)u.pn * 128) + (unsigned)(lrow * 512);
            EPI_COLS( { const float g0 = v0[0] * is, g1 = v0[2] * is, g2 = v1[0] * is, g3 = v1[2] * is;
                int p8 = __builtin_amdgcn_cvt_pk_fp8_f32(g0 * sigmoidf_(g0) * v0[1] * w, g1 * sigmoidf_(g1) * v0[3] * w, 0, false);
                p8 = __builtin_amdgcn_cvt_pk_fp8_f32(g2 * sigmoidf_(g2) * v1[1] * w, g3 * sigmoidf_(g3) * v1[3] * w, p8, true); *(unsigned*)(rp + (lcol >> 1)) = (unsigned)p8; } ) } )
    }
};
struct EpiDown {
    __device__ __forceinline__ void operator()(Acc& acc, const GU& u, int wr, int wc, int fr, int fq) const {
        constexpr float ys = 16.f / GATE_WSCALE;
        EPI_ROWS( if (lrow < u.rows) { char* rp = (u.C + (size_t)u.pn * 256) + (unsigned)(lrow * 2048);
            EPI_COLS( { int q0 = __builtin_amdgcn_cvt_pk_fp8_f32(v0[0] * ys, v0[1] * ys, 0, false); q0 = __builtin_amdgcn_cvt_pk_fp8_f32(v0[2] * ys, v0[3] * ys, q0, true);
                int q1 = __builtin_amdgcn_cvt_pk_fp8_f32(v1[0] * ys, v1[1] * ys, 0, false); q1 = __builtin_amdgcn_cvt_pk_fp8_f32(v1[2] * ys, v1[3] * ys, q1, true); *(u32x2*)(rp + lcol) = (u32x2){(unsigned)q0, (unsigned)q1}; } ) } )
    }
};
}
#include <hip/hip_bf16.h>
#include <cmath>
namespace attn_body {
using bf16=__hip_bfloat16;
using bf16x8=__attribute__((ext_vector_type(8)))short;
using s16x4=__attribute__((ext_vector_type(4)))short;
using f32x16=__attribute__((ext_vector_type(16)))float;
using u32x4=__attribute__((ext_vector_type(4)))unsigned;
constexpr int BATCH=1,NHEAD=16,SEQ=8192,D=64,DM=NHEAD*D;
constexpr int NW=8,QBLK=32,QB=QBLK*NW,KVBLK=64,NQB=SEQ/QB;
constexpr int ATTN_PITCH=DM, ATTN_UNIT_ROWS=QB;
__device__ __forceinline__ int crow(int r,int hi){return (r&3)+8*(r>>2)+4*hi;}
#define SBAR() __builtin_amdgcn_sched_barrier(0)
__device__ __forceinline__ void cmask(f32x16&p0,f32x16&p1,int jb,int qrel,int hi){
  const float NEG=-INFINITY; int kb=64*jb+4*hi;
  #pragma unroll
  for(int r=0;r<16;++r){int kv=kb+(r&3)+8*(r>>2); if(kv>qrel)p0[r]=NEG; if(kv+32>qrel)p1[r]=NEG;}
}

constexpr int NSLOT=3, SLOTB=8192;
constexpr int LDS_K=0, LDS_V=NSLOT*SLOTB, LDS_WS=2*NSLOT*SLOTB, LDS_OST=LDS_WS+NW*64*4, LDS_BYTES=LDS_OST+NW*4096;
constexpr float C2=0.125f*1.4426950408889634f;
__device__ __forceinline__ void glds16(const void*gsrc,unsigned lds_dst){unsigned keep;
  asm volatile("s_mov_b32 %0, m0\n\ts_mov_b32 m0, %2\n\ts_nop 0\n\tglobal_load_lds_dwordx4 %1, off\n\ts_mov_b32 m0, %0":"=&s"(keep):"v"(gsrc),"s"(lds_dst):"memory");}
__device__ __forceinline__ float max3f(float a,float b,float c){float r;asm("v_max3_f32 %0, %1, %2, %3":"=v"(r):"v"(a),"v"(b),"v"(c));return r;}
__device__ __forceinline__ float max2f(float a,float b){float r;asm("v_max_f32_e32 %0, %1, %2":"=v"(r):"v"(a),"v"(b));return r;}
__device__ __forceinline__ float fadd_s(float a,float b){float r;asm("v_add_f32_e32 %0, %1, %2":"=v"(r):"v"(a),"v"(b));return r;}
__device__ __forceinline__ float fsub_s(float a,float b){float r;asm("v_sub_f32_e32 %0, %1, %2":"=v"(r):"v"(a),"v"(b));return r;}
typedef float f32x2_t __attribute__((ext_vector_type(2))); typedef __bf16 bf16x2_t __attribute__((ext_vector_type(2)));
__device__ __forceinline__ unsigned cvtpk_s(float lo,float hi){f32x2_t v={lo,hi};bf16x2_t b=__builtin_convertvector(v,bf16x2_t);return __builtin_bit_cast(unsigned,b);}
#define WAIT_BAR(N) asm volatile("s_waitcnt vmcnt(" #N ") lgkmcnt(0)\n\ts_barrier":::"memory")

__device__ __forceinline__ void qkt(f32x16&p0,f32x16&p1,const char*Kslot,const bf16x8*qr,const f32x16&negm,int r32,int hi){
  const char*kb=Kslot+hi*1024+r32*16;
  #pragma unroll
  for(int d0=0;d0<4;++d0){
    const bf16x8 b0=*reinterpret_cast<const bf16x8*>(kb+d0*2048);
    const bf16x8 b1=*reinterpret_cast<const bf16x8*>(kb+d0*2048+512);
    if(d0==0){p0=__builtin_amdgcn_mfma_f32_32x32x16_bf16(b0,qr[0],negm,0,0,0);p1=__builtin_amdgcn_mfma_f32_32x32x16_bf16(b1,qr[0],negm,0,0,0);}
    else{p0=__builtin_amdgcn_mfma_f32_32x32x16_bf16(b0,qr[d0],p0,0,0,0);p1=__builtin_amdgcn_mfma_f32_32x32x16_bf16(b1,qr[d0],p1,0,0,0);}}
}
typedef __attribute__((address_space(3))) const char* lds_cptr;
typedef short v4i16_t __attribute__((ext_vector_type(4)));
__device__ __forceinline__ void kload8(bf16x8*kf,lds_cptr kp){
  kf[0]=*(const __attribute__((address_space(3))) bf16x8*)(kp);      kf[1]=*(const __attribute__((address_space(3))) bf16x8*)(kp+512);
  kf[2]=*(const __attribute__((address_space(3))) bf16x8*)(kp+2048); kf[3]=*(const __attribute__((address_space(3))) bf16x8*)(kp+2560);
  kf[4]=*(const __attribute__((address_space(3))) bf16x8*)(kp+4096); kf[5]=*(const __attribute__((address_space(3))) bf16x8*)(kp+4608);
  kf[6]=*(const __attribute__((address_space(3))) bf16x8*)(kp+6144); kf[7]=*(const __attribute__((address_space(3))) bf16x8*)(kp+6656);
}
__device__ __forceinline__ void kload2(bf16x8*kf,lds_cptr kp,int j){ kf[2*j]=*(const __attribute__((address_space(3))) bf16x8*)(kp+j*2048); kf[2*j+1]=*(const __attribute__((address_space(3))) bf16x8*)(kp+j*2048+512); }
__device__ __forceinline__ s16x4 vtr(lds_cptr p){ return __builtin_bit_cast(s16x4,__builtin_amdgcn_ds_read_tr16_b64_v4i16((__attribute__((address_space(3))) v4i16_t*)p)); }
__device__ __forceinline__ float rowmax(const f32x16&p0,const f32x16&p1){
  float a=max3f(p0[0],p0[1],p1[0]),b=max3f(p0[2],p0[3],p1[1]);a=max3f(a,p1[2],p1[3]);
  #pragma unroll
  for(int r=4;r<16;r+=4){a=max3f(a,p0[r],p0[r+1]);b=max3f(b,p0[r+2],p0[r+3]);a=max3f(a,p1[r],p1[r+1]);b=max3f(b,p1[r+2],p1[r+3]);}
  const float m=max2f(a,b);
  auto rr=__builtin_amdgcn_permlane32_swap(__float_as_uint(m),__float_as_uint(m),false,false);
  return max2f(__uint_as_float(rr[0]),__uint_as_float(rr[1]));
}
__device__ __forceinline__ void pv(f32x16*o,int vb,bf16x8 pa0,bf16x8 pa1,bf16x8 pa2,bf16x8 pa3){
  #pragma unroll
  for(int d0=0;d0<2;++d0){s16x4 lo[4],hi[4];
    #pragma unroll
    for(int ks=0;ks<4;++ks){
      asm volatile("ds_read_b64_tr_b16 %0,%1 offset:%c2":"=&v"(lo[ks]):"v"(vb),"i"(d0*4096+ks*1024):"memory");
      asm volatile("ds_read_b64_tr_b16 %0,%1 offset:%c2":"=&v"(hi[ks]):"v"(vb),"i"(d0*4096+ks*1024+512):"memory");}
    asm volatile("s_waitcnt lgkmcnt(0)":::"memory");SBAR();
    #define PK(k) (bf16x8){lo[k][0],lo[k][1],lo[k][2],lo[k][3],hi[k][0],hi[k][1],hi[k][2],hi[k][3]}
    o[d0]=__builtin_amdgcn_mfma_f32_32x32x16_bf16(pa0,PK(0),o[d0],0,0,0);
    o[d0]=__builtin_amdgcn_mfma_f32_32x32x16_bf16(pa1,PK(1),o[d0],0,0,0);
    o[d0]=__builtin_amdgcn_mfma_f32_32x32x16_bf16(pa2,PK(2),o[d0],0,0,0);
    o[d0]=__builtin_amdgcn_mfma_f32_32x32x16_bf16(pa3,PK(3),o[d0],0,0,0);
    #undef PK
  }
}

#ifndef ATTN_STORE16
#define ATTN_STORE16(p,v) (*(u32x4*)(p)=(v))
#endif
template<int THRL> __device__ __forceinline__ void attn_unit(int hq,int hv,int qb,const bf16*Q,const bf16*__restrict__ K,const bf16*__restrict__ V,bf16*O,char*shm,const int tid){
  const int lane=tid&63,r32=lane&31,hi=lane>>5; const int wid=__builtin_amdgcn_readfirstlane(tid>>6);
  const long rowbase=0; const int q0=qb*QB;
  const bf16*Qw=Q+(rowbase+q0+wid*QBLK)*DM+hq*D;
  const bf16*Kh=K+rowbase*DM+hq*D,*Vh=V+rowbase*DM+hv*D;
  const unsigned lds0=(unsigned)(uintptr_t)shm;
  float*wsf=(float*)(shm+LDS_WS)+wid*64;
  const bf16*ksrc=Kh+(long)lane*DM+wid*8;
  const bf16*vsrc=Vh+(long)(16*(wid&3)+(lane>>2))*DM+(wid>>2)*32+(lane&3)*8;
  const unsigned kdst=lds0+LDS_K+wid*1024, vdst=lds0+LDS_V+wid*1024;
  #define DMA_K(t,slot) glds16(ksrc+(long)(t)*KVBLK*DM,(unsigned)__builtin_amdgcn_readfirstlane(kdst+(slot)))
  #define DMA_V(t,slot) glds16(vsrc+(long)(t)*KVBLK*DM,(unsigned)__builtin_amdgcn_readfirstlane(vdst+(slot)))
  const int vb0=(int)(lds0+LDS_V)+((lane>>4)&1)*32+(lane&3)*8+(4*hi+((lane&15)>>2))*64;
  const char*Kbase=shm+LDS_K; bf16x8 kf[8];
  const lds_cptr shm3=(lds_cptr)shm; const lds_cptr kp0=shm3+LDS_K+hi*1024+r32*16; const lds_cptr vp0=shm3+LDS_V+((lane>>4)&1)*32+(lane&3)*8+(4*hi+((lane&15)>>2))*64;
  const int NT=(q0+QB)/KVBLK;
  DMA_K(0,0);DMA_V(0,0);DMA_K(1,SLOTB);
  bf16x8 qr[4];
  #pragma unroll
  for(int d0=0;d0<4;++d0)qr[d0]=*reinterpret_cast<const bf16x8*>(&Qw[(long)r32*DM+d0*16+hi*8]);
  float mhat=0.f,l_reg=0.f;f32x16 o[2];o[0]=f32x16{};o[1]=f32x16{};f32x16 negm=f32x16{};asm volatile("":"+v"(negm));
  const int qrel=wid*QBLK+r32;
  #define CMASK(P0,P1,t) do{int jb_=(t)-(NT-4); if(jb_>=0)cmask(P0,P1,jb_,qrel,hi);}while(0)
  bool resc=false;
  #define START(P0,P1) do{ const float rm=rowmax(P0,P1); resc=false; \
    { const float dl=rm; mhat=fadd_s(mhat,dl); \
      _Pragma("unroll") for(int r=0;r<16;++r){P0[r]=fsub_s(P0[r],dl);P1[r]=fsub_s(P1[r],dl);} \
      _Pragma("unroll") for(int r=0;r<16;++r)negm[r]=-mhat; asm volatile("":"+v"(negm)); } \
    _Pragma("unroll") for(int r=0;r<16;++r)P0[r]=__builtin_amdgcn_exp2f(P0[r]); }while(0)
  #define RESC() do{ if(resc){ asm volatile("s_waitcnt lgkmcnt(0)":::"memory"); \
      _Pragma("unroll") for(int d_=0;d_<2;++d_) _Pragma("unroll") for(int r=0;r<16;++r)o[d_][r]*=wsf[crow(r,hi)]; } }while(0)
  f32x16 pA0,pA1,pB0,pB1;
  int sl_prev=0,sl_cur=0,sl_next=SLOTB;
  #define ROT() do{sl_prev=sl_cur;sl_cur=sl_next;sl_next=(sl_next==(NSLOT-1)*SLOTB)?0:sl_next+SLOTB;}while(0)
  DMA_K(2,2*SLOTB);
  WAIT_BAR(3);
  qkt(pA0,pA1,Kbase,qr,negm,r32,hi);asm volatile("s_nop 15\n\ts_nop 7":"+v"(pA0),"+v"(pA1));CMASK(pA0,pA1,0);
  START(pA0,pA1);
  _Pragma("unroll") for(int r=0;r<16;++r)pA1[r]=__builtin_amdgcn_exp2f(pA1[r]);
  WAIT_BAR(0);
  DMA_K(3,0);DMA_V(1,SLOTB);
  ROT();
  kload8(kf,kp0+sl_cur);
  WAIT_BAR(2);
  s16x4 vlo[8],vhi[8]; u32x4 pw0,pw1,pw2,pw3;
  #define PKW(P,B) cvtpk_s(P[B],P[B+1])
  #define PAF(k) __builtin_bit_cast(bf16x8,pw##k)
  #define VFR(i) (bf16x8){vlo[i][0],vlo[i][1],vlo[i][2],vlo[i][3],vhi[i][0],vhi[i][1],vhi[i][2],vhi[i][3]}
  #define PIN(x) asm volatile("":"+v"(x))
  #define MX3(a,b,c) __builtin_fmaxf(__builtin_fmaxf((a),(b)),(c))
  #define GAPA(MF,A0,A1,A2,A3,W0,W1,PW) do{ MF; sacc+=A0; sacc+=A1; sacc+=A2; sacc+=A3; PIN(sacc); W0; W1; PIN(PW); SBAR(); }while(0)
  #define EX(v) __builtin_amdgcn_exp2f(v)
  #define GAPB(MF,X,B) do{ MF; X[B]=EX(X[B]); X[B+1]=EX(X[B+1]); X[B+2]=EX(X[B+2]); X[B+3]=EX(X[B+3]); PIN(X); SBAR(); }while(0)
  #define VRD(i) do{ vlo[i]=vtr(vp_+(((i)>>2)*4096+((i)&3)*1024)); vhi[i]=vtr(vp_+(((i)>>2)*4096+((i)&3)*1024+512)); }while(0)
  #define KRD(G,j) do{ if(G){ kload2(kf,kp0+sl_next,j); SBAR(); } }while(0)
  #define STEP(C0,C1,P0,P1,t,GK,GV,GL) do{ SBAR(); \
    const lds_cptr vp_=vp0+sl_prev; \
    VRD(0); SBAR(); float sacc=(P0[0]+P0[1]); \
    GAPA(C0=__builtin_amdgcn_mfma_f32_32x32x16_bf16(kf[0],qr[0],negm,0,0,0), P0[2],P0[3],P0[4],P0[5],     pw0[0]=PKW(P0,0), pw0[1]=PKW(P0,2), pw0); \
    VRD(4); SBAR(); GAPA(C1=__builtin_amdgcn_mfma_f32_32x32x16_bf16(kf[1],qr[0],negm,0,0,0), P0[6],P0[7],P0[8],P0[9],     pw0[2]=PKW(P0,4), pw0[3]=PKW(P0,6), pw0); \
    VRD(1); SBAR(); GAPA(C0=__builtin_amdgcn_mfma_f32_32x32x16_bf16(kf[2],qr[1],C0,0,0,0),   P0[10],P0[11],P0[12],P0[13], pw1[0]=PKW(P0,8), pw1[1]=PKW(P0,10), pw1); \
    VRD(5); SBAR(); GAPA(C1=__builtin_amdgcn_mfma_f32_32x32x16_bf16(kf[3],qr[1],C1,0,0,0),   P0[14],P0[15],P1[0],P1[1],   pw1[2]=PKW(P0,12),pw1[3]=PKW(P0,14), pw1); \
    VRD(2); SBAR(); GAPA(C0=__builtin_amdgcn_mfma_f32_32x32x16_bf16(kf[4],qr[2],C0,0,0,0),   P1[2],P1[3],P1[4],P1[5],     pw2[0]=PKW(P1,0), pw2[1]=PKW(P1,2), pw2); \
    VRD(6); SBAR(); GAPA(C1=__builtin_amdgcn_mfma_f32_32x32x16_bf16(kf[5],qr[2],C1,0,0,0),   P1[6],P1[7],P1[8],P1[9],     pw2[2]=PKW(P1,4), pw2[3]=PKW(P1,6), pw2); \
    VRD(3); SBAR(); GAPA(C0=__builtin_amdgcn_mfma_f32_32x32x16_bf16(kf[6],qr[3],C0,0,0,0),   P1[10],P1[11],P1[12],P1[13], pw3[0]=PKW(P1,8), pw3[1]=PKW(P1,10), pw3); \
    VRD(7); SBAR(); GAPA(C1=__builtin_amdgcn_mfma_f32_32x32x16_bf16(kf[7],qr[3],C1,0,0,0),   P1[14],P1[15],0.f,0.f,       pw3[2]=PKW(P1,12),pw3[3]=PKW(P1,14), pw3); \
    l_reg+=sacc; \
    if(GK){DMA_K((t)+3,sl_cur);} if(GV){DMA_V((t)+1,sl_next);} \
    CMASK(C0,C1,t); \
    { float a=MX3(C0[0],C0[1],C1[0]),b=MX3(C0[2],C0[3],C1[1]); a=MX3(a,C1[2],C1[3]); \
      _Pragma("unroll") for(int r=4;r<16;r+=4){a=MX3(a,C0[r],C0[r+1]);b=MX3(b,C0[r+2],C0[r+3]);a=MX3(a,C1[r],C1[r+1]);b=MX3(b,C1[r+2],C1[r+3]);} \
      float rm=__builtin_fmaxf(a,b); { auto rr=__builtin_amdgcn_permlane32_swap(__float_as_uint(rm),__float_as_uint(rm),false,false); rm=__builtin_fmaxf(__uint_as_float(rr[0]),__uint_as_float(rr[1])); } \
      resc=false; \
      if(__builtin_expect(__any(rm>(float)THRL),0)){ const float dl=__builtin_fmaxf(rm,0.f); mhat+=dl; \
        _Pragma("unroll") for(int r=0;r<16;++r){C0[r]-=dl;C1[r]-=dl;} \
        _Pragma("unroll") for(int r=0;r<16;++r)negm[r]=-mhat; asm volatile("":"+v"(negm)); \
        const float f=__builtin_amdgcn_exp2f(-dl); l_reg*=f; if(hi==0)wsf[r32]=f; resc=true; } } \
    SBAR(); \
    GAPB(o[0]=__builtin_amdgcn_mfma_f32_32x32x16_bf16(PAF(0),VFR(0),o[0],0,0,0), C0,0); \
    GAPB(o[1]=__builtin_amdgcn_mfma_f32_32x32x16_bf16(PAF(0),VFR(4),o[1],0,0,0), C0,4); \
    KRD(GL,0); GAPB(o[0]=__builtin_amdgcn_mfma_f32_32x32x16_bf16(PAF(1),VFR(1),o[0],0,0,0), C0,8); \
    KRD(GL,1); GAPB(o[1]=__builtin_amdgcn_mfma_f32_32x32x16_bf16(PAF(1),VFR(5),o[1],0,0,0), C0,12); \
    KRD(GL,2); GAPB(o[0]=__builtin_amdgcn_mfma_f32_32x32x16_bf16(PAF(2),VFR(2),o[0],0,0,0), C1,0); \
    KRD(GL,3); GAPB(o[1]=__builtin_amdgcn_mfma_f32_32x32x16_bf16(PAF(2),VFR(6),o[1],0,0,0), C1,4); \
    GAPB(o[0]=__builtin_amdgcn_mfma_f32_32x32x16_bf16(PAF(3),VFR(3),o[0],0,0,0), C1,8); \
    GAPB(o[1]=__builtin_amdgcn_mfma_f32_32x32x16_bf16(PAF(3),VFR(7),o[1],0,0,0), C1,12); \
    }while(0)
  int t=1;
  #undef CMASK
  #define CMASK(P0,P1,t) do{}while(0)
  for(;t+5<NT;t+=2){
    STEP(pB0,pB1,pA0,pA1,t,true,true,true);     WAIT_BAR(2); RESC(); ROT();
    STEP(pA0,pA1,pB0,pB1,t+1,true,true,true);   WAIT_BAR(2); RESC(); ROT();
  }
  #undef CMASK
  #define CMASK(P0,P1,t) do{int jb_=(t)-(NT-4); if(jb_>=0)cmask(P0,P1,jb_,qrel,hi);}while(0)
  #define ENDW(tt) do{ if((tt)+3<NT){WAIT_BAR(2);} else if((tt)+2<NT){WAIT_BAR(1);} else {WAIT_BAR(0);} }while(0)
  for(;t+1<NT;t+=2){
    STEP(pB0,pB1,pA0,pA1,t,(t+3<NT),(t+1<NT),(t+1<NT));       ENDW(t);   RESC(); ROT();
    STEP(pA0,pA1,pB0,pB1,t+1,(t+4<NT),(t+2<NT),(t+2<NT));     ENDW(t+1); RESC(); ROT();
  }
  STEP(pB0,pB1,pA0,pA1,NT-1,false,false,false); RESC();
  { float sacc=pB0[0]+pB0[1]; _Pragma("unroll") for(int r=2;r<16;++r)sacc+=pB0[r]; _Pragma("unroll") for(int r=0;r<16;++r)sacc+=pB1[r]; l_reg+=sacc;
    pw0=(u32x4){PKW(pB0,0),PKW(pB0,2),PKW(pB0,4),PKW(pB0,6)};pw1=(u32x4){PKW(pB0,8),PKW(pB0,10),PKW(pB0,12),PKW(pB0,14)};pw2=(u32x4){PKW(pB1,0),PKW(pB1,2),PKW(pB1,4),PKW(pB1,6)};pw3=(u32x4){PKW(pB1,8),PKW(pB1,10),PKW(pB1,12),PKW(pB1,14)};
    SBAR(); pv(o,vb0+sl_cur,PAF(0),PAF(1),PAF(2),PAF(3)); }
  #undef PKW
  #undef PAF
  #undef VFR
  #undef PIN
  #undef MX3
  #undef GAPA
  #undef GAPB
  #undef EX
  #undef VRD
  #undef KRD
  #undef STEP
  #undef ENDW
  {auto rr=__builtin_amdgcn_permlane32_swap(__float_as_uint(l_reg),__float_as_uint(l_reg),false,false);l_reg=__uint_as_float(rr[0])+__uint_as_float(rr[1]);}
  if(hi==0)wsf[32+r32]=l_reg;asm volatile("s_waitcnt lgkmcnt(0)":::"memory");
  float rli[16];
  #pragma unroll
  for(int r=0;r<16;++r)rli[r]=__builtin_amdgcn_rcpf(wsf[32+crow(r,hi)]);
  bf16*Ow=O+(rowbase+q0+wid*QBLK)*DM+hv*D;
  { bf16*stg=(bf16*)(shm+LDS_OST)+wid*2048;
    #pragma unroll
    for(int r=0;r<16;++r){const int orow=crow(r,hi);
      #pragma unroll
      for(int d0=0;d0<2;++d0)stg[orow*64+d0*32+r32]=__float2bfloat16(o[d0][r]*rli[r]);}
    asm volatile("s_waitcnt lgkmcnt(0)":::"memory");
    #pragma unroll
    for(int i=0;i<4;++i){const int row=i*8+(lane>>3),ch=lane&7; const u32x4 v=*(const u32x4*)(stg+row*64+ch*8); ATTN_STORE16(Ow+(long)row*DM+ch*8,v);} }
  asm volatile("s_waitcnt lgkmcnt(0)\n\ts_barrier":::"memory");
  #undef DMA_K
  #undef DMA_V
  #undef CMASK
  #undef START
  #undef RESC
  #undef ROT
}

constexpr int ATTN_LDS_BYTES=LDS_BYTES;
#undef SBAR
#undef WAIT_BAR
}
namespace attn_body {
#if NAIVE_ATTN
__device__ __forceinline__ void attn_unit_naive(int hq,int hv,int qb,const bf16_t*Q,const bf16_t*K,const bf16_t*V,bf16_t*O,const int tid_){
  const int lane=tid_&63, wid=tid_>>6;
#pragma unroll 1
  for(int r=0;r<32;++r){ const int row=qb*256+wid*32+r;
    float q[64];
#pragma unroll
    for(int c=0;c<8;++c){ const ::u32x4 w=*(const ::u32x4*)(Q+(size_t)row*1024+hq*64+c*8); q[c*8+0]=bflo(w.x);q[c*8+1]=bfhi(w.x);q[c*8+2]=bflo(w.y);q[c*8+3]=bfhi(w.y);q[c*8+4]=bflo(w.z);q[c*8+5]=bfhi(w.z);q[c*8+6]=bflo(w.w);q[c*8+7]=bfhi(w.w); }
    float m=-INFINITY,l=0.f,o=0.f;
#pragma unroll 1
    for(int j0=0;j0<=row;j0+=64){ const int j=j0+lane; float s=-INFINITY;
      if(j<=row){ float a=0.f;
#pragma unroll
        for(int c=0;c<8;++c){ const ::u32x4 w=*(const ::u32x4*)(K+(size_t)j*1024+hq*64+c*8); a+=q[c*8+0]*bflo(w.x)+q[c*8+1]*bfhi(w.x)+q[c*8+2]*bflo(w.y)+q[c*8+3]*bfhi(w.y)+q[c*8+4]*bflo(w.z)+q[c*8+5]*bfhi(w.z)+q[c*8+6]*bflo(w.w)+q[c*8+7]*bfhi(w.w); }
        s=a; }
      const float mb=wave_max(s);
      const float mn=fmaxf(m,mb), alpha=exp2f(m-mn); const float p=(j<=row)?exp2f(s-mn):0.f;
      l=l*alpha+wave_sum(p); o*=alpha;
      const int nj=(row-j0+1)<64?(row-j0+1):64;
#pragma unroll 1
      for(int jj=0;jj<nj;++jj){ const float pj=__builtin_bit_cast(float,__builtin_amdgcn_readlane(__builtin_bit_cast(int,p),jj)); o+=pj*bf2f(V[(size_t)(j0+jj)*1024+hv*64+lane]); }
      m=mn; }
    O[(size_t)row*1024+hv*64+lane]=(bf16_t)f2bf(o/l);
  }
}
#endif
__device__ __forceinline__ void attn_phase(char* lds, const bf16_t* Q, const bf16_t* K, const bf16_t* V, bf16_t* O1, bf16_t* O2, int vcu, int G, const int tid) {
  const int nu = (G == 256) ? 4 : (1024 - vcu + G - 1) / G;
#pragma unroll 1
  for (int i = 0; i < nu; ++i) {
    int bh, qb;
    if (G == 256) { const int s = vcu & 7; bh = vcu >> 3; qb = (i == 0) ? s : (i == 1) ? 15 - s : (i == 2) ? 16 + s : 31 - s; }
    else { const int L = vcu + i * G; bh = L >> 5; qb = L & 31; }
    const int h = bh >> 2, c = (bh >> 1) & 1, vh = bh & 1;
    int tid_u = tid; asm volatile("" : "+v"(tid_u));
#if NAIVE_ATTN
    attn_unit_naive(h * 2 + c, h * 2 + vh, qb, Q, K, V, c ? O2 : O1, tid_u);
#else
    attn_unit<8>(h * 2 + c, h * 2 + vh, qb, (const bf16*)Q, (const bf16*)K, (const bf16*)V, (bf16*)(c ? O2 : O1), lds, tid_u);
#endif
  }
}
}
namespace attn128 {
using bf16=__hip_bfloat16;
using bf16x8=__attribute__((ext_vector_type(8)))short;
using s16x4=__attribute__((ext_vector_type(4)))short;
using f32x16=__attribute__((ext_vector_type(16)))float;
using u32x4=__attribute__((ext_vector_type(4)))unsigned;
constexpr int BATCH=1,NHEAD=16,SEQ=8192,D=64,DM=NHEAD*D;
constexpr int NW=8,QBLK=32,QB=QBLK*NW,KVBLK=64,NQB=SEQ/QB;
constexpr int ATTN_PITCH=DM, ATTN_UNIT_ROWS=QB;
__device__ __forceinline__ int crow(int r,int hi){return (r&3)+8*(r>>2)+4*hi;}
#define SBAR() __builtin_amdgcn_sched_barrier(0)
__device__ __forceinline__ void cmask(f32x16&p0,f32x16&p1,int jb,int qrel,int hi){
  const float NEG=-INFINITY; int kb=64*jb+4*hi;
  #pragma unroll
  for(int r=0;r<16;++r){int kv=kb+(r&3)+8*(r>>2); if(kv>qrel)p0[r]=NEG; if(kv+32>qrel)p1[r]=NEG;}
}

constexpr int NSLOT=3, SLOTB=8192;
constexpr int VSLOTB=2*SLOTB;
constexpr int LDS_K=0, LDS_V=NSLOT*SLOTB, LDS_WS=LDS_V+NSLOT*VSLOTB, LDS_OST=LDS_WS+NW*64*4, LDS_BYTES=LDS_OST+NW*4096;
constexpr float C2=0.125f*1.4426950408889634f;
__device__ __forceinline__ void glds16(const void*gsrc,unsigned lds_dst){unsigned keep;
  asm volatile("s_mov_b32 %0, m0\n\ts_mov_b32 m0, %2\n\ts_nop 0\n\tglobal_load_lds_dwordx4 %1, off\n\ts_mov_b32 m0, %0":"=&s"(keep):"v"(gsrc),"s"(lds_dst):"memory");}
__device__ __forceinline__ float max3f(float a,float b,float c){float r;asm("v_max3_f32 %0, %1, %2, %3":"=v"(r):"v"(a),"v"(b),"v"(c));return r;}
__device__ __forceinline__ float max2f(float a,float b){float r;asm("v_max_f32_e32 %0, %1, %2":"=v"(r):"v"(a),"v"(b));return r;}
__device__ __forceinline__ float fadd_s(float a,float b){float r;asm("v_add_f32_e32 %0, %1, %2":"=v"(r):"v"(a),"v"(b));return r;}
__device__ __forceinline__ float fsub_s(float a,float b){float r;asm("v_sub_f32_e32 %0, %1, %2":"=v"(r):"v"(a),"v"(b));return r;}
typedef float f32x2_t __attribute__((ext_vector_type(2))); typedef __bf16 bf16x2_t __attribute__((ext_vector_type(2)));
__device__ __forceinline__ unsigned cvtpk_s(float lo,float hi){f32x2_t v={lo,hi};bf16x2_t b=__builtin_convertvector(v,bf16x2_t);return __builtin_bit_cast(unsigned,b);}
#define WAIT_BAR(N) asm volatile("s_waitcnt vmcnt(" #N ") lgkmcnt(0)\n\ts_barrier":::"memory")

__device__ __forceinline__ void qkt(f32x16&p0,f32x16&p1,const char*Kslot,const bf16x8*qr,const f32x16&negm,int r32,int hi){
  const char*kb=Kslot+hi*1024+r32*16;
  #pragma unroll
  for(int d0=0;d0<4;++d0){
    const bf16x8 b0=*reinterpret_cast<const bf16x8*>(kb+d0*2048);
    const bf16x8 b1=*reinterpret_cast<const bf16x8*>(kb+d0*2048+512);
    if(d0==0){p0=__builtin_amdgcn_mfma_f32_32x32x16_bf16(b0,qr[0],negm,0,0,0);p1=__builtin_amdgcn_mfma_f32_32x32x16_bf16(b1,qr[0],negm,0,0,0);}
    else{p0=__builtin_amdgcn_mfma_f32_32x32x16_bf16(b0,qr[d0],p0,0,0,0);p1=__builtin_amdgcn_mfma_f32_32x32x16_bf16(b1,qr[d0],p1,0,0,0);}}
}
typedef __attribute__((address_space(3))) const char* lds_cptr;
typedef short v4i16_t __attribute__((ext_vector_type(4)));
__device__ __forceinline__ void kload8(bf16x8*kf,lds_cptr kp){
  kf[0]=*(const __attribute__((address_space(3))) bf16x8*)(kp);      kf[1]=*(const __attribute__((address_space(3))) bf16x8*)(kp+512);
  kf[2]=*(const __attribute__((address_space(3))) bf16x8*)(kp+2048); kf[3]=*(const __attribute__((address_space(3))) bf16x8*)(kp+2560);
  kf[4]=*(const __attribute__((address_space(3))) bf16x8*)(kp+4096); kf[5]=*(const __attribute__((address_space(3))) bf16x8*)(kp+4608);
  kf[6]=*(const __attribute__((address_space(3))) bf16x8*)(kp+6144); kf[7]=*(const __attribute__((address_space(3))) bf16x8*)(kp+6656);
}
__device__ __forceinline__ void kload2(bf16x8*kf,lds_cptr kp,int j){ kf[2*j]=*(const __attribute__((address_space(3))) bf16x8*)(kp+j*2048); kf[2*j+1]=*(const __attribute__((address_space(3))) bf16x8*)(kp+j*2048+512); }
__device__ __forceinline__ s16x4 vtr(lds_cptr p){ return __builtin_bit_cast(s16x4,__builtin_amdgcn_ds_read_tr16_b64_v4i16((__attribute__((address_space(3))) v4i16_t*)p)); }
__device__ __forceinline__ float rowmax(const f32x16&p0,const f32x16&p1){
  float a=max3f(p0[0],p0[1],p1[0]),b=max3f(p0[2],p0[3],p1[1]);a=max3f(a,p1[2],p1[3]);
  #pragma unroll
  for(int r=4;r<16;r+=4){a=max3f(a,p0[r],p0[r+1]);b=max3f(b,p0[r+2],p0[r+3]);a=max3f(a,p1[r],p1[r+1]);b=max3f(b,p1[r+2],p1[r+3]);}
  const float m=max2f(a,b);
  auto rr=__builtin_amdgcn_permlane32_swap(__float_as_uint(m),__float_as_uint(m),false,false);
  return max2f(__uint_as_float(rr[0]),__uint_as_float(rr[1]));
}
__device__ __forceinline__ void pv(f32x16*o,int vb,bf16x8 pa0,bf16x8 pa1,bf16x8 pa2,bf16x8 pa3){
  #pragma unroll
  for(int d0=0;d0<4;++d0){s16x4 lo[4],hi[4];
    #pragma unroll
    for(int ks=0;ks<4;++ks){
      asm volatile("ds_read_b64_tr_b16 %0,%1 offset:%c2":"=&v"(lo[ks]):"v"(vb),"i"(d0*4096+ks*1024):"memory");
      asm volatile("ds_read_b64_tr_b16 %0,%1 offset:%c2":"=&v"(hi[ks]):"v"(vb),"i"(d0*4096+ks*1024+512):"memory");}
    asm volatile("s_waitcnt lgkmcnt(0)":::"memory");SBAR();
    #define PK(k) (bf16x8){lo[k][0],lo[k][1],lo[k][2],lo[k][3],hi[k][0],hi[k][1],hi[k][2],hi[k][3]}
    o[d0]=__builtin_amdgcn_mfma_f32_32x32x16_bf16(pa0,PK(0),o[d0],0,0,0);
    o[d0]=__builtin_amdgcn_mfma_f32_32x32x16_bf16(pa1,PK(1),o[d0],0,0,0);
    o[d0]=__builtin_amdgcn_mfma_f32_32x32x16_bf16(pa2,PK(2),o[d0],0,0,0);
    o[d0]=__builtin_amdgcn_mfma_f32_32x32x16_bf16(pa3,PK(3),o[d0],0,0,0);
    #undef PK
  }
}

#ifndef ATTN_STORE16
#define ATTN_STORE16(p,v) (*(u32x4*)(p)=(v))
#endif
template<int THRL> __device__ __forceinline__ void attn_unit(int hq,int hv,int qb,const bf16*Q,const bf16*__restrict__ K,const bf16*__restrict__ V,bf16*O,char*shm,const int tid){
  const int lane=tid&63,r32=lane&31,hi=lane>>5; const int wid=__builtin_amdgcn_readfirstlane(tid>>6);
  const long rowbase=0; const int q0=qb*QB;
  const bf16*Qw=Q+(rowbase+q0+wid*QBLK)*DM+hq*D;
  const bf16*Kh=K+rowbase*DM+hq*D,*Vh=V+rowbase*DM+hv*128;
  const unsigned lds0=(unsigned)(uintptr_t)shm;
  float*wsf=(float*)(shm+LDS_WS)+wid*64;
  const bf16*ksrc=Kh+(long)lane*DM+wid*8;
  const bf16*vsrc=Vh+(long)(16*(wid&3)+(lane>>2))*DM+(wid>>2)*32+(lane&3)*8;
  const unsigned kdst=lds0+LDS_K+wid*1024, vdst=lds0+LDS_V+wid*1024;
  #define DMA_K(t,slot) glds16(ksrc+(long)(t)*KVBLK*DM,(unsigned)__builtin_amdgcn_readfirstlane(kdst+(slot)))
  #define DMA_V(t,slot) do{ glds16(vsrc+(long)(t)*KVBLK*DM,(unsigned)__builtin_amdgcn_readfirstlane(vdst+2*(slot))); glds16(vsrc+(long)(t)*KVBLK*DM+64,(unsigned)__builtin_amdgcn_readfirstlane(vdst+2*(slot)+8192)); }while(0)
  const int vb0=(int)(lds0+LDS_V)+((lane>>4)&1)*32+(lane&3)*8+(4*hi+((lane&15)>>2))*64;
  const char*Kbase=shm+LDS_K; bf16x8 kf[8];
  const lds_cptr shm3=(lds_cptr)shm; const lds_cptr kp0=shm3+LDS_K+hi*1024+r32*16; const lds_cptr vp0=shm3+LDS_V+((lane>>4)&1)*32+(lane&3)*8+(4*hi+((lane&15)>>2))*64;
  const int NT=(q0+QB)/KVBLK;
  DMA_K(0,0);DMA_V(0,0);DMA_K(1,SLOTB);
  bf16x8 qr[4];
  #pragma unroll
  for(int d0=0;d0<4;++d0)qr[d0]=*reinterpret_cast<const bf16x8*>(&Qw[(long)r32*DM+d0*16+hi*8]);
  float mhat=0.f,l_reg=0.f;f32x16 o[4];o[0]=f32x16{};o[1]=f32x16{};o[2]=f32x16{};o[3]=f32x16{};
  const int qrel=wid*QBLK+r32;
  #define CMASK(P0,P1,t) do{int jb_=(t)-(NT-4); if(jb_>=0)cmask(P0,P1,jb_,qrel,hi);}while(0)
  bool resc=false;
  #define START(P0,P1) do{ const float rm=rowmax(P0,P1); resc=false; \
    { const float dl=rm; mhat=fadd_s(mhat,dl); \
      _Pragma("unroll") for(int r=0;r<16;++r){P0[r]=fsub_s(P0[r],dl);P1[r]=fsub_s(P1[r],dl);} \
      } \
    _Pragma("unroll") for(int r=0;r<16;++r)P0[r]=__builtin_amdgcn_exp2f(P0[r]); }while(0)
  #define RESC() do{ if(resc){ asm volatile("s_waitcnt lgkmcnt(0)":::"memory"); \
      _Pragma("unroll") for(int d_=0;d_<4;++d_) _Pragma("unroll") for(int r=0;r<16;++r)o[d_][r]*=wsf[crow(r,hi)]; } }while(0)
  f32x16 pA0,pA1,pB0,pB1;
  int sl_prev=0,sl_cur=0,sl_next=SLOTB;
  #define ROT() do{sl_prev=sl_cur;sl_cur=sl_next;sl_next=(sl_next==(NSLOT-1)*SLOTB)?0:sl_next+SLOTB;}while(0)
  DMA_K(2,2*SLOTB);
  WAIT_BAR(4);
  { const f32x16 zero16=f32x16{}; qkt(pA0,pA1,Kbase,qr,zero16,r32,hi); }asm volatile("s_nop 15\n\ts_nop 7":"+v"(pA0),"+v"(pA1));CMASK(pA0,pA1,0);
  START(pA0,pA1);
  _Pragma("unroll") for(int r=0;r<16;++r)pA1[r]=__builtin_amdgcn_exp2f(pA1[r]);
  WAIT_BAR(0);
  DMA_K(3,0);DMA_V(1,SLOTB);
  ROT();
  kload8(kf,kp0+sl_cur);
  WAIT_BAR(3);
  s16x4 vlo[8],vhi[8]; u32x4 pw0,pw1,pw2,pw3;
  #define PKW(P,B) cvtpk_s(P[B],P[B+1])
  #define PAF(k) __builtin_bit_cast(bf16x8,pw##k)
  #define VFR(i) (bf16x8){vlo[i][0],vlo[i][1],vlo[i][2],vlo[i][3],vhi[i][0],vhi[i][1],vhi[i][2],vhi[i][3]}
  #define PIN(x) asm volatile("":"+v"(x))
  #define MX3(a,b,c) __builtin_fmaxf(__builtin_fmaxf((a),(b)),(c))
  #define GAPA(MF,A0,A1,A2,A3,W0,W1,PW) do{ MF; sacc+=A0; sacc+=A1; sacc+=A2; sacc+=A3; PIN(sacc); W0; W1; PIN(PW); SBAR(); }while(0)
  #define EX(v) __builtin_amdgcn_exp2f(v)
  #define GAPB(MF,X,B) do{ MF; X[B]=EX(X[B]); X[B+1]=EX(X[B+1]); X[B+2]=EX(X[B+2]); X[B+3]=EX(X[B+3]); PIN(X); SBAR(); }while(0)
  #define GAPB2(MF,RD,X,B) do{ MF; RD; X[B]=EX(X[B]); X[B+1]=EX(X[B+1]); PIN(X); SBAR(); }while(0)
  #define VRD2(i) do{ vlo[i]=vtr(vp_+((((i)>>2)+2)*4096+((i)&3)*1024)); vhi[i]=vtr(vp_+((((i)>>2)+2)*4096+((i)&3)*1024+512)); }while(0)
  #define VRD(i) do{ vlo[i]=vtr(vp_+(((i)>>2)*4096+((i)&3)*1024)); vhi[i]=vtr(vp_+(((i)>>2)*4096+((i)&3)*1024+512)); }while(0)
  #define KRD(G,j) do{ if(G){ kload2(kf,kp0+sl_next,j); SBAR(); } }while(0)
  #define STEP(C0,C1,P0,P1,t,GK,GV,GL) do{ SBAR(); \
    const lds_cptr vp_=vp0+2*sl_prev; \
    { const float nm_=-mhat; _Pragma("unroll") for(int r=0;r<16;++r){C0[r]=nm_;C1[r]=nm_;} }     \
    VRD(0); SBAR(); float sacc=(P0[0]+P0[1]); \
    GAPA(C0=__builtin_amdgcn_mfma_f32_32x32x16_bf16(kf[0],qr[0],C0,0,0,0), P0[2],P0[3],P0[4],P0[5],     pw0[0]=PKW(P0,0), pw0[1]=PKW(P0,2), pw0); \
    VRD(4); SBAR(); GAPA(C1=__builtin_amdgcn_mfma_f32_32x32x16_bf16(kf[1],qr[0],C1,0,0,0), P0[6],P0[7],P0[8],P0[9],     pw0[2]=PKW(P0,4), pw0[3]=PKW(P0,6), pw0); \
    VRD(1); SBAR(); GAPA(C0=__builtin_amdgcn_mfma_f32_32x32x16_bf16(kf[2],qr[1],C0,0,0,0),   P0[10],P0[11],P0[12],P0[13], pw1[0]=PKW(P0,8), pw1[1]=PKW(P0,10), pw1); \
    VRD(5); SBAR(); GAPA(C1=__builtin_amdgcn_mfma_f32_32x32x16_bf16(kf[3],qr[1],C1,0,0,0),   P0[14],P0[15],P1[0],P1[1],   pw1[2]=PKW(P0,12),pw1[3]=PKW(P0,14), pw1); \
    VRD(2); SBAR(); GAPA(C0=__builtin_amdgcn_mfma_f32_32x32x16_bf16(kf[4],qr[2],C0,0,0,0),   P1[2],P1[3],P1[4],P1[5],     pw2[0]=PKW(P1,0), pw2[1]=PKW(P1,2), pw2); \
    VRD(6); SBAR(); GAPA(C1=__builtin_amdgcn_mfma_f32_32x32x16_bf16(kf[5],qr[2],C1,0,0,0),   P1[6],P1[7],P1[8],P1[9],     pw2[2]=PKW(P1,4), pw2[3]=PKW(P1,6), pw2); \
    VRD(3); SBAR(); GAPA(C0=__builtin_amdgcn_mfma_f32_32x32x16_bf16(kf[6],qr[3],C0,0,0,0),   P1[10],P1[11],P1[12],P1[13], pw3[0]=PKW(P1,8), pw3[1]=PKW(P1,10), pw3); \
    VRD(7); SBAR(); GAPA(C1=__builtin_amdgcn_mfma_f32_32x32x16_bf16(kf[7],qr[3],C1,0,0,0),   P1[14],P1[15],0.f,0.f,       pw3[2]=PKW(P1,12),pw3[3]=PKW(P1,14), pw3); \
    l_reg+=sacc; \
    if(GK){DMA_K((t)+3,sl_cur);} if(GV){DMA_V((t)+1,sl_next);} \
    CMASK(C0,C1,t); \
    { float a=MX3(C0[0],C0[1],C1[0]),b=MX3(C0[2],C0[3],C1[1]); a=MX3(a,C1[2],C1[3]); \
      _Pragma("unroll") for(int r=4;r<16;r+=4){a=MX3(a,C0[r],C0[r+1]);b=MX3(b,C0[r+2],C0[r+3]);a=MX3(a,C1[r],C1[r+1]);b=MX3(b,C1[r+2],C1[r+3]);} \
      float rm=__builtin_fmaxf(a,b); { auto rr=__builtin_amdgcn_permlane32_swap(__float_as_uint(rm),__float_as_uint(rm),false,false); rm=__builtin_fmaxf(__uint_as_float(rr[0]),__uint_as_float(rr[1])); } \
      resc=false; \
      if(__builtin_expect(__any(rm>(float)THRL),0)){ const float dl=__builtin_fmaxf(rm,0.f); mhat+=dl; \
        _Pragma("unroll") for(int r=0;r<16;++r){C0[r]-=dl;C1[r]-=dl;} \
        const float f=__builtin_amdgcn_exp2f(-dl); l_reg*=f; if(hi==0)wsf[r32]=f; resc=true; } } \
    SBAR(); \
    GAPB2(o[0]=__builtin_amdgcn_mfma_f32_32x32x16_bf16(PAF(0),VFR(0),o[0],0,0,0), VRD2(0), C0,0); \
    GAPB2(o[1]=__builtin_amdgcn_mfma_f32_32x32x16_bf16(PAF(0),VFR(4),o[1],0,0,0), VRD2(4), C0,2); \
    GAPB2(o[0]=__builtin_amdgcn_mfma_f32_32x32x16_bf16(PAF(1),VFR(1),o[0],0,0,0), VRD2(1), C0,4); \
    GAPB2(o[1]=__builtin_amdgcn_mfma_f32_32x32x16_bf16(PAF(1),VFR(5),o[1],0,0,0), VRD2(5), C0,6); \
    GAPB2(o[0]=__builtin_amdgcn_mfma_f32_32x32x16_bf16(PAF(2),VFR(2),o[0],0,0,0), VRD2(2), C0,8); \
    GAPB2(o[1]=__builtin_amdgcn_mfma_f32_32x32x16_bf16(PAF(2),VFR(6),o[1],0,0,0), VRD2(6), C0,10); \
    GAPB2(o[0]=__builtin_amdgcn_mfma_f32_32x32x16_bf16(PAF(3),VFR(3),o[0],0,0,0), VRD2(3), C0,12); \
    GAPB2(o[1]=__builtin_amdgcn_mfma_f32_32x32x16_bf16(PAF(3),VFR(7),o[1],0,0,0), VRD2(7), C0,14); \
    KRD(GL,0); GAPB2(o[2]=__builtin_amdgcn_mfma_f32_32x32x16_bf16(PAF(0),VFR(0),o[2],0,0,0), (void)0, C1,0); \
    KRD(GL,1); GAPB2(o[3]=__builtin_amdgcn_mfma_f32_32x32x16_bf16(PAF(0),VFR(4),o[3],0,0,0), (void)0, C1,2); \
    KRD(GL,2); GAPB2(o[2]=__builtin_amdgcn_mfma_f32_32x32x16_bf16(PAF(1),VFR(1),o[2],0,0,0), (void)0, C1,4); \
    KRD(GL,3); GAPB2(o[3]=__builtin_amdgcn_mfma_f32_32x32x16_bf16(PAF(1),VFR(5),o[3],0,0,0), (void)0, C1,6); \
    GAPB2(o[2]=__builtin_amdgcn_mfma_f32_32x32x16_bf16(PAF(2),VFR(2),o[2],0,0,0), (void)0, C1,8); \
    GAPB2(o[3]=__builtin_amdgcn_mfma_f32_32x32x16_bf16(PAF(2),VFR(6),o[3],0,0,0), (void)0, C1,10); \
    GAPB2(o[2]=__builtin_amdgcn_mfma_f32_32x32x16_bf16(PAF(3),VFR(3),o[2],0,0,0), (void)0, C1,12); \
    GAPB2(o[3]=__builtin_amdgcn_mfma_f32_32x32x16_bf16(PAF(3),VFR(7),o[3],0,0,0), (void)0, C1,14); \
    }while(0)
  int t=1;
  #undef CMASK
  #define CMASK(P0,P1,t) do{}while(0)
  for(;t+5<NT;t+=2){
    STEP(pB0,pB1,pA0,pA1,t,true,true,true);     WAIT_BAR(3); RESC(); ROT();
    STEP(pA0,pA1,pB0,pB1,t+1,true,true,true);   WAIT_BAR(3); RESC(); ROT();
  }
  #undef CMASK
  #define CMASK(P0,P1,t) do{int jb_=(t)-(NT-4); if(jb_>=0)cmask(P0,P1,jb_,qrel,hi);}while(0)
  #define ENDW(tt) do{ if((tt)+3<NT){WAIT_BAR(3);} else if((tt)+2<NT){WAIT_BAR(2);} else {WAIT_BAR(0);} }while(0)
  for(;t+1<NT;t+=2){
    STEP(pB0,pB1,pA0,pA1,t,(t+3<NT),(t+1<NT),(t+1<NT));       ENDW(t);   RESC(); ROT();
    STEP(pA0,pA1,pB0,pB1,t+1,(t+4<NT),(t+2<NT),(t+2<NT));     ENDW(t+1); RESC(); ROT();
  }
  STEP(pB0,pB1,pA0,pA1,NT-1,false,false,false); RESC();
  { float sacc=pB0[0]+pB0[1]; _Pragma("unroll") for(int r=2;r<16;++r)sacc+=pB0[r]; _Pragma("unroll") for(int r=0;r<16;++r)sacc+=pB1[r]; l_reg+=sacc;
    pw0=(u32x4){PKW(pB0,0),PKW(pB0,2),PKW(pB0,4),PKW(pB0,6)};pw1=(u32x4){PKW(pB0,8),PKW(pB0,10),PKW(pB0,12),PKW(pB0,14)};pw2=(u32x4){PKW(pB1,0),PKW(pB1,2),PKW(pB1,4),PKW(pB1,6)};pw3=(u32x4){PKW(pB1,8),PKW(pB1,10),PKW(pB1,12),PKW(pB1,14)};
    SBAR(); pv(o,vb0+2*sl_cur,PAF(0),PAF(1),PAF(2),PAF(3)); }
  #undef PKW
  #undef PAF
  #undef VFR
  #undef PIN
  #undef MX3
  #undef GAPA
  #undef GAPB
  #undef GAPB2
  #undef VRD2
  #undef EX
  #undef VRD
  #undef KRD
  #undef STEP
  #undef ENDW
  {auto rr=__builtin_amdgcn_permlane32_swap(__float_as_uint(l_reg),__float_as_uint(l_reg),false,false);l_reg=__uint_as_float(rr[0])+__uint_as_float(rr[1]);}
  if(hi==0)wsf[32+r32]=l_reg;asm volatile("s_waitcnt lgkmcnt(0)":::"memory");
  float rli[16];
  #pragma unroll
  for(int r=0;r<16;++r)rli[r]=__builtin_amdgcn_rcpf(wsf[32+crow(r,hi)]);
  bf16*Ow=O+(rowbase+q0+wid*QBLK)*DM+hv*128;
  { bf16*stg=(bf16*)(shm+LDS_OST)+wid*2048;
    #pragma unroll
    for(int p=0;p<2;++p){
      #pragma unroll
      for(int r=0;r<16;++r){const int orow=crow(r,hi);
        #pragma unroll
        for(int d0=0;d0<2;++d0)stg[orow*64+d0*32+r32]=__float2bfloat16(o[2*p+d0][r]*rli[r]);}
      asm volatile("s_waitcnt lgkmcnt(0)":::"memory");
      #pragma unroll
      for(int i=0;i<4;++i){const int row=i*8+(lane>>3),ch=lane&7; const u32x4 v=*(const u32x4*)(stg+row*64+ch*8); ATTN_STORE16(Ow+(long)row*DM+p*64+ch*8,v);}
      asm volatile("s_waitcnt lgkmcnt(0)":::"memory"); } }
  asm volatile("s_waitcnt lgkmcnt(0)\n\ts_barrier":::"memory");
  #undef DMA_K
  #undef DMA_V
  #undef CMASK
  #undef START
  #undef RESC
  #undef ROT
}

constexpr int ATTN_LDS_BYTES=LDS_BYTES;
#undef SBAR
#undef WAIT_BAR
}

#ifndef ATTN128
#define ATTN128 1
#endif
namespace attn128 {
__device__ __forceinline__ void attn_phase(char* lds, const bf16_t* Q, const bf16_t* K, const bf16_t* V, bf16_t* O1, bf16_t* O2, int vcu, int G, const int tid) {
  const int nu = (G == 256) ? 2 : (512 - vcu + G - 1) / G;
#pragma unroll 1
  for (int i = 0; i < nu; ++i) {
    int hc, qb;
    if (G == 256) { const int s = vcu & 15; hc = vcu >> 4; qb = (i == 0) ? s : 31 - s; }
    else { const int L = vcu + i * G; hc = L >> 5; qb = L & 31; }
    int tid_u = tid; asm volatile("" : "+v"(tid_u));
    attn_unit<8>(hc, hc >> 1, qb, (const bf16*)Q, (const bf16*)K, (const bf16*)V, (bf16*)((hc & 1) ? O2 : O1), lds, tid_u);
  }
}
}
struct Ctx { unsigned char* ws; LAS unsigned char* lds; gu32* ctl; int tid, lane, wave, vcu, G, gw, NGW; };
__device__ __forceinline__ unsigned char* lwp(const Ctx& F, int l, size_t off) { return F.ws + WS_LW + (size_t)l * LW_SIZE + off; }

__device__ __forceinline__ int rowmap(int kind, int n, int H) {
    if (kind == 1) { const int d = n & 63; return (n & ~63) | (d < 32 ? 2 * d : 2 * (d - 32) + 1); }
    if (kind == 2) return n < H ? 2 * n : 2 * (n - H) + 1;
    if (kind == 3) return 2 * n;
    if (kind == 4) return 2 * n + 1;
    return n;
}
__device__ __forceinline__ void xpose_item(const float* W, int N, bf16_t* WT, int dpitch, int koff, int kind, int nbase, int H, int rbase, int k0, int n0, int lane, const float* gk = nullptr) {
    const int q = lane >> 4, c = lane & 15;
    const float* src = W + (size_t)(k0 + 16 * q) * N + n0 + 4 * c;
    f32x4 v[16];
#pragma unroll
    for (int i = 0; i < 16; ++i) v[i] = __builtin_nontemporal_load((const f32x4*)(src + (size_t)i * N));
    if (gk) { const f32x4* g4 = (const f32x4*)(gk + k0 + 16 * q); const f32x4 ga = g4[0], gb = g4[1], gc = g4[2], gd = g4[3];
#pragma unroll
        for (int i = 0; i < 4; ++i) { v[i] = v[i] * ga[i]; v[4 + i] = v[4 + i] * gb[i]; v[8 + i] = v[8 + i] * gc[i]; v[12 + i] = v[12 + i] * gd[i]; } }
#pragma unroll
    for (int j = 0; j < 4; ++j) { const int drow = rbase + rowmap(kind, n0 + 4 * c + j - nbase, H);
        u32x4 o0, o1; o0.x = pk2(v[0][j], v[1][j]); o0.y = pk2(v[2][j], v[3][j]); o0.z = pk2(v[4][j], v[5][j]); o0.w = pk2(v[6][j], v[7][j]);
        o1.x = pk2(v[8][j], v[9][j]); o1.y = pk2(v[10][j], v[11][j]); o1.z = pk2(v[12][j], v[13][j]); o1.w = pk2(v[14][j], v[15][j]);
        u32x4* dp = (u32x4*)(WT + (size_t)drow * dpitch + koff + k0 + 16 * q); dp[0] = o0; dp[1] = o1; }
}
__device__ __forceinline__ void xpose_item8(const float* W, int N, unsigned char* WT, int dpitch, int kind, int nbase, int k0, int n0, int lane, float scale, int H = 0, int rbase = 0, const float* gk = nullptr) {
    const int q = lane >> 4, c = lane & 15;
    const float* src = W + (size_t)(k0 + 16 * q) * N + n0 + 4 * c;
    f32x4 v[16];
#pragma unroll
    for (int i = 0; i < 16; ++i) v[i] = __builtin_nontemporal_load((const f32x4*)(src + (size_t)i * N)) * scale;
    if (gk) { const f32x4* g4 = (const f32x4*)(gk + k0 + 16 * q); const f32x4 ga = g4[0], gb = g4[1], gc = g4[2], gd = g4[3];
#pragma unroll
        for (int i = 0; i < 4; ++i) { v[i] = v[i] * ga[i]; v[4 + i] = v[4 + i] * gb[i]; v[8 + i] = v[8 + i] * gc[i]; v[12 + i] = v[12 + i] * gd[i]; } }
#pragma unroll
    for (int j = 0; j < 4; ++j) { const int drow = rbase + rowmap(kind, n0 + 4 * c + j - nbase, H); int w[4];
#pragma unroll
        for (int t = 0; t < 4; ++t) { int p8 = __builtin_amdgcn_cvt_pk_fp8_f32(v[4 * t][j], v[4 * t + 1][j], 0, false); w[t] = __builtin_amdgcn_cvt_pk_fp8_f32(v[4 * t + 2][j], v[4 * t + 3][j], p8, true); }
        *(u32x4*)(WT + (size_t)drow * dpitch + k0 + 16 * q) = (u32x4){(unsigned)w[0], (unsigned)w[1], (unsigned)w[2], (unsigned)w[3]}; }
}
#define XP_MAT(W_, K_, N_, WT_, DP_, KOFF_, KIND_, NBASE_, H_, RBASE_, NLO_, NHI_) { const int nb_ = ((NHI_) - (NLO_)) / 64, items_ = ((K_) / 64) * nb_; \
    if (r < items_) { xpose_item((W_), (N_), (bf16_t*)(WT_), (DP_), (KOFF_), (KIND_), (NBASE_), (H_), (RBASE_), 64 * (r / nb_), (NLO_) + 64 * (r % nb_), F.lane); continue; } r -= items_; }

#define XP_MATG(W_, K_, N_, WT_, DP_, KOFF_, KIND_, NBASE_, H_, RBASE_, NLO_, NHI_, GK_) { const int nb_ = ((NHI_) - (NLO_)) / 64, items_ = ((K_) / 64) * nb_; \
    if (r < items_) { xpose_item((W_), (N_), (bf16_t*)(WT_), (DP_), (KOFF_), (KIND_), (NBASE_), (H_), (RBASE_), 64 * (r / nb_), (NLO_) + 64 * (r % nb_), F.lane, (GK_)); continue; } r -= items_; }

__device__ __forceinline__ void sincos_d(double a, float& s, float& c) {
    const double k = rint(a * 0.15915494309189535); const double rr = a - k * 6.283185307179586476925; const float rf = (float)rr; s = sinf(rf); c = cosf(rf);
}

struct Inputs { const LAS unsigned* tab;
    __device__ __forceinline__ const float* ptr(int i) const { const unsigned lo = __builtin_amdgcn_readfirstlane(tab[2 * i]), hi = __builtin_amdgcn_readfirstlane(tab[2 * i + 1]);
        return (const float*)(((unsigned long long)hi << 32) | lo); } };

#ifndef DEFER_CONV
#define DEFER_CONV 1
#endif
constexpr int IT_WIN = 32 * (NPROJ / 64), IT_DA = 16 * 32, IT_CV = 8 * 32, IT_SO = 8 * 32, IT_GLU = 8 * 16, IT_MIX = 32 * 32, IT_KV = 32 * 16, IT_XO = 8 * 32, IT_G = 16 * 32 * 8, IT_D = 16 * 8 * 32;
constexpr int IT_BIG = IT_WIN + IT_DA + IT_CV + IT_SO + IT_GLU + IT_MIX + 2 * IT_G + IT_D;
__device__ __forceinline__ void conv_item(const Ctx& F, const Inputs& I, const int l, int r) {
    do {
        const float* win = I.ptr(4) + (size_t)l * DM * NPROJ;
        const float* gmix = I.ptr(3) + (size_t)l * DM;
        XP_MATG(win, DM, NPROJ, lwp(F, l, LW_WIN), DM, 0, 1, 0, 0, 0, 0, 2048, gmix)
        XP_MATG(win, DM, NPROJ, lwp(F, l, LW_WIN), DM, 0, 0, 0, 0, 0, 2048, 3072, gmix)
        { const int nb_ = 1024 / 64, items_ = (DM / 64) * nb_;
            if (r < items_) { xpose_item8(win, NPROJ, lwp(F, l, LW_WG8), DM, 2, 3072, 64 * (r / nb_), 3072 + 64 * (r % nb_), F.lane, GATE_WSCALE, 512, 6144, gmix); continue; } r -= items_; }
        XP_MATG(win, DM, NPROJ, lwp(F, l, LW_WIN), DM, 0, 0, 4096, 0, 3072, 4096, 4608, gmix)
        { const int nb_ = (NPROJ - 4608) / 64, items_ = (DM / 64) * nb_;
            if (r < items_) { xpose_item8(win, NPROJ, lwp(F, l, LW_WG8), DM, 0, 4608, 64 * (r / nb_), 4608 + 64 * (r % nb_), F.lane, GATE_WSCALE, 0, 0, gmix); continue; } r -= items_; }
        XP_MAT(I.ptr(10) + (size_t)l * 1024 * DM, 1024, DM, lwp(F, l, LW_WCAT), DM, 0, 0, 0, 0, 0, 0, DM)
        XP_MAT(I.ptr(15) + (size_t)l * 512 * DM, 512, DM, lwp(F, l, LW_WCAT), DM, 1024, 0, 0, 0, 0, 0, DM)
        XP_MAT(I.ptr(26) + (size_t)l * 512 * DM, 512, DM, lwp(F, l, LW_WCAT), DM, 1536, 0, 0, 0, 0, 0, DM)
        XP_MAT(I.ptr(24) + (size_t)l * 512 * 1024, 512, 1024, lwp(F, l, LW_WGLU), 512, 0, 2, 0, 512, 0, 0, 1024)
        XP_MAT(I.ptr(27) + (size_t)l * DM * DM, DM, DM, lwp(F, l, LW_WMIX), DM, 0, 0, 0, 0, 0, 0, DM)
        if (r < 2 * IT_G) { const int up = r >= IT_G; if (up) r -= IT_G; const int e = r / (32 * 8); r %= (32 * 8);
            const float* w = I.ptr(up ? 39 : 38) + ((size_t)l * NEXP + e) * DM * FFE;
            xpose_item8(w, FFE, lwp(F, l, LW_WGU) + (size_t)e * 1024 * DM, DM, up ? 4 : 3, 0, 64 * (r / 8), 64 * (r % 8), F.lane, GATE_WSCALE); continue; }
        r -= 2 * IT_G;
        { const int e = r / (8 * 32); r %= (8 * 32); const float* w = I.ptr(40) + ((size_t)l * NEXP + e) * FFE * DM;
            xpose_item8(w, DM, lwp(F, l, LW_WD) + (size_t)e * DM * FFE, FFE, 0, 0, 64 * (r / 32), 64 * (r % 32), F.lane, GATE_WSCALE); }
    } while (0);
}
__device__ __forceinline__ void conv_item_xa(const Ctx& F, const Inputs& I, const int l, int r) {
    do {
        XP_MAT(I.ptr(31) + (size_t)l * DM * 1024, DM, 1024, F.ws + WS_WKVT + (size_t)l * 1024 * DM * 2, DM, 0, 0, 0, 0, 0, 0, 1024)
        XP_MAT(I.ptr(32) + (size_t)l * 512 * DM, 512, DM, F.ws + WS_WXOT + (size_t)l * DM * 512 * 2, 512, 0, 0, 0, 0, 0, 0, DM)
    } while (0);
}
__device__ __forceinline__ void conv_window(const Ctx& F, const Inputs& I, const int l, const int base, const int wave_rank, const int nper) {
#pragma unroll 1
    for (int k = 0; k < nper; ++k) { const int r = base + wave_rank * nper + k; if (r < IT_BIG) conv_item(F, I, l, r); }
}
constexpr int IT_EXP = 2 * IT_G + IT_D, IT_EARLY = IT_BIG - IT_EXP;
__device__ __forceinline__ void ph_prologue_a(const Ctx& F, const Inputs& I) {
    if (DEFER_CONV && F.G == 256) { for (int it = F.gw; it < IT_EARLY; it += F.NGW) conv_item(F, I, 0, it); }
    else for (int it = F.gw; it < NL * IT_BIG; it += F.NGW) conv_item(F, I, it / IT_BIG, it % IT_BIG);
    for (int it = F.gw; it < NL * (IT_KV + IT_XO); it += F.NGW) conv_item_xa(F, I, it / (IT_KV + IT_XO), it % (IT_KV + IT_XO));
    for (size_t i = (size_t)F.gw * 64 + F.lane; i < (size_t)NL * DM * 512 / 8; i += (size_t)F.NGW * 64) {
        const f32x4 a = *(const f32x4*)(I.ptr(30) + i * 8), b = *(const f32x4*)(I.ptr(30) + i * 8 + 4); const float g = FUSE_N2 ? I.ptr(28)[(i * 8) / 512] : 1.f;
        u32x4 o; o.x = pk2(a[0] * g, a[1] * g); o.y = pk2(a[2] * g, a[3] * g); o.z = pk2(b[0] * g, b[1] * g); o.w = pk2(b[2] * g, b[3] * g); *(u32x4*)(F.ws + WS_WQB + i * 16) = o; }
    for (int i = F.gw * 64 + F.lane; i < NL * 20 * DM; i += F.NGW * 64) { const int l = i / (20 * DM), j = (i / DM) % 20, k = i % DM;
        const float g = I.ptr(33)[l * DM + k]; const float w = j < 4 ? I.ptr(34)[((size_t)l * DM + k) * 4 + j] : I.ptr(36)[((size_t)l * DM + k) * 16 + (j - 4)];
        const float p = g * w; const unsigned hb = pk2(p, 0.f) & 0xffffu; const unsigned lb = pk2(p - bflo(hb), 0.f) & 0xffffu;
        ((unsigned short*)lwp(F, l, LW_RT))[j * DM + k] = (unsigned short)hb; ((unsigned short*)lwp(F, l, LW_RT))[(20 + j) * DM + k] = (unsigned short)lb; }
    for (int i = F.gw * 64 + F.lane; i < T * 32; i += F.NGW * 64) { const int t = i >> 5, d = i & 31;
        const double inv = exp(-(double)d * (1.0 / 32.0) * 9.210340371976184); float s, c; sincos_d((double)((const int*)I.ptr(2))[t] * inv, s, c);
        ((float*)(F.ws + WS_ROPE))[i] = c; ((float*)(F.ws + WS_ROPE))[T * 32 + i] = s; }
    for (int rw = F.gw; rw < NL * MEML; rw += F.NGW) { const int l = rw / MEML, m = rw % MEML;
        const f32x4* xr = (const f32x4*)(I.ptr(1) + (size_t)m * DM) + F.lane; f32x4 v[8]; float s = 0.f;
#pragma unroll
        for (int j = 0; j < 8; ++j) { v[j] = xr[64 * j]; s += (v[j][0] * v[j][0] + v[j][1] * v[j][1]) + (v[j][2] * v[j][2] + v[j][3] * v[j][3]); }
        const float rstd = rsqrtf(wave_sum(s) * (1.f / DM) + RMS_EPS);
        const f32x4* gr = (const f32x4*)(I.ptr(29) + (size_t)l * DM) + F.lane; u32x2* o = (u32x2*)(F.ws + WS_MNORM + (size_t)rw * DM * 2) + F.lane;
#pragma unroll
        for (int j = 0; j < 8; ++j) { const f32x4 g = gr[64 * j]; u32x2 w; w.x = pk2(v[j][0] * rstd * g[0], v[j][1] * rstd * g[1]); w.y = pk2(v[j][2] * rstd * g[2], v[j][3] * rstd * g[3]); o[64 * j] = w; } }
    __syncthreads();
    for (int it = F.vcu; it < NL * 32; it += F.G) {
        const int l = it >> 5, g = it & 31;
        LAS f32x2* lamP = (LAS f32x2*)(F.lds + RING_OFF);
        LAS f32x2* Bb = lamP + 33 * 64;
        LAS f32x2* Cc = Bb + 64 * 16;
        LAS float* Kt = (LAS float*)(Cc + 16 * 64);
        LAS f32x2* fz = (LAS f32x2*)(Kt + 32 * 256);
        if (F.tid < 64) { const int p = F.tid; const float lr = I.ptr(16)[(l * 32 + g) * 64 + p], li = I.ptr(17)[(l * 32 + g) * 64 + p]; const float dt = expf(I.ptr(18)[l * 32 + g]);
            for (int tau = 0; tau <= 32; ++tau) { float s, c; sincos_d((double)tau * (double)li * (double)dt, s, c); const float mg = expf((float)tau * lr * dt); lamP[tau * 64 + p] = (f32x2){mg * c, mg * s}; }
            float s1, c1; sincos_d((double)li * (double)dt, s1, c1); const float mg1 = expf(lr * dt), abr = mg1 * c1, abi = mg1 * s1, den = lr * lr + li * li;
            fz[p] = (f32x2){((abr - 1.f) * lr + abi * li) / den, (abi * lr - (abr - 1.f) * li) / den};
            ((f32x2*)lwp(F, l, LW_LAM))[g * 64 + p] = lamP[32 * 64 + p]; }
        __syncthreads();
        for (int i = F.tid; i < 1024; i += 512) { const int p = i >> 4, h = i & 15; const float br = I.ptr(19)[((size_t)(l * 32 + g) * 64 + p) * 16 + h], bi = I.ptr(20)[((size_t)(l * 32 + g) * 64 + p) * 16 + h]; const f32x2 f = fz[p];
            Bb[i] = (f32x2){f[0] * br - f[1] * bi, f[0] * bi + f[1] * br};
            const int hh = i >> 6, pp = i & 63; Cc[i] = (f32x2){I.ptr(21)[((size_t)(l * 32 + g) * 16 + hh) * 64 + pp], I.ptr(22)[((size_t)(l * 32 + g) * 16 + hh) * 64 + pp]}; }
        __syncthreads();
        for (int i = F.tid; i < 32 * 256; i += 512) { const int tau = i >> 8, h = (i >> 4) & 15, h2 = i & 15; float a = 0.f;
            for (int p = 0; p < 64; ++p) { const f32x2 lm = lamP[tau * 64 + p], b = Bb[p * 16 + h2], c = Cc[h * 64 + p]; const float wr_ = lm[0] * b[0] - lm[1] * b[1], wi_ = lm[0] * b[1] + lm[1] * b[0]; a += c[0] * wr_ - c[1] * wi_; }
            if (tau == 0 && h == h2) a += I.ptr(23)[(l * 32 + g) * 16 + h];
            Kt[i] = a; }
        __syncthreads();
        bf16_t* bke = (bf16_t*)(lwp(F, l, LW_BKE) + (size_t)g * 512 * 640 * 2);
        for (int i = F.tid; i < 512 * 80; i += 512) { const int n = i / 80, k8 = i % 80, j = n >> 4, h = n & 15; float v[8];
            if (k8 < 64) { const int ii = k8 >> 1, h0 = (k8 & 1) * 8;
#pragma unroll
                for (int q = 0; q < 8; ++q) v[q] = (ii <= j) ? Kt[(j - ii) * 256 + h * 16 + h0 + q] : 0.f; }
            else { const int p0 = (k8 - 64) * 4;
#pragma unroll
                for (int q = 0; q < 4; ++q) { const f32x2 c = Cc[h * 64 + p0 + q], lm = lamP[(j + 1) * 64 + p0 + q]; v[2 * q] = c[0] * lm[0] - c[1] * lm[1]; v[2 * q + 1] = -(c[0] * lm[1] + c[1] * lm[0]); } }
            u32x4 o; o.x = pk2(v[0], v[1]); o.y = pk2(v[2], v[3]); o.z = pk2(v[4], v[5]); o.w = pk2(v[6], v[7]); *(u32x4*)(bke + (size_t)n * 640 + k8 * 8) = o; }
        bf16_t* fm = (bf16_t*)(lwp(F, l, LW_F) + (size_t)g * 128 * 512 * 2);
        for (int i = F.tid; i < 128 * 64; i += 512) { const int n = i >> 6, k8 = i & 63, p = n >> 1, im = n & 1, ii = k8 >> 1, h0 = (k8 & 1) * 8; float v[8]; const f32x2 lm = lamP[(31 - ii) * 64 + p];
#pragma unroll
            for (int q = 0; q < 8; ++q) { const f32x2 b = Bb[p * 16 + h0 + q]; v[q] = im ? (lm[0] * b[1] + lm[1] * b[0]) : (lm[0] * b[0] - lm[1] * b[1]); }
            u32x4 o; o.x = pk2(v[0], v[1]); o.y = pk2(v[2], v[3]); o.z = pk2(v[4], v[5]); o.w = pk2(v[6], v[7]); *(u32x4*)(fm + (size_t)n * 512 + k8 * 8) = o; }
        __syncthreads();
    }
}

__device__ __forceinline__ void ph_norm1(const Ctx& F, int l, const float* xin, const float* gain, float* fout) {
    char* X = (char*)(F.ws + WS_X);
    for (int rowb = F.gw; rowb < T; rowb += 2 * F.NGW) {
        f32x4 v[2][8];
        if (l == 0) {
#pragma unroll
            for (int r = 0; r < 2; ++r) { const int row = rowb + r * F.NGW; if (row < T) { const f32x4* xr = (const f32x4*)(xin + (size_t)row * DM) + F.lane;
#pragma unroll
                for (int j = 0; j < 8; ++j) v[r][j] = xr[64 * j]; } } }
        else {
            const int cv = (F.lane < 16) ? (int)__hip_atomic_load(F.ctl + CW_CNT + ((l - 1) * 16 + F.lane) * 16, RLX_AGENT) : 0;
            int4 tk[2];
#pragma unroll
            for (int r = 0; r < 2; ++r) { const int row = rowb + r * F.NGW; tk[r] = (row < T) ? *(const int4*)(F.ws + WS_TOK + (size_t)row * 16) : make_int4(0, 0, 0, 0); }
            unsigned ya[2][8], yb[2][8]; u32x2 xq[2][8];
#pragma unroll
            for (int r = 0; r < 2; ++r) { const int row = rowb + r * F.NGW; if (row < T) {
                int o0 = 0, o1 = 0;
#pragma unroll
                for (int k = 0; k < 16; ++k) { const int ck = __builtin_amdgcn_readlane(cv, k); o0 += (k < tk[r].x) ? ck : 0; o1 += (k < tk[r].z) ? ck : 0; }
                const unsigned* y0 = (const unsigned*)(F.ws + WS_Y + (size_t)(o0 + tk[r].y) * 2048) + F.lane; const unsigned* y1 = (const unsigned*)(F.ws + WS_Y + (size_t)(o1 + tk[r].w) * 2048) + F.lane;
                const u32x2* xr = (const u32x2*)(X + (size_t)row * DM * 2) + F.lane;
#pragma unroll
                for (int j = 0; j < 8; ++j) { ya[r][j] = y0[64 * j]; yb[r][j] = y1[64 * j]; xq[r][j] = xr[64 * j]; } } }
#pragma unroll
            for (int r = 0; r < 2; ++r)
#pragma unroll
                for (int j = 0; j < 8; ++j) { const int a = (int)ya[r][j], b = (int)yb[r][j]; const u32x2 xb = xq[r][j]; f32x4 x = (f32x4){bflo(xb.x), bfhi(xb.x), bflo(xb.y), bfhi(xb.y)};
#ifndef DBG_NO_MOE
                    const f32x2 a0 = __builtin_amdgcn_cvt_pk_f32_fp8(a, false), a1 = __builtin_amdgcn_cvt_pk_f32_fp8(a, true), b0 = __builtin_amdgcn_cvt_pk_f32_fp8(b, false), b1 = __builtin_amdgcn_cvt_pk_f32_fp8(b, true);
                    x[0] += (a0[0] + b0[0]) * (1.f / 16.f); x[1] += (a0[1] + b0[1]) * (1.f / 16.f); x[2] += (a1[0] + b1[0]) * (1.f / 16.f); x[3] += (a1[1] + b1[1]) * (1.f / 16.f);
#endif
                    v[r][j] = x; } }
        const f32x4* gr = (const f32x4*)gain + F.lane;
#pragma unroll
        for (int r = 0; r < 2; ++r) { const int row = rowb + r * F.NGW; if (row < T) {
            float s = 0.f;
#pragma unroll
            for (int j = 0; j < 8; ++j) s += (v[r][j][0] * v[r][j][0] + v[r][j][1] * v[r][j][1]) + (v[r][j][2] * v[r][j][2] + v[r][j][3] * v[r][j][3]);
            const float rstd = rsqrtf(wave_sum(s) * (1.f / DM) + RMS_EPS);
            if (fout) { f32x4* o = (f32x4*)(fout + (size_t)row * DM) + F.lane;
#pragma unroll
                for (int j = 0; j < 8; ++j) { const f32x4 g = gr[64 * j]; o[64 * j] = (f32x4){v[r][j][0] * rstd * g[0], v[r][j][1] * rstd * g[1], v[r][j][2] * rstd * g[2], v[r][j][3] * rstd * g[3]}; } }
            else { u32x2* xo = (u32x2*)(X + (size_t)row * DM * 2) + F.lane; unsigned* o8 = (unsigned*)(F.ws + WS_H8 + (size_t)row * DM) + F.lane;
                if (F.lane == 0) ((float*)(F.ws + WS_RSTD))[row] = rstd;
#pragma unroll
                for (int j = 0; j < 8; ++j) { u32x2 xw; xw.x = pk2(v[r][j][0], v[r][j][1]); xw.y = pk2(v[r][j][2], v[r][j][3]); xo[64 * j] = xw;
                    int p8 = __builtin_amdgcn_cvt_pk_fp8_f32(v[r][j][0], v[r][j][1], 0, false); p8 = __builtin_amdgcn_cvt_pk_fp8_f32(v[r][j][2], v[r][j][3], p8, true); o8[64 * j] = (unsigned)p8; } } } }
    }
}
__device__ __forceinline__ void ph_norm2(const Ctx& F, const float* gain) {
    const float* X = (const float*)(F.ws + WS_X);
    for (int row = F.gw; row < T; row += F.NGW) {
        const f32x4* xr = (const f32x4*)(X + (size_t)row * DM) + F.lane; f32x4 v[8]; float s = 0.f;
#pragma unroll
        for (int j = 0; j < 8; ++j) { v[j] = xr[64 * j]; s += (v[j][0] * v[j][0] + v[j][1] * v[j][1]) + (v[j][2] * v[j][2] + v[j][3] * v[j][3]); }
        const float rstd = rsqrtf(wave_sum(s) * (1.f / DM) + RMS_EPS);
        const f32x4* gr = (const f32x4*)gain + F.lane; u32x2* o = (u32x2*)(F.ws + WS_H + (size_t)row * DM * 2) + F.lane;
#pragma unroll
        for (int j = 0; j < 8; ++j) { const f32x4 g = gr[64 * j]; u32x2 w; w.x = pk2(v[j][0] * rstd * g[0], v[j][1] * rstd * g[1]); w.y = pk2(v[j][2] * rstd * g[2], v[j][3] * rstd * g[3]); o[64 * j] = w; }
    }
}
__device__ __forceinline__ void ph_conv(const Ctx& F, const float* dww, const float* dwb, const float* lng, const float* lnb) {
    LAS float* cs = (LAS float*)(F.lds + RING_OFF);
    const bf16_t* Z = (const bf16_t*)(F.ws + WS_Z);
    for (int run = F.vcu; run < T / 32; run += F.G) {
        const int t0 = run * 32, c = F.tid;
        float w[31];
#pragma unroll
        for (int k = 0; k < 31; ++k) w[k] = dww[k * 512 + c];
        const float b = dwb[c];
        float zz[62];
#pragma unroll
        for (int i = 0; i < 62; ++i) { const int t = t0 - 30 + i; zz[i] = (t >= 0) ? bf2f(Z[(size_t)t * 512 + c]) : 0.f; }
#pragma unroll
        for (int j = 0; j < 32; ++j) { float a = b;
#pragma unroll
            for (int k = 0; k < 31; ++k) a += w[k] * zz[j + k];
            cs[j * 512 + c] = a; }
        __syncthreads();
#pragma unroll
        for (int q = 0; q < 4; ++q) { const int j = F.wave * 4 + q; const f32x4 a0 = *(const LAS f32x4*)(cs + j * 512 + F.lane * 8), a1 = *(const LAS f32x4*)(cs + j * 512 + F.lane * 8 + 4);
            const float mu = wave_sum((a0[0] + a0[1]) + (a0[2] + a0[3]) + (a1[0] + a1[1]) + (a1[2] + a1[3])) * (1.f / 512.f);
            const f32x4 d0 = a0 - mu, d1 = a1 - mu;
            const float var = wave_sum((d0[0] * d0[0] + d0[1] * d0[1]) + (d0[2] * d0[2] + d0[3] * d0[3]) + (d1[0] * d1[0] + d1[1] * d1[1]) + (d1[2] * d1[2] + d1[3] * d1[3])) * (1.f / 512.f);
            const float rstd = rsqrtf(var + LN_EPS);
            const f32x4 g0 = *(const f32x4*)(lng + F.lane * 8), g1 = *(const f32x4*)(lng + F.lane * 8 + 4), b0 = *(const f32x4*)(lnb + F.lane * 8), b1 = *(const f32x4*)(lnb + F.lane * 8 + 4);
            f32x4 y0 = d0 * rstd * g0 + b0, y1 = d1 * rstd * g1 + b1;
#pragma unroll
            for (int i = 0; i < 4; ++i) { y0[i] = y0[i] * sigmoidf_(y0[i]); y1[i] = y1[i] * sigmoidf_(y1[i]); }
            u32x4 o; o.x = pk2(y0[0], y0[1]); o.y = pk2(y0[2], y0[3]); o.z = pk2(y1[0], y1[1]); o.w = pk2(y1[2], y1[3]);
            *(u32x4*)(F.ws + WS_CVO + ((size_t)(t0 + j) * 512 + F.lane * 8) * 2) = o; }
        __syncthreads();
    }
}
__device__ __forceinline__ void ph_ssm2(const Ctx& F, int l) {
    if (F.vcu < 64) { const int g = F.vcu >> 1, p = (F.vcu & 1) * 32 + (F.tid & 31), q = F.tid >> 5; const f32x2 lm = ((const f32x2*)lwp(F, l, LW_LAM))[g * 64 + p];
        LAS f32x2* Tq = (LAS f32x2*)(F.lds + RING_OFF);
        const float* S = (const float*)(F.ws + WS_SS) + g * 128 + 2 * p + (size_t)(16 * q) * 4096;
        f32x2 sv[16];
#pragma unroll
        for (int i = 0; i < 16; ++i) sv[i] = *(const f32x2*)(S + (size_t)i * 4096);
        f32x2 loc[16]; float xr = 0.f, xi = 0.f;
#pragma unroll
        for (int i = 0; i < 16; ++i) { const float nr = lm[0] * xr - lm[1] * xi + sv[i][0], ni = lm[0] * xi + lm[1] * xr + sv[i][1]; xr = nr; xi = ni; loc[i] = (f32x2){xr, xi}; }
        Tq[q * 32 + (F.tid & 31)] = loc[15];
        float pr = lm[0], pi = lm[1];
#pragma unroll
        for (int k = 0; k < 4; ++k) { const float nr = pr * pr - pi * pi, ni = 2.f * pr * pi; pr = nr; pi = ni; }
        __syncthreads();
        float cr = 0.f, ci = 0.f;
        for (int qq = 0; qq < q; ++qq) { const f32x2 t = Tq[qq * 32 + (F.tid & 31)]; const float nr = pr * cr - pi * ci + t[0], ni = pr * ci + pi * cr + t[1]; cr = nr; ci = ni; }
        unsigned* xp = (unsigned*)(F.ws + WS_XP) + ((size_t)g * 256 + 16 * q) * 64 + p;
        xp[0] = pk2(cr, ci);
#pragma unroll
        for (int i = 1; i < 16; ++i) { const float nr = lm[0] * cr - lm[1] * ci, ni = lm[0] * ci + lm[1] * cr; cr = nr; ci = ni; xp[i * 64] = pk2(cr + loc[i - 1][0], ci + loc[i - 1][1]); }
    }
    __syncthreads();
}
#if NAIVE_SSM
__device__ __forceinline__ void ph_ssm_naive(const Ctx& F, int l, const Inputs& I) {
    if (F.vcu < 32) { const int g = F.vcu; LAS f32x2* xs = (LAS f32x2*)(F.lds + RING_OFF); LAS float* us = (LAS float*)(xs + 64);
        float br[16], bi[16], abr = 0.f, abi = 0.f, xr = 0.f, xi = 0.f, cr[64], ci[64], dsk = 0.f;
        if (F.tid < 64) { const int p = F.tid; const float lr = I.ptr(16)[(l * 32 + g) * 64 + p], li = I.ptr(17)[(l * 32 + g) * 64 + p]; const float dt = expf(I.ptr(18)[l * 32 + g]);
            float s1, c1; sincos_d((double)li * (double)dt, s1, c1); const float mg1 = expf(lr * dt); abr = mg1 * c1; abi = mg1 * s1; const float den = lr * lr + li * li;
            const float fr_ = ((abr - 1.f) * lr + abi * li) / den, fi_ = (abi * lr - (abr - 1.f) * li) / den;
#pragma unroll
            for (int h = 0; h < 16; ++h) { const float b_r = I.ptr(19)[((size_t)(l * 32 + g) * 64 + p) * 16 + h], b_i = I.ptr(20)[((size_t)(l * 32 + g) * 64 + p) * 16 + h]; br[h] = fr_ * b_r - fi_ * b_i; bi[h] = fr_ * b_i + fi_ * b_r; } }
        if (F.tid < 16) { const int h = F.tid;
#pragma unroll
            for (int p = 0; p < 64; ++p) { cr[p] = I.ptr(21)[((size_t)(l * 32 + g) * 16 + h) * 64 + p]; ci[p] = I.ptr(22)[((size_t)(l * 32 + g) * 16 + h) * 64 + p]; }
            dsk = I.ptr(23)[(l * 32 + g) * 16 + h]; }
        const bf16_t* UC = (const bf16_t*)(F.ws + WS_UC) + (size_t)g * 256 * 512;
#pragma unroll 1
        for (int t = 0; t < T; ++t) {
            if (F.tid < 16) us[F.tid] = bf2f(UC[(size_t)(t >> 5) * 512 + (t & 31) * 16 + F.tid]);
            __syncthreads();
            if (F.tid < 64) { float ar = 0.f, ai = 0.f;
#pragma unroll
                for (int h = 0; h < 16; ++h) { ar += br[h] * us[h]; ai += bi[h] * us[h]; }
                const float nr = abr * xr - abi * xi + ar, ni = abr * xi + abi * xr + ai; xr = nr; xi = ni; xs[F.tid] = (f32x2){xr, xi}; }
            __syncthreads();
            if (F.tid < 16) { float y = dsk * us[F.tid];
#pragma unroll
                for (int p = 0; p < 64; ++p) { const f32x2 x = xs[p]; y += cr[p] * x[0] - ci[p] * x[1]; }
                ((bf16_t*)(F.ws + WS_YS))[(size_t)t * 512 + g * 16 + F.tid] = (bf16_t)f2bf(y); }
        }
        __syncthreads();
    }
}
#endif
__device__ __forceinline__ void ph_diff(const Ctx& F, int l, const Inputs& I) {
    const float lam_init = 0.8f - 0.6f * expf(-0.3f * (float)l);
    const float d1 = wave_sum(I.ptr(5)[l * 64 + F.lane] * I.ptr(6)[l * 64 + F.lane]), d2 = wave_sum(I.ptr(7)[l * 64 + F.lane] * I.ptr(8)[l * 64 + F.lane]);
    const float lam = expf(d1) - expf(d2) + lam_init, post = 1.f - lam_init;
    float hn[16];
#pragma unroll
    for (int i = 0; i < 16; ++i) hn[i] = I.ptr(9)[l * 128 + (F.lane & 7) * 16 + i] * post;
    for (int row = F.gw; row < T; row += F.NGW) {
        const u32x4* a = (const u32x4*)(F.ws + WS_O1 + (size_t)row * 2048) + F.lane * 2; const u32x4* b = (const u32x4*)(F.ws + WS_O2 + (size_t)row * 2048) + F.lane * 2;
        float d[16]; float ss = 0.f;
#pragma unroll
        for (int q = 0; q < 2; ++q) { const u32x4 x = a[q], y = b[q];
            d[q * 8 + 0] = bflo(x.x) - lam * bflo(y.x); d[q * 8 + 1] = bfhi(x.x) - lam * bfhi(y.x); d[q * 8 + 2] = bflo(x.y) - lam * bflo(y.y); d[q * 8 + 3] = bfhi(x.y) - lam * bfhi(y.y);
            d[q * 8 + 4] = bflo(x.z) - lam * bflo(y.z); d[q * 8 + 5] = bfhi(x.z) - lam * bfhi(y.z); d[q * 8 + 6] = bflo(x.w) - lam * bflo(y.w); d[q * 8 + 7] = bfhi(x.w) - lam * bfhi(y.w); }
#pragma unroll
        for (int i = 0; i < 16; ++i) ss += d[i] * d[i];
        ss += xor_lane<1>(ss); ss += xor_lane<2>(ss); ss += xor_lane<4>(ss);
        const float rstd = rsqrtf(ss * (1.f / 128.f) + HEAD_EPS);
        u32x4* o = (u32x4*)(F.ws + WS_OAN + (size_t)row * 2048) + F.lane * 2;
#pragma unroll
        for (int q = 0; q < 2; ++q) { u32x4 w; w.x = pk2(d[q * 8 + 0] * rstd * hn[q * 8 + 0], d[q * 8 + 1] * rstd * hn[q * 8 + 1]); w.y = pk2(d[q * 8 + 2] * rstd * hn[q * 8 + 2], d[q * 8 + 3] * rstd * hn[q * 8 + 3]);
            w.z = pk2(d[q * 8 + 4] * rstd * hn[q * 8 + 4], d[q * 8 + 5] * rstd * hn[q * 8 + 5]); w.w = pk2(d[q * 8 + 6] * rstd * hn[q * 8 + 6], d[q * 8 + 7] * rstd * hn[q * 8 + 7]); o[q] = w; }
    }
}
__device__ __forceinline__ void ph_norm3_router(const Ctx& F, int l, const Inputs& I, const bool commit = true) {
    const char* X = (const char*)(F.ws + WS_X); LAS float* part = (LAS float*)(F.lds + RING_OFF);
    const char* RT = (const char*)lwp(F, l, LW_RT);
    for (int run = F.vcu; run < T / 32; run += F.G) {
        const int r0 = run * 32;
        int ln = F.lane; asm volatile("" : "+v"(ln));
        const int fr = ln & 15, fq = ln >> 4;
        const unsigned lo16 = (unsigned)ln * 16u;
        f32x4 acc[2][2];
#pragma unroll
        for (int m = 0; m < 2; ++m)
#pragma unroll
            for (int n = 0; n < 2; ++n) acc[m][n] = (f32x4){0.f, 0.f, 0.f, 0.f};
        {
            const char* xa = X + (size_t)(r0 + fr) * (DM * 2) + (unsigned)((F.wave * 256 + fq * 8) * 2);
            const char* wa = RT + (size_t)fr * (DM * 2) + (unsigned)((F.wave * 256 + fq * 8) * 2);
            const char* wb = RT + (size_t)(16 + (fr & 3)) * (DM * 2) + (unsigned)((F.wave * 256 + fq * 8) * 2);
#pragma unroll 4
            for (int ks = 0; ks < 8; ++ks) {
                const bf16x8 x0 = *(const bf16x8*)(xa + ks * 64), x1 = *(const bf16x8*)(xa + 16 * DM * 2 + ks * 64);
                const bf16x8 ha = *(const bf16x8*)(wa + ks * 64), la = *(const bf16x8*)(wa + 20 * DM * 2 + ks * 64), hb = *(const bf16x8*)(wb + ks * 64), lb = *(const bf16x8*)(wb + 20 * DM * 2 + ks * 64);
                acc[0][0] = __builtin_amdgcn_mfma_f32_16x16x32_bf16(ha, x0, acc[0][0], 0, 0, 0); acc[1][0] = __builtin_amdgcn_mfma_f32_16x16x32_bf16(ha, x1, acc[1][0], 0, 0, 0);
                acc[0][1] = __builtin_amdgcn_mfma_f32_16x16x32_bf16(hb, x0, acc[0][1], 0, 0, 0); acc[1][1] = __builtin_amdgcn_mfma_f32_16x16x32_bf16(hb, x1, acc[1][1], 0, 0, 0);
                acc[0][0] = __builtin_amdgcn_mfma_f32_16x16x32_bf16(la, x0, acc[0][0], 0, 0, 0); acc[1][0] = __builtin_amdgcn_mfma_f32_16x16x32_bf16(la, x1, acc[1][0], 0, 0, 0);
                acc[0][1] = __builtin_amdgcn_mfma_f32_16x16x32_bf16(lb, x0, acc[0][1], 0, 0, 0); acc[1][1] = __builtin_amdgcn_mfma_f32_16x16x32_bf16(lb, x1, acc[1][1], 0, 0, 0);
            }
        }
        __syncthreads();
#pragma unroll
        for (int m = 0; m < 2; ++m) { LAS float* pw = part + ((F.wave * 32 + 16 * m + fr) * 24);
            *(LAS f32x4*)(pw + 4 * fq) = acc[m][0]; if (fq == 0) *(LAS f32x4*)(pw + 16) = acc[m][1]; }
        __syncthreads();
        u32x2 xb[4][8];
#pragma unroll
        for (int rr = 0; rr < 4; ++rr)
#pragma unroll
            for (int j = 0; j < 8; ++j) xb[rr][j] = *(const u32x2*)(X + (size_t)(r0 + F.wave * 4 + rr) * (DM * 2) + 512 * j + (lo16 >> 1));
#pragma unroll
        for (int rr = 0; rr < 4; ++rr) { const int rl = F.wave * 4 + rr, row = r0 + rl;
            float lgv = 0.f;
            if (ln < 20) {
#pragma unroll
                for (int w = 0; w < 8; ++w) lgv += part[(w * 32 + rl) * 24 + ln]; }
            f32x4 v[8]; float ss = 0.f;
#pragma unroll
            for (int j = 0; j < 8; ++j) { v[j] = (f32x4){bflo(xb[rr][j].x), bfhi(xb[rr][j].x), bflo(xb[rr][j].y), bfhi(xb[rr][j].y)}; ss += (v[j][0] * v[j][0] + v[j][1] * v[j][1]) + (v[j][2] * v[j][2] + v[j][3] * v[j][3]); }
            const float rstd = rsqrtf(wave_sum(ss) * (1.f / DM) + RMS_EPS);
            float lg[20];
#pragma unroll
            for (int j = 0; j < 20; ++j) lg[j] = __builtin_bit_cast(float, __builtin_amdgcn_readlane(__builtin_bit_cast(int, lgv), j));
            float gl[4], el[16];
#pragma unroll
            for (int i = 0; i < 4; ++i) gl[i] = lg[i] * rstd + I.ptr(35)[l * 4 + i];
#pragma unroll
            for (int i = 0; i < 16; ++i) el[i] = lg[4 + i] * rstd + I.ptr(37)[l * 16 + i];
            int gi = 0; float gm = gl[0];
#pragma unroll
            for (int i = 1; i < 4; ++i) if (gl[i] > gm) { gm = gl[i]; gi = i; }
            float gs = 0.f;
#pragma unroll
            for (int i = 0; i < 4; ++i) gs += expf(gl[i] - gm);
            const float gw_ = 1.f / gs;
            float sel[4];
#pragma unroll
            for (int i = 0; i < 4; ++i) sel[i] = gi == 0 ? el[i] : gi == 1 ? el[4 + i] : gi == 2 ? el[8 + i] : el[12 + i];
            int i0 = 0; float v0 = sel[0];
#pragma unroll
            for (int i = 1; i < 4; ++i) if (sel[i] > v0) { v0 = sel[i]; i0 = i; }
            int i1 = -1; float v1 = -INFINITY;
#pragma unroll
            for (int i = 0; i < 4; ++i) if (i != i0 && sel[i] > v1) { v1 = sel[i]; i1 = i; }
            const float w0 = gw_ / (1.f + expf(v1 - v0)), w1 = gw_ - w0;
            const int e0 = gi * 4 + i0, e1 = gi * 4 + i1;
            if (F.lane == 0 && commit) {
                const int s0 = (int)__hip_atomic_fetch_add(F.ctl + CW_CNT + (l * 16 + e0) * 16, 1u, RLX_AGENT), s1 = (int)__hip_atomic_fetch_add(F.ctl + CW_CNT + (l * 16 + e1) * 16, 1u, RLX_AGENT);
                ((int*)(F.ws + WS_LIST))[e0 * T + s0] = row; ((float*)(F.ws + WS_WL))[e0 * T + s0] = w0;
                ((int*)(F.ws + WS_LIST))[e1 * T + s1] = row; ((float*)(F.ws + WS_WL))[e1 * T + s1] = w1;
                *(int4*)(F.ws + WS_TOK + (size_t)row * 16) = make_int4(e0, s0, e1, s1); }
            const char* gr = (const char*)(I.ptr(33) + (size_t)l * DM); char* o = (char*)(F.ws + WS_H8 + (size_t)row * DM);
#pragma unroll
            for (int j = 0; j < 8; ++j) { const f32x4 g = *(const f32x4*)(gr + 1024 * j + lo16);
                int p8 = __builtin_amdgcn_cvt_pk_fp8_f32(v[j][0] * rstd * g[0], v[j][1] * rstd * g[1], 0, false); p8 = __builtin_amdgcn_cvt_pk_fp8_f32(v[j][2] * rstd * g[2], v[j][3] * rstd * g[3], p8, true); *(unsigned*)(o + 256 * j + (lo16 >> 2)) = (unsigned)p8; }
        }
    }
    __syncthreads();
}
namespace pg8 {
struct SchedKV { unsigned char* ws; int G, c; static constexpr bool GATHER = false;
    __device__ __forceinline__ bool next(int i, GU& u) const { const int L = i * G + c; if (L >= 16) return false; const int l = L >> 2, pn = L & 3;
        u.A = (const char*)ws + WS_MNORM + (size_t)l * MEML * DM * 2; u.B = (const char*)ws + WS_WKVT + (size_t)l * 1024 * DM * 2 + (size_t)pn * 256 * 4096; u.C = (char*)ws + WS_KVB + (size_t)l * MEML * 2048 + pn * 512; u.P = nullptr;
        u.lda = 4096; u.ldb = 4096; u.nt = 32; u.pm = 0; u.pn = pn; u.seg = 0; u.flags = GU_LAST; u.rows = 256; u.aux = __builtin_bit_cast(int, 1.0f); u.f8 = 0; return true; }
    __device__ __forceinline__ unsigned arow(const GU& u, int r) const { return (unsigned)(r * u.lda); } };
struct SchedAbsorb { unsigned char* ws; int G, c; static constexpr bool GATHER = false;
    __device__ __forceinline__ bool next(int i, GU& u) const { const int L = i * G + c; if (L >= 256) return false; const int w = L & 127, l = w >> 5, h = (w >> 3) & 3, t = w & 7;
        unsigned char* lw = ws + WS_LW + (size_t)l * LW_SIZE; const char* kvb = (const char*)ws + WS_KVB + (size_t)l * MEML * 2048;
        int two = 2; asm volatile("" : "+s"(two));
        u.P = nullptr; u.nt = two; u.pm = 0; u.pn = 0; u.seg = 0; u.flags = GU_LAST; u.rows = 256;
        if (L < 128) { u.A = kvb + h * 256; u.lda = 2048; u.B = (const char*)ws + WS_WQB + (size_t)l * DM * 1024 + (size_t)t * 256 * 1024 + h * 256; u.ldb = 1024;
            u.C = (char*)lw + LW_WQK + (size_t)(h * 256) * (S_FP8 ? 2048 : 4096) + t * (S_FP8 ? 256 : 512); u.aux = __builtin_bit_cast(int, C2X * SQK_SCALE); u.f8 = 0; u.seg = S_FP8; }
        else { u.A = (const char*)ws + WS_WXOT + (size_t)l * DM * 1024 + (size_t)t * 256 * 1024 + h * 256; u.lda = 1024; u.B = kvb + 1024 + h * 256; u.ldb = 2048;
            u.C = (char*)lw + LW_VW + (size_t)(t * 256) * (XAO_FP8 ? 1024 : 2048) + h * (XAO_FP8 ? 256 : 512); u.aux = __builtin_bit_cast(int, VW_SCALE); u.f8 = 0; u.seg = XAO_FP8; }
        u.pm = (L < 128) ? (S_FP8 ? 2048 : 4096) : (XAO_FP8 ? 1024 : 2048);
        return true; }
    __device__ __forceinline__ unsigned arow(const GU& u, int r) const { return (unsigned)(r * u.lda); } };
struct EpiStoreP {
    __device__ __forceinline__ void operator()(Acc& acc, const GU& u, int wr, int wc, int fr, int fq) const {
        const float sc = __builtin_bit_cast(float, u.aux);
        if (u.seg) { EPI_ROWS( { char* rp = u.C + (unsigned)(lrow * u.pm); EPI_COLS( { int q0 = __builtin_amdgcn_cvt_pk_fp8_f32(v0[0] * sc, v0[1] * sc, 0, false); q0 = __builtin_amdgcn_cvt_pk_fp8_f32(v0[2] * sc, v0[3] * sc, q0, true);
                int q1 = __builtin_amdgcn_cvt_pk_fp8_f32(v1[0] * sc, v1[1] * sc, 0, false); q1 = __builtin_amdgcn_cvt_pk_fp8_f32(v1[2] * sc, v1[3] * sc, q1, true); *(u32x2*)(rp + lcol) = (u32x2){(unsigned)q0, (unsigned)q1}; } ) } ) }
        else { EPI_ROWS( { char* rp = u.C + (unsigned)(lrow * u.pm); EPI_COLS( st8(rp + lcol * 2, v0 * sc, v1 * sc); ) } ) }
    } };
struct SchedSsm1 { unsigned char* ws; unsigned char* lw; int G, c; static constexpr bool GATHER = false;
    __device__ __forceinline__ bool next(int i, GU& u) const { const int g = i * G + c; if (g >= 32) return false;
        u.A = (const char*)ws + WS_UC + (size_t)g * 256 * 1024; u.lda = 1024; u.B = (const char*)lw + LW_F + (size_t)g * 128 * 1024; u.ldb = 1024; u.C = (char*)ws + WS_SS + g * 512; u.P = nullptr;
        u.nt = 8; u.pm = 0; u.pn = g; u.seg = 0; u.flags = GU_LAST; u.rows = 256; u.aux = 0; u.f8 = 0; return true; }
    __device__ __forceinline__ unsigned arow(const GU& u, int r) const { return (unsigned)(r * u.lda); } };
struct SchedSsm3 { unsigned char* ws; unsigned char* lw; int G, c; static constexpr bool GATHER = false;
    __device__ __forceinline__ bool next(int i, GU& u) const { const int ti = i >> 1, sg = i & 1, L = ti * G + c; if (L >= 64) return false; const int g = L >> 1, pn = L & 1;
        const char* b = (const char*)lw + LW_BKE + (size_t)g * 512 * 1280 + (size_t)pn * 256 * 1280;
        if (sg == 0) { u.A = (const char*)ws + WS_UC + (size_t)g * 256 * 1024; u.lda = 1024; u.B = b; u.nt = 8; }
        else { u.A = (const char*)ws + WS_XP + (size_t)g * 256 * 256; u.lda = 256; u.B = b + 1024; u.nt = 2; }
        u.ldb = 1280; u.C = nullptr; u.P = nullptr; u.pm = g; u.pn = pn; u.seg = sg; u.flags = sg ? GU_LAST : 0; u.rows = 256; u.aux = 0; u.f8 = 0; return true; }
    __device__ __forceinline__ unsigned arow(const GU& u, int r) const { return (unsigned)(r * u.lda); } };
}

constexpr int PH_PRO_A = 0, PH_PRO_B = 1, PH_PRO_C = 2, PH_L0 = 3, NPL = 15, PH_FINAL = PH_L0 + NL * NPL, NPHASES = PH_FINAL + 1;
constexpr int INTAB_OFF = LDSCTL_OFF + 1024;
struct Args { const float* in[42]; float* out; unsigned char* ws; int ph_lo, ph_hi; };
#define LAUNDER_S(x) asm volatile("" : "+s"(x))
#define MKCTX() Ctx F; { unsigned char* w_ = args.ws; LAUNDER_S(w_); F.ws = w_; F.lds = (LAS unsigned char*)lds_raw; F.ctl = (gu32*)(w_ + WS_CTL); \
    F.tid = tid_of(wave_s); F.lane = F.tid & 63; F.wave = __builtin_amdgcn_readfirstlane(F.tid >> 6); \
    int g_ = gridDim.x; LAUNDER_S(g_); F.G = g_; { int bx_ = blockIdx.x; LAUNDER_S(bx_); F.vcu = (g_ % 8 == 0) ? (bx_ % 8) * (g_ / 8) + bx_ / 8 : bx_; } \
    F.gw = F.vcu * NWAVES + F.wave; F.NGW = F.G * NWAVES; } \
    unsigned char* const ws = F.ws; (void)ws; const Inputs I{(const LAS unsigned*)(F.lds + INTAB_OFF)}; (void)I; int bx = blockIdx.x; LAUNDER_S(bx);
#if MK_PER_PHASE
#define GRID_BAR() do { } while (0)
#else
#define GRID_BAR() do { unsigned char* w_ = args.ws; LAUNDER_S(w_); XcdBarrier bar_; bar_.bar = (unsigned*)((gu32*)(w_ + WS_CTL) + CW_BAR); bar_.x = xb_xcc_id(); \
        bar_.st = (volatile LAS unsigned*)((LAS unsigned char*)lds_raw + MISC_OFF) + 8; xcd_barrier(bar_); } while (0)
#endif
#define IN(k) (lo <= (k) && (k) < hi)
#define SEAM(k) do { if (IN(k) && IN((k) + 1)) GRID_BAR(); } while (0)
#ifndef ONLY_LPH
#define ONLY_LPH -1
#endif
#define LPH_ON(j) (ONLY_LPH < 0 || ONLY_LPH == (j))
#ifndef DBG_DUP_MASK
#define DBG_DUP_MASK 0
#endif
#define NREP(j) (1 + ((DBG_DUP_MASK >> (j)) & 1))
#define INL(j) (LPH_ON(j) && lo <= (P0 + (j)) && (P0 + (j)) < hi)
#define SEAML(j) do { if ((lo <= (P0 + (j)) && (P0 + (j)) < hi) && (lo <= (P0 + (j) + 1) && (P0 + (j) + 1) < hi)) GRID_BAR(); } while (0)
template <int l> __device__ __forceinline__ void run_layer(const Args& args, unsigned char* lds_raw, const int lo, const int hi, const int wave_s) {
        const int P0 = PH_L0 + l * NPL;
#define LW() (ws + WS_LW + (size_t)l * LW_SIZE)
        if (INL(0)) for (int rep_ = 0; rep_ < NREP(0); ++rep_) { MKCTX(); ph_norm1(F, l, I.ptr(0), I.ptr(3) + (size_t)l * DM, nullptr); } SEAML(0);
        if (INL(1)) for (int rep_ = 0; rep_ < NREP(1); ++rep_) { MKCTX(); pg8::EpiProj E{(char*)ws, (const float*)(ws + WS_ROPE), (const float*)(ws + WS_ROPE) + T * 32, (const float*)(ws + WS_RSTD)};
            { pg8::SchedProj<false> S{ws, LW(), F.G, bx}; pg8::gemm_phase<pg8::EpiProj, pg8::SchedProj<false>, false>(F.lds + RING_OFF, S, E, F.tid); }
            { pg8::SchedProj<true> S{ws, LW(), F.G, bx}; pg8::gemm_phase<pg8::EpiProj, pg8::SchedProj<true>, true>(F.lds + RING_OFF, S, E, F.tid); } } SEAML(1);
#if NAIVE_SSM
        if (INL(2)) for (int rep_ = 0; rep_ < NREP(2); ++rep_) { MKCTX(); ph_conv(F, I.ptr(11) + (size_t)l * 31 * 512, I.ptr(12) + l * 512, I.ptr(13) + l * 512, I.ptr(14) + l * 512); ph_ssm_naive(F, l, I); } SEAML(2);
        SEAML(3); SEAML(4);
#else
        if (INL(2)) for (int rep_ = 0; rep_ < NREP(2); ++rep_) { MKCTX(); ph_conv(F, I.ptr(11) + (size_t)l * 31 * 512, I.ptr(12) + l * 512, I.ptr(13) + l * 512, I.ptr(14) + l * 512);
            pg8::SchedSsm1 S{ws, LW(), F.G, bx}; pg8::EpiStoreF32 E{16384}; pg8::gemm_phase(F.lds + RING_OFF, S, E, F.tid);
            if (DEFER_CONV && l + 1 < NL && F.G == 256 && bx >= 32) conv_window(F, I, l + 1, 0, (bx - 32) * NWAVES + F.wave, 2); } SEAML(2);
        if (INL(3)) for (int rep_ = 0; rep_ < NREP(3); ++rep_) { MKCTX(); ph_ssm2(F, l);
            if (DEFER_CONV && l + 1 < NL && F.G == 256 && F.vcu >= 64) conv_window(F, I, l + 1, 3584, (F.vcu - 64) * NWAVES + F.wave, 1); } SEAML(3);
#endif
        if (INL(5)) for (int rep_ = 0; rep_ < NREP(5); ++rep_) { MKCTX(); { pg8::SchedSsm3 S{ws, LW(), F.G, bx}; pg8::EpiSsm3 E{(char*)ws + WS_YS}; pg8::gemm_phase(F.lds + RING_OFF, S, E, F.tid);
            if (DEFER_CONV && l + 1 < NL && F.G == 256 && bx >= 64) conv_window(F, I, l + 1, 5120, (bx - 64) * NWAVES + F.wave, 2); }
            (ATTN128 && !NAIVE_ATTN ? attn128::attn_phase : attn_body::attn_phase)((char*)lds_raw + RING_OFF, (const bf16_t*)(ws + WS_Q), (const bf16_t*)(ws + WS_K), (const bf16_t*)(ws + WS_V), (bf16_t*)(ws + WS_O1), (bf16_t*)(ws + WS_O2), F.vcu, F.G, F.tid); } SEAML(5);
        if (INL(6)) for (int rep_ = 0; rep_ < NREP(6); ++rep_) { MKCTX(); ph_diff(F, l, I); __syncthreads();
            pg8::SchedDense S{(const char*)ws + WS_YS, (const char*)LW() + LW_WGLU, 1024, 1024, 8, 32, 4, F.G, bx}; pg8::EpiGlu E{(char*)ws + WS_GLUO, I.ptr(25) + (size_t)l * 1024}; pg8::gemm_phase(F.lds + RING_OFF, S, E, F.tid);
            if (DEFER_CONV && l + 1 < NL && F.G == 256 && bx >= 128) conv_window(F, I, l + 1, 8192, (bx - 128) * NWAVES + F.wave, 2); } SEAML(6);
        if (INL(7)) for (int rep_ = 0; rep_ < NREP(7); ++rep_) { MKCTX(); pg8::SchedSeg<0> S{ws, LW(), F.G, bx}; pg8::EpiGated E{(const char*)ws + WS_GATES, (char*)ws + WS_MERGED}; pg8::gemm_phase(F.lds + RING_OFF, S, E, F.tid); } SEAML(7);
        if (INL(8)) for (int rep_ = 0; rep_ < NREP(8); ++rep_) { MKCTX(); pg8::SchedDense S{(const char*)ws + WS_MERGED, (const char*)LW() + LW_WMIX, 4096, 4096, 32, 32, 8, F.G, bx}; pg8::EpiResid E{(char*)ws + WS_X, (char*)ws + ((S_FP8 || !FUSE_N2) ? WS_H8 : WS_H), (float*)(ws + WS_RSQ)}; pg8::gemm_phase(F.lds + RING_OFF, S, E, F.tid); } SEAML(8);
#ifdef DBG_EXTRA_BAR
        if (INL(9)) GRID_BAR();
#endif
#if !FUSE_N2
        if (INL(9)) for (int rep_ = 0; rep_ < NREP(9); ++rep_) { MKCTX(); ph_norm2(F, I.ptr(28) + (size_t)l * DM); } SEAML(9);
#endif
        if (INL(10)) for (int rep_ = 0; rep_ < NREP(10); ++rep_) { MKCTX(); pg8::SchedDense S{(const char*)ws + (S_FP8 ? WS_H8 : WS_H), (const char*)LW() + LW_WQK, S_FP8 ? 2048 : 4096, S_FP8 ? 2048 : 4096, S_FP8 ? 16 : 32, 32, 4, F.G, bx}; pg8::EpiSexp E{(char*)ws + WS_P, (float*)(ws + WS_RS), (const float*)(ws + WS_RSQ)}; pg8::gemm_phase<pg8::EpiSexp, pg8::SchedDense, S_FP8 != 0>(F.lds + RING_OFF, S, E, F.tid);
            if (DEFER_CONV && l + 1 < NL && F.G == 256 && bx >= 128) conv_window(F, I, l + 1, 10240, (bx - 128) * NWAVES + F.wave, 6); } SEAML(10);
        if (INL(11)) for (int rep_ = 0; rep_ < NREP(11); ++rep_) { MKCTX(); pg8::SchedSeg<1> S{ws, LW(), F.G, bx}; pg8::EpiXao E{(const float*)(ws + WS_RS), (char*)ws + WS_X}; pg8::gemm_phase<pg8::EpiXao, pg8::SchedSeg<1>, XAO_FP8 != 0>(F.lds + RING_OFF, S, E, F.tid); } SEAML(11);
        if (INL(12)) for (int rep_ = 0; rep_ < NREP(12); ++rep_) { MKCTX(); ph_norm3_router(F, l, I, rep_ == NREP(12) - 1); } SEAML(12);
        if (INL(13)) for (int rep_ = 0; rep_ < NREP(13); ++rep_) { MKCTX(); volatile LAS unsigned* MISC = (volatile LAS unsigned*)(F.lds + MISC_OFF);
            if (F.tid < 16) MISC[16 + F.tid] = __hip_atomic_load(F.ctl + CW_CNT + (l * 16 + F.tid) * 16, RLX_AGENT);
            __syncthreads();
            pg8::SchedMoE<false> S{(const volatile LAS int*)(MISC + 16), ws, LW(), F.G, bx}; pg8::EpiGu E{}; pg8::gemm_phase<pg8::EpiGu, pg8::SchedMoE<false>, true>(F.lds + RING_OFF, S, E, F.tid);
            if (DEFER_CONV && l + 1 < NL && F.G == 256 && bx >= 64) conv_window(F, I, l + 1, 16384, (bx - 64) * NWAVES + F.wave, 3); } SEAML(13);
        if (INL(14)) for (int rep_ = 0; rep_ < NREP(14); ++rep_) { MKCTX(); volatile LAS unsigned* MISC = (volatile LAS unsigned*)(F.lds + MISC_OFF);
            if (F.tid < 16) MISC[16 + F.tid] = __hip_atomic_load(F.ctl + CW_CNT + (l * 16 + F.tid) * 16, RLX_AGENT);
            __syncthreads();
            pg8::SchedMoE<true> S{(const volatile LAS int*)(MISC + 16), ws, LW(), F.G, bx}; pg8::EpiDown E{}; pg8::gemm_phase<pg8::EpiDown, pg8::SchedMoE<true>, true>(F.lds + RING_OFF, S, E, F.tid); } SEAML(14);
#undef LW
}
__global__ void __launch_bounds__(NWAVES * 64, 2) mk_fwd(Args args) {
    extern __shared__ __attribute__((aligned(16))) unsigned char lds_raw[];
    const int wave_s = __builtin_amdgcn_readfirstlane((int)threadIdx.x >> 6);
    {   LAS unsigned char* l0 = (LAS unsigned char*)lds_raw;
        for (int u = threadIdx.x; u < (LDS_BYTES - LDSCTL_OFF) / 4; u += NWAVES * 64) ((LAS unsigned*)(l0 + LDSCTL_OFF))[u] = 0u;
        __syncthreads();
        if (threadIdx.x < 84) { const unsigned* ka = (const unsigned*)__builtin_amdgcn_kernarg_segment_ptr(); ((LAS unsigned*)(l0 + INTAB_OFF))[threadIdx.x] = ka[threadIdx.x]; }
        __syncthreads(); }
#if !MK_PER_PHASE
    {   unsigned char* w_ = args.ws; LAUNDER_S(w_); (void)xcd_barrier_post((unsigned*)((gu32*)(w_ + WS_CTL) + CW_BAR), (volatile LAS unsigned*)((LAS unsigned char*)lds_raw + MISC_OFF) + 8); }
#endif
    const int lo = args.ph_lo, hi = args.ph_hi;

    if ((ONLY_LPH < 0 || ONLY_LPH == 100) && IN(PH_PRO_A)) for (int rep_ = 0; rep_ < NREP(20); ++rep_) { MKCTX(); ph_prologue_a(F, I); } SEAM(PH_PRO_A);
    if ((ONLY_LPH < 0 || ONLY_LPH == 101) && IN(PH_PRO_B)) { MKCTX(); pg8::SchedKV S{ws, F.G, bx}; pg8::EpiStore E{2048, 2}; pg8::gemm_phase(F.lds + RING_OFF, S, E, F.tid);
        if (DEFER_CONV && F.G == 256 && bx >= 16) { for (int it = (bx - 16) * NWAVES + F.wave; it < IT_EXP; it += 240 * NWAVES) conv_item(F, I, 0, IT_EARLY + it); } } SEAM(PH_PRO_B);
    if ((ONLY_LPH < 0 || ONLY_LPH == 102) && IN(PH_PRO_C)) { MKCTX(); pg8::SchedAbsorb S{ws, F.G, bx}; pg8::EpiStoreP E{}; pg8::gemm_phase(F.lds + RING_OFF, S, E, F.tid); } SEAM(PH_PRO_C);

    run_layer<0>(args, lds_raw, lo, hi, wave_s); run_layer<1>(args, lds_raw, lo, hi, wave_s); run_layer<2>(args, lds_raw, lo, hi, wave_s); run_layer<3>(args, lds_raw, lo, hi, wave_s);
    if ((ONLY_LPH < 0 || ONLY_LPH == 103) && IN(PH_FINAL)) { MKCTX(); float* outp = args.out; ph_norm1(F, NL, I.ptr(0), I.ptr(41), outp); }
}

extern "C" void kernel_launch(void* const* d_in, const int* in_sizes, int n_in, void* d_out, int out_size, void* d_ws, size_t ws_size, hipStream_t stream) {
    static int grid = 0;
    if (grid == 0) {
        if (n_in != 42 || out_size != T * DM || ws_size < WS_END) { fprintf(stderr, "kernel_launch: unexpected problem shape / workspace (%d inputs, out %d, ws %zu < %zu); nothing launched\n", n_in, out_size, ws_size, (size_t)WS_END); grid = -1; return; }
        int dev = 0, cus = 0, per_cu = 0;
        if (hipGetDevice(&dev) != hipSuccess || hipDeviceGetAttribute(&cus, hipDeviceAttributeMultiprocessorCount, dev) != hipSuccess) { grid = -1; return; }
        if (hipFuncSetAttribute((const void*)mk_fwd, hipFuncAttributeMaxDynamicSharedMemorySize, LDS_BYTES) != hipSuccess) { fprintf(stderr, "kernel_launch: hipFuncSetAttribute failed\n"); grid = -1; return; }
        if (hipOccupancyMaxActiveBlocksPerMultiprocessor(&per_cu, (const void*)mk_fwd, NWAVES * 64, LDS_BYTES) != hipSuccess || per_cu < 1) { fprintf(stderr, "kernel_launch: occupancy query says %d workgroups per CU\n", per_cu); }
        (void)hipGetLastError();
        grid = cus;
    }
    if (grid < 0) return;
    if (hipMemsetAsync((char*)d_ws + WS_CTL, 0, CTL_ZERO_BYTES, stream) != hipSuccess) return;
    Args a{};
    for (int i = 0; i < 42; ++i) a.in[i] = (const float*)d_in[i];
    a.out = (float*)d_out; a.ws = (unsigned char*)d_ws;
#if MK_PER_PHASE
    for (int ph = 0; ph < NPHASES; ++ph) { a.ph_lo = ph; a.ph_hi = ph + 1; hipLaunchKernelGGL(mk_fwd, dim3(grid), dim3(NWAVES * 64), LDS_BYTES, stream, a); }
#else
    a.ph_lo = 0; a.ph_hi = NPHASES;
    hipLaunchKernelGGL(mk_fwd, dim3(grid), dim3(NWAVES * 64), LDS_BYTES, stream, a);
#endif
}
```

```cpp
#include <hip/hip_runtime.h>
#include <cstdio>
#include <cstdint>
#include <cmath>

#ifndef NAIVE_GEMM
#define NAIVE_GEMM 0
#endif
#ifndef NAIVE_ATTN
#define NAIVE_ATTN 0
#endif
#ifndef NAIVE_SSM
#define NAIVE_SSM 0
#endif
#ifndef MK_PER_PHASE
#define MK_PER_PHASE 0
#endif

#define GAS __attribute__((address_space(1)))
#define LAS __attribute__((address_space(3)))
typedef unsigned short bf16_t;
typedef short bf16x8 __attribute__((ext_vector_type(8)));
typedef float f32x4 __attribute__((ext_vector_type(4)));
typedef float f32x2 __attribute__((ext_vector_type(2)));
typedef unsigned u32x4 __attribute__((ext_vector_type(4)));
typedef unsigned u32x2 __attribute__((ext_vector_type(2)));
typedef GAS unsigned gu32;
#define RLX_AGENT __ATOMIC_RELAXED, __HIP_MEMORY_SCOPE_AGENT
#define LDS_WAIT() asm volatile("s_waitcnt lgkmcnt(0)" ::: "memory")
#define VM_WAIT() asm volatile("s_waitcnt vmcnt(0)" ::: "memory")
__device__ __forceinline__ unsigned f2bf(float f) { unsigned u = __builtin_bit_cast(unsigned, f); return (u + 0x7fffu + ((u >> 16) & 1u)) >> 16; }
__device__ __forceinline__ unsigned pk2(float lo, float hi) { return f2bf(lo) | (f2bf(hi) << 16); }
__device__ __forceinline__ float bflo(unsigned w) { return __builtin_bit_cast(float, w << 16); }
__device__ __forceinline__ float bfhi(unsigned w) { return __builtin_bit_cast(float, w & 0xffff0000u); }
__device__ __forceinline__ float bf2f(bf16_t h) { return __builtin_bit_cast(float, (unsigned)h << 16); }
template <int M> __device__ __forceinline__ float xor_lane(float v) {
    if (M < 32) return __builtin_bit_cast(float, __builtin_amdgcn_ds_swizzle(__builtin_bit_cast(int, v), (M << 10) | 0x1f));
    const auto rr = __builtin_amdgcn_permlane32_swap(__builtin_bit_cast(unsigned, v), __builtin_bit_cast(unsigned, v), false, false);
    return __builtin_bit_cast(float, rr[0] ^ rr[1] ^ __builtin_bit_cast(unsigned, v));
}
__device__ __forceinline__ float wave_sum(float v) {
    v += xor_lane<1>(v); v += xor_lane<2>(v); v += xor_lane<4>(v); v += xor_lane<8>(v); v += xor_lane<16>(v); v += xor_lane<32>(v);
    return v;
}
__device__ __forceinline__ float wave_max(float v) {
    v = fmaxf(v, xor_lane<1>(v)); v = fmaxf(v, xor_lane<2>(v)); v = fmaxf(v, xor_lane<4>(v)); v = fmaxf(v, xor_lane<8>(v)); v = fmaxf(v, xor_lane<16>(v)); v = fmaxf(v, xor_lane<32>(v));
    return v;
}
__device__ __forceinline__ int tid_of(int wave_s) { int ln; asm volatile("v_mbcnt_lo_u32_b32 %0, -1, 0\n\tv_mbcnt_hi_u32_b32 %0, -1, %0" : "=v"(ln)); return (wave_s << 6) | ln; }
__device__ __forceinline__ float sigmoidf_(float x) { return __builtin_amdgcn_rcpf(1.f + __expf(-x)); }

constexpr int T = 8192, DM = 2048, NL = 4, MEML = 256, NPROJ = 10752, NEXP = 16, FFE = 512;
constexpr int NWAVES = 8;
constexpr float RMS_EPS = 1e-6f, HEAD_EPS = 1e-5f, LN_EPS = 1e-5f;
constexpr float C2Q = 0.125f * 1.4426950408889634f;
constexpr float GATE_WSCALE = 128.f;
#ifndef S_FP8
#define S_FP8 1
#endif
#ifndef FUSE_N2
#define FUSE_N2 1
#endif
constexpr float SQK_SCALE = S_FP8 ? 64.f : 1.f;
#ifndef XAO_FP8
#define XAO_FP8 1
#endif
constexpr float VW_SCALE = XAO_FP8 ? 64.f : 1.f;
constexpr float C2X = 0.08838834764831845f * 1.4426950408889634f;
constexpr size_t MiB = 1u << 20;
constexpr size_t WS_CTL = 0, CTL_ZERO_BYTES = 64 * 1024;
constexpr size_t LW_WIN = 0;
constexpr size_t LW_WG8 = LW_WIN + (size_t)3584 * DM * 2;
constexpr size_t LW_WCAT = LW_WG8 + (size_t)7680 * DM;
constexpr size_t LW_WGLU = LW_WCAT + (size_t)DM * DM * 2;
constexpr size_t LW_WMIX = LW_WGLU + (size_t)1024 * 512 * 2;
constexpr size_t LW_WQK = LW_WMIX + (size_t)DM * DM * 2;
constexpr size_t LW_VW = LW_WQK + (size_t)1024 * DM * 2;
constexpr size_t LW_WGU = LW_VW + (size_t)DM * 1024 * 2;
constexpr size_t LW_WD = LW_WGU + (size_t)NEXP * 1024 * DM;
constexpr size_t LW_BKE = LW_WD + (size_t)NEXP * DM * FFE;
constexpr size_t LW_F = LW_BKE + (size_t)32 * 512 * 640 * 2;
constexpr size_t LW_RT = LW_F + (size_t)32 * 128 * 512 * 2;
constexpr size_t LW_LAM = LW_RT + (size_t)20 * DM * 4;
constexpr size_t LW_SIZE = ((LW_LAM + (size_t)32 * 64 * 8 + 4095) / 4096) * 4096;
constexpr size_t WS_LW = 1 * MiB;
constexpr size_t WS_ACT = WS_LW + NL * LW_SIZE;
constexpr size_t WS_X = WS_ACT;
constexpr size_t WS_RSTD = WS_X + (size_t)T * DM * 2;
constexpr size_t WS_H = WS_X + (size_t)T * DM * 4;
constexpr size_t WS_Q = WS_H + (size_t)T * DM * 2;
constexpr size_t WS_K = WS_Q + (size_t)T * 1024 * 2;
constexpr size_t WS_V = WS_K + (size_t)T * 1024 * 2;
constexpr size_t WS_O1 = WS_V + (size_t)T * 1024 * 2;
constexpr size_t WS_O2 = WS_O1 + (size_t)T * 1024 * 2;
constexpr size_t WS_OAN = WS_O2 + (size_t)T * 1024 * 2;
constexpr size_t WS_Z = WS_OAN + (size_t)T * 1024 * 2;
constexpr size_t WS_UC = WS_Z + (size_t)T * 512 * 2;
constexpr size_t WS_GATES = WS_UC + (size_t)T * 512 * 2;
constexpr size_t WS_CVO = WS_GATES + (size_t)T * 6144 * 2;
constexpr size_t WS_SS = WS_CVO + (size_t)T * 512 * 2;
constexpr size_t WS_XP = WS_SS + (size_t)256 * 4096 * 4;
constexpr size_t WS_YS = WS_XP + (size_t)32 * 256 * 128 * 2;
constexpr size_t WS_GLUO = WS_YS + (size_t)T * 512 * 2;
constexpr size_t WS_MERGED = WS_GLUO + (size_t)T * 512 * 2;
constexpr size_t WS_P = WS_MERGED + (size_t)T * DM * 2;
constexpr size_t WS_RS = WS_P + (size_t)T * 1024 * 2;
constexpr size_t WS_HE = WS_RS + (size_t)T * 16 * 4;
constexpr size_t WS_Y = WS_HE + (size_t)(2 * T + 256) * 512 * 2;
constexpr size_t WS_LIST = WS_Y + (size_t)2 * T * DM * 2;
constexpr size_t WS_WL = WS_LIST + (size_t)NEXP * T * 4;
constexpr size_t WS_TOK = WS_WL + (size_t)NEXP * T * 4;
constexpr size_t WS_ROPE = WS_TOK + (size_t)T * 16;
constexpr size_t WS_H8 = WS_ROPE + (size_t)T * 64 * 4;
constexpr size_t WS_RSQ = WS_H8 + (size_t)T * DM;
constexpr size_t WS_END = WS_RSQ + (size_t)T * 32 * 4;
constexpr size_t WS_WQB = WS_GATES;
constexpr size_t WS_WKVT = WS_WQB + (size_t)NL * DM * 512 * 2;
constexpr size_t WS_WXOT = WS_WKVT + (size_t)NL * 1024 * DM * 2;
constexpr size_t WS_MNORM = WS_WXOT + (size_t)NL * DM * 512 * 2;
constexpr size_t WS_KVB = WS_MNORM + (size_t)NL * MEML * DM * 2;
static_assert(WS_KVB + (size_t)NL * MEML * 1024 * 2 <= WS_CVO, "prologue temporaries inside GATES");
static_assert(WS_END < (size_t)1350000000, "workspace plan");
constexpr int CW_TMO = 0, CW_CODE = 1;
constexpr int CW_BAR = 4096;
constexpr int CW_CNT = 8192;
constexpr int RING_OFF = 0, RING_BYTES = 131072;
constexpr int LDSCTL_OFF = RING_BYTES, MISC_OFF = LDSCTL_OFF + 320;
constexpr int LDS_BYTES = 147456;
#define XB_TMO      128
#define XB_XCNT(j)  (256  + 64 * (j))
#define XB_XSUB(j)  (1280 + 64 * (j))
#define XB_XGEN(j)  (2304 + 64 * (j))
#define XB_TOP      3328
#define XB_TOPGEN   3392
#define XCD_BAR_WORDS 3456
#define XB_SPIN_CAP (1u << 24)

__device__ __forceinline__ unsigned xb_ld(unsigned* p)              { return __hip_atomic_load(p, __ATOMIC_RELAXED, __HIP_MEMORY_SCOPE_AGENT); }
__device__ __forceinline__ unsigned xb_add(unsigned* p, unsigned v) { return __hip_atomic_fetch_add(p, v, __ATOMIC_RELAXED, __HIP_MEMORY_SCOPE_AGENT); }
__device__ __forceinline__ unsigned xb_xcc_id() { return (unsigned)__builtin_amdgcn_s_getreg((3 << 11) | 20) & 0xFu; }
#define XB_SPIN(cond, bar) do { unsigned _sp = 0; while (cond) { __builtin_amdgcn_s_sleep(1); \
    if ((++_sp & 255u) == 0u) { if (xb_ld(&(bar)[XB_TMO])) break; if (_sp > XB_SPIN_CAP) { atomicAdd(&(bar)[XB_TMO], 1u); break; } } } } while (0)

struct XcdBarrier {
    unsigned* bar; unsigned x;
    volatile LAS unsigned* st;
};

__device__ __forceinline__ XcdBarrier xcd_barrier_post(unsigned* bar, volatile LAS unsigned* st) {
    XcdBarrier b; b.bar = bar; b.x = xb_xcc_id(); b.st = st;
    if (threadIdx.x == 0) (void)xb_add(&bar[XB_XCNT(b.x)], 1u);
    return b;
}
__device__ __forceinline__ void xcd_barrier_complete(unsigned* bar, unsigned x, unsigned& nloc, unsigned& nx) {
    const unsigned G = gridDim.x * gridDim.y * gridDim.z;
    unsigned sum, cnt, mine, sp = 0u;
    for (;;) {
        sum = 0u; cnt = 0u; mine = 0u;
#pragma unroll
        for (unsigned j = 0; j < 16; ++j) { const unsigned c = xb_ld(&bar[XB_XCNT(j)]); sum += c; cnt += (c > 0u) ? 1u : 0u; mine = (j == x) ? c : mine; }
        if (sum == G) break;
        __builtin_amdgcn_s_sleep(1);
        if ((++sp & 255u) == 0u) { if (xb_ld(&bar[XB_TMO])) break; if (sp > XB_SPIN_CAP) { atomicAdd(&bar[XB_TMO], 1u); break; } }
    }
    nloc = mine > 0u ? mine : 1u; nx = cnt > 0u ? cnt : 1u;
}

__device__ __forceinline__ void xcd_barrier(const XcdBarrier& b) {
    asm volatile("s_waitcnt vmcnt(0)" ::: "memory");
    __syncthreads();
    if (threadIdx.x == 0) {
        unsigned* bar = b.bar;
        __builtin_amdgcn_s_waitcnt(0);
        unsigned nloc = b.st[0], nx = b.st[1];
        if (nloc == 0u) { xcd_barrier_complete(bar, b.x, nloc, nx); b.st[0] = nloc; b.st[1] = nx; }
        const unsigned old = xb_add(&bar[XB_XSUB(b.x)], 1u);
        const unsigned gen = old / nloc;
        if (old + 1u == (gen + 1u) * nloc) {
            __builtin_amdgcn_fence(__ATOMIC_RELEASE, "agent");
            asm volatile("s_waitcnt vmcnt(0)" ::: "memory");
            const unsigned og = xb_add(&bar[XB_TOP], 1u);
            const unsigned tg = og / nx;
            if (og + 1u == (tg + 1u) * nx) xb_add(&bar[XB_TOPGEN], 1u);
            else XB_SPIN(xb_ld(&bar[XB_TOPGEN]) == tg, bar);
            __builtin_amdgcn_fence(__ATOMIC_ACQUIRE, "agent");
            xb_add(&bar[XB_XGEN(b.x)], 1u);
            asm volatile("s_waitcnt vmcnt(0)" ::: "memory");
        } else {
            XB_SPIN(xb_ld(&bar[XB_XGEN(b.x)]) == gen, bar);
            __builtin_amdgcn_fence(__ATOMIC_ACQUIRE, "agent");
            asm volatile("s_waitcnt vmcnt(0)" ::: "memory");
        }
    }
    __syncthreads();
}
namespace pg8 {
constexpr int BM = 256, BK = 64, HALF = 128, HTB = HALF * BK * 2  , STAGE_BYTES = 8 * HTB;
__host__ __device__ __forceinline__ int lds_byte(int r, int c) { const int st = (r >> 4) * 2 + (c >> 5), rr = r & 15, cc = c & 31, ob = rr * 64 + cc * 2; return st * 1024 + (ob ^ (((ob >> 9) & 1) << 5)); }
__host__ __device__ __forceinline__ void stage_rc(int b, int& R, int& C) { const int st = b / 1024, sb = b % 1024, swz = sb ^ (((sb >> 9) & 1) << 5); R = (st >> 1) * 16 + swz / 64; C = (st & 1) * 32 + (swz % 64) / 2; }
__host__ __device__ __forceinline__ int perm32(int rho) { const int n = rho >> 4, i = rho & 15; return 8 * (i >> 2) + 4 * n + (i & 3); }

enum { GU_LAST = 1 };
struct GU {
    const char* A;
    const char* B;
    char* C;
    const char* P;
    int lda, ldb;
    int nt;
    int pm, pn;
    int seg;
    int flags;
    int rows;
    int aux;
    int f8;
};
typedef f32x4 Acc[2][2][4][2];
typedef int i32x4 __attribute__((ext_vector_type(4)));
typedef int i32x8 __attribute__((ext_vector_type(8)));

#if !NAIVE_GEMM
template <class Epi, class Sched, bool HAS_F8 = false>
__device__ __forceinline__ void gemm_phase(LAS unsigned char* lds, const Sched& S, const Epi& E, const int tid) {
    const int wid = __builtin_amdgcn_readfirstlane(tid >> 6), lane = tid & 63, wr = wid >> 2, wc = wid & 3, fr = lane & 15, fq = lane >> 4;
    const unsigned ldsw = (unsigned)wid * 1024u;
    const int aoff = lds_byte(wr * 64 + fr, fq * 8), boff = lds_byte(wc * 32 + fr, fq * 8);
#define PG8_SA(b, h) (((b) * 2 + (h)) * HTB)
#define PG8_SB(b, h) ((4 + (b) * 2 + (h)) * HTB)
#define PG8_STAGE(bufoff, gbase, voff) do { _Pragma("unroll") for (int _i = 0; _i < 2; ++_i) { unsigned o_ = (voff)[_i]; asm volatile("" : "+v"(o_));     \
        __builtin_amdgcn_global_load_lds((const unsigned*)((const char*)(gbase) + o_), (LAS unsigned*)(lds + (bufoff) + ldsw + _i * 8192), 16, 0, 0); } } while (0)
#define PG8_LDA(dst, b, h) do { _Pragma("unroll") for (int m = 0; m < 4; ++m) _Pragma("unroll") for (int k = 0; k < 2; ++k) dst[m][k] = *(const LAS bf16x8*)(lds + PG8_SA(b, h) + aoff + m * 2048 + k * 1024); } while (0)
#define PG8_LDB(dst, b, h) do { _Pragma("unroll") for (int n = 0; n < 2; ++n) _Pragma("unroll") for (int k = 0; k < 2; ++k) dst[n][k] = *(const LAS bf16x8*)(lds + PG8_SB(b, h) + boff + n * 2048 + k * 1024); } while (0)
#define PG8_MFMA8(c, a, b) do { const i32x8 a_ = (a), b_ = (b); asm volatile("s_nop 4\n\tv_mfma_scale_f32_16x16x128_f8f6f4 %0, %1, %2, %0, %3, %3 op_sel_hi:[0,0,0]" : "+v"(c) : "v"(a_), "v"(b_), "v"(f8scale)); } while (0)
#define PG8_MFMA_DRAIN() do { if (HAS_F8) asm volatile("s_nop 15\n\ts_nop 15\n\ts_nop 15" ::: "memory"); } while (0)
#define PG8_CAT8(x) __builtin_shufflevector(__builtin_bit_cast(i32x4, (x)[0]), __builtin_bit_cast(i32x4, (x)[1]), 0, 1, 2, 3, 4, 5, 6, 7)
#define PG8_MMA(ai, bj, At, Bt) do { __builtin_amdgcn_s_setprio(1); if (HAS_F8) { _Pragma("unroll") for (int m = 0; m < 4; ++m) _Pragma("unroll") for (int n = 0; n < 2; ++n) \
        PG8_MFMA8(acc[ai][bj][m][n], PG8_CAT8(Bt[n]), PG8_CAT8(At[m])); } \
    else { _Pragma("unroll") for (int m = 0; m < 4; ++m) _Pragma("unroll") for (int n = 0; n < 2; ++n) _Pragma("unroll") for (int k = 0; k < 2; ++k) \
        acc[ai][bj][m][n] = __builtin_amdgcn_mfma_f32_16x16x32_bf16(Bt[n][k], At[m][k], acc[ai][bj][m][n], 0, 0, 0); } __builtin_amdgcn_s_setprio(0); } while (0)
#define PG8_WAIT_V(n) asm volatile("s_waitcnt vmcnt(" #n ")" ::: "memory")
#define PG8_WAIT_L(n) asm volatile("s_waitcnt lgkmcnt(" #n ")" ::: "memory")
#define PG8_BAR __builtin_amdgcn_s_barrier()
#define PG8_SCHED __builtin_amdgcn_sched_barrier(0)
#define PG8_MKV(u, va, vb) do { _Pragma("unroll") for (int _i = 0; _i < 2; ++_i) { int R_, C_; stage_rc(tid * 16 + _i * 8192, R_, C_); const int Rb_ = (R_ & ~31) + perm32(R_ & 31);     \
        vb[_i] = (unsigned)(Rb_ * (u).ldb + C_ * 2); va[0][_i] = S.arow((u), R_) + (unsigned)(C_ * 2); if (Sched::GATHER) va[1][_i] = S.arow((u), 128 + R_) + (unsigned)(C_ * 2); } } while (0)
    GU cur, nxt; int ui = 0;
    if (!S.next(0, cur)) return;
    Acc acc;
#pragma unroll
    for (int a = 0; a < 2; ++a)
#pragma unroll
        for (int b = 0; b < 2; ++b)
#pragma unroll
            for (int m = 0; m < 4; ++m)
#pragma unroll
                for (int n = 0; n < 2; ++n) acc[a][b][m][n] = (f32x4){0.f, 0.f, 0.f, 0.f};
    bf16x8 At[4][2], B0[2][2], B1[2][2];
    int f8scale = 0x7f7f7f7f; asm volatile("" : "+v"(f8scale));
    constexpr int NH = Sched::GATHER ? 2 : 1;
    unsigned vA[NH][2], vB[2], nvA[NH][2], nvB[2];
    PG8_MKV(cur, vA, vB);
    const size_t kstep = (size_t)(BK * 2);
    {
        const char* cA = cur.A; const char* cB = cur.B; const size_t hsB = (size_t)HALF * cur.ldb;
        const char* cBh = cB + hsB; const char* cAk = cA + kstep; const char* cBk = cB + kstep; const char* cBhk = cB + hsB + kstep; const char* cAh = Sched::GATHER ? cA : cA + (size_t)HALF * cur.lda;
        asm volatile("" : "+s"(cA), "+s"(cB), "+s"(cBh), "+s"(cAk), "+s"(cBk), "+s"(cBhk), "+s"(cAh));
        PG8_STAGE(PG8_SB(0, 0), cB, vB); PG8_STAGE(PG8_SB(0, 1), cBh, vB); PG8_STAGE(PG8_SA(0, 0), cA, vA[0]); PG8_STAGE(PG8_SA(0, 1), cAh, vA[NH - 1]);
        if (wr == 1) PG8_BAR;
        PG8_WAIT_V(2); PG8_BAR;
        PG8_STAGE(PG8_SB(1, 0), cBk, vB); PG8_STAGE(PG8_SA(1, 0), cAk, vA[0]); PG8_STAGE(PG8_SB(1, 1), cBhk, vB);
        PG8_WAIT_V(6); PG8_BAR;
    }
    for (;;) {
        const bool has_next = S.next(ui + 1, nxt);
        if (has_next) { PG8_MKV(nxt, nvA, nvB); }
        else {
#pragma unroll
            for (int i = 0; i < 2; ++i) { nvB[i] = vB[i]; nvA[0][i] = vA[0][i]; nvA[NH - 1][i] = vA[NH - 1][i]; }
        }
        const char* cA = cur.A; const char* cB = cur.B; const size_t hsB = (size_t)HALF * cur.ldb;
        const char* nA = has_next ? nxt.A : cA; const char* nB = has_next ? nxt.B : cB; const size_t nhsB = has_next ? (size_t)HALF * nxt.ldb : hsB;
        const size_t hsA = Sched::GATHER ? 0 : (size_t)HALF * cur.lda, nhsA = Sched::GATHER ? 0 : (has_next ? (size_t)HALF * nxt.lda : hsA);
        const int nt = cur.nt;
        for (int t = 0; t < nt; t += 2) {
            const bool last = (t == nt - 2);
            const char* a1 = cA + (size_t)(t + 1) * kstep;
            const char* a2 = last ? nA : cA + (size_t)(t + 2) * kstep; const char* b2 = last ? nB : cB + (size_t)(t + 2) * kstep;
            const char* a3 = a2 + kstep; const char* b3 = b2 + kstep;
            const size_t xhsB = last ? nhsB : hsB, xhsA = last ? nhsA : hsA;
            const char* b2h = b2 + xhsB; const char* b3h = b3 + xhsB; const char* a1h = a1 + hsA; const char* a2h = a2 + xhsA;
            asm volatile("" : "+s"(a1h), "+s"(a2), "+s"(a3), "+s"(b2), "+s"(b3), "+s"(b2h), "+s"(b3h), "+s"(a2h));
            unsigned xA[NH][2], xB[2];
#pragma unroll
            for (int i = 0; i < 2; ++i) { xB[i] = last ? nvB[i] : vB[i]; xA[0][i] = last ? nvA[0][i] : vA[0][i]; xA[NH - 1][i] = last ? nvA[NH - 1][i] : vA[NH - 1][i]; }
            PG8_LDB(B0, 0, 0); PG8_LDB(B1, 0, 1); PG8_SCHED; PG8_LDA(At, 0, 0); PG8_STAGE(PG8_SA(1, 1), a1h, vA[NH - 1]);
            PG8_WAIT_V(8); PG8_WAIT_L(0); PG8_BAR; PG8_MMA(0, 0, At, B0); PG8_MMA(0, 1, At, B1); PG8_BAR; PG8_SCHED;
            PG8_LDA(At, 0, 1); PG8_STAGE(PG8_SB(0, 0), b2, xB); PG8_STAGE(PG8_SB(0, 1), b2h, xB); PG8_STAGE(PG8_SA(0, 0), a2, xA[0]);
            PG8_WAIT_V(8); PG8_WAIT_L(0); PG8_BAR; PG8_MMA(1, 0, At, B0); PG8_MMA(1, 1, At, B1); PG8_BAR; PG8_SCHED;
            PG8_LDB(B0, 1, 0); PG8_LDB(B1, 1, 1); PG8_SCHED; PG8_LDA(At, 1, 0); PG8_STAGE(PG8_SA(0, 1), a2h, xA[NH - 1]);
            PG8_WAIT_V(8); PG8_WAIT_L(0); PG8_BAR; PG8_MMA(0, 0, At, B0); PG8_MMA(0, 1, At, B1); PG8_BAR; PG8_SCHED;
            PG8_LDA(At, 1, 1); PG8_STAGE(PG8_SB(1, 0), b3, xB); PG8_STAGE(PG8_SB(1, 1), b3h, xB); PG8_STAGE(PG8_SA(1, 0), a3, xA[0]);
            PG8_WAIT_V(8); PG8_WAIT_L(0); PG8_BAR; PG8_MMA(1, 0, At, B0); PG8_MMA(1, 1, At, B1); PG8_BAR; PG8_SCHED;
        }
        if (wr == 0) PG8_BAR;
        PG8_MFMA_DRAIN();
        { int fr_e = fr, fq_e = fq; asm volatile("" : "+v"(fr_e), "+v"(fq_e));
          E(acc, cur, wr, wc, fr_e, fq_e); }
        if (!has_next) break;
        if (cur.flags & GU_LAST) {
#pragma unroll
            for (int a = 0; a < 2; ++a)
#pragma unroll
                for (int b = 0; b < 2; ++b)
#pragma unroll
                    for (int m = 0; m < 4; ++m)
#pragma unroll
                        for (int n = 0; n < 2; ++n) acc[a][b][m][n] = (f32x4){0.f, 0.f, 0.f, 0.f};
        }
        cur = nxt; ++ui;
#pragma unroll
        for (int i = 0; i < 2; ++i) { vB[i] = nvB[i]; vA[0][i] = nvA[0][i]; vA[NH - 1][i] = nvA[NH - 1][i]; }
        if (wr == 1) PG8_BAR;
    }
    PG8_WAIT_V(0);
    PG8_BAR;
#undef PG8_SA
#undef PG8_SB
#undef PG8_STAGE
#undef PG8_LDA
#undef PG8_LDB
#undef PG8_MMA
#undef PG8_WAIT_V
#undef PG8_WAIT_L
#undef PG8_BAR
#undef PG8_SCHED
#undef PG8_MKV
#undef PG8_CAT8
}
#else
template <class Epi, class Sched>
__device__ __forceinline__ void gemm_phase(LAS unsigned char* lds, const Sched& S, const Epi& E, const int tid) {
    const int wid = __builtin_amdgcn_readfirstlane(tid >> 6), lane = tid & 63, wr = wid >> 2, wc = wid & 3, fr = lane & 15, fq = lane >> 4;
    GU cur; Acc acc;
#pragma unroll
    for (int a = 0; a < 2; ++a)
#pragma unroll
        for (int b = 0; b < 2; ++b)
#pragma unroll
            for (int m = 0; m < 4; ++m)
#pragma unroll
                for (int n = 0; n < 2; ++n) acc[a][b][m][n] = (f32x4){0.f, 0.f, 0.f, 0.f};
    for (int ui = 0; S.next(ui, cur); ++ui) {
        const int K = cur.nt * 64;
#pragma unroll 1
        for (int ai = 0; ai < 2; ++ai)
#pragma unroll 1
            for (int m = 0; m < 4; ++m) {
                const char* ap = cur.A + S.arow(cur, ai * 128 + wr * 64 + m * 16 + fr);
#pragma unroll 1
                for (int bj = 0; bj < 2; ++bj) {
                    float s[8];
#pragma unroll
                    for (int j = 0; j < 8; ++j) s[j] = 0.f;
                    const char* bp = cur.B + (size_t)(bj * 128 + wc * 32 + 8 * fq) * cur.ldb;
#pragma unroll 1
                    for (int k = 0; k < K; k += 8) {
                        const u32x4 av = *(const u32x4*)(ap + k * 2);
                        const float a0 = bflo(av.x), a1 = bfhi(av.x), a2 = bflo(av.y), a3 = bfhi(av.y), a4 = bflo(av.z), a5 = bfhi(av.z), a6 = bflo(av.w), a7 = bfhi(av.w);
#pragma unroll
                        for (int j = 0; j < 8; ++j) { const u32x4 bv = *(const u32x4*)(bp + (size_t)j * cur.ldb + k * 2);
                            s[j] += a0 * bflo(bv.x) + a1 * bfhi(bv.x) + a2 * bflo(bv.y) + a3 * bfhi(bv.y) + a4 * bflo(bv.z) + a5 * bfhi(bv.z) + a6 * bflo(bv.w) + a7 * bfhi(bv.w); }
                    }
#pragma unroll
                    for (int a_ = 0; a_ < 2; ++a_)
#pragma unroll
                        for (int m_ = 0; m_ < 4; ++m_)
#pragma unroll
                            for (int b_ = 0; b_ < 2; ++b_) if (a_ == ai && m_ == m && b_ == bj) {
                                acc[a_][b_][m_][0] += (f32x4){s[0], s[1], s[2], s[3]}; acc[a_][b_][m_][1] += (f32x4){s[4], s[5], s[6], s[7]}; }
                }
            }
        E(acc, cur, wr, wc, fr, fq);
        if (cur.flags & GU_LAST) {
#pragma unroll
            for (int a = 0; a < 2; ++a)
#pragma unroll
                for (int b = 0; b < 2; ++b)
#pragma unroll
                    for (int m = 0; m < 4; ++m)
#pragma unroll
                        for (int n = 0; n < 2; ++n) acc[a][b][m][n] = (f32x4){0.f, 0.f, 0.f, 0.f};
        }
    }
    __syncthreads();
}
#endif
}
namespace pg8 {
__device__ __forceinline__ unsigned cvt_pk_bf16(float lo, float hi) { unsigned r; asm volatile("v_cvt_pk_bf16_f32 %0, %1, %2" : "=v"(r) : "v"(lo), "v"(hi)); return r; }
__device__ __forceinline__ void st8(char* p, const f32x4 v0, const f32x4 v1) { u32x4 w; w.x = cvt_pk_bf16(v0[0], v0[1]); w.y = cvt_pk_bf16(v0[2], v0[3]); w.z = cvt_pk_bf16(v1[0], v1[1]); w.w = cvt_pk_bf16(v1[2], v1[3]); *(u32x4*)p = w; }
__device__ __forceinline__ void ld8(const char* p, f32x4& v0, f32x4& v1) { const u32x4 w = *(const u32x4*)p; v0 = (f32x4){bflo(w.x), bfhi(w.x), bflo(w.y), bfhi(w.y)}; v1 = (f32x4){bflo(w.z), bfhi(w.z), bflo(w.w), bfhi(w.w)}; }
__device__ __forceinline__ void tile_of(int L, int nM, int nN, int& pm, int& pn) {
    const int nwg = nM * nN; int wgid = L; { const int q = nwg / 8, r = nwg % 8, xcd = wgid % 8, off = wgid / 8; wgid = (xcd < r ? xcd * (q + 1) : r * (q + 1) + (xcd - r) * q) + off; }
    const int nig = 8 * nN, gid = wgid / nig, fm = gid * 8, gsz = (nM - fm) < 8 ? (nM - fm) : 8;
    pm = fm + ((wgid % nig) % gsz); pn = (wgid % nig) / gsz;
}
#define EPI_ROWS(...) _Pragma("unroll") for (int ai = 0; ai < 2; ++ai) _Pragma("unroll") for (int m = 0; m < 4; ++m) { const int lrow = ai * 128 + wr * 64 + m * 16 + fr; __VA_ARGS__ }
#define EPI_COLS(...) _Pragma("unroll") for (int bj = 0; bj < 2; ++bj) { const int lcol = bj * 128 + wc * 32 + 8 * fq; f32x4& v0 = acc[ai][bj][m][0]; f32x4& v1 = acc[ai][bj][m][1]; __VA_ARGS__ }

struct SchedDense {
    const char* A; const char* B; int lda, ldb, nt, nM, nN, G, c;
    static constexpr bool GATHER = false;
    __device__ __forceinline__ bool next(int i, GU& u) const {
        const int L = i * G + c; if (L >= nM * nN) return false;
        int pm, pn; tile_of(L, nM, nN, pm, pn);
        u.A = A + (size_t)pm * 256 * lda; u.B = B + (size_t)pn * 256 * ldb; u.C = nullptr; u.P = nullptr; u.lda = lda; u.ldb = ldb; u.nt = nt; u.pm = pm; u.pn = pn; u.seg = 0; u.flags = GU_LAST; u.rows = 256; u.aux = 0; u.f8 = 0;
        return true;
    }
    __device__ __forceinline__ unsigned arow(const GU& u, int r) const { return (unsigned)(r * u.lda); }
};
template <bool HALF> struct SchedProj {
    unsigned char* ws; unsigned char* lw; int G, c;
    static constexpr bool GATHER = false;
    __device__ __forceinline__ bool next(int i, GU& u) const {
        int id = -1;
        if (G == 256) {
            if (!HALF) { if (i == 0) id = c; else if (i == 1 && c < 192) id = c + 256; }
            else { if (c < 192) { if (i < 3) id = c * 3 + i; } else { if (i < 5) id = 576 + (c - 192) * 5 + i; } } }
        else { const int L = i * G + c; if (L < (HALF ? 896 : 448)) id = L; }
        if (id < 0) return false;
        int pm, pn;
        if (!HALF) { int t14; tile_of(id, 32, 14, pm, t14); u.A = (const char*)ws + WS_X + (size_t)pm * 256 * 4096; u.lda = 4096; u.B = (const char*)lw + LW_WIN + (size_t)t14 * 256 * 4096; u.ldb = 4096; u.nt = 32; u.f8 = 0;
            pn = t14 < 12 ? t14 : 16 + (t14 - 12); }
        else { int t28; tile_of(id, 32, 28, pm, t28); u.A = (const char*)ws + WS_H8 + (size_t)pm * 256 * 2048; u.lda = 2048; u.B = (const char*)lw + LW_WG8 + (size_t)t28 * 256 * 2048; u.ldb = 2048; u.nt = 16; u.f8 = 1;
            pn = t28 < 24 ? 18 + t28 : 12 + (t28 - 24); }
        u.C = nullptr; u.P = nullptr; u.pm = pm; u.pn = pn; u.seg = 0; u.flags = GU_LAST; u.rows = 256; u.aux = 0;
        return true;
    }
    __device__ __forceinline__ unsigned arow(const GU& u, int r) const { return (unsigned)(r * u.lda); }
};
template <int MODE> struct SchedSeg {
    unsigned char* ws; unsigned char* lw; int G, c;
    static constexpr bool GATHER = false; static constexpr int NS = MODE == 0 ? 3 : 4;
    __device__ __forceinline__ bool next(int i, GU& u) const {
        const int ti = i / NS, sg = i % NS; const int L = ti * G + c; if (L >= 256) return false;
        int pm, pn; tile_of(L, 32, 8, pm, pn);
        if (MODE == 0) { const size_t ao = sg == 0 ? WS_OAN : sg == 1 ? WS_CVO : WS_GLUO; const int la = sg == 0 ? 2048 : 1024; const size_t bo = sg == 0 ? 0 : sg == 1 ? 2048 : 3072;
            u.A = (const char*)ws + ao + (size_t)pm * 256 * la; u.lda = la; u.nt = sg == 0 ? 16 : 8; u.B = (const char*)lw + LW_WCAT + bo + (size_t)pn * 256 * 4096; u.ldb = 4096; }
        else if (XAO_FP8) { int two = 2; asm volatile("" : "+s"(two)); u.A = (const char*)ws + WS_P + sg * 256 + (size_t)pm * 256 * 1024; u.lda = 1024; u.nt = two; u.B = (const char*)lw + LW_VW + sg * 256 + (size_t)pn * 256 * 1024; u.ldb = 1024; }
        else { u.A = (const char*)ws + WS_P + sg * 512 + (size_t)pm * 256 * 2048; u.lda = 2048; u.nt = 4; u.B = (const char*)lw + LW_VW + sg * 512 + (size_t)pn * 256 * 2048; u.ldb = 2048; }
        u.C = nullptr; u.P = nullptr; u.pm = pm; u.pn = pn; u.seg = sg; u.flags = (sg == NS - 1) ? GU_LAST : 0; u.rows = 256; u.aux = 0; u.f8 = 0;
        return true;
    }
    __device__ __forceinline__ unsigned arow(const GU& u, int r) const { return (unsigned)(r * u.lda); }
};
struct EpiStore { int ldc; int ncolh;
    __device__ __forceinline__ void operator()(Acc& acc, const GU& u, int wr, int wc, int fr, int fq) const {
        const float sc = __builtin_bit_cast(float, u.aux);
        EPI_ROWS( if (lrow < u.rows) { char* rp = u.C + (unsigned)(lrow * ldc); EPI_COLS( if (bj < ncolh) st8(rp + lcol * 2, v0 * sc, v1 * sc); ) } )
    }
};
struct EpiStoreF32 { int ldc;
    __device__ __forceinline__ void operator()(Acc& acc, const GU& u, int wr, int wc, int fr, int fq) const {
        EPI_ROWS( { char* rp = u.C + (unsigned)(lrow * ldc); const int lcol = wc * 32 + 8 * fq; *(f32x4*)(rp + lcol * 4) = acc[ai][0][m][0]; *(f32x4*)(rp + lcol * 4 + 16) = acc[ai][0][m][1]; } )
    }
};
struct EpiProj { char* ws; const float* ropeC; const float* ropeS; const float* rstd;
    __device__ __forceinline__ void operator()(Acc& acc, const GU& u, int wr, int wc, int fr, int fq) const {
        const int pn = u.pn;
        if (pn < 8) {
            char* dst = ws + (pn < 4 ? WS_Q : WS_K) + (size_t)(pn & 3) * 512; const float sc0 = pn < 4 ? C2Q : 1.f;
            EPI_ROWS( { const int tok = u.pm * 256 + lrow; char* rp = dst + (unsigned)(tok * 2048); const float sc = sc0 * rstd[tok];
                EPI_COLS( { const int i0 = (lcol & 63) >> 1; const f32x4 c4 = *(const f32x4*)(ropeC + tok * 32 + i0), s4 = *(const f32x4*)(ropeS + tok * 32 + i0);
                    const f32x4 o0 = (f32x4){v0[0] * c4[0] - v0[1] * s4[0], v0[1] * c4[0] + v0[0] * s4[0], v0[2] * c4[1] - v0[3] * s4[1], v0[3] * c4[1] + v0[2] * s4[1]};
                    const f32x4 o1 = (f32x4){v1[0] * c4[2] - v1[1] * s4[2], v1[1] * c4[2] + v1[0] * s4[2], v1[2] * c4[3] - v1[3] * s4[3], v1[3] * c4[3] + v1[2] * s4[3]};
                    st8(rp + lcol * 2, o0 * sc, o1 * sc); } ) } )
        } else if (pn < 12) {
            char* dst = ws + WS_V + (size_t)(pn - 8) * 512;
            EPI_ROWS( { const int tok = u.pm * 256 + lrow; char* rp = dst + (unsigned)(tok * 2048); const float rs = rstd[tok]; EPI_COLS( st8(rp + lcol * 2, v0 * rs, v1 * rs); ) } )
        } else if (pn < 16) {
            char* dst = ws + WS_Z + (size_t)(pn - 12) * 256;
            EPI_ROWS( { const int tok = u.pm * 256 + lrow; char* rp = dst + (unsigned)(tok * 1024); const float is = rstd[tok] * (1.f / GATE_WSCALE);
                EPI_COLS( { u32x2 w; w.x = cvt_pk_bf16(v0[0] * is * sigmoidf_(v0[1] * is), v0[2] * is * sigmoidf_(v0[3] * is)); w.y = cvt_pk_bf16(v1[0] * is * sigmoidf_(v1[1] * is), v1[2] * is * sigmoidf_(v1[3] * is)); *(u32x2*)(rp + lcol) = w; } ) } )
        } else if (pn < 18) {
            EPI_ROWS( { const int tok = u.pm * 256 + lrow; const float rs = rstd[tok];
                EPI_COLS( { const int ch = (pn - 16) * 256 + lcol, g = ch >> 4, h = ch & 15; st8((ws + WS_UC) + (unsigned)(((g * 256 + (tok >> 5)) * 512 + (tok & 31) * 16 + h) * 2), v0 * rs, v1 * rs); } ) } )
        } else {
            char* dst = ws + WS_GATES + (size_t)(pn - 18) * 256;
            EPI_ROWS( { const int tok = u.pm * 256 + lrow; char* rp = dst + (unsigned)(tok * 6144); const float is = rstd[tok] * (1.f / GATE_WSCALE);
                EPI_COLS( { unsigned qa[4], qb[4];
                    _Pragma("unroll") for (int j = 0; j < 4; ++j) { qa[j] = (unsigned)fminf(sigmoidf_(v0[j] * is) * 256.f, 255.f); qb[j] = (unsigned)fminf(sigmoidf_(v1[j] * is) * 256.f, 255.f); }
                    u32x2 w; w.x = qa[0] | (qa[1] << 8) | (qa[2] << 16) | (qa[3] << 24); w.y = qb[0] | (qb[1] << 8) | (qb[2] << 16) | (qb[3] << 24);
                    *(u32x2*)(rp + lcol) = w; } ) } )
        }
    }
};
struct EpiSsm3 { char* ys;
    __device__ __forceinline__ void operator()(Acc& acc, const GU& u, int wr, int wc, int fr, int fq) const {
        if (!(u.flags & GU_LAST)) return;
        const int g = u.pm;
        EPI_ROWS( { const int chunk = lrow;
            EPI_COLS( { const int jh = u.pn * 256 + lcol, j = jh >> 4, h = jh & 15; st8(ys + (unsigned)(((chunk * 32 + j) * 512 + g * 16 + h) * 2), v0, v1); } ) } )
    }
};
struct EpiGlu { char* dst; const float* bias;
    __device__ __forceinline__ void operator()(Acc& acc, const GU& u, int wr, int wc, int fr, int fq) const {
        EPI_ROWS( { const int tok = u.pm * 256 + lrow; char* rp = (dst + (size_t)u.pn * 256) + (unsigned)(tok * 1024);
            EPI_COLS( { const int j0 = u.pn * 128 + (lcol >> 1); const f32x4 ba = *(const f32x4*)(bias + j0), bb = *(const f32x4*)(bias + 512 + j0);
                u32x2 w; w.x = cvt_pk_bf16((v0[0] + ba[0]) * sigmoidf_(v0[1] + bb[0]), (v0[2] + ba[1]) * sigmoidf_(v0[3] + bb[1]));
                w.y = cvt_pk_bf16((v1[0] + ba[2]) * sigmoidf_(v1[1] + bb[2]), (v1[2] + ba[3]) * sigmoidf_(v1[3] + bb[3])); *(u32x2*)(rp + lcol) = w; } ) } )
    }
};
struct EpiGated { const char* gates; char* merged;
    __device__ __forceinline__ void operator()(Acc& acc, const GU& u, int wr, int wc, int fr, int fq) const {
        const int sg = u.seg;
        EPI_ROWS( { const int tok = u.pm * 256 + lrow; const char* gp = (gates + (size_t)u.pn * 256) + (unsigned)(tok * 6144); char* mp = (merged + (size_t)u.pn * 512) + (unsigned)(tok * 4096);
            EPI_COLS( { const u32x2 nq = *(const u32x2*)(gp + (size_t)sg * 2048 + lcol);
                if (sg < 2) { const u32x2 dq = *(const u32x2*)(gp + (size_t)(sg + 1) * 2048 + lcol);
                    _Pragma("unroll") for (int j = 0; j < 4; ++j) { v0[j] *= ((float)((nq.x >> (8 * j)) & 255u) + 0.5f) * __builtin_amdgcn_rcpf((float)((dq.x >> (8 * j)) & 255u) + 0.5f); v1[j] *= ((float)((nq.y >> (8 * j)) & 255u) + 0.5f) * __builtin_amdgcn_rcpf((float)((dq.y >> (8 * j)) & 255u) + 0.5f); } }
                else { _Pragma("unroll") for (int j = 0; j < 4; ++j) { v0[j] *= fmaf((float)((nq.x >> (8 * j)) & 255u), 1.f / 256.f, 0.5f / 256.f); v1[j] *= fmaf((float)((nq.y >> (8 * j)) & 255u), 1.f / 256.f, 0.5f / 256.f); }
                    st8(mp + lcol * 2, v0, v1); } } ) } )
    }
};
struct EpiResid { char* x; char* h8; float* rsq;
    __device__ __forceinline__ void operator()(Acc& acc, const GU& u, int wr, int wc, int fr, int fq) const {
        EPI_ROWS( { const int tok = u.pm * 256 + lrow; char* rp = (x + (size_t)u.pn * 512) + (unsigned)(tok * 4096); char* hp = (h8 + (size_t)u.pn * (S_FP8 ? 256 : 512)) + (unsigned)(tok * (S_FP8 ? 2048 : 4096)); float s = 0.f;
            EPI_COLS( { f32x4 a, b; ld8(rp + lcol * 2, a, b); a = a + v0; b = b + v1; st8(rp + lcol * 2, a, b);
                s += (a[0] * a[0] + a[1] * a[1]) + (a[2] * a[2] + a[3] * a[3]) + (b[0] * b[0] + b[1] * b[1]) + (b[2] * b[2] + b[3] * b[3]);
#if S_FP8
                int q0 = __builtin_amdgcn_cvt_pk_fp8_f32(a[0], a[1], 0, false); q0 = __builtin_amdgcn_cvt_pk_fp8_f32(a[2], a[3], q0, true);
                int q1 = __builtin_amdgcn_cvt_pk_fp8_f32(b[0], b[1], 0, false); q1 = __builtin_amdgcn_cvt_pk_fp8_f32(b[2], b[3], q1, true); *(u32x2*)(hp + lcol) = (u32x2){(unsigned)q0, (unsigned)q1};
#elif !defined(DBG_NO_HST)
                st8(hp + lcol * 2, a, b);
#endif
                } )
#ifndef DBG_NO_RSQ
            s += xor_lane<16>(s); s += xor_lane<32>(s);
            if (fq == 0) rsq[(u.pn * T + tok) * 4 + wc] = s;
#endif
            } )
    }
};
struct EpiSexp { char* P; float* rs; const float* rsq;
    __device__ __forceinline__ void operator()(Acc& acc, const GU& u, int wr, int wc, int fr, int fq) const {
        EPI_ROWS( { const int tok = u.pm * 256 + lrow; char* rp = (P + (size_t)u.pn * 512) + (unsigned)(tok * 2048); char* rp8 = (P + (size_t)u.pn * 256) + (unsigned)(tok * 1024); (void)rp; (void)rp8; float s = 0.f;
            float sq = 0.f;
#ifdef DBG_READ_RS
            _Pragma("unroll") for (int q = 0; q < 8; ++q) { const f32x4 t4 = *(const f32x4*)(rs + 262144 + tok * 32 + q * 4); sq += (t4[0] + t4[1]) + (t4[2] + t4[3]); }
#elif defined(DBG_RSQ_ATOMIC_LD)
            _Pragma("unroll") for (int q = 0; q < 32; ++q) sq += __hip_atomic_load(rsq + tok * 32 + q, __ATOMIC_RELAXED, __HIP_MEMORY_SCOPE_AGENT);
#else
            _Pragma("unroll") for (int q = 0; q < 8; ++q) { const f32x4 t4 = *(const f32x4*)(rsq + (q * T + tok) * 4); sq += (t4[0] + t4[1]) + (t4[2] + t4[3]); }
#endif
#ifdef DBG_RN1
            const float rn = 1.f;
#elif defined(DBG_RN1_KEEP)
            asm volatile("" :: "v"(sq)); const float rn = 1.f;
#else
            const float rn = FUSE_N2 ? rsqrtf(sq * (1.f / DM) + RMS_EPS) * (1.f / SQK_SCALE) : 1.f + 0.f * sq;
#endif
#if XAO_FP8
            EPI_COLS( { v0 = v0 * rn - 2.f; v1 = v1 * rn - 2.f;
                const float e0 = __builtin_amdgcn_exp2f(v0[0]), e1 = __builtin_amdgcn_exp2f(v0[1]), e2 = __builtin_amdgcn_exp2f(v0[2]), e3 = __builtin_amdgcn_exp2f(v0[3]);
                const float e4 = __builtin_amdgcn_exp2f(v1[0]), e5 = __builtin_amdgcn_exp2f(v1[1]), e6 = __builtin_amdgcn_exp2f(v1[2]), e7 = __builtin_amdgcn_exp2f(v1[3]);
                int q0 = __builtin_amdgcn_cvt_pk_fp8_f32(e0, e1, 0, false); q0 = __builtin_amdgcn_cvt_pk_fp8_f32(e2, e3, q0, true);
                int q1 = __builtin_amdgcn_cvt_pk_fp8_f32(e4, e5, 0, false); q1 = __builtin_amdgcn_cvt_pk_fp8_f32(e6, e7, q1, true);
                *(u32x2*)(rp8 + lcol) = (u32x2){(unsigned)q0, (unsigned)q1};
                const f32x2 a0 = __builtin_amdgcn_cvt_pk_f32_fp8(q0, false), a1 = __builtin_amdgcn_cvt_pk_f32_fp8(q0, true), a2 = __builtin_amdgcn_cvt_pk_f32_fp8(q1, false), a3 = __builtin_amdgcn_cvt_pk_f32_fp8(q1, true);
                s += ((a0[0] + a0[1]) + (a1[0] + a1[1])) + ((a2[0] + a2[1]) + (a3[0] + a3[1])); } )
#else
            EPI_COLS( { v0 = v0 * rn; v1 = v1 * rn; u32x4 w; w.x = cvt_pk_bf16(__builtin_amdgcn_exp2f(v0[0]), __builtin_amdgcn_exp2f(v0[1])); w.y = cvt_pk_bf16(__builtin_amdgcn_exp2f(v0[2]), __builtin_amdgcn_exp2f(v0[3]));
                w.z = cvt_pk_bf16(__builtin_amdgcn_exp2f(v1[0]), __builtin_amdgcn_exp2f(v1[1])); w.w = cvt_pk_bf16(__builtin_amdgcn_exp2f(v1[2]), __builtin_amdgcn_exp2f(v1[3]));
                *(u32x4*)(rp + lcol * 2) = w; s += ((bflo(w.x) + bfhi(w.x)) + (bflo(w.y) + bfhi(w.y))) + ((bflo(w.z) + bfhi(w.z)) + (bflo(w.w) + bfhi(w.w))); } )
#endif
            s += xor_lane<16>(s); s += xor_lane<32>(s);
            if (fq == 0) rs[(u.pn * T + tok) * 4 + wc] = s; } )
    }
};
#ifdef DBG_NO_XA
#define XA_DBG_COND && false
#else
#define XA_DBG_COND
#endif
struct EpiXao { const float* rs; char* x;
    __device__ __forceinline__ void operator()(Acc& acc, const GU& u, int wr, int wc, int fr, int fq) const {
        const int sg = u.seg;
        EPI_ROWS( { const int tok = u.pm * 256 + lrow; const f32x4 a = *(const f32x4*)(rs + (sg * T + tok) * 4); const float lh = (a[0] + a[1]) + (a[2] + a[3]);
            float f = __builtin_amdgcn_rcpf(lh) * (sg == 3 ? 1.f / VW_SCALE : 1.f);
            if (sg < 3) { const f32x4 b = *(const f32x4*)(rs + ((sg + 1) * T + tok) * 4); f *= (b[0] + b[1]) + (b[2] + b[3]); }
            char* rp = (x + (size_t)u.pn * 512) + (unsigned)(tok * 4096);
            EPI_COLS( { v0 = v0 * f; v1 = v1 * f; if (sg == 3 XA_DBG_COND) { f32x4 a, b; ld8(rp + lcol * 2, a, b); st8(rp + lcol * 2, a + v0, b + v1); } } ) } )
    }
};
template <bool DOWN> struct SchedMoE {
    const volatile LAS int* cnt;
    unsigned char* ws; unsigned char* lw; int G, c;
    static constexpr bool GATHER = !DOWN;
    static constexpr int nN = DOWN ? 8 : 4;
    __device__ __forceinline__ bool next(int i, GU& u) const {
        const int L = i * G + c; const int tile = L / nN, pn = L % nN;
        int e = -1, mt = 0, off = 0, tacc = 0, ce = 0;
#pragma unroll 1
        for (int k = 0; k < NEXP; ++k) { const int ck = __builtin_amdgcn_readfirstlane(cnt[k]); const int tk = (ck + 255) >> 8;
            if (e < 0 && tile < tacc + tk) { e = k; mt = tile - tacc; ce = ck; }
            if (e < 0) { off += ck; tacc += tk; } }
        if (e < 0) return false;
        u.pm = mt; u.pn = pn; u.seg = 0; u.flags = GU_LAST; u.aux = e; u.f8 = 1;
        u.rows = (ce - mt * 256) < 256 ? (ce - mt * 256) : 256;
        int ntd = 4, ntg = 16; asm volatile("" : "+s"(ntd), "+s"(ntg));
        if (DOWN) { u.nt = ntd; u.lda = 512; u.ldb = 512; u.B = (const char*)lw + LW_WD + (size_t)e * DM * FFE + (size_t)pn * 256 * 512;
            u.A = (const char*)ws + WS_HE + (size_t)(off + mt * 256) * 512; u.C = (char*)ws + WS_Y + (size_t)(off + mt * 256) * 2048; u.P = nullptr; }
        else { u.nt = ntg; u.lda = 2048; u.ldb = 2048; u.B = (const char*)lw + LW_WGU + (size_t)e * 1024 * DM + (size_t)pn * 256 * 2048;
            u.A = (const char*)ws + WS_H8; u.C = (char*)ws + WS_HE + (size_t)(off + mt * 256) * 512; u.P = (const char*)ws + WS_WL + ((size_t)e * T + mt * 256) * 4; }
        return true;
    }
    __device__ __forceinline__ unsigned arow(const GU& u, int r) const {
        if (DOWN) return (unsigned)(r * u.lda);
        const int tok = (r < u.rows) ? ((const int*)(ws + WS_LIST))[u.aux * T + u.pm * 256 + r] : 0;
        return (unsigned)tok * (unsigned)u.lda;
    }
};
struct EpiGu {
    __device__ __forceinline__ void operator()(Acc& acc, const GU& u, int wr, int wc, int fr, int fq) const {
        constexpr float is = 1.f / GATE_WSCALE;
        EPI_ROWS( if (lrow < u.rows) { const float w = *(const float*)(u.P + lrow * 4) * is; char* rp = (u.C + (size_t)u.pn * 128) + (unsigned)(lrow * 512);
            EPI_COLS( { const float g0 = v0[0] * is, g1 = v0[2] * is, g2 = v1[0] * is, g3 = v1[2] * is;
                int p8 = __builtin_amdgcn_cvt_pk_fp8_f32(g0 * sigmoidf_(g0) * v0[1] * w, g1 * sigmoidf_(g1) * v0[3] * w, 0, false);
                p8 = __builtin_amdgcn_cvt_pk_fp8_f32(g2 * sigmoidf_(g2) * v1[1] * w, g3 * sigmoidf_(g3) * v1[3] * w, p8, true); *(unsigned*)(rp + (lcol >> 1)) = (unsigned)p8; } ) } )
    }
};
struct EpiDown {
    __device__ __forceinline__ void operator()(Acc& acc, const GU& u, int wr, int wc, int fr, int fq) const {
        constexpr float ys = 16.f / GATE_WSCALE;
        EPI_ROWS( if (lrow < u.rows) { char* rp = (u.C + (size_t)u.pn * 256) + (unsigned)(lrow * 2048);
            EPI_COLS( { int q0 = __builtin_amdgcn_cvt_pk_fp8_f32(v0[0] * ys, v0[1] * ys, 0, false); q0 = __builtin_amdgcn_cvt_pk_fp8_f32(v0[2] * ys, v0[3] * ys, q0, true);
                int q1 = __builtin_amdgcn_cvt_pk_fp8_f32(v1[0] * ys, v1[1] * ys, 0, false); q1 = __builtin_amdgcn_cvt_pk_fp8_f32(v1[2] * ys, v1[3] * ys, q1, true); *(u32x2*)(rp + lcol) = (u32x2){(unsigned)q0, (unsigned)q1}; } ) } )
    }
};
}
#include <hip/hip_bf16.h>
#include <cmath>
namespace attn_body {
using bf16=__hip_bfloat16;
using bf16x8=__attribute__((ext_vector_type(8)))short;
using s16x4=__attribute__((ext_vector_type(4)))short;
using f32x16=__attribute__((ext_vector_type(16)))float;
using u32x4=__attribute__((ext_vector_type(4)))unsigned;
constexpr int BATCH=1,NHEAD=16,SEQ=8192,D=64,DM=NHEAD*D;
constexpr int NW=8,QBLK=32,QB=QBLK*NW,KVBLK=64,NQB=SEQ/QB;
constexpr int ATTN_PITCH=DM, ATTN_UNIT_ROWS=QB;
__device__ __forceinline__ int crow(int r,int hi){return (r&3)+8*(r>>2)+4*hi;}
#define SBAR() __builtin_amdgcn_sched_barrier(0)
__device__ __forceinline__ void cmask(f32x16&p0,f32x16&p1,int jb,int qrel,int hi){
  const float NEG=-INFINITY; int kb=64*jb+4*hi;
  #pragma unroll
  for(int r=0;r<16;++r){int kv=kb+(r&3)+8*(r>>2); if(kv>qrel)p0[r]=NEG; if(kv+32>qrel)p1[r]=NEG;}
}

constexpr int NSLOT=3, SLOTB=8192;
constexpr int LDS_K=0, LDS_V=NSLOT*SLOTB, LDS_WS=2*NSLOT*SLOTB, LDS_OST=LDS_WS+NW*64*4, LDS_BYTES=LDS_OST+NW*4096;
constexpr float C2=0.125f*1.4426950408889634f;
__device__ __forceinline__ void glds16(const void*gsrc,unsigned lds_dst){unsigned keep;
  asm volatile("s_mov_b32 %0, m0\n\ts_mov_b32 m0, %2\n\ts_nop 0\n\tglobal_load_lds_dwordx4 %1, off\n\ts_mov_b32 m0, %0":"=&s"(keep):"v"(gsrc),"s"(lds_dst):"memory");}
__device__ __forceinline__ float max3f(float a,float b,float c){float r;asm("v_max3_f32 %0, %1, %2, %3":"=v"(r):"v"(a),"v"(b),"v"(c));return r;}
__device__ __forceinline__ float max2f(float a,float b){float r;asm("v_max_f32_e32 %0, %1, %2":"=v"(r):"v"(a),"v"(b));return r;}
__device__ __forceinline__ float fadd_s(float a,float b){float r;asm("v_add_f32_e32 %0, %1, %2":"=v"(r):"v"(a),"v"(b));return r;}
__device__ __forceinline__ float fsub_s(float a,float b){float r;asm("v_sub_f32_e32 %0, %1, %2":"=v"(r):"v"(a),"v"(b));return r;}
typedef float f32x2_t __attribute__((ext_vector_type(2))); typedef __bf16 bf16x2_t __attribute__((ext_vector_type(2)));
__device__ __forceinline__ unsigned cvtpk_s(float lo,float hi){f32x2_t v={lo,hi};bf16x2_t b=__builtin_convertvector(v,bf16x2_t);return __builtin_bit_cast(unsigned,b);}
#define WAIT_BAR(N) asm volatile("s_waitcnt vmcnt(" #N ") lgkmcnt(0)\n\ts_barrier":::"memory")

__device__ __forceinline__ void qkt(f32x16&p0,f32x16&p1,const char*Kslot,const bf16x8*qr,const f32x16&negm,int r32,int hi){
  const char*kb=Kslot+hi*1024+r32*16;
  #pragma unroll
  for(int d0=0;d0<4;++d0){
    const bf16x8 b0=*reinterpret_cast<const bf16x8*>(kb+d0*2048);
    const bf16x8 b1=*reinterpret_cast<const bf16x8*>(kb+d0*2048+512);
    if(d0==0){p0=__builtin_amdgcn_mfma_f32_32x32x16_bf16(b0,qr[0],negm,0,0,0);p1=__builtin_amdgcn_mfma_f32_32x32x16_bf16(b1,qr[0],negm,0,0,0);}
    else{p0=__builtin_amdgcn_mfma_f32_32x32x16_bf16(b0,qr[d0],p0,0,0,0);p1=__builtin_amdgcn_mfma_f32_32x32x16_bf16(b1,qr[d0],p1,0,0,0);}}
}
typedef __attribute__((address_space(3))) const char* lds_cptr;
typedef short v4i16_t __attribute__((ext_vector_type(4)));
__device__ __forceinline__ void kload8(bf16x8*kf,lds_cptr kp){
  kf[0]=*(const __attribute__((address_space(3))) bf16x8*)(kp);      kf[1]=*(const __attribute__((address_space(3))) bf16x8*)(kp+512);
  kf[2]=*(const __attribute__((address_space(3))) bf16x8*)(kp+2048); kf[3]=*(const __attribute__((address_space(3))) bf16x8*)(kp+2560);
  kf[4]=*(const __attribute__((address_space(3))) bf16x8*)(kp+4096); kf[5]=*(const __attribute__((address_space(3))) bf16x8*)(kp+4608);
  kf[6]=*(const __attribute__((address_space(3))) bf16x8*)(kp+6144); kf[7]=*(const __attribute__((address_space(3))) bf16x8*)(kp+6656);
}
__device__ __forceinline__ void kload2(bf16x8*kf,lds_cptr kp,int j){ kf[2*j]=*(const __attribute__((address_space(3))) bf16x8*)(kp+j*2048); kf[2*j+1]=*(const __attribute__((address_space(3))) bf16x8*)(kp+j*2048+512); }
__device__ __forceinline__ s16x4 vtr(lds_cptr p){ return __builtin_bit_cast(s16x4,__builtin_amdgcn_ds_read_tr16_b64_v4i16((__attribute__((address_space(3))) v4i16_t*)p)); }
__device__ __forceinline__ float rowmax(const f32x16&p0,const f32x16&p1){
  float a=max3f(p0[0],p0[1],p1[0]),b=max3f(p0[2],p0[3],p1[1]);a=max3f(a,p1[2],p1[3]);
  #pragma unroll
  for(int r=4;r<16;r+=4){a=max3f(a,p0[r],p0[r+1]);b=max3f(b,p0[r+2],p0[r+3]);a=max3f(a,p1[r],p1[r+1]);b=max3f(b,p1[r+2],p1[r+3]);}
  const float m=max2f(a,b);
  auto rr=__builtin_amdgcn_permlane32_swap(__float_as_uint(m),__float_as_uint(m),false,false);
  return max2f(__uint_as_float(rr[0]),__uint_as_float(rr[1]));
}
__device__ __forceinline__ void pv(f32x16*o,int vb,bf16x8 pa0,bf16x8 pa1,bf16x8 pa2,bf16x8 pa3){
  #pragma unroll
  for(int d0=0;d0<2;++d0){s16x4 lo[4],hi[4];
    #pragma unroll
    for(int ks=0;ks<4;++ks){
      asm volatile("ds_read_b64_tr_b16 %0,%1 offset:%c2":"=&v"(lo[ks]):"v"(vb),"i"(d0*4096+ks*1024):"memory");
      asm volatile("ds_read_b64_tr_b16 %0,%1 offset:%c2":"=&v"(hi[ks]):"v"(vb),"i"(d0*4096+ks*1024+512):"memory");}
    asm volatile("s_waitcnt lgkmcnt(0)":::"memory");SBAR();
    #define PK(k) (bf16x8){lo[k][0],lo[k][1],lo[k][2],lo[k][3],hi[k][0],hi[k][1],hi[k][2],hi[k][3]}
    o[d0]=__builtin_amdgcn_mfma_f32_32x32x16_bf16(pa0,PK(0),o[d0],0,0,0);
    o[d0]=__builtin_amdgcn_mfma_f32_32x32x16_bf16(pa1,PK(1),o[d0],0,0,0);
    o[d0]=__builtin_amdgcn_mfma_f32_32x32x16_bf16(pa2,PK(2),o[d0],0,0,0);
    o[d0]=__builtin_amdgcn_mfma_f32_32x32x16_bf16(pa3,PK(3),o[d0],0,0,0);
    #undef PK
  }
}

#ifndef ATTN_STORE16
#define ATTN_STORE16(p,v) (*(u32x4*)(p)=(v))
#endif
template<int THRL> __device__ __forceinline__ void attn_unit(int hq,int hv,int qb,const bf16*Q,const bf16*__restrict__ K,const bf16*__restrict__ V,bf16*O,char*shm,const int tid){
  const int lane=tid&63,r32=lane&31,hi=lane>>5; const int wid=__builtin_amdgcn_readfirstlane(tid>>6);
  const long rowbase=0; const int q0=qb*QB;
  const bf16*Qw=Q+(rowbase+q0+wid*QBLK)*DM+hq*D;
  const bf16*Kh=K+rowbase*DM+hq*D,*Vh=V+rowbase*DM+hv*D;
  const unsigned lds0=(unsigned)(uintptr_t)shm;
  float*wsf=(float*)(shm+LDS_WS)+wid*64;
  const bf16*ksrc=Kh+(long)lane*DM+wid*8;
  const bf16*vsrc=Vh+(long)(16*(wid&3)+(lane>>2))*DM+(wid>>2)*32+(lane&3)*8;
  const unsigned kdst=lds0+LDS_K+wid*1024, vdst=lds0+LDS_V+wid*1024;
  #define DMA_K(t,slot) glds16(ksrc+(long)(t)*KVBLK*DM,(unsigned)__builtin_amdgcn_readfirstlane(kdst+(slot)))
  #define DMA_V(t,slot) glds16(vsrc+(long)(t)*KVBLK*DM,(unsigned)__builtin_amdgcn_readfirstlane(vdst+(slot)))
  const int vb0=(int)(lds0+LDS_V)+((lane>>4)&1)*32+(lane&3)*8+(4*hi+((lane&15)>>2))*64;
  const char*Kbase=shm+LDS_K; bf16x8 kf[8];
  const lds_cptr shm3=(lds_cptr)shm; const lds_cptr kp0=shm3+LDS_K+hi*1024+r32*16; const lds_cptr vp0=shm3+LDS_V+((lane>>4)&1)*32+(lane&3)*8+(4*hi+((lane&15)>>2))*64;
  const int NT=(q0+QB)/KVBLK;
  DMA_K(0,0);DMA_V(0,0);DMA_K(1,SLOTB);
  bf16x8 qr[4];
  #pragma unroll
  for(int d0=0;d0<4;++d0)qr[d0]=*reinterpret_cast<const bf16x8*>(&Qw[(long)r32*DM+d0*16+hi*8]);
  float mhat=0.f,l_reg=0.f;f32x16 o[2];o[0]=f32x16{};o[1]=f32x16{};f32x16 negm=f32x16{};asm volatile("":"+v"(negm));
  const int qrel=wid*QBLK+r32;
  #define CMASK(P0,P1,t) do{int jb_=(t)-(NT-4); if(jb_>=0)cmask(P0,P1,jb_,qrel,hi);}while(0)
  bool resc=false;
  #define START(P0,P1) do{ const float rm=rowmax(P0,P1); resc=false; \
    { const float dl=rm; mhat=fadd_s(mhat,dl); \
      _Pragma("unroll") for(int r=0;r<16;++r){P0[r]=fsub_s(P0[r],dl);P1[r]=fsub_s(P1[r],dl);} \
      _Pragma("unroll") for(int r=0;r<16;++r)negm[r]=-mhat; asm volatile("":"+v"(negm)); } \
    _Pragma("unroll") for(int r=0;r<16;++r)P0[r]=__builtin_amdgcn_exp2f(P0[r]); }while(0)
  #define RESC() do{ if(resc){ asm volatile("s_waitcnt lgkmcnt(0)":::"memory"); \
      _Pragma("unroll") for(int d_=0;d_<2;++d_) _Pragma("unroll") for(int r=0;r<16;++r)o[d_][r]*=wsf[crow(r,hi)]; } }while(0)
  f32x16 pA0,pA1,pB0,pB1;
  int sl_prev=0,sl_cur=0,sl_next=SLOTB;
  #define ROT() do{sl_prev=sl_cur;sl_cur=sl_next;sl_next=(sl_next==(NSLOT-1)*SLOTB)?0:sl_next+SLOTB;}while(0)
  DMA_K(2,2*SLOTB);
  WAIT_BAR(3);
  qkt(pA0,pA1,Kbase,qr,negm,r32,hi);asm volatile("s_nop 15\n\ts_nop 7":"+v"(pA0),"+v"(pA1));CMASK(pA0,pA1,0);
  START(pA0,pA1);
  _Pragma("unroll") for(int r=0;r<16;++r)pA1[r]=__builtin_amdgcn_exp2f(pA1[r]);
  WAIT_BAR(0);
  DMA_K(3,0);DMA_V(1,SLOTB);
  ROT();
  kload8(kf,kp0+sl_cur);
  WAIT_BAR(2);
  s16x4 vlo[8],vhi[8]; u32x4 pw0,pw1,pw2,pw3;
  #define PKW(P,B) cvtpk_s(P[B],P[B+1])
  #define PAF(k) __builtin_bit_cast(bf16x8,pw##k)
  #define VFR(i) (bf16x8){vlo[i][0],vlo[i][1],vlo[i][2],vlo[i][3],vhi[i][0],vhi[i][1],vhi[i][2],vhi[i][3]}
  #define PIN(x) asm volatile("":"+v"(x))
  #define MX3(a,b,c) __builtin_fmaxf(__builtin_fmaxf((a),(b)),(c))
  #define GAPA(MF,A0,A1,A2,A3,W0,W1,PW) do{ MF; sacc+=A0; sacc+=A1; sacc+=A2; sacc+=A3; PIN(sacc); W0; W1; PIN(PW); SBAR(); }while(0)
  #define EX(v) __builtin_amdgcn_exp2f(v)
  #define GAPB(MF,X,B) do{ MF; X[B]=EX(X[B]); X[B+1]=EX(X[B+1]); X[B+2]=EX(X[B+2]); X[B+3]=EX(X[B+3]); PIN(X); SBAR(); }while(0)
  #define VRD(i) do{ vlo[i]=vtr(vp_+(((i)>>2)*4096+((i)&3)*1024)); vhi[i]=vtr(vp_+(((i)>>2)*4096+((i)&3)*1024+512)); }while(0)
  #define KRD(G,j) do{ if(G){ kload2(kf,kp0+sl_next,j); SBAR(); } }while(0)
  #define STEP(C0,C1,P0,P1,t,GK,GV,GL) do{ SBAR(); \
    const lds_cptr vp_=vp0+sl_prev; \
    VRD(0); SBAR(); float sacc=(P0[0]+P0[1]); \
    GAPA(C0=__builtin_amdgcn_mfma_f32_32x32x16_bf16(kf[0],qr[0],negm,0,0,0), P0[2],P0[3],P0[4],P0[5],     pw0[0]=PKW(P0,0), pw0[1]=PKW(P0,2), pw0); \
    VRD(4); SBAR(); GAPA(C1=__builtin_amdgcn_mfma_f32_32x32x16_bf16(kf[1],qr[0],negm,0,0,0), P0[6],P0[7],P0[8],P0[9],     pw0[2]=PKW(P0,4), pw0[3]=PKW(P0,6), pw0); \
    VRD(1); SBAR(); GAPA(C0=__builtin_amdgcn_mfma_f32_32x32x16_bf16(kf[2],qr[1],C0,0,0,0),   P0[10],P0[11],P0[12],P0[13], pw1[0]=PKW(P0,8), pw1[1]=PKW(P0,10), pw1); \
    VRD(5); SBAR(); GAPA(C1=__builtin_amdgcn_mfma_f32_32x32x16_bf16(kf[3],qr[1],C1,0,0,0),   P0[14],P0[15],P1[0],P1[1],   pw1[2]=PKW(P0,12),pw1[3]=PKW(P0,14), pw1); \
    VRD(2); SBAR(); GAPA(C0=__builtin_amdgcn_mfma_f32_32x32x16_bf16(kf[4],qr[2],C0,0,0,0),   P1[2],P1[3],P1[4],P1[5],     pw2[0]=PKW(P1,0), pw2[1]=PKW(P1,2), pw2); \
    VRD(6); SBAR(); GAPA(C1=__builtin_amdgcn_mfma_f32_32x32x16_bf16(kf[5],qr[2],C1,0,0,0),   P1[6],P1[7],P1[8],P1[9],     pw2[2]=PKW(P1,4), pw2[3]=PKW(P1,6), pw2); \
    VRD(3); SBAR(); GAPA(C0=__builtin_amdgcn_mfma_f32_32x32x16_bf16(kf[6],qr[3],C0,0,0,0),   P1[10],P1[11],P1[12],P1[13], pw3[0]=PKW(P1,8), pw3[1]=PKW(P1,10), pw3); \
    VRD(7); SBAR(); GAPA(C1=__builtin_amdgcn_mfma_f32_32x32x16_bf16(kf[7],qr[3],C1,0,0,0),   P1[14],P1[15],0.f,0.f,       pw3[2]=PKW(P1,12),pw3[3]=PKW(P1,14), pw3); \
    l_reg+=sacc; \
    if(GK){DMA_K((t)+3,sl_cur);} if(GV){DMA_V((t)+1,sl_next);} \
    CMASK(C0,C1,t); \
    { float a=MX3(C0[0],C0[1],C1[0]),b=MX3(C0[2],C0[3],C1[1]); a=MX3(a,C1[2],C1[3]); \
      _Pragma("unroll") for(int r=4;r<16;r+=4){a=MX3(a,C0[r],C0[r+1]);b=MX3(b,C0[r+2],C0[r+3]);a=MX3(a,C1[r],C1[r+1]);b=MX3(b,C1[r+2],C1[r+3]);} \
      float rm=__builtin_fmaxf(a,b); { auto rr=__builtin_amdgcn_permlane32_swap(__float_as_uint(rm),__float_as_uint(rm),false,false); rm=__builtin_fmaxf(__uint_as_float(rr[0]),__uint_as_float(rr[1])); } \
      resc=false; \
      if(__builtin_expect(__any(rm>(float)THRL),0)){ const float dl=__builtin_fmaxf(rm,0.f); mhat+=dl; \
        _Pragma("unroll") for(int r=0;r<16;++r){C0[r]-=dl;C1[r]-=dl;} \
        _Pragma("unroll") for(int r=0;r<16;++r)negm[r]=-mhat; asm volatile("":"+v"(negm)); \
        const float f=__builtin_amdgcn_exp2f(-dl); l_reg*=f; if(hi==0)wsf[r32]=f; resc=true; } } \
    SBAR(); \
    GAPB(o[0]=__builtin_amdgcn_mfma_f32_32x32x16_bf16(PAF(0),VFR(0),o[0],0,0,0), C0,0); \
    GAPB(o[1]=__builtin_amdgcn_mfma_f32_32x32x16_bf16(PAF(0),VFR(4),o[1],0,0,0), C0,4); \
    KRD(GL,0); GAPB(o[0]=__builtin_amdgcn_mfma_f32_32x32x16_bf16(PAF(1),VFR(1),o[0],0,0,0), C0,8); \
    KRD(GL,1); GAPB(o[1]=__builtin_amdgcn_mfma_f32_32x32x16_bf16(PAF(1),VFR(5),o[1],0,0,0), C0,12); \
    KRD(GL,2); GAPB(o[0]=__builtin_amdgcn_mfma_f32_32x32x16_bf16(PAF(2),VFR(2),o[0],0,0,0), C1,0); \
    KRD(GL,3); GAPB(o[1]=__builtin_amdgcn_mfma_f32_32x32x16_bf16(PAF(2),VFR(6),o[1],0,0,0), C1,4); \
    GAPB(o[0]=__builtin_amdgcn_mfma_f32_32x32x16_bf16(PAF(3),VFR(3),o[0],0,0,0), C1,8); \
    GAPB(o[1]=__builtin_amdgcn_mfma_f32_32x32x16_bf16(PAF(3),VFR(7),o[1],0,0,0), C1,12); \
    }while(0)
  int t=1;
  #undef CMASK
  #define CMASK(P0,P1,t) do{}while(0)
  for(;t+5<NT;t+=2){
    STEP(pB0,pB1,pA0,pA1,t,true,true,true);     WAIT_BAR(2); RESC(); ROT();
    STEP(pA0,pA1,pB0,pB1,t+1,true,true,true);   WAIT_BAR(2); RESC(); ROT();
  }
  #undef CMASK
  #define CMASK(P0,P1,t) do{int jb_=(t)-(NT-4); if(jb_>=0)cmask(P0,P1,jb_,qrel,hi);}while(0)
  #define ENDW(tt) do{ if((tt)+3<NT){WAIT_BAR(2);} else if((tt)+2<NT){WAIT_BAR(1);} else {WAIT_BAR(0);} }while(0)
  for(;t+1<NT;t+=2){
    STEP(pB0,pB1,pA0,pA1,t,(t+3<NT),(t+1<NT),(t+1<NT));       ENDW(t);   RESC(); ROT();
    STEP(pA0,pA1,pB0,pB1,t+1,(t+4<NT),(t+2<NT),(t+2<NT));     ENDW(t+1); RESC(); ROT();
  }
  STEP(pB0,pB1,pA0,pA1,NT-1,false,false,false); RESC();
  { float sacc=pB0[0]+pB0[1]; _Pragma("unroll") for(int r=2;r<16;++r)sacc+=pB0[r]; _Pragma("unroll") for(int r=0;r<16;++r)sacc+=pB1[r]; l_reg+=sacc;
    pw0=(u32x4){PKW(pB0,0),PKW(pB0,2),PKW(pB0,4),PKW(pB0,6)};pw1=(u32x4){PKW(pB0,8),PKW(pB0,10),PKW(pB0,12),PKW(pB0,14)};pw2=(u32x4){PKW(pB1,0),PKW(pB1,2),PKW(pB1,4),PKW(pB1,6)};pw3=(u32x4){PKW(pB1,8),PKW(pB1,10),PKW(pB1,12),PKW(pB1,14)};
    SBAR(); pv(o,vb0+sl_cur,PAF(0),PAF(1),PAF(2),PAF(3)); }
  #undef PKW
  #undef PAF
  #undef VFR
  #undef PIN
  #undef MX3
  #undef GAPA
  #undef GAPB
  #undef EX
  #undef VRD
  #undef KRD
  #undef STEP
  #undef ENDW
  {auto rr=__builtin_amdgcn_permlane32_swap(__float_as_uint(l_reg),__float_as_uint(l_reg),false,false);l_reg=__uint_as_float(rr[0])+__uint_as_float(rr[1]);}
  if(hi==0)wsf[32+r32]=l_reg;asm volatile("s_waitcnt lgkmcnt(0)":::"memory");
  float rli[16];
  #pragma unroll
  for(int r=0;r<16;++r)rli[r]=__builtin_amdgcn_rcpf(wsf[32+crow(r,hi)]);
  bf16*Ow=O+(rowbase+q0+wid*QBLK)*DM+hv*D;
  { bf16*stg=(bf16*)(shm+LDS_OST)+wid*2048;
    #pragma unroll
    for(int r=0;r<16;++r){const int orow=crow(r,hi);
      #pragma unroll
      for(int d0=0;d0<2;++d0)stg[orow*64+d0*32+r32]=__float2bfloat16(o[d0][r]*rli[r]);}
    asm volatile("s_waitcnt lgkmcnt(0)":::"memory");
    #pragma unroll
    for(int i=0;i<4;++i){const int row=i*8+(lane>>3),ch=lane&7; const u32x4 v=*(const u32x4*)(stg+row*64+ch*8); ATTN_STORE16(Ow+(long)row*DM+ch*8,v);} }
  asm volatile("s_waitcnt lgkmcnt(0)\n\ts_barrier":::"memory");
  #undef DMA_K
  #undef DMA_V
  #undef CMASK
  #undef START
  #undef RESC
  #undef ROT
}

constexpr int ATTN_LDS_BYTES=LDS_BYTES;
#undef SBAR
#undef WAIT_BAR
}
namespace attn_body {
#if NAIVE_ATTN
__device__ __forceinline__ void attn_unit_naive(int hq,int hv,int qb,const bf16_t*Q,const bf16_t*K,const bf16_t*V,bf16_t*O,const int tid_){
  const int lane=tid_&63, wid=tid_>>6;
#pragma unroll 1
  for(int r=0;r<32;++r){ const int row=qb*256+wid*32+r;
    float q[64];
#pragma unroll
    for(int c=0;c<8;++c){ const ::u32x4 w=*(const ::u32x4*)(Q+(size_t)row*1024+hq*64+c*8); q[c*8+0]=bflo(w.x);q[c*8+1]=bfhi(w.x);q[c*8+2]=bflo(w.y);q[c*8+3]=bfhi(w.y);q[c*8+4]=bflo(w.z);q[c*8+5]=bfhi(w.z);q[c*8+6]=bflo(w.w);q[c*8+7]=bfhi(w.w); }
    float m=-INFINITY,l=0.f,o=0.f;
#pragma unroll 1
    for(int j0=0;j0<=row;j0+=64){ const int j=j0+lane; float s=-INFINITY;
      if(j<=row){ float a=0.f;
#pragma unroll
        for(int c=0;c<8;++c){ const ::u32x4 w=*(const ::u32x4*)(K+(size_t)j*1024+hq*64+c*8); a+=q[c*8+0]*bflo(w.x)+q[c*8+1]*bfhi(w.x)+q[c*8+2]*bflo(w.y)+q[c*8+3]*bfhi(w.y)+q[c*8+4]*bflo(w.z)+q[c*8+5]*bfhi(w.z)+q[c*8+6]*bflo(w.w)+q[c*8+7]*bfhi(w.w); }
        s=a; }
      const float mb=wave_max(s);
      const float mn=fmaxf(m,mb), alpha=exp2f(m-mn); const float p=(j<=row)?exp2f(s-mn):0.f;
      l=l*alpha+wave_sum(p); o*=alpha;
      const int nj=(row-j0+1)<64?(row-j0+1):64;
#pragma unroll 1
      for(int jj=0;jj<nj;++jj){ const float pj=__builtin_bit_cast(float,__builtin_amdgcn_readlane(__builtin_bit_cast(int,p),jj)); o+=pj*bf2f(V[(size_t)(j0+jj)*1024+hv*64+lane]); }
      m=mn; }
    O[(size_t)row*1024+hv*64+lane]=(bf16_t)f2bf(o/l);
  }
}
#endif
__device__ __forceinline__ void attn_phase(char* lds, const bf16_t* Q, const bf16_t* K, const bf16_t* V, bf16_t* O1, bf16_t* O2, int vcu, int G, const int tid) {
  const int nu = (G == 256) ? 4 : (1024 - vcu + G - 1) / G;
#pragma unroll 1
  for (int i = 0; i < nu; ++i) {
    int bh, qb;
    if (G == 256) { const int s = vcu & 7; bh = vcu >> 3; qb = (i == 0) ? s : (i == 1) ? 15 - s : (i == 2) ? 16 + s : 31 - s; }
    else { const int L = vcu + i * G; bh = L >> 5; qb = L & 31; }
    const int h = bh >> 2, c = (bh >> 1) & 1, vh = bh & 1;
    int tid_u = tid; asm volatile("" : "+v"(tid_u));
#if NAIVE_ATTN
    attn_unit_naive(h * 2 + c, h * 2 + vh, qb, Q, K, V, c ? O2 : O1, tid_u);
#else
    attn_unit<8>(h * 2 + c, h * 2 + vh, qb, (const bf16*)Q, (const bf16*)K, (const bf16*)V, (bf16*)(c ? O2 : O1), lds, tid_u);
#endif
  }
}
}
namespace attn128 {
using bf16=__hip_bfloat16;
using bf16x8=__attribute__((ext_vector_type(8)))short;
using s16x4=__attribute__((ext_vector_type(4)))short;
using f32x16=__attribute__((ext_vector_type(16)))float;
using u32x4=__attribute__((ext_vector_type(4)))unsigned;
constexpr int BATCH=1,NHEAD=16,SEQ=8192,D=64,DM=NHEAD*D;
constexpr int NW=8,QBLK=32,QB=QBLK*NW,KVBLK=64,NQB=SEQ/QB;
constexpr int ATTN_PITCH=DM, ATTN_UNIT_ROWS=QB;
__device__ __forceinline__ int crow(int r,int hi){return (r&3)+8*(r>>2)+4*hi;}
#define SBAR() __builtin_amdgcn_sched_barrier(0)
__device__ __forceinline__ void cmask(f32x16&p0,f32x16&p1,int jb,int qrel,int hi){
  const float NEG=-INFINITY; int kb=64*jb+4*hi;
  #pragma unroll
  for(int r=0;r<16;++r){int kv=kb+(r&3)+8*(r>>2); if(kv>qrel)p0[r]=NEG; if(kv+32>qrel)p1[r]=NEG;}
}

constexpr int NSLOT=3, SLOTB=8192;
constexpr int VSLOTB=2*SLOTB;
constexpr int LDS_K=0, LDS_V=NSLOT*SLOTB, LDS_WS=LDS_V+NSLOT*VSLOTB, LDS_OST=LDS_WS+NW*64*4, LDS_BYTES=LDS_OST+NW*4096;
constexpr float C2=0.125f*1.4426950408889634f;
__device__ __forceinline__ void glds16(const void*gsrc,unsigned lds_dst){unsigned keep;
  asm volatile("s_mov_b32 %0, m0\n\ts_mov_b32 m0, %2\n\ts_nop 0\n\tglobal_load_lds_dwordx4 %1, off\n\ts_mov_b32 m0, %0":"=&s"(keep):"v"(gsrc),"s"(lds_dst):"memory");}
__device__ __forceinline__ float max3f(float a,float b,float c){float r;asm("v_max3_f32 %0, %1, %2, %3":"=v"(r):"v"(a),"v"(b),"v"(c));return r;}
__device__ __forceinline__ float max2f(float a,float b){float r;asm("v_max_f32_e32 %0, %1, %2":"=v"(r):"v"(a),"v"(b));return r;}
__device__ __forceinline__ float fadd_s(float a,float b){float r;asm("v_add_f32_e32 %0, %1, %2":"=v"(r):"v"(a),"v"(b));return r;}
__device__ __forceinline__ float fsub_s(float a,float b){float r;asm("v_sub_f32_e32 %0, %1, %2":"=v"(r):"v"(a),"v"(b));return r;}
typedef float f32x2_t __attribute__((ext_vector_type(2))); typedef __bf16 bf16x2_t __attribute__((ext_vector_type(2)));
__device__ __forceinline__ unsigned cvtpk_s(float lo,float hi){f32x2_t v={lo,hi};bf16x2_t b=__builtin_convertvector(v,bf16x2_t);return __builtin_bit_cast(unsigned,b);}
#define WAIT_BAR(N) asm volatile("s_waitcnt vmcnt(" #N ") lgkmcnt(0)\n\ts_barrier":::"memory")

__device__ __forceinline__ void qkt(f32x16&p0,f32x16&p1,const char*Kslot,const bf16x8*qr,const f32x16&negm,int r32,int hi){
  const char*kb=Kslot+hi*1024+r32*16;
  #pragma unroll
  for(int d0=0;d0<4;++d0){
    const bf16x8 b0=*reinterpret_cast<const bf16x8*>(kb+d0*2048);
    const bf16x8 b1=*reinterpret_cast<const bf16x8*>(kb+d0*2048+512);
    if(d0==0){p0=__builtin_amdgcn_mfma_f32_32x32x16_bf16(b0,qr[0],negm,0,0,0);p1=__builtin_amdgcn_mfma_f32_32x32x16_bf16(b1,qr[0],negm,0,0,0);}
    else{p0=__builtin_amdgcn_mfma_f32_32x32x16_bf16(b0,qr[d0],p0,0,0,0);p1=__builtin_amdgcn_mfma_f32_32x32x16_bf16(b1,qr[d0],p1,0,0,0);}}
}
typedef __attribute__((address_space(3))) const char* lds_cptr;
typedef short v4i16_t __attribute__((ext_vector_type(4)));
__device__ __forceinline__ void kload8(bf16x8*kf,lds_cptr kp){
  kf[0]=*(const __attribute__((address_space(3))) bf16x8*)(kp);      kf[1]=*(const __attribute__((address_space(3))) bf16x8*)(kp+512);
  kf[2]=*(const __attribute__((address_space(3))) bf16x8*)(kp+2048); kf[3]=*(const __attribute__((address_space(3))) bf16x8*)(kp+2560);
  kf[4]=*(const __attribute__((address_space(3))) bf16x8*)(kp+4096); kf[5]=*(const __attribute__((address_space(3))) bf16x8*)(kp+4608);
  kf[6]=*(const __attribute__((address_space(3))) bf16x8*)(kp+6144); kf[7]=*(const __attribute__((address_space(3))) bf16x8*)(kp+6656);
}
__device__ __forceinline__ void kload2(bf16x8*kf,lds_cptr kp,int j){ kf[2*j]=*(const __attribute__((address_space(3))) bf16x8*)(kp+j*2048); kf[2*j+1]=*(const __attribute__((address_space(3))) bf16x8*)(kp+j*2048+512); }
__device__ __forceinline__ s16x4 vtr(lds_cptr p){ return __builtin_bit_cast(s16x4,__builtin_amdgcn_ds_read_tr16_b64_v4i16((__attribute__((address_space(3))) v4i16_t*)p)); }
__device__ __forceinline__ float rowmax(const f32x16&p0,const f32x16&p1){
  float a=max3f(p0[0],p0[1],p1[0]),b=max3f(p0[2],p0[3],p1[1]);a=max3f(a,p1[2],p1[3]);
  #pragma unroll
  for(int r=4;r<16;r+=4){a=max3f(a,p0[r],p0[r+1]);b=max3f(b,p0[r+2],p0[r+3]);a=max3f(a,p1[r],p1[r+1]);b=max3f(b,p1[r+2],p1[r+3]);}
  const float m=max2f(a,b);
  auto rr=__builtin_amdgcn_permlane32_swap(__float_as_uint(m),__float_as_uint(m),false,false);
  return max2f(__uint_as_float(rr[0]),__uint_as_float(rr[1]));
}
__device__ __forceinline__ void pv(f32x16*o,int vb,bf16x8 pa0,bf16x8 pa1,bf16x8 pa2,bf16x8 pa3){
  #pragma unroll
  for(int d0=0;d0<4;++d0){s16x4 lo[4],hi[4];
    #pragma unroll
    for(int ks=0;ks<4;++ks){
      asm volatile("ds_read_b64_tr_b16 %0,%1 offset:%c2":"=&v"(lo[ks]):"v"(vb),"i"(d0*4096+ks*1024):"memory");
      asm volatile("ds_read_b64_tr_b16 %0,%1 offset:%c2":"=&v"(hi[ks]):"v"(vb),"i"(d0*4096+ks*1024+512):"memory");}
    asm volatile("s_waitcnt lgkmcnt(0)":::"memory");SBAR();
    #define PK(k) (bf16x8){lo[k][0],lo[k][1],lo[k][2],lo[k][3],hi[k][0],hi[k][1],hi[k][2],hi[k][3]}
    o[d0]=__builtin_amdgcn_mfma_f32_32x32x16_bf16(pa0,PK(0),o[d0],0,0,0);
    o[d0]=__builtin_amdgcn_mfma_f32_32x32x16_bf16(pa1,PK(1),o[d0],0,0,0);
    o[d0]=__builtin_amdgcn_mfma_f32_32x32x16_bf16(pa2,PK(2),o[d0],0,0,0);
    o[d0]=__builtin_amdgcn_mfma_f32_32x32x16_bf16(pa3,PK(3),o[d0],0,0,0);
    #undef PK
  }
}

#ifndef ATTN_STORE16
#define ATTN_STORE16(p,v) (*(u32x4*)(p)=(v))
#endif
template<int THRL> __device__ __forceinline__ void attn_unit(int hq,int hv,int qb,const bf16*Q,const bf16*__restrict__ K,const bf16*__restrict__ V,bf16*O,char*shm,const int tid){
  const int lane=tid&63,r32=lane&31,hi=lane>>5; const int wid=__builtin_amdgcn_readfirstlane(tid>>6);
  const long rowbase=0; const int q0=qb*QB;
  const bf16*Qw=Q+(rowbase+q0+wid*QBLK)*DM+hq*D;
  const bf16*Kh=K+rowbase*DM+hq*D,*Vh=V+rowbase*DM+hv*128;
  const unsigned lds0=(unsigned)(uintptr_t)shm;
  float*wsf=(float*)(shm+LDS_WS)+wid*64;
  const bf16*ksrc=Kh+(long)lane*DM+wid*8;
  const bf16*vsrc=Vh+(long)(16*(wid&3)+(lane>>2))*DM+(wid>>2)*32+(lane&3)*8;
  const unsigned kdst=lds0+LDS_K+wid*1024, vdst=lds0+LDS_V+wid*1024;
  #define DMA_K(t,slot) glds16(ksrc+(long)(t)*KVBLK*DM,(unsigned)__builtin_amdgcn_readfirstlane(kdst+(slot)))
  #define DMA_V(t,slot) do{ glds16(vsrc+(long)(t)*KVBLK*DM,(unsigned)__builtin_amdgcn_readfirstlane(vdst+2*(slot))); glds16(vsrc+(long)(t)*KVBLK*DM+64,(unsigned)__builtin_amdgcn_readfirstlane(vdst+2*(slot)+8192)); }while(0)
  const int vb0=(int)(lds0+LDS_V)+((lane>>4)&1)*32+(lane&3)*8+(4*hi+((lane&15)>>2))*64;
  const char*Kbase=shm+LDS_K; bf16x8 kf[8];
  const lds_cptr shm3=(lds_cptr)shm; const lds_cptr kp0=shm3+LDS_K+hi*1024+r32*16; const lds_cptr vp0=shm3+LDS_V+((lane>>4)&1)*32+(lane&3)*8+(4*hi+((lane&15)>>2))*64;
  const int NT=(q0+QB)/KVBLK;
  DMA_K(0,0);DMA_V(0,0);DMA_K(1,SLOTB);
  bf16x8 qr[4];
  #pragma unroll
  for(int d0=0;d0<4;++d0)qr[d0]=*reinterpret_cast<const bf16x8*>(&Qw[(long)r32*DM+d0*16+hi*8]);
  float mhat=0.f,l_reg=0.f;f32x16 o[4];o[0]=f32x16{};o[1]=f32x16{};o[2]=f32x16{};o[3]=f32x16{};
  const int qrel=wid*QBLK+r32;
  #define CMASK(P0,P1,t) do{int jb_=(t)-(NT-4); if(jb_>=0)cmask(P0,P1,jb_,qrel,hi);}while(0)
  bool resc=false;
  #define START(P0,P1) do{ const float rm=rowmax(P0,P1); resc=false; \
    { const float dl=rm; mhat=fadd_s(mhat,dl); \
      _Pragma("unroll") for(int r=0;r<16;++r){P0[r]=fsub_s(P0[r],dl);P1[r]=fsub_s(P1[r],dl);} \
      } \
    _Pragma("unroll") for(int r=0;r<16;++r)P0[r]=__builtin_amdgcn_exp2f(P0[r]); }while(0)
  #define RESC() do{ if(resc){ asm volatile("s_waitcnt lgkmcnt(0)":::"memory"); \
      _Pragma("unroll") for(int d_=0;d_<4;++d_) _Pragma("unroll") for(int r=0;r<16;++r)o[d_][r]*=wsf[crow(r,hi)]; } }while(0)
  f32x16 pA0,pA1,pB0,pB1;
  int sl_prev=0,sl_cur=0,sl_next=SLOTB;
  #define ROT() do{sl_prev=sl_cur;sl_cur=sl_next;sl_next=(sl_next==(NSLOT-1)*SLOTB)?0:sl_next+SLOTB;}while(0)
  DMA_K(2,2*SLOTB);
  WAIT_BAR(4);
  { const f32x16 zero16=f32x16{}; qkt(pA0,pA1,Kbase,qr,zero16,r32,hi); }asm volatile("s_nop 15\n\ts_nop 7":"+v"(pA0),"+v"(pA1));CMASK(pA0,pA1,0);
  START(pA0,pA1);
  _Pragma("unroll") for(int r=0;r<16;++r)pA1[r]=__builtin_amdgcn_exp2f(pA1[r]);
  WAIT_BAR(0);
  DMA_K(3,0);DMA_V(1,SLOTB);
  ROT();
  kload8(kf,kp0+sl_cur);
  WAIT_BAR(3);
  s16x4 vlo[8],vhi[8]; u32x4 pw0,pw1,pw2,pw3;
  #define PKW(P,B) cvtpk_s(P[B],P[B+1])
  #define PAF(k) __builtin_bit_cast(bf16x8,pw##k)
  #define VFR(i) (bf16x8){vlo[i][0],vlo[i][1],vlo[i][2],vlo[i][3],vhi[i][0],vhi[i][1],vhi[i][2],vhi[i][3]}
  #define PIN(x) asm volatile("":"+v"(x))
  #define MX3(a,b,c) __builtin_fmaxf(__builtin_fmaxf((a),(b)),(c))
  #define GAPA(MF,A0,A1,A2,A3,W0,W1,PW) do{ MF; sacc+=A0; sacc+=A1; sacc+=A2; sacc+=A3; PIN(sacc); W0; W1; PIN(PW); SBAR(); }while(0)
  #define EX(v) __builtin_amdgcn_exp2f(v)
  #define GAPB(MF,X,B) do{ MF; X[B]=EX(X[B]); X[B+1]=EX(X[B+1]); X[B+2]=EX(X[B+2]); X[B+3]=EX(X[B+3]); PIN(X); SBAR(); }while(0)
  #define GAPB2(MF,RD,X,B) do{ MF; RD; X[B]=EX(X[B]); X[B+1]=EX(X[B+1]); PIN(X); SBAR(); }while(0)
  #define VRD2(i) do{ vlo[i]=vtr(vp_+((((i)>>2)+2)*4096+((i)&3)*1024)); vhi[i]=vtr(vp_+((((i)>>2)+2)*4096+((i)&3)*1024+512)); }while(0)
  #define VRD(i) do{ vlo[i]=vtr(vp_+(((i)>>2)*4096+((i)&3)*1024)); vhi[i]=vtr(vp_+(((i)>>2)*4096+((i)&3)*1024+512)); }while(0)
  #define KRD(G,j) do{ if(G){ kload2(kf,kp0+sl_next,j); SBAR(); } }while(0)
  #define STEP(C0,C1,P0,P1,t,GK,GV,GL) do{ SBAR(); \
    const lds_cptr vp_=vp0+2*sl_prev; \
    { const float nm_=-mhat; _Pragma("unroll") for(int r=0;r<16;++r){C0[r]=nm_;C1[r]=nm_;} }     \
    VRD(0); SBAR(); float sacc=(P0[0]+P0[1]); \
    GAPA(C0=__builtin_amdgcn_mfma_f32_32x32x16_bf16(kf[0],qr[0],C0,0,0,0), P0[2],P0[3],P0[4],P0[5],     pw0[0]=PKW(P0,0), pw0[1]=PKW(P0,2), pw0); \
    VRD(4); SBAR(); GAPA(C1=__builtin_amdgcn_mfma_f32_32x32x16_bf16(kf[1],qr[0],C1,0,0,0), P0[6],P0[7],P0[8],P0[9],     pw0[2]=PKW(P0,4), pw0[3]=PKW(P0,6), pw0); \
    VRD(1); SBAR(); GAPA(C0=__builtin_amdgcn_mfma_f32_32x32x16_bf16(kf[2],qr[1],C0,0,0,0),   P0[10],P0[11],P0[12],P0[13], pw1[0]=PKW(P0,8), pw1[1]=PKW(P0,10), pw1); \
    VRD(5); SBAR(); GAPA(C1=__builtin_amdgcn_mfma_f32_32x32x16_bf16(kf[3],qr[1],C1,0,0,0),   P0[14],P0[15],P1[0],P1[1],   pw1[2]=PKW(P0,12),pw1[3]=PKW(P0,14), pw1); \
    VRD(2); SBAR(); GAPA(C0=__builtin_amdgcn_mfma_f32_32x32x16_bf16(kf[4],qr[2],C0,0,0,0),   P1[2],P1[3],P1[4],P1[5],     pw2[0]=PKW(P1,0), pw2[1]=PKW(P1,2), pw2); \
    VRD(6); SBAR(); GAPA(C1=__builtin_amdgcn_mfma_f32_32x32x16_bf16(kf[5],qr[2],C1,0,0,0),   P1[6],P1[7],P1[8],P1[9],     pw2[2]=PKW(P1,4), pw2[3]=PKW(P1,6), pw2); \
    VRD(3); SBAR(); GAPA(C0=__builtin_amdgcn_mfma_f32_32x32x16_bf16(kf[6],qr[3],C0,0,0,0),   P1[10],P1[11],P1[12],P1[13], pw3[0]=PKW(P1,8), pw3[1]=PKW(P1,10), pw3); \
    VRD(7); SBAR(); GAPA(C1=__builtin_amdgcn_mfma_f32_32x32x16_bf16(kf[7],qr[3],C1,0,0,0),   P1[14],P1[15],0.f,0.f,       pw3[2]=PKW(P1,12),pw3[3]=PKW(P1,14), pw3); \
    l_reg+=sacc; \
    if(GK){DMA_K((t)+3,sl_cur);} if(GV){DMA_V((t)+1,sl_next);} \
    CMASK(C0,C1,t); \
    { float a=MX3(C0[0],C0[1],C1[0]),b=MX3(C0[2],C0[3],C1[1]); a=MX3(a,C1[2],C1[3]); \
      _Pragma("unroll") for(int r=4;r<16;r+=4){a=MX3(a,C0[r],C0[r+1]);b=MX3(b,C0[r+2],C0[r+3]);a=MX3(a,C1[r],C1[r+1]);b=MX3(b,C1[r+2],C1[r+3]);} \
      float rm=__builtin_fmaxf(a,b); { auto rr=__builtin_amdgcn_permlane32_swap(__float_as_uint(rm),__float_as_uint(rm),false,false); rm=__builtin_fmaxf(__uint_as_float(rr[0]),__uint_as_float(rr[1])); } \
      resc=false; \
      if(__builtin_expect(__any(rm>(float)THRL),0)){ const float dl=__builtin_fmaxf(rm,0.f); mhat+=dl; \
        _Pragma("unroll") for(int r=0;r<16;++r){C0[r]-=dl;C1[r]-=dl;} \
        const float f=__builtin_amdgcn_exp2f(-dl); l_reg*=f; if(hi==0)wsf[r32]=f; resc=true; } } \
    SBAR(); \
    GAPB2(o[0]=__builtin_amdgcn_mfma_f32_32x32x16_bf16(PAF(0),VFR(0),o[0],0,0,0), VRD2(0), C0,0); \
    GAPB2(o[1]=__builtin_amdgcn_mfma_f32_32x32x16_bf16(PAF(0),VFR(4),o[1],0,0,0), VRD2(4), C0,2); \
    GAPB2(o[0]=__builtin_amdgcn_mfma_f32_32x32x16_bf16(PAF(1),VFR(1),o[0],0,0,0), VRD2(1), C0,4); \
    GAPB2(o[1]=__builtin_amdgcn_mfma_f32_32x32x16_bf16(PAF(1),VFR(5),o[1],0,0,0), VRD2(5), C0,6); \
    GAPB2(o[0]=__builtin_amdgcn_mfma_f32_32x32x16_bf16(PAF(2),VFR(2),o[0],0,0,0), VRD2(2), C0,8); \
    GAPB2(o[1]=__builtin_amdgcn_mfma_f32_32x32x16_bf16(PAF(2),VFR(6),o[1],0,0,0), VRD2(6), C0,10); \
    GAPB2(o[0]=__builtin_amdgcn_mfma_f32_32x32x16_bf16(PAF(3),VFR(3),o[0],0,0,0), VRD2(3), C0,12); \
    GAPB2(o[1]=__builtin_amdgcn_mfma_f32_32x32x16_bf16(PAF(3),VFR(7),o[1],0,0,0), VRD2(7), C0,14); \
    KRD(GL,0); GAPB2(o[2]=__builtin_amdgcn_mfma_f32_32x32x16_bf16(PAF(0),VFR(0),o[2],0,0,0), (void)0, C1,0); \
    KRD(GL,1); GAPB2(o[3]=__builtin_amdgcn_mfma_f32_32x32x16_bf16(PAF(0),VFR(4),o[3],0,0,0), (void)0, C1,2); \
    KRD(GL,2); GAPB2(o[2]=__builtin_amdgcn_mfma_f32_32x32x16_bf16(PAF(1),VFR(1),o[2],0,0,0), (void)0, C1,4); \
    KRD(GL,3); GAPB2(o[3]=__builtin_amdgcn_mfma_f32_32x32x16_bf16(PAF(1),VFR(5),o[3],0,0,0), (void)0, C1,6); \
    GAPB2(o[2]=__builtin_amdgcn_mfma_f32_32x32x16_bf16(PAF(2),VFR(2),o[2],0,0,0), (void)0, C1,8); \
    GAPB2(o[3]=__builtin_amdgcn_mfma_f32_32x32x16_bf16(PAF(2),VFR(6),o[3],0,0,0), (void)0, C1,10); \
    GAPB2(o[2]=__builtin_amdgcn_mfma_f32_32x32x16_bf16(PAF(3),VFR(3),o[2],0,0,0), (void)0, C1,12); \
    GAPB2(o[3]=__builtin_amdgcn_mfma_f32_32x32x16_bf16(PAF(3),VFR(7),o[3],0,0,0), (void)0, C1,14); \
    }while(0)
  int t=1;
  #undef CMASK
  #define CMASK(P0,P1,t) do{}while(0)
  for(;t+5<NT;t+=2){
    STEP(pB0,pB1,pA0,pA1,t,true,true,true);     WAIT_BAR(3); RESC(); ROT();
    STEP(pA0,pA1,pB0,pB1,t+1,true,true,true);   WAIT_BAR(3); RESC(); ROT();
  }
  #undef CMASK
  #define CMASK(P0,P1,t) do{int jb_=(t)-(NT-4); if(jb_>=0)cmask(P0,P1,jb_,qrel,hi);}while(0)
  #define ENDW(tt) do{ if((tt)+3<NT){WAIT_BAR(3);} else if((tt)+2<NT){WAIT_BAR(2);} else {WAIT_BAR(0);} }while(0)
  for(;t+1<NT;t+=2){
    STEP(pB0,pB1,pA0,pA1,t,(t+3<NT),(t+1<NT),(t+1<NT));       ENDW(t);   RESC(); ROT();
    STEP(pA0,pA1,pB0,pB1,t+1,(t+4<NT),(t+2<NT),(t+2<NT));     ENDW(t+1); RESC(); ROT();
  }
  STEP(pB0,pB1,pA0,pA1,NT-1,false,false,false); RESC();
  { float sacc=pB0[0]+pB0[1]; _Pragma("unroll") for(int r=2;r<16;++r)sacc+=pB0[r]; _Pragma("unroll") for(int r=0;r<16;++r)sacc+=pB1[r]; l_reg+=sacc;
    pw0=(u32x4){PKW(pB0,0),PKW(pB0,2),PKW(pB0,4),PKW(pB0,6)};pw1=(u32x4){PKW(pB0,8),PKW(pB0,10),PKW(pB0,12),PKW(pB0,14)};pw2=(u32x4){PKW(pB1,0),PKW(pB1,2),PKW(pB1,4),PKW(pB1,6)};pw3=(u32x4){PKW(pB1,8),PKW(pB1,10),PKW(pB1,12),PKW(pB1,14)};
    SBAR(); pv(o,vb0+2*sl_cur,PAF(0),PAF(1),PAF(2),PAF(3)); }
  #undef PKW
  #undef PAF
  #undef VFR
  #undef PIN
  #undef MX3
  #undef GAPA
  #undef GAPB
  #undef GAPB2
  #undef VRD2
  #undef EX
  #undef VRD
  #undef KRD
  #undef STEP
  #undef ENDW
  {auto rr=__builtin_amdgcn_permlane32_swap(__float_as_uint(l_reg),__float_as_uint(l_reg),false,false);l_reg=__uint_as_float(rr[0])+__uint_as_float(rr[1]);}
  if(hi==0)wsf[32+r32]=l_reg;asm volatile("s_waitcnt lgkmcnt(0)":::"memory");
  float rli[16];
  #pragma unroll
  for(int r=0;r<16;++r)rli[r]=__builtin_amdgcn_rcpf(wsf[32+crow(r,hi)]);
  bf16*Ow=O+(rowbase+q0+wid*QBLK)*DM+hv*128;
  { bf16*stg=(bf16*)(shm+LDS_OST)+wid*2048;
    #pragma unroll
    for(int p=0;p<2;++p){
      #pragma unroll
      for(int r=0;r<16;++r){const int orow=crow(r,hi);
        #pragma unroll
        for(int d0=0;d0<2;++d0)stg[orow*64+d0*32+r32]=__float2bfloat16(o[2*p+d0][r]*rli[r]);}
      asm volatile("s_waitcnt lgkmcnt(0)":::"memory");
      #pragma unroll
      for(int i=0;i<4;++i){const int row=i*8+(lane>>3),ch=lane&7; const u32x4 v=*(const u32x4*)(stg+row*64+ch*8); ATTN_STORE16(Ow+(long)row*DM+p*64+ch*8,v);}
      asm volatile("s_waitcnt lgkmcnt(0)":::"memory"); } }
  asm volatile("s_waitcnt lgkmcnt(0)\n\ts_barrier":::"memory");
  #undef DMA_K
  #undef DMA_V
  #undef CMASK
  #undef START
  #undef RESC
  #undef ROT
}

constexpr int ATTN_LDS_BYTES=LDS_BYTES;
#undef SBAR
#undef WAIT_BAR
}

#ifndef ATTN128
#define ATTN128 1
#endif
namespace attn128 {
__device__ __forceinline__ void attn_phase(char* lds, const bf16_t* Q, const bf16_t* K, const bf16_t* V, bf16_t* O1, bf16_t* O2, int vcu, int G, const int tid) {
  const int nu = (G == 256) ? 2 : (512 - vcu + G - 1) / G;
#pragma unroll 1
  for (int i = 0; i < nu; ++i) {
    int hc, qb;
    if (G == 256) { const int s = vcu & 15; hc = vcu >> 4; qb = (i == 0) ? s : 31 - s; }
    else { const int L = vcu + i * G; hc = L >> 5; qb = L & 31; }
    int tid_u = tid; asm volatile("" : "+v"(tid_u));
    attn_unit<8>(hc, hc >> 1, qb, (const bf16*)Q, (const bf16*)K, (const bf16*)V, (bf16*)((hc & 1) ? O2 : O1), lds, tid_u);
  }
}
}
struct Ctx { unsigned char* ws; LAS unsigned char* lds; gu32* ctl; int tid, lane, wave, vcu, G, gw, NGW; };
__device__ __forceinline__ unsigned char* lwp(const Ctx& F, int l, size_t off) { return F.ws + WS_LW + (size_t)l * LW_SIZE + off; }

__device__ __forceinline__ int rowmap(int kind, int n, int H) {
    if (kind == 1) { const int d = n & 63; return (n & ~63) | (d < 32 ? 2 * d : 2 * (d - 32) + 1); }
    if (kind == 2) return n < H ? 2 * n : 2 * (n - H) + 1;
    if (kind == 3) return 2 * n;
    if (kind == 4) return 2 * n + 1;
    return n;
}
__device__ __forceinline__ void xpose_item(const float* W, int N, bf16_t* WT, int dpitch, int koff, int kind, int nbase, int H, int rbase, int k0, int n0, int lane, const float* gk = nullptr) {
    const int q = lane >> 4, c = lane & 15;
    const float* src = W + (size_t)(k0 + 16 * q) * N + n0 + 4 * c;
    f32x4 v[16];
#pragma unroll
    for (int i = 0; i < 16; ++i) v[i] = __builtin_nontemporal_load((const f32x4*)(src + (size_t)i * N));
    if (gk) { const f32x4* g4 = (const f32x4*)(gk + k0 + 16 * q); const f32x4 ga = g4[0], gb = g4[1], gc = g4[2], gd = g4[3];
#pragma unroll
        for (int i = 0; i < 4; ++i) { v[i] = v[i] * ga[i]; v[4 + i] = v[4 + i] * gb[i]; v[8 + i] = v[8 + i] * gc[i]; v[12 + i] = v[12 + i] * gd[i]; } }
#pragma unroll
    for (int j = 0; j < 4; ++j) { const int drow = rbase + rowmap(kind, n0 + 4 * c + j - nbase, H);
        u32x4 o0, o1; o0.x = pk2(v[0][j], v[1][j]); o0.y = pk2(v[2][j], v[3][j]); o0.z = pk2(v[4][j], v[5][j]); o0.w = pk2(v[6][j], v[7][j]);
        o1.x = pk2(v[8][j], v[9][j]); o1.y = pk2(v[10][j], v[11][j]); o1.z = pk2(v[12][j], v[13][j]); o1.w = pk2(v[14][j], v[15][j]);
        u32x4* dp = (u32x4*)(WT + (size_t)drow * dpitch + koff + k0 + 16 * q); dp[0] = o0; dp[1] = o1; }
}
__device__ __forceinline__ void xpose_item8(const float* W, int N, unsigned char* WT, int dpitch, int kind, int nbase, int k0, int n0, int lane, float scale, int H = 0, int rbase = 0, const float* gk = nullptr) {
    const int q = lane >> 4, c = lane & 15;
    const float* src = W + (size_t)(k0 + 16 * q) * N + n0 + 4 * c;
    f32x4 v[16];
#pragma unroll
    for (int i = 0; i < 16; ++i) v[i] = __builtin_nontemporal_load((const f32x4*)(src + (size_t)i * N)) * scale;
    if (gk) { const f32x4* g4 = (const f32x4*)(gk + k0 + 16 * q); const f32x4 ga = g4[0], gb = g4[1], gc = g4[2], gd = g4[3];
#pragma unroll
        for (int i = 0; i < 4; ++i) { v[i] = v[i] * ga[i]; v[4 + i] = v[4 + i] * gb[i]; v[8 + i] = v[8 + i] * gc[i]; v[12 + i] = v[12 + i] * gd[i]; } }
#pragma unroll
    for (int j = 0; j < 4; ++j) { const int drow = rbase + rowmap(kind, n0 + 4 * c + j - nbase, H); int w[4];
#pragma unroll
        for (int t = 0; t < 4; ++t) { int p8 = __builtin_amdgcn_cvt_pk_fp8_f32(v[4 * t][j], v[4 * t + 1][j], 0, false); w[t] = __builtin_amdgcn_cvt_pk_fp8_f32(v[4 * t + 2][j], v[4 * t + 3][j], p8, true); }
        *(u32x4*)(WT + (size_t)drow * dpitch + k0 + 16 * q) = (u32x4){(unsigned)w[0], (unsigned)w[1], (unsigned)w[2], (unsigned)w[3]}; }
}
#define XP_MAT(W_, K_, N_, WT_, DP_, KOFF_, KIND_, NBASE_, H_, RBASE_, NLO_, NHI_) { const int nb_ = ((NHI_) - (NLO_)) / 64, items_ = ((K_) / 64) * nb_; \
    if (r < items_) { xpose_item((W_), (N_), (bf16_t*)(WT_), (DP_), (KOFF_), (KIND_), (NBASE_), (H_), (RBASE_), 64 * (r / nb_), (NLO_) + 64 * (r % nb_), F.lane); continue; } r -= items_; }

#define XP_MATG(W_, K_, N_, WT_, DP_, KOFF_, KIND_, NBASE_, H_, RBASE_, NLO_, NHI_, GK_) { const int nb_ = ((NHI_) - (NLO_)) / 64, items_ = ((K_) / 64) * nb_; \
    if (r < items_) { xpose_item((W_), (N_), (bf16_t*)(WT_), (DP_), (KOFF_), (KIND_), (NBASE_), (H_), (RBASE_), 64 * (r / nb_), (NLO_) + 64 * (r % nb_), F.lane, (GK_)); continue; } r -= items_; }

__device__ __forceinline__ void sincos_d(double a, float& s, float& c) {
    const double k = rint(a * 0.15915494309189535); const double rr = a - k * 6.283185307179586476925; const float rf = (float)rr; s = sinf(rf); c = cosf(rf);
}

struct Inputs { const LAS unsigned* tab;
    __device__ __forceinline__ const float* ptr(int i) const { const unsigned lo = __builtin_amdgcn_readfirstlane(tab[2 * i]), hi = __builtin_amdgcn_readfirstlane(tab[2 * i + 1]);
        return (const float*)(((unsigned long long)hi << 32) | lo); } };

#ifndef DEFER_CONV
#define DEFER_CONV 1
#endif
constexpr int IT_WIN = 32 * (NPROJ / 64), IT_DA = 16 * 32, IT_CV = 8 * 32, IT_SO = 8 * 32, IT_GLU = 8 * 16, IT_MIX = 32 * 32, IT_KV = 32 * 16, IT_XO = 8 * 32, IT_G = 16 * 32 * 8, IT_D = 16 * 8 * 32;
constexpr int IT_BIG = IT_WIN + IT_DA + IT_CV + IT_SO + IT_GLU + IT_MIX + 2 * IT_G + IT_D;
__device__ __forceinline__ void conv_item(const Ctx& F, const Inputs& I, const int l, int r) {
    do {
        const float* win = I.ptr(4) + (size_t)l * DM * NPROJ;
        const float* gmix = I.ptr(3) + (size_t)l * DM;
        XP_MATG(win, DM, NPROJ, lwp(F, l, LW_WIN), DM, 0, 1, 0, 0, 0, 0, 2048, gmix)
        XP_MATG(win, DM, NPROJ, lwp(F, l, LW_WIN), DM, 0, 0, 0, 0, 0, 2048, 3072, gmix)
        { const int nb_ = 1024 / 64, items_ = (DM / 64) * nb_;
            if (r < items_) { xpose_item8(win, NPROJ, lwp(F, l, LW_WG8), DM, 2, 3072, 64 * (r / nb_), 3072 + 64 * (r % nb_), F.lane, GATE_WSCALE, 512, 6144, gmix); continue; } r -= items_; }
        XP_MATG(win, DM, NPROJ, lwp(F, l, LW_WIN), DM, 0, 0, 4096, 0, 3072, 4096, 4608, gmix)
        { const int nb_ = (NPROJ - 4608) / 64, items_ = (DM / 64) * nb_;
            if (r < items_) { xpose_item8(win, NPROJ, lwp(F, l, LW_WG8), DM, 0, 4608, 64 * (r / nb_), 4608 + 64 * (r % nb_), F.lane, GATE_WSCALE, 0, 0, gmix); continue; } r -= items_; }
        XP_MAT(I.ptr(10) + (size_t)l * 1024 * DM, 1024, DM, lwp(F, l, LW_WCAT), DM, 0, 0, 0, 0, 0, 0, DM)
        XP_MAT(I.ptr(15) + (size_t)l * 512 * DM, 512, DM, lwp(F, l, LW_WCAT), DM, 1024, 0, 0, 0, 0, 0, DM)
        XP_MAT(I.ptr(26) + (size_t)l * 512 * DM, 512, DM, lwp(F, l, LW_WCAT), DM, 1536, 0, 0, 0, 0, 0, DM)
        XP_MAT(I.ptr(24) + (size_t)l * 512 * 1024, 512, 1024, lwp(F, l, LW_WGLU), 512, 0, 2, 0, 512, 0, 0, 1024)
        XP_MAT(I.ptr(27) + (size_t)l * DM * DM, DM, DM, lwp(F, l, LW_WMIX), DM, 0, 0, 0, 0, 0, 0, DM)
        if (r < 2 * IT_G) { const int up = r >= IT_G; if (up) r -= IT_G; const int e = r / (32 * 8); r %= (32 * 8);
            const float* w = I.ptr(up ? 39 : 38) + ((size_t)l * NEXP + e) * DM * FFE;
            xpose_item8(w, FFE, lwp(F, l, LW_WGU) + (size_t)e * 1024 * DM, DM, up ? 4 : 3, 0, 64 * (r / 8), 64 * (r % 8), F.lane, GATE_WSCALE); continue; }
        r -= 2 * IT_G;
        { const int e = r / (8 * 32); r %= (8 * 32); const float* w = I.ptr(40) + ((size_t)l * NEXP + e) * FFE * DM;
            xpose_item8(w, DM, lwp(F, l, LW_WD) + (size_t)e * DM * FFE, FFE, 0, 0, 64 * (r / 32), 64 * (r % 32), F.lane, GATE_WSCALE); }
    } while (0);
}
__device__ __forceinline__ void conv_item_xa(const Ctx& F, const Inputs& I, const int l, int r) {
    do {
        XP_MAT(I.ptr(31) + (size_t)l * DM * 1024, DM, 1024, F.ws + WS_WKVT + (size_t)l * 1024 * DM * 2, DM, 0, 0, 0, 0, 0, 0, 1024)
        XP_MAT(I.ptr(32) + (size_t)l * 512 * DM, 512, DM, F.ws + WS_WXOT + (size_t)l * DM * 512 * 2, 512, 0, 0, 0, 0, 0, 0, DM)
    } while (0);
}
__device__ __forceinline__ void conv_window(const Ctx& F, const Inputs& I, const int l, const int base, const int wave_rank, const int nper) {
#pragma unroll 1
    for (int k = 0; k < nper; ++k) { const int r = base + wave_rank * nper + k; if (r < IT_BIG) conv_item(F, I, l, r); }
}
constexpr int IT_EXP = 2 * IT_G + IT_D, IT_EARLY = IT_BIG - IT_EXP;
__device__ __forceinline__ void ph_prologue_a(const Ctx& F, const Inputs& I) {
    if (DEFER_CONV && F.G == 256) { for (int it = F.gw; it < IT_EARLY; it += F.NGW) conv_item(F, I, 0, it); }
    else for (int it = F.gw; it < NL * IT_BIG; it += F.NGW) conv_item(F, I, it / IT_BIG, it % IT_BIG);
    for (int it = F.gw; it < NL * (IT_KV + IT_XO); it += F.NGW) conv_item_xa(F, I, it / (IT_KV + IT_XO), it % (IT_KV + IT_XO));
    for (size_t i = (size_t)F.gw * 64 + F.lane; i < (size_t)NL * DM * 512 / 8; i += (size_t)F.NGW * 64) {
        const f32x4 a = *(const f32x4*)(I.ptr(30) + i * 8), b = *(const f32x4*)(I.ptr(30) + i * 8 + 4); const float g = FUSE_N2 ? I.ptr(28)[(i * 8) / 512] : 1.f;
        u32x4 o; o.x = pk2(a[0] * g, a[1] * g); o.y = pk2(a[2] * g, a[3] * g); o.z = pk2(b[0] * g, b[1] * g); o.w = pk2(b[2] * g, b[3] * g); *(u32x4*)(F.ws + WS_WQB + i * 16) = o; }
    for (int i = F.gw * 64 + F.lane; i < NL * 20 * DM; i += F.NGW * 64) { const int l = i / (20 * DM), j = (i / DM) % 20, k = i % DM;
        const float g = I.ptr(33)[l * DM + k]; const float w = j < 4 ? I.ptr(34)[((size_t)l * DM + k) * 4 + j] : I.ptr(36)[((size_t)l * DM + k) * 16 + (j - 4)];
        const float p = g * w; const unsigned hb = pk2(p, 0.f) & 0xffffu; const unsigned lb = pk2(p - bflo(hb), 0.f) & 0xffffu;
        ((unsigned short*)lwp(F, l, LW_RT))[j * DM + k] = (unsigned short)hb; ((unsigned short*)lwp(F, l, LW_RT))[(20 + j) * DM + k] = (unsigned short)lb; }
    for (int i = F.gw * 64 + F.lane; i < T * 32; i += F.NGW * 64) { const int t = i >> 5, d = i & 31;
        const double inv = exp(-(double)d * (1.0 / 32.0) * 9.210340371976184); float s, c; sincos_d((double)((const int*)I.ptr(2))[t] * inv, s, c);
        ((float*)(F.ws + WS_ROPE))[i] = c; ((float*)(F.ws + WS_ROPE))[T * 32 + i] = s; }
    for (int rw = F.gw; rw < NL * MEML; rw += F.NGW) { const int l = rw / MEML, m = rw % MEML;
        const f32x4* xr = (const f32x4*)(I.ptr(1) + (size_t)m * DM) + F.lane; f32x4 v[8]; float s = 0.f;
#pragma unroll
        for (int j = 0; j < 8; ++j) { v[j] = xr[64 * j]; s += (v[j][0] * v[j][0] + v[j][1] * v[j][1]) + (v[j][2] * v[j][2] + v[j][3] * v[j][3]); }
        const float rstd = rsqrtf(wave_sum(s) * (1.f / DM) + RMS_EPS);
        const f32x4* gr = (const f32x4*)(I.ptr(29) + (size_t)l * DM) + F.lane; u32x2* o = (u32x2*)(F.ws + WS_MNORM + (size_t)rw * DM * 2) + F.lane;
#pragma unroll
        for (int j = 0; j < 8; ++j) { const f32x4 g = gr[64 * j]; u32x2 w; w.x = pk2(v[j][0] * rstd * g[0], v[j][1] * rstd * g[1]); w.y = pk2(v[j][2] * rstd * g[2], v[j][3] * rstd * g[3]); o[64 * j] = w; } }
    __syncthreads();
    for (int it2 = F.vcu; it2 < NL * 32 * 2; it2 += F.G) {
        const int it = it2 >> 1, hs = it2 & 1, l = it >> 5, g = it & 31;
        LAS f32x2* lamP = (LAS f32x2*)(F.lds + RING_OFF);
        LAS f32x2* Bb = lamP + 33 * 64;
        LAS f32x2* Cc = Bb + 64 * 16;
        LAS float* Kt = (LAS float*)(Cc + 16 * 64);
        LAS f32x2* fz = (LAS f32x2*)(Kt + 32 * 256);
        for (int i = F.tid; i < 33 * 64; i += NWAVES * 64) { const int tau = i >> 6, p = i & 63; const float lr = I.ptr(16)[(l * 32 + g) * 64 + p], li = I.ptr(17)[(l * 32 + g) * 64 + p]; const float dt = expf(I.ptr(18)[l * 32 + g]);
            float s, c; sincos_d((double)tau * (double)li * (double)dt, s, c); const float mg = expf((float)tau * lr * dt); lamP[tau * 64 + p] = (f32x2){mg * c, mg * s}; }
        if (F.tid < 64) { const int p = F.tid; const float lr = I.ptr(16)[(l * 32 + g) * 64 + p], li = I.ptr(17)[(l * 32 + g) * 64 + p]; const float dt = expf(I.ptr(18)[l * 32 + g]);
            float s1, c1; sincos_d((double)li * (double)dt, s1, c1); const float mg1 = expf(lr * dt), abr = mg1 * c1, abi = mg1 * s1, den = lr * lr + li * li;
            fz[p] = (f32x2){((abr - 1.f) * lr + abi * li) / den, (abi * lr - (abr - 1.f) * li) / den}; }
        __syncthreads();
        if (hs == 0 && F.tid < 64) ((f32x2*)lwp(F, l, LW_LAM))[g * 64 + F.tid] = lamP[32 * 64 + F.tid];
        for (int i = F.tid; i < 1024; i += 512) { const int p = i >> 4, h = i & 15; const float br = I.ptr(19)[((size_t)(l * 32 + g) * 64 + p) * 16 + h], bi = I.ptr(20)[((size_t)(l * 32 + g) * 64 + p) * 16 + h]; const f32x2 f = fz[p];
            Bb[i] = (f32x2){f[0] * br - f[1] * bi, f[0] * bi + f[1] * br};
            const int hh = i >> 6, pp = i & 63; Cc[i] = (f32x2){I.ptr(21)[((size_t)(l * 32 + g) * 16 + hh) * 64 + pp], I.ptr(22)[((size_t)(l * 32 + g) * 16 + hh) * 64 + pp]}; }
        __syncthreads();
        for (int i = F.tid; i < 32 * 128; i += 512) { const int tau = i >> 7, h = hs * 8 + ((i >> 4) & 7), h2 = i & 15; float a = 0.f;
            for (int p = 0; p < 64; ++p) { const f32x2 lm = lamP[tau * 64 + p], b = Bb[p * 16 + h2], c = Cc[h * 64 + p]; const float wr_ = lm[0] * b[0] - lm[1] * b[1], wi_ = lm[0] * b[1] + lm[1] * b[0]; a += c[0] * wr_ - c[1] * wi_; }
            if (tau == 0 && h == h2) a += I.ptr(23)[(l * 32 + g) * 16 + h];
            Kt[tau * 256 + h * 16 + h2] = a; }
        __syncthreads();
        bf16_t* bke = (bf16_t*)(lwp(F, l, LW_BKE) + (size_t)g * 512 * 640 * 2);
        for (int i = F.tid; i < 256 * 80; i += 512) { const int nn = i / 80, k8 = i % 80, j = nn >> 3, h = hs * 8 + (nn & 7), n = j * 16 + h; float v[8];
            if (k8 < 64) { const int ii = k8 >> 1, h0 = (k8 & 1) * 8;
#pragma unroll
                for (int q = 0; q < 8; ++q) v[q] = (ii <= j) ? Kt[(j - ii) * 256 + h * 16 + h0 + q] : 0.f; }
            else { const int p0 = (k8 - 64) * 4;
#pragma unroll
                for (int q = 0; q < 4; ++q) { const f32x2 c = Cc[h * 64 + p0 + q], lm = lamP[(j + 1) * 64 + p0 + q]; v[2 * q] = c[0] * lm[0] - c[1] * lm[1]; v[2 * q + 1] = -(c[0] * lm[1] + c[1] * lm[0]); } }
            u32x4 o; o.x = pk2(v[0], v[1]); o.y = pk2(v[2], v[3]); o.z = pk2(v[4], v[5]); o.w = pk2(v[6], v[7]); *(u32x4*)(bke + (size_t)n * 640 + k8 * 8) = o; }
        bf16_t* fm = (bf16_t*)(lwp(F, l, LW_F) + (size_t)g * 128 * 512 * 2);
        for (int i = F.tid; i < 64 * 64; i += 512) { const int n = hs * 64 + (i >> 6), k8 = i & 63, p = n >> 1, im = n & 1, ii = k8 >> 1, h0 = (k8 & 1) * 8; float v[8]; const f32x2 lm = lamP[(31 - ii) * 64 + p];
#pragma unroll
            for (int q = 0; q < 8; ++q) { const f32x2 b = Bb[p * 16 + h0 + q]; v[q] = im ? (lm[0] * b[1] + lm[1] * b[0]) : (lm[0] * b[0] - lm[1] * b[1]); }
            u32x4 o; o.x = pk2(v[0], v[1]); o.y = pk2(v[2], v[3]); o.z = pk2(v[4], v[5]); o.w = pk2(v[6], v[7]); *(u32x4*)(fm + (size_t)n * 512 + k8 * 8) = o; }
        __syncthreads();
    }
}

__device__ __forceinline__ void ph_norm1(const Ctx& F, int l, const float* xin, const float* gain, float* fout) {
    char* X = (char*)(F.ws + WS_X);
    for (int rowb = F.gw; rowb < T; rowb += 2 * F.NGW) {
        f32x4 v[2][8];
        if (l == 0) {
#pragma unroll
            for (int r = 0; r < 2; ++r) { const int row = rowb + r * F.NGW; if (row < T) { const f32x4* xr = (const f32x4*)(xin + (size_t)row * DM) + F.lane;
#pragma unroll
                for (int j = 0; j < 8; ++j) v[r][j] = xr[64 * j]; } } }
        else {
            const int cv = (F.lane < 16) ? (int)__hip_atomic_load(F.ctl + CW_CNT + ((l - 1) * 16 + F.lane) * 16, RLX_AGENT) : 0;
            int4 tk[2];
#pragma unroll
            for (int r = 0; r < 2; ++r) { const int row = rowb + r * F.NGW; tk[r] = (row < T) ? *(const int4*)(F.ws + WS_TOK + (size_t)row * 16) : make_int4(0, 0, 0, 0); }
            unsigned ya[2][8], yb[2][8]; u32x2 xq[2][8];
#pragma unroll
            for (int r = 0; r < 2; ++r) { const int row = rowb + r * F.NGW; if (row < T) {
                int o0 = 0, o1 = 0;
#pragma unroll
                for (int k = 0; k < 16; ++k) { const int ck = __builtin_amdgcn_readlane(cv, k); o0 += (k < tk[r].x) ? ck : 0; o1 += (k < tk[r].z) ? ck : 0; }
                const unsigned* y0 = (const unsigned*)(F.ws + WS_Y + (size_t)(o0 + tk[r].y) * 2048) + F.lane; const unsigned* y1 = (const unsigned*)(F.ws + WS_Y + (size_t)(o1 + tk[r].w) * 2048) + F.lane;
                const u32x2* xr = (const u32x2*)(X + (size_t)row * DM * 2) + F.lane;
#pragma unroll
                for (int j = 0; j < 8; ++j) { ya[r][j] = y0[64 * j]; yb[r][j] = y1[64 * j]; xq[r][j] = xr[64 * j]; } } }
#pragma unroll
            for (int r = 0; r < 2; ++r)
#pragma unroll
                for (int j = 0; j < 8; ++j) { const int a = (int)ya[r][j], b = (int)yb[r][j]; const u32x2 xb = xq[r][j]; f32x4 x = (f32x4){bflo(xb.x), bfhi(xb.x), bflo(xb.y), bfhi(xb.y)};
#ifndef DBG_NO_MOE
                    const f32x2 a0 = __builtin_amdgcn_cvt_pk_f32_fp8(a, false), a1 = __builtin_amdgcn_cvt_pk_f32_fp8(a, true), b0 = __builtin_amdgcn_cvt_pk_f32_fp8(b, false), b1 = __builtin_amdgcn_cvt_pk_f32_fp8(b, true);
                    x[0] += (a0[0] + b0[0]) * (1.f / 16.f); x[1] += (a0[1] + b0[1]) * (1.f / 16.f); x[2] += (a1[0] + b1[0]) * (1.f / 16.f); x[3] += (a1[1] + b1[1]) * (1.f / 16.f);
#endif
                    v[r][j] = x; } }
        const f32x4* gr = (const f32x4*)gain + F.lane;
#pragma unroll
        for (int r = 0; r < 2; ++r) { const int row = rowb + r * F.NGW; if (row < T) {
            float s = 0.f;
#pragma unroll
            for (int j = 0; j < 8; ++j) s += (v[r][j][0] * v[r][j][0] + v[r][j][1] * v[r][j][1]) + (v[r][j][2] * v[r][j][2] + v[r][j][3] * v[r][j][3]);
            const float rstd = rsqrtf(wave_sum(s) * (1.f / DM) + RMS_EPS);
            if (fout) { f32x4* o = (f32x4*)(fout + (size_t)row * DM) + F.lane;
#pragma unroll
                for (int j = 0; j < 8; ++j) { const f32x4 g = gr[64 * j]; o[64 * j] = (f32x4){v[r][j][0] * rstd * g[0], v[r][j][1] * rstd * g[1], v[r][j][2] * rstd * g[2], v[r][j][3] * rstd * g[3]}; } }
            else { u32x2* xo = (u32x2*)(X + (size_t)row * DM * 2) + F.lane; unsigned* o8 = (unsigned*)(F.ws + WS_H8 + (size_t)row * DM) + F.lane;
                if (F.lane == 0) ((float*)(F.ws + WS_RSTD))[row] = rstd;
#pragma unroll
                for (int j = 0; j < 8; ++j) { u32x2 xw; xw.x = pk2(v[r][j][0], v[r][j][1]); xw.y = pk2(v[r][j][2], v[r][j][3]); xo[64 * j] = xw;
                    int p8 = __builtin_amdgcn_cvt_pk_fp8_f32(v[r][j][0], v[r][j][1], 0, false); p8 = __builtin_amdgcn_cvt_pk_fp8_f32(v[r][j][2], v[r][j][3], p8, true); o8[64 * j] = (unsigned)p8; } } } }
    }
}
__device__ __forceinline__ void ph_norm2(const Ctx& F, const float* gain) {
    const float* X = (const float*)(F.ws + WS_X);
    for (int row = F.gw; row < T; row += F.NGW) {
        const f32x4* xr = (const f32x4*)(X + (size_t)row * DM) + F.lane; f32x4 v[8]; float s = 0.f;
#pragma unroll
        for (int j = 0; j < 8; ++j) { v[j] = xr[64 * j]; s += (v[j][0] * v[j][0] + v[j][1] * v[j][1]) + (v[j][2] * v[j][2] + v[j][3] * v[j][3]); }
        const float rstd = rsqrtf(wave_sum(s) * (1.f / DM) + RMS_EPS);
        const f32x4* gr = (const f32x4*)gain + F.lane; u32x2* o = (u32x2*)(F.ws + WS_H + (size_t)row * DM * 2) + F.lane;
#pragma unroll
        for (int j = 0; j < 8; ++j) { const f32x4 g = gr[64 * j]; u32x2 w; w.x = pk2(v[j][0] * rstd * g[0], v[j][1] * rstd * g[1]); w.y = pk2(v[j][2] * rstd * g[2], v[j][3] * rstd * g[3]); o[64 * j] = w; }
    }
}
__device__ __forceinline__ void ph_conv(const Ctx& F, const float* dww, const float* dwb, const float* lng, const float* lnb) {
    LAS float* cs = (LAS float*)(F.lds + RING_OFF);
    const bf16_t* Z = (const bf16_t*)(F.ws + WS_Z);
    for (int run = F.vcu; run < T / 32; run += F.G) {
        const int t0 = run * 32, c = F.tid;
        float w[31];
#pragma unroll
        for (int k = 0; k < 31; ++k) w[k] = dww[k * 512 + c];
        const float b = dwb[c];
        float zz[62];
#pragma unroll
        for (int i = 0; i < 62; ++i) { const int t = t0 - 30 + i; zz[i] = (t >= 0) ? bf2f(Z[(size_t)t * 512 + c]) : 0.f; }
#pragma unroll
        for (int j = 0; j < 32; ++j) { float a = b;
#pragma unroll
            for (int k = 0; k < 31; ++k) a += w[k] * zz[j + k];
            cs[j * 512 + c] = a; }
        __syncthreads();
#pragma unroll
        for (int q = 0; q < 4; ++q) { const int j = F.wave * 4 + q; const f32x4 a0 = *(const LAS f32x4*)(cs + j * 512 + F.lane * 8), a1 = *(const LAS f32x4*)(cs + j * 512 + F.lane * 8 + 4);
            const float mu = wave_sum((a0[0] + a0[1]) + (a0[2] + a0[3]) + (a1[0] + a1[1]) + (a1[2] + a1[3])) * (1.f / 512.f);
            const f32x4 d0 = a0 - mu, d1 = a1 - mu;
            const float var = wave_sum((d0[0] * d0[0] + d0[1] * d0[1]) + (d0[2] * d0[2] + d0[3] * d0[3]) + (d1[0] * d1[0] + d1[1] * d1[1]) + (d1[2] * d1[2] + d1[3] * d1[3])) * (1.f / 512.f);
            const float rstd = rsqrtf(var + LN_EPS);
            const f32x4 g0 = *(const f32x4*)(lng + F.lane * 8), g1 = *(const f32x4*)(lng + F.lane * 8 + 4), b0 = *(const f32x4*)(lnb + F.lane * 8), b1 = *(const f32x4*)(lnb + F.lane * 8 + 4);
            f32x4 y0 = d0 * rstd * g0 + b0, y1 = d1 * rstd * g1 + b1;
#pragma unroll
            for (int i = 0; i < 4; ++i) { y0[i] = y0[i] * sigmoidf_(y0[i]); y1[i] = y1[i] * sigmoidf_(y1[i]); }
            u32x4 o; o.x = pk2(y0[0], y0[1]); o.y = pk2(y0[2], y0[3]); o.z = pk2(y1[0], y1[1]); o.w = pk2(y1[2], y1[3]);
            *(u32x4*)(F.ws + WS_CVO + ((size_t)(t0 + j) * 512 + F.lane * 8) * 2) = o; }
        __syncthreads();
    }
}
__device__ __forceinline__ void ph_ssm2(const Ctx& F, int l) {
    if (F.vcu < 64) { const int g = F.vcu >> 1, p = (F.vcu & 1) * 32 + (F.tid & 31), q = F.tid >> 5; const f32x2 lm = ((const f32x2*)lwp(F, l, LW_LAM))[g * 64 + p];
        LAS f32x2* Tq = (LAS f32x2*)(F.lds + RING_OFF);
        const float* S = (const float*)(F.ws + WS_SS) + g * 128 + 2 * p + (size_t)(16 * q) * 4096;
        f32x2 sv[16];
#pragma unroll
        for (int i = 0; i < 16; ++i) sv[i] = *(const f32x2*)(S + (size_t)i * 4096);
        f32x2 loc[16]; float xr = 0.f, xi = 0.f;
#pragma unroll
        for (int i = 0; i < 16; ++i) { const float nr = lm[0] * xr - lm[1] * xi + sv[i][0], ni = lm[0] * xi + lm[1] * xr + sv[i][1]; xr = nr; xi = ni; loc[i] = (f32x2){xr, xi}; }
        Tq[q * 32 + (F.tid & 31)] = loc[15];
        float pr = lm[0], pi = lm[1];
#pragma unroll
        for (int k = 0; k < 4; ++k) { const float nr = pr * pr - pi * pi, ni = 2.f * pr * pi; pr = nr; pi = ni; }
        __syncthreads();
        float cr = 0.f, ci = 0.f;
        for (int qq = 0; qq < q; ++qq) { const f32x2 t = Tq[qq * 32 + (F.tid & 31)]; const float nr = pr * cr - pi * ci + t[0], ni = pr * ci + pi * cr + t[1]; cr = nr; ci = ni; }
        unsigned* xp = (unsigned*)(F.ws + WS_XP) + ((size_t)g * 256 + 16 * q) * 64 + p;
        xp[0] = pk2(cr, ci);
#pragma unroll
        for (int i = 1; i < 16; ++i) { const float nr = lm[0] * cr - lm[1] * ci, ni = lm[0] * ci + lm[1] * cr; cr = nr; ci = ni; xp[i * 64] = pk2(cr + loc[i - 1][0], ci + loc[i - 1][1]); }
    }
    __syncthreads();
}
#if NAIVE_SSM
__device__ __forceinline__ void ph_ssm_naive(const Ctx& F, int l, const Inputs& I) {
    if (F.vcu < 32) { const int g = F.vcu; LAS f32x2* xs = (LAS f32x2*)(F.lds + RING_OFF); LAS float* us = (LAS float*)(xs + 64);
        float br[16], bi[16], abr = 0.f, abi = 0.f, xr = 0.f, xi = 0.f, cr[64], ci[64], dsk = 0.f;
        if (F.tid < 64) { const int p = F.tid; const float lr = I.ptr(16)[(l * 32 + g) * 64 + p], li = I.ptr(17)[(l * 32 + g) * 64 + p]; const float dt = expf(I.ptr(18)[l * 32 + g]);
            float s1, c1; sincos_d((double)li * (double)dt, s1, c1); const float mg1 = expf(lr * dt); abr = mg1 * c1; abi = mg1 * s1; const float den = lr * lr + li * li;
            const float fr_ = ((abr - 1.f) * lr + abi * li) / den, fi_ = (abi * lr - (abr - 1.f) * li) / den;
#pragma unroll
            for (int h = 0; h < 16; ++h) { const float b_r = I.ptr(19)[((size_t)(l * 32 + g) * 64 + p) * 16 + h], b_i = I.ptr(20)[((size_t)(l * 32 + g) * 64 + p) * 16 + h]; br[h] = fr_ * b_r - fi_ * b_i; bi[h] = fr_ * b_i + fi_ * b_r; } }
        if (F.tid < 16) { const int h = F.tid;
#pragma unroll
            for (int p = 0; p < 64; ++p) { cr[p] = I.ptr(21)[((size_t)(l * 32 + g) * 16 + h) * 64 + p]; ci[p] = I.ptr(22)[((size_t)(l * 32 + g) * 16 + h) * 64 + p]; }
            dsk = I.ptr(23)[(l * 32 + g) * 16 + h]; }
        const bf16_t* UC = (const bf16_t*)(F.ws + WS_UC) + (size_t)g * 256 * 512;
#pragma unroll 1
        for (int t = 0; t < T; ++t) {
            if (F.tid < 16) us[F.tid] = bf2f(UC[(size_t)(t >> 5) * 512 + (t & 31) * 16 + F.tid]);
            __syncthreads();
            if (F.tid < 64) { float ar = 0.f, ai = 0.f;
#pragma unroll
                for (int h = 0; h < 16; ++h) { ar += br[h] * us[h]; ai += bi[h] * us[h]; }
                const float nr = abr * xr - abi * xi + ar, ni = abr * xi + abi * xr + ai; xr = nr; xi = ni; xs[F.tid] = (f32x2){xr, xi}; }
            __syncthreads();
            if (F.tid < 16) { float y = dsk * us[F.tid];
#pragma unroll
                for (int p = 0; p < 64; ++p) { const f32x2 x = xs[p]; y += cr[p] * x[0] - ci[p] * x[1]; }
                ((bf16_t*)(F.ws + WS_YS))[(size_t)t * 512 + g * 16 + F.tid] = (bf16_t)f2bf(y); }
        }
        __syncthreads();
    }
}
#endif
__device__ __forceinline__ void ph_diff(const Ctx& F, int l, const Inputs& I) {
    const float lam_init = 0.8f - 0.6f * expf(-0.3f * (float)l);
    const float d1 = wave_sum(I.ptr(5)[l * 64 + F.lane] * I.ptr(6)[l * 64 + F.lane]), d2 = wave_sum(I.ptr(7)[l * 64 + F.lane] * I.ptr(8)[l * 64 + F.lane]);
    const float lam = expf(d1) - expf(d2) + lam_init, post = 1.f - lam_init;
    float hn[16];
#pragma unroll
    for (int i = 0; i < 16; ++i) hn[i] = I.ptr(9)[l * 128 + (F.lane & 7) * 16 + i] * post;
    for (int row = F.gw; row < T; row += F.NGW) {
        const u32x4* a = (const u32x4*)(F.ws + WS_O1 + (size_t)row * 2048) + F.lane * 2; const u32x4* b = (const u32x4*)(F.ws + WS_O2 + (size_t)row * 2048) + F.lane * 2;
        float d[16]; float ss = 0.f;
#pragma unroll
        for (int q = 0; q < 2; ++q) { const u32x4 x = a[q], y = b[q];
            d[q * 8 + 0] = bflo(x.x) - lam * bflo(y.x); d[q * 8 + 1] = bfhi(x.x) - lam * bfhi(y.x); d[q * 8 + 2] = bflo(x.y) - lam * bflo(y.y); d[q * 8 + 3] = bfhi(x.y) - lam * bfhi(y.y);
            d[q * 8 + 4] = bflo(x.z) - lam * bflo(y.z); d[q * 8 + 5] = bfhi(x.z) - lam * bfhi(y.z); d[q * 8 + 6] = bflo(x.w) - lam * bflo(y.w); d[q * 8 + 7] = bfhi(x.w) - lam * bfhi(y.w); }
#pragma unroll
        for (int i = 0; i < 16; ++i) ss += d[i] * d[i];
        ss += xor_lane<1>(ss); ss += xor_lane<2>(ss); ss += xor_lane<4>(ss);
        const float rstd = rsqrtf(ss * (1.f / 128.f) + HEAD_EPS);
        u32x4* o = (u32x4*)(F.ws + WS_OAN + (size_t)row * 2048) + F.lane * 2;
#pragma unroll
        for (int q = 0; q < 2; ++q) { u32x4 w; w.x = pk2(d[q * 8 + 0] * rstd * hn[q * 8 + 0], d[q * 8 + 1] * rstd * hn[q * 8 + 1]); w.y = pk2(d[q * 8 + 2] * rstd * hn[q * 8 + 2], d[q * 8 + 3] * rstd * hn[q * 8 + 3]);
            w.z = pk2(d[q * 8 + 4] * rstd * hn[q * 8 + 4], d[q * 8 + 5] * rstd * hn[q * 8 + 5]); w.w = pk2(d[q * 8 + 6] * rstd * hn[q * 8 + 6], d[q * 8 + 7] * rstd * hn[q * 8 + 7]); o[q] = w; }
    }
}
__device__ __forceinline__ void ph_norm3_router(const Ctx& F, int l, const Inputs& I, const bool commit = true) {
    const char* X = (const char*)(F.ws + WS_X); LAS float* part = (LAS float*)(F.lds + RING_OFF);
    const char* RT = (const char*)lwp(F, l, LW_RT);
    for (int run = F.vcu; run < T / 32; run += F.G) {
        const int r0 = run * 32;
        int ln = F.lane; asm volatile("" : "+v"(ln));
        const int fr = ln & 15, fq = ln >> 4;
        const unsigned lo16 = (unsigned)ln * 16u;
        f32x4 acc[2][2];
#pragma unroll
        for (int m = 0; m < 2; ++m)
#pragma unroll
            for (int n = 0; n < 2; ++n) acc[m][n] = (f32x4){0.f, 0.f, 0.f, 0.f};
        {
            const char* xa = X + (size_t)(r0 + fr) * (DM * 2) + (unsigned)((F.wave * 256 + fq * 8) * 2);
            const char* wa = RT + (size_t)fr * (DM * 2) + (unsigned)((F.wave * 256 + fq * 8) * 2);
            const char* wb = RT + (size_t)(16 + (fr & 3)) * (DM * 2) + (unsigned)((F.wave * 256 + fq * 8) * 2);
#pragma unroll 4
            for (int ks = 0; ks < 8; ++ks) {
                const bf16x8 x0 = *(const bf16x8*)(xa + ks * 64), x1 = *(const bf16x8*)(xa + 16 * DM * 2 + ks * 64);
                const bf16x8 ha = *(const bf16x8*)(wa + ks * 64), la = *(const bf16x8*)(wa + 20 * DM * 2 + ks * 64), hb = *(const bf16x8*)(wb + ks * 64), lb = *(const bf16x8*)(wb + 20 * DM * 2 + ks * 64);
                acc[0][0] = __builtin_amdgcn_mfma_f32_16x16x32_bf16(ha, x0, acc[0][0], 0, 0, 0); acc[1][0] = __builtin_amdgcn_mfma_f32_16x16x32_bf16(ha, x1, acc[1][0], 0, 0, 0);
                acc[0][1] = __builtin_amdgcn_mfma_f32_16x16x32_bf16(hb, x0, acc[0][1], 0, 0, 0); acc[1][1] = __builtin_amdgcn_mfma_f32_16x16x32_bf16(hb, x1, acc[1][1], 0, 0, 0);
                acc[0][0] = __builtin_amdgcn_mfma_f32_16x16x32_bf16(la, x0, acc[0][0], 0, 0, 0); acc[1][0] = __builtin_amdgcn_mfma_f32_16x16x32_bf16(la, x1, acc[1][0], 0, 0, 0);
                acc[0][1] = __builtin_amdgcn_mfma_f32_16x16x32_bf16(lb, x0, acc[0][1], 0, 0, 0); acc[1][1] = __builtin_amdgcn_mfma_f32_16x16x32_bf16(lb, x1, acc[1][1], 0, 0, 0);
            }
        }
        __syncthreads();
#pragma unroll
        for (int m = 0; m < 2; ++m) { LAS float* pw = part + ((F.wave * 32 + 16 * m + fr) * 24);
            *(LAS f32x4*)(pw + 4 * fq) = acc[m][0]; if (fq == 0) *(LAS f32x4*)(pw + 16) = acc[m][1]; }
        __syncthreads();
        u32x2 xb[4][8];
#pragma unroll
        for (int rr = 0; rr < 4; ++rr)
#pragma unroll
            for (int j = 0; j < 8; ++j) xb[rr][j] = *(const u32x2*)(X + (size_t)(r0 + F.wave * 4 + rr) * (DM * 2) + 512 * j + (lo16 >> 1));
#pragma unroll
        for (int rr = 0; rr < 4; ++rr) { const int rl = F.wave * 4 + rr, row = r0 + rl;
            float lgv = 0.f;
            if (ln < 20) {
#pragma unroll
                for (int w = 0; w < 8; ++w) lgv += part[(w * 32 + rl) * 24 + ln]; }
            f32x4 v[8]; float ss = 0.f;
#pragma unroll
            for (int j = 0; j < 8; ++j) { v[j] = (f32x4){bflo(xb[rr][j].x), bfhi(xb[rr][j].x), bflo(xb[rr][j].y), bfhi(xb[rr][j].y)}; ss += (v[j][0] * v[j][0] + v[j][1] * v[j][1]) + (v[j][2] * v[j][2] + v[j][3] * v[j][3]); }
            const float rstd = rsqrtf(wave_sum(ss) * (1.f / DM) + RMS_EPS);
            float lg[20];
#pragma unroll
            for (int j = 0; j < 20; ++j) lg[j] = __builtin_bit_cast(float, __builtin_amdgcn_readlane(__builtin_bit_cast(int, lgv), j));
            float gl[4], el[16];
#pragma unroll
            for (int i = 0; i < 4; ++i) gl[i] = lg[i] * rstd + I.ptr(35)[l * 4 + i];
#pragma unroll
            for (int i = 0; i < 16; ++i) el[i] = lg[4 + i] * rstd + I.ptr(37)[l * 16 + i];
            int gi = 0; float gm = gl[0];
#pragma unroll
            for (int i = 1; i < 4; ++i) if (gl[i] > gm) { gm = gl[i]; gi = i; }
            float gs = 0.f;
#pragma unroll
            for (int i = 0; i < 4; ++i) gs += expf(gl[i] - gm);
            const float gw_ = 1.f / gs;
            float sel[4];
#pragma unroll
            for (int i = 0; i < 4; ++i) sel[i] = gi == 0 ? el[i] : gi == 1 ? el[4 + i] : gi == 2 ? el[8 + i] : el[12 + i];
            int i0 = 0; float v0 = sel[0];
#pragma unroll
            for (int i = 1; i < 4; ++i) if (sel[i] > v0) { v0 = sel[i]; i0 = i; }
            int i1 = -1; float v1 = -INFINITY;
#pragma unroll
            for (int i = 0; i < 4; ++i) if (i != i0 && sel[i] > v1) { v1 = sel[i]; i1 = i; }
            const float w0 = gw_ / (1.f + expf(v1 - v0)), w1 = gw_ - w0;
            const int e0 = gi * 4 + i0, e1 = gi * 4 + i1;
            if (F.lane == 0 && commit) {
                const int s0 = (int)__hip_atomic_fetch_add(F.ctl + CW_CNT + (l * 16 + e0) * 16, 1u, RLX_AGENT), s1 = (int)__hip_atomic_fetch_add(F.ctl + CW_CNT + (l * 16 + e1) * 16, 1u, RLX_AGENT);
                ((int*)(F.ws + WS_LIST))[e0 * T + s0] = row; ((float*)(F.ws + WS_WL))[e0 * T + s0] = w0;
                ((int*)(F.ws + WS_LIST))[e1 * T + s1] = row; ((float*)(F.ws + WS_WL))[e1 * T + s1] = w1;
                *(int4*)(F.ws + WS_TOK + (size_t)row * 16) = make_int4(e0, s0, e1, s1); }
            const char* gr = (const char*)(I.ptr(33) + (size_t)l * DM); char* o = (char*)(F.ws + WS_H8 + (size_t)row * DM);
#pragma unroll
            for (int j = 0; j < 8; ++j) { const f32x4 g = *(const f32x4*)(gr + 1024 * j + lo16);
                int p8 = __builtin_amdgcn_cvt_pk_fp8_f32(v[j][0] * rstd * g[0], v[j][1] * rstd * g[1], 0, false); p8 = __builtin_amdgcn_cvt_pk_fp8_f32(v[j][2] * rstd * g[2], v[j][3] * rstd * g[3], p8, true); *(unsigned*)(o + 256 * j + (lo16 >> 2)) = (unsigned)p8; }
        }
    }
    __syncthreads();
}
namespace pg8 {
struct SchedKV { unsigned char* ws; int G, c; static constexpr bool GATHER = false;
    __device__ __forceinline__ bool next(int i, GU& u) const { const int L = i * G + c; if (L >= 16) return false; const int l = L >> 2, pn = L & 3;
        u.A = (const char*)ws + WS_MNORM + (size_t)l * MEML * DM * 2; u.B = (const char*)ws + WS_WKVT + (size_t)l * 1024 * DM * 2 + (size_t)pn * 256 * 4096; u.C = (char*)ws + WS_KVB + (size_t)l * MEML * 2048 + pn * 512; u.P = nullptr;
        u.lda = 4096; u.ldb = 4096; u.nt = 32; u.pm = 0; u.pn = pn; u.seg = 0; u.flags = GU_LAST; u.rows = 256; u.aux = __builtin_bit_cast(int, 1.0f); u.f8 = 0; return true; }
    __device__ __forceinline__ unsigned arow(const GU& u, int r) const { return (unsigned)(r * u.lda); } };
struct SchedAbsorb { unsigned char* ws; int G, c; static constexpr bool GATHER = false;
    __device__ __forceinline__ bool next(int i, GU& u) const { const int L = i * G + c; if (L >= 256) return false; const int w = L & 127, l = w >> 5, h = (w >> 3) & 3, t = w & 7;
        unsigned char* lw = ws + WS_LW + (size_t)l * LW_SIZE; const char* kvb = (const char*)ws + WS_KVB + (size_t)l * MEML * 2048;
        int two = 2; asm volatile("" : "+s"(two));
        u.P = nullptr; u.nt = two; u.pm = 0; u.pn = 0; u.seg = 0; u.flags = GU_LAST; u.rows = 256;
        if (L < 128) { u.A = kvb + h * 256; u.lda = 2048; u.B = (const char*)ws + WS_WQB + (size_t)l * DM * 1024 + (size_t)t * 256 * 1024 + h * 256; u.ldb = 1024;
            u.C = (char*)lw + LW_WQK + (size_t)(h * 256) * (S_FP8 ? 2048 : 4096) + t * (S_FP8 ? 256 : 512); u.aux = __builtin_bit_cast(int, C2X * SQK_SCALE); u.f8 = 0; u.seg = S_FP8; }
        else { u.A = (const char*)ws + WS_WXOT + (size_t)l * DM * 1024 + (size_t)t * 256 * 1024 + h * 256; u.lda = 1024; u.B = kvb + 1024 + h * 256; u.ldb = 2048;
            u.C = (char*)lw + LW_VW + (size_t)(t * 256) * (XAO_FP8 ? 1024 : 2048) + h * (XAO_FP8 ? 256 : 512); u.aux = __builtin_bit_cast(int, VW_SCALE); u.f8 = 0; u.seg = XAO_FP8; }
        u.pm = (L < 128) ? (S_FP8 ? 2048 : 4096) : (XAO_FP8 ? 1024 : 2048);
        return true; }
    __device__ __forceinline__ unsigned arow(const GU& u, int r) const { return (unsigned)(r * u.lda); } };
struct EpiStoreP {
    __device__ __forceinline__ void operator()(Acc& acc, const GU& u, int wr, int wc, int fr, int fq) const {
        const float sc = __builtin_bit_cast(float, u.aux);
        if (u.seg) { EPI_ROWS( { char* rp = u.C + (unsigned)(lrow * u.pm); EPI_COLS( { int q0 = __builtin_amdgcn_cvt_pk_fp8_f32(v0[0] * sc, v0[1] * sc, 0, false); q0 = __builtin_amdgcn_cvt_pk_fp8_f32(v0[2] * sc, v0[3] * sc, q0, true);
                int q1 = __builtin_amdgcn_cvt_pk_fp8_f32(v1[0] * sc, v1[1] * sc, 0, false); q1 = __builtin_amdgcn_cvt_pk_fp8_f32(v1[2] * sc, v1[3] * sc, q1, true); *(u32x2*)(rp + lcol) = (u32x2){(unsigned)q0, (unsigned)q1}; } ) } ) }
        else { EPI_ROWS( { char* rp = u.C + (unsigned)(lrow * u.pm); EPI_COLS( st8(rp + lcol * 2, v0 * sc, v1 * sc); ) } ) }
    } };
struct SchedSsm1 { unsigned char* ws; unsigned char* lw; int G, c; static constexpr bool GATHER = false;
    __device__ __forceinline__ bool next(int i, GU& u) const { const int g = i * G + c; if (g >= 32) return false;
        u.A = (const char*)ws + WS_UC + (size_t)g * 256 * 1024; u.lda = 1024; u.B = (const char*)lw + LW_F + (size_t)g * 128 * 1024; u.ldb = 1024; u.C = (char*)ws + WS_SS + g * 512; u.P = nullptr;
        u.nt = 8; u.pm = 0; u.pn = g; u.seg = 0; u.flags = GU_LAST; u.rows = 256; u.aux = 0; u.f8 = 0; return true; }
    __device__ __forceinline__ unsigned arow(const GU& u, int r) const { return (unsigned)(r * u.lda); } };
struct SchedSsm3 { unsigned char* ws; unsigned char* lw; int G, c; static constexpr bool GATHER = false;
    __device__ __forceinline__ bool next(int i, GU& u) const { const int ti = i >> 1, sg = i & 1, L = ti * G + c; if (L >= 64) return false; const int g = L >> 1, pn = L & 1;
        const char* b = (const char*)lw + LW_BKE + (size_t)g * 512 * 1280 + (size_t)pn * 256 * 1280;
        if (sg == 0) { u.A = (const char*)ws + WS_UC + (size_t)g * 256 * 1024; u.lda = 1024; u.B = b; u.nt = 8; }
        else { u.A = (const char*)ws + WS_XP + (size_t)g * 256 * 256; u.lda = 256; u.B = b + 1024; u.nt = 2; }
        u.ldb = 1280; u.C = nullptr; u.P = nullptr; u.pm = g; u.pn = pn; u.seg = sg; u.flags = sg ? GU_LAST : 0; u.rows = 256; u.aux = 0; u.f8 = 0; return true; }
    __device__ __forceinline__ unsigned arow(const GU& u, int r) const { return (unsigned)(r * u.lda); } };
}

constexpr int PH_PRO_A = 0, PH_PRO_B = 1, PH_PRO_C = 2, PH_L0 = 3, NPL = 15, PH_FINAL = PH_L0 + NL * NPL, NPHASES = PH_FINAL + 1;
constexpr int INTAB_OFF = LDSCTL_OFF + 1024;
struct Args { const float* in[42]; float* out; unsigned char* ws; int ph_lo, ph_hi; };
#define LAUNDER_S(x) asm volatile("" : "+s"(x))
#define MKCTX() Ctx F; { unsigned char* w_ = args.ws; LAUNDER_S(w_); F.ws = w_; F.lds = (LAS unsigned char*)lds_raw; F.ctl = (gu32*)(w_ + WS_CTL); \
    F.tid = tid_of(wave_s); F.lane = F.tid & 63; F.wave = __builtin_amdgcn_readfirstlane(F.tid >> 6); \
    int g_ = gridDim.x; LAUNDER_S(g_); F.G = g_; { int bx_ = blockIdx.x; LAUNDER_S(bx_); F.vcu = (g_ % 8 == 0) ? (bx_ % 8) * (g_ / 8) + bx_ / 8 : bx_; } \
    F.gw = F.vcu * NWAVES + F.wave; F.NGW = F.G * NWAVES; } \
    unsigned char* const ws = F.ws; (void)ws; const Inputs I{(const LAS unsigned*)(F.lds + INTAB_OFF)}; (void)I; int bx = blockIdx.x; LAUNDER_S(bx);
#if MK_PER_PHASE
#define GRID_BAR() do { } while (0)
#else
#define GRID_BAR() do { unsigned char* w_ = args.ws; LAUNDER_S(w_); XcdBarrier bar_; bar_.bar = (unsigned*)((gu32*)(w_ + WS_CTL) + CW_BAR); bar_.x = xb_xcc_id(); \
        bar_.st = (volatile LAS unsigned*)((LAS unsigned char*)lds_raw + MISC_OFF) + 8; xcd_barrier(bar_); } while (0)
#endif
#define IN(k) (lo <= (k) && (k) < hi)
#define SEAM(k) do { if (IN(k) && IN((k) + 1)) GRID_BAR(); } while (0)
#ifndef ONLY_LPH
#define ONLY_LPH -1
#endif
#define LPH_ON(j) (ONLY_LPH < 0 || ONLY_LPH == (j))
#ifndef DBG_DUP_MASK
#define DBG_DUP_MASK 0
#endif
#define NREP(j) (1 + ((DBG_DUP_MASK >> (j)) & 1))
#define INL(j) (LPH_ON(j) && lo <= (P0 + (j)) && (P0 + (j)) < hi)
#define SEAML(j) do { if ((lo <= (P0 + (j)) && (P0 + (j)) < hi) && (lo <= (P0 + (j) + 1) && (P0 + (j) + 1) < hi)) GRID_BAR(); } while (0)
template <int l> __device__ __forceinline__ void run_layer(const Args& args, unsigned char* lds_raw, const int lo, const int hi, const int wave_s) {
        const int P0 = PH_L0 + l * NPL;
#define LW() (ws + WS_LW + (size_t)l * LW_SIZE)
        if (INL(0)) for (int rep_ = 0; rep_ < NREP(0); ++rep_) { MKCTX(); ph_norm1(F, l, I.ptr(0), I.ptr(3) + (size_t)l * DM, nullptr); } SEAML(0);
        if (INL(1)) for (int rep_ = 0; rep_ < NREP(1); ++rep_) { MKCTX(); pg8::EpiProj E{(char*)ws, (const float*)(ws + WS_ROPE), (const float*)(ws + WS_ROPE) + T * 32, (const float*)(ws + WS_RSTD)};
            { pg8::SchedProj<false> S{ws, LW(), F.G, bx}; pg8::gemm_phase<pg8::EpiProj, pg8::SchedProj<false>, false>(F.lds + RING_OFF, S, E, F.tid); }
            { pg8::SchedProj<true> S{ws, LW(), F.G, bx}; pg8::gemm_phase<pg8::EpiProj, pg8::SchedProj<true>, true>(F.lds + RING_OFF, S, E, F.tid); } } SEAML(1);
#if NAIVE_SSM
        if (INL(2)) for (int rep_ = 0; rep_ < NREP(2); ++rep_) { MKCTX(); ph_conv(F, I.ptr(11) + (size_t)l * 31 * 512, I.ptr(12) + l * 512, I.ptr(13) + l * 512, I.ptr(14) + l * 512); ph_ssm_naive(F, l, I); } SEAML(2);
        SEAML(3); SEAML(4);
#else
        if (INL(2)) for (int rep_ = 0; rep_ < NREP(2); ++rep_) { MKCTX(); ph_conv(F, I.ptr(11) + (size_t)l * 31 * 512, I.ptr(12) + l * 512, I.ptr(13) + l * 512, I.ptr(14) + l * 512);
            pg8::SchedSsm1 S{ws, LW(), F.G, bx}; pg8::EpiStoreF32 E{16384}; pg8::gemm_phase(F.lds + RING_OFF, S, E, F.tid);
            if (DEFER_CONV && l + 1 < NL && F.G == 256 && bx >= 32) conv_window(F, I, l + 1, 0, (bx - 32) * NWAVES + F.wave, 2); } SEAML(2);
        if (INL(3)) for (int rep_ = 0; rep_ < NREP(3); ++rep_) { MKCTX(); ph_ssm2(F, l);
            if (DEFER_CONV && l + 1 < NL && F.G == 256 && F.vcu >= 64) conv_window(F, I, l + 1, 3584, (F.vcu - 64) * NWAVES + F.wave, 1); } SEAML(3);
#endif
        if (INL(5)) for (int rep_ = 0; rep_ < NREP(5); ++rep_) { MKCTX(); { pg8::SchedSsm3 S{ws, LW(), F.G, bx}; pg8::EpiSsm3 E{(char*)ws + WS_YS}; pg8::gemm_phase(F.lds + RING_OFF, S, E, F.tid);
            if (DEFER_CONV && l + 1 < NL && F.G == 256 && bx >= 64) conv_window(F, I, l + 1, 5120, (bx - 64) * NWAVES + F.wave, 2); }
            (ATTN128 && !NAIVE_ATTN ? attn128::attn_phase : attn_body::attn_phase)((char*)lds_raw + RING_OFF, (const bf16_t*)(ws + WS_Q), (const bf16_t*)(ws + WS_K), (const bf16_t*)(ws + WS_V), (bf16_t*)(ws + WS_O1), (bf16_t*)(ws + WS_O2), F.vcu, F.G, F.tid); } SEAML(5);
        if (INL(6)) for (int rep_ = 0; rep_ < NREP(6); ++rep_) { MKCTX(); ph_diff(F, l, I); __syncthreads();
            pg8::SchedDense S{(const char*)ws + WS_YS, (const char*)LW() + LW_WGLU, 1024, 1024, 8, 32, 4, F.G, bx}; pg8::EpiGlu E{(char*)ws + WS_GLUO, I.ptr(25) + (size_t)l * 1024}; pg8::gemm_phase(F.lds + RING_OFF, S, E, F.tid);
            if (DEFER_CONV && l + 1 < NL && F.G == 256 && bx >= 128) conv_window(F, I, l + 1, 8192, (bx - 128) * NWAVES + F.wave, 2); } SEAML(6);
        if (INL(7)) for (int rep_ = 0; rep_ < NREP(7); ++rep_) { MKCTX(); pg8::SchedSeg<0> S{ws, LW(), F.G, bx}; pg8::EpiGated E{(const char*)ws + WS_GATES, (char*)ws + WS_MERGED}; pg8::gemm_phase(F.lds + RING_OFF, S, E, F.tid); } SEAML(7);
        if (INL(8)) for (int rep_ = 0; rep_ < NREP(8); ++rep_) { MKCTX(); pg8::SchedDense S{(const char*)ws + WS_MERGED, (const char*)LW() + LW_WMIX, 4096, 4096, 32, 32, 8, F.G, bx}; pg8::EpiResid E{(char*)ws + WS_X, (char*)ws + ((S_FP8 || !FUSE_N2) ? WS_H8 : WS_H), (float*)(ws + WS_RSQ)}; pg8::gemm_phase(F.lds + RING_OFF, S, E, F.tid); } SEAML(8);
#ifdef DBG_EXTRA_BAR
        if (INL(9)) GRID_BAR();
#endif
#if !FUSE_N2
        if (INL(9)) for (int rep_ = 0; rep_ < NREP(9); ++rep_) { MKCTX(); ph_norm2(F, I.ptr(28) + (size_t)l * DM); } SEAML(9);
#endif
        if (INL(10)) for (int rep_ = 0; rep_ < NREP(10); ++rep_) { MKCTX(); pg8::SchedDense S{(const char*)ws + (S_FP8 ? WS_H8 : WS_H), (const char*)LW() + LW_WQK, S_FP8 ? 2048 : 4096, S_FP8 ? 2048 : 4096, S_FP8 ? 16 : 32, 32, 4, F.G, bx}; pg8::EpiSexp E{(char*)ws + WS_P, (float*)(ws + WS_RS), (const float*)(ws + WS_RSQ)}; pg8::gemm_phase<pg8::EpiSexp, pg8::SchedDense, S_FP8 != 0>(F.lds + RING_OFF, S, E, F.tid);
            if (DEFER_CONV && l + 1 < NL && F.G == 256 && bx >= 128) conv_window(F, I, l + 1, 10240, (bx - 128) * NWAVES + F.wave, 6); } SEAML(10);
        if (INL(11)) for (int rep_ = 0; rep_ < NREP(11); ++rep_) { MKCTX(); pg8::SchedSeg<1> S{ws, LW(), F.G, bx}; pg8::EpiXao E{(const float*)(ws + WS_RS), (char*)ws + WS_X}; pg8::gemm_phase<pg8::EpiXao, pg8::SchedSeg<1>, XAO_FP8 != 0>(F.lds + RING_OFF, S, E, F.tid); } SEAML(11);
        if (INL(12)) for (int rep_ = 0; rep_ < NREP(12); ++rep_) { MKCTX(); ph_norm3_router(F, l, I, rep_ == NREP(12) - 1); } SEAML(12);
        if (INL(13)) for (int rep_ = 0; rep_ < NREP(13); ++rep_) { MKCTX(); volatile LAS unsigned* MISC = (volatile LAS unsigned*)(F.lds + MISC_OFF);
            if (F.tid < 16) MISC[16 + F.tid] = __hip_atomic_load(F.ctl + CW_CNT + (l * 16 + F.tid) * 16, RLX_AGENT);
            __syncthreads();
            pg8::SchedMoE<false> S{(const volatile LAS int*)(MISC + 16), ws, LW(), F.G, bx}; pg8::EpiGu E{}; pg8::gemm_phase<pg8::EpiGu, pg8::SchedMoE<false>, true>(F.lds + RING_OFF, S, E, F.tid);
            if (DEFER_CONV && l + 1 < NL && F.G == 256 && bx >= 64) conv_window(F, I, l + 1, 16384, (bx - 64) * NWAVES + F.wave, 3); } SEAML(13);
        if (INL(14)) for (int rep_ = 0; rep_ < NREP(14); ++rep_) { MKCTX(); volatile LAS unsigned* MISC = (volatile LAS unsigned*)(F.lds + MISC_OFF);
            if (F.tid < 16) MISC[16 + F.tid] = __hip_atomic_load(F.ctl + CW_CNT + (l * 16 + F.tid) * 16, RLX_AGENT);
            __syncthreads();
            pg8::SchedMoE<true> S{(const volatile LAS int*)(MISC + 16), ws, LW(), F.G, bx}; pg8::EpiDown E{}; pg8::gemm_phase<pg8::EpiDown, pg8::SchedMoE<true>, true>(F.lds + RING_OFF, S, E, F.tid); } SEAML(14);
#undef LW
}
__global__ void __launch_bounds__(NWAVES * 64, 2) mk_fwd(Args args) {
    extern __shared__ __attribute__((aligned(16))) unsigned char lds_raw[];
    const int wave_s = __builtin_amdgcn_readfirstlane((int)threadIdx.x >> 6);
    {   LAS unsigned char* l0 = (LAS unsigned char*)lds_raw;
        for (int u = threadIdx.x; u < (LDS_BYTES - LDSCTL_OFF) / 4; u += NWAVES * 64) ((LAS unsigned*)(l0 + LDSCTL_OFF))[u] = 0u;
        __syncthreads();
        if (threadIdx.x < 84) { const unsigned* ka = (const unsigned*)__builtin_amdgcn_kernarg_segment_ptr(); ((LAS unsigned*)(l0 + INTAB_OFF))[threadIdx.x] = ka[threadIdx.x]; }
        __syncthreads(); }
#if !MK_PER_PHASE
    {   unsigned char* w_ = args.ws; LAUNDER_S(w_); (void)xcd_barrier_post((unsigned*)((gu32*)(w_ + WS_CTL) + CW_BAR), (volatile LAS unsigned*)((LAS unsigned char*)lds_raw + MISC_OFF) + 8); }
#endif
    const int lo = args.ph_lo, hi = args.ph_hi;

    if ((ONLY_LPH < 0 || ONLY_LPH == 100) && IN(PH_PRO_A)) for (int rep_ = 0; rep_ < NREP(20); ++rep_) { MKCTX(); ph_prologue_a(F, I); } SEAM(PH_PRO_A);
    if ((ONLY_LPH < 0 || ONLY_LPH == 101) && IN(PH_PRO_B)) { MKCTX(); pg8::SchedKV S{ws, F.G, bx}; pg8::EpiStore E{2048, 2}; pg8::gemm_phase(F.lds + RING_OFF, S, E, F.tid);
        if (DEFER_CONV && F.G == 256 && bx >= 16) { for (int it = (bx - 16) * NWAVES + F.wave; it < IT_EXP; it += 240 * NWAVES) conv_item(F, I, 0, IT_EARLY + it); } } SEAM(PH_PRO_B);
    if ((ONLY_LPH < 0 || ONLY_LPH == 102) && IN(PH_PRO_C)) { MKCTX(); pg8::SchedAbsorb S{ws, F.G, bx}; pg8::EpiStoreP E{}; pg8::gemm_phase(F.lds + RING_OFF, S, E, F.tid); } SEAM(PH_PRO_C);

    run_layer<0>(args, lds_raw, lo, hi, wave_s); run_layer<1>(args, lds_raw, lo, hi, wave_s); run_layer<2>(args, lds_raw, lo, hi, wave_s); run_layer<3>(args, lds_raw, lo, hi, wave_s);
    if ((ONLY_LPH < 0 || ONLY_LPH == 103) && IN(PH_FINAL)) { MKCTX(); float* outp = args.out; ph_norm1(F, NL, I.ptr(0), I.ptr(41), outp); }
}

extern "C" void kernel_launch(void* const* d_in, const int* in_sizes, int n_in, void* d_out, int out_size, void* d_ws, size_t ws_size, hipStream_t stream) {
    static int grid = 0;
    if (grid == 0) {
        if (n_in != 42 || out_size != T * DM || ws_size < WS_END) { fprintf(stderr, "kernel_launch: unexpected problem shape / workspace (%d inputs, out %d, ws %zu < %zu); nothing launched\n", n_in, out_size, ws_size, (size_t)WS_END); grid = -1; return; }
        int dev = 0, cus = 0, per_cu = 0;
        if (hipGetDevice(&dev) != hipSuccess || hipDeviceGetAttribute(&cus, hipDeviceAttributeMultiprocessorCount, dev) != hipSuccess) { grid = -1; return; }
        if (hipFuncSetAttribute((const void*)mk_fwd, hipFuncAttributeMaxDynamicSharedMemorySize, LDS_BYTES) != hipSuccess) { fprintf(stderr, "kernel_launch: hipFuncSetAttribute failed\n"); grid = -1; return; }
        if (hipOccupancyMaxActiveBlocksPerMultiprocessor(&per_cu, (const void*)mk_fwd, NWAVES * 64, LDS_BYTES) != hipSuccess || per_cu < 1) { fprintf(stderr, "kernel_launch: occupancy query says %d workgroups per CU\n", per_cu); }
        (void)hipGetLastError();
        grid = cus;
    }
    if (grid < 0) return;
    if (hipMemsetAsync((char*)d_ws + WS_CTL, 0, CTL_ZERO_BYTES, stream) != hipSuccess) return;
    Args a{};
    for (int i = 0; i < 42; ++i) a.in[i] = (const float*)d_in[i];
    a.out = (float*)d_out; a.ws = (unsigned char*)d_ws;
#if MK_PER_PHASE
    for (int ph = 0; ph < NPHASES; ++ph) { a.ph_lo = ph; a.ph_hi = ph + 1; hipLaunchKernelGGL(mk_fwd, dim3(grid), dim3(NWAVES * 64), LDS_BYTES, stream, a); }
#else
    a.ph_lo = 0; a.ph_hi = NPHASES;
    hipLaunchKernelGGL(mk_fwd, dim3(grid), dim3(NWAVES * 64), LDS_BYTES, stream, a);
#endif
}
```

```cpp
#include <hip/hip_runtime.h>
#include <cstdio>
#include <cstdint>
#include <cmath>

#ifndef NAIVE_GEMM
#define NAIVE_GEMM 0
#endif
#ifndef NAIVE_ATTN
#define NAIVE_ATTN 0
#endif
#ifndef NAIVE_SSM
#define NAIVE_SSM 0
#endif
#ifndef MK_PER_PHASE
#define MK_PER_PHASE 0
#endif

#define GAS __attribute__((address_space(1)))
#define LAS __attribute__((address_space(3)))
typedef unsigned short bf16_t;
typedef short bf16x8 __attribute__((ext_vector_type(8)));
typedef float f32x4 __attribute__((ext_vector_type(4)));
typedef float f32x2 __attribute__((ext_vector_type(2)));
typedef unsigned u32x4 __attribute__((ext_vector_type(4)));
typedef unsigned u32x2 __attribute__((ext_vector_type(2)));
typedef GAS unsigned gu32;
#define RLX_AGENT __ATOMIC_RELAXED, __HIP_MEMORY_SCOPE_AGENT
#define LDS_WAIT() asm volatile("s_waitcnt lgkmcnt(0)" ::: "memory")
#define VM_WAIT() asm volatile("s_waitcnt vmcnt(0)" ::: "memory")
__device__ __forceinline__ unsigned f2bf(float f) { unsigned u = __builtin_bit_cast(unsigned, f); return (u + 0x7fffu + ((u >> 16) & 1u)) >> 16; }
__device__ __forceinline__ unsigned pk2(float lo, float hi) { return f2bf(lo) | (f2bf(hi) << 16); }
__device__ __forceinline__ float bflo(unsigned w) { return __builtin_bit_cast(float, w << 16); }
__device__ __forceinline__ float bfhi(unsigned w) { return __builtin_bit_cast(float, w & 0xffff0000u); }
__device__ __forceinline__ float bf2f(bf16_t h) { return __builtin_bit_cast(float, (unsigned)h << 16); }
template <int M> __device__ __forceinline__ float xor_lane(float v) {
    if (M < 32) return __builtin_bit_cast(float, __builtin_amdgcn_ds_swizzle(__builtin_bit_cast(int, v), (M << 10) | 0x1f));
    const auto rr = __builtin_amdgcn_permlane32_swap(__builtin_bit_cast(unsigned, v), __builtin_bit_cast(unsigned, v), false, false);
    return __builtin_bit_cast(float, rr[0] ^ rr[1] ^ __builtin_bit_cast(unsigned, v));
}
__device__ __forceinline__ float wave_sum(float v) {
    v += xor_lane<1>(v); v += xor_lane<2>(v); v += xor_lane<4>(v); v += xor_lane<8>(v); v += xor_lane<16>(v); v += xor_lane<32>(v);
    return v;
}
__device__ __forceinline__ float wave_max(float v) {
    v = fmaxf(v, xor_lane<1>(v)); v = fmaxf(v, xor_lane<2>(v)); v = fmaxf(v, xor_lane<4>(v)); v = fmaxf(v, xor_lane<8>(v)); v = fmaxf(v, xor_lane<16>(v)); v = fmaxf(v, xor_lane<32>(v));
    return v;
}
__device__ __forceinline__ int tid_of(int wave_s) { int ln; asm volatile("v_mbcnt_lo_u32_b32 %0, -1, 0\n\tv_mbcnt_hi_u32_b32 %0, -1, %0" : "=v"(ln)); return (wave_s << 6) | ln; }
__device__ __forceinline__ float sigmoidf_(float x) { return __builtin_amdgcn_rcpf(1.f + __expf(-x)); }

constexpr int T = 8192, DM = 2048, NL = 4, MEML = 256, NPROJ = 10752, NEXP = 16, FFE = 512;
constexpr int NWAVES = 8;
constexpr float RMS_EPS = 1e-6f, HEAD_EPS = 1e-5f, LN_EPS = 1e-5f;
constexpr float C2Q = 0.125f * 1.4426950408889634f;
constexpr float GATE_WSCALE = 128.f;
#ifndef S_FP8
#define S_FP8 1
#endif
#ifndef FUSE_N2
#define FUSE_N2 1
#endif
constexpr float SQK_SCALE = S_FP8 ? 64.f : 1.f;
#ifndef XAO_FP8
#define XAO_FP8 1
#endif
constexpr float VW_SCALE = XAO_FP8 ? 64.f : 1.f;
constexpr float C2X = 0.08838834764831845f * 1.4426950408889634f;
constexpr size_t MiB = 1u << 20;
constexpr size_t WS_CTL = 0, CTL_ZERO_BYTES = 64 * 1024;
constexpr size_t LW_WIN = 0;
constexpr size_t LW_WG8 = LW_WIN + (size_t)3584 * DM * 2;
constexpr size_t LW_WCAT = LW_WG8 + (size_t)7680 * DM;
constexpr size_t LW_WGLU = LW_WCAT + (size_t)DM * DM * 2;
constexpr size_t LW_WMIX = LW_WGLU + (size_t)1024 * 512 * 2;
constexpr size_t LW_WQK = LW_WMIX + (size_t)DM * DM * 2;
constexpr size_t LW_VW = LW_WQK + (size_t)1024 * DM * 2;
constexpr size_t LW_WGU = LW_VW + (size_t)DM * 1024 * 2;
constexpr size_t LW_WD = LW_WGU + (size_t)NEXP * 1024 * DM;
constexpr size_t LW_BKE = LW_WD + (size_t)NEXP * DM * FFE;
constexpr size_t LW_F = LW_BKE + (size_t)32 * 512 * 640 * 2;
constexpr size_t LW_RT = LW_F + (size_t)32 * 128 * 512 * 2;
constexpr size_t LW_LAM = LW_RT + (size_t)20 * DM * 4;
constexpr size_t LW_SIZE = ((LW_LAM + (size_t)32 * 64 * 8 + 4095) / 4096) * 4096;
constexpr size_t WS_LW = 1 * MiB;
constexpr size_t WS_ACT = WS_LW + NL * LW_SIZE;
constexpr size_t WS_X = WS_ACT;
constexpr size_t WS_RSTD = WS_X + (size_t)T * DM * 2;
constexpr size_t WS_H = WS_X + (size_t)T * DM * 4;
constexpr size_t WS_Q = WS_H + (size_t)T * DM * 2;
constexpr size_t WS_K = WS_Q + (size_t)T * 1024 * 2;
constexpr size_t WS_V = WS_K + (size_t)T * 1024 * 2;
constexpr size_t WS_O1 = WS_V + (size_t)T * 1024 * 2;
constexpr size_t WS_O2 = WS_O1 + (size_t)T * 1024 * 2;
constexpr size_t WS_OAN = WS_O2 + (size_t)T * 1024 * 2;
constexpr size_t WS_Z = WS_OAN + (size_t)T * 1024 * 2;
constexpr size_t WS_UC = WS_Z + (size_t)T * 512 * 2;
constexpr size_t WS_GATES = WS_UC + (size_t)T * 512 * 2;
constexpr size_t WS_CVO = WS_GATES + (size_t)T * 6144 * 2;
constexpr size_t WS_SS = WS_CVO + (size_t)T * 512 * 2;
constexpr size_t WS_XP = WS_SS + (size_t)256 * 4096 * 4;
constexpr size_t WS_YS = WS_XP + (size_t)32 * 256 * 128 * 2;
constexpr size_t WS_GLUO = WS_YS + (size_t)T * 512 * 2;
constexpr size_t WS_MERGED = WS_GLUO + (size_t)T * 512 * 2;
constexpr size_t WS_P = WS_MERGED + (size_t)T * DM * 2;
constexpr size_t WS_RS = WS_P + (size_t)T * 1024 * 2;
constexpr size_t WS_HE = WS_RS + (size_t)T * 16 * 4;
constexpr size_t WS_Y = WS_HE + (size_t)(2 * T + 256) * 512 * 2;
constexpr size_t WS_LIST = WS_Y + (size_t)2 * T * DM * 2;
constexpr size_t WS_WL = WS_LIST + (size_t)NEXP * T * 4;
constexpr size_t WS_TOK = WS_WL + (size_t)NEXP * T * 4;
constexpr size_t WS_ROPE = WS_TOK + (size_t)T * 16;
constexpr size_t WS_H8 = WS_ROPE + (size_t)T * 64 * 4;
constexpr size_t WS_RSQ = WS_H8 + (size_t)T * DM;
constexpr size_t WS_END = WS_RSQ + (size_t)T * 32 * 4;
constexpr size_t WS_WQB = WS_GATES;
constexpr size_t WS_WKVT = WS_WQB + (size_t)NL * DM * 512 * 2;
constexpr size_t WS_WXOT = WS_WKVT + (size_t)NL * 1024 * DM * 2;
constexpr size_t WS_MNORM = WS_WXOT + (size_t)NL * DM * 512 * 2;
constexpr size_t WS_KVB = WS_MNORM + (size_t)NL * MEML * DM * 2;
static_assert(WS_KVB + (size_t)NL * MEML * 1024 * 2 <= WS_CVO, "prologue temporaries inside GATES");
static_assert(WS_END < (size_t)1350000000, "workspace plan");
constexpr int CW_TMO = 0, CW_CODE = 1;
constexpr int CW_BAR = 4096;
constexpr int CW_CNT = 8192;
constexpr int RING_OFF = 0, RING_BYTES = 131072;
constexpr int LDSCTL_OFF = RING_BYTES, MISC_OFF = LDSCTL_OFF + 320;
constexpr int LDS_BYTES = 147456;
#define XB_TMO      128
#define XB_XCNT(j)  (256  + 64 * (j))
#define XB_XSUB(j)  (1280 + 64 * (j))
#define XB_XGEN(j)  (2304 + 64 * (j))
#define XB_TOP      3328
#define XB_TOPGEN   3392
#define XCD_BAR_WORDS 3456
#define XB_SPIN_CAP (1u << 24)

__device__ __forceinline__ unsigned xb_ld(unsigned* p)              { return __hip_atomic_load(p, __ATOMIC_RELAXED, __HIP_MEMORY_SCOPE_AGENT); }
__device__ __forceinline__ unsigned xb_add(unsigned* p, unsigned v) { return __hip_atomic_fetch_add(p, v, __ATOMIC_RELAXED, __HIP_MEMORY_SCOPE_AGENT); }
__device__ __forceinline__ unsigned xb_xcc_id() { return (unsigned)__builtin_amdgcn_s_getreg((3 << 11) | 20) & 0xFu; }
#define XB_SPIN(cond, bar) do { unsigned _sp = 0; while (cond) { __builtin_amdgcn_s_sleep(1); \
    if ((++_sp & 255u) == 0u) { if (xb_ld(&(bar)[XB_TMO])) break; if (_sp > XB_SPIN_CAP) { atomicAdd(&(bar)[XB_TMO], 1u); break; } } } } while (0)

struct XcdBarrier {
    unsigned* bar; unsigned x;
    volatile LAS unsigned* st;
};

__device__ __forceinline__ XcdBarrier xcd_barrier_post(unsigned* bar, volatile LAS unsigned* st) {
    XcdBarrier b; b.bar = bar; b.x = xb_xcc_id(); b.st = st;
    if (threadIdx.x == 0) (void)xb_add(&bar[XB_XCNT(b.x)], 1u);
    return b;
}
__device__ __forceinline__ void xcd_barrier_complete(unsigned* bar, unsigned x, unsigned& nloc, unsigned& nx) {
    const unsigned G = gridDim.x * gridDim.y * gridDim.z;
    unsigned sum, cnt, mine, sp = 0u;
    for (;;) {
        sum = 0u; cnt = 0u; mine = 0u;
#pragma unroll
        for (unsigned j = 0; j < 16; ++j) { const unsigned c = xb_ld(&bar[XB_XCNT(j)]); sum += c; cnt += (c > 0u) ? 1u : 0u; mine = (j == x) ? c : mine; }
        if (sum == G) break;
        __builtin_amdgcn_s_sleep(1);
        if ((++sp & 255u) == 0u) { if (xb_ld(&bar[XB_TMO])) break; if (sp > XB_SPIN_CAP) { atomicAdd(&bar[XB_TMO], 1u); break; } }
    }
    nloc = mine > 0u ? mine : 1u; nx = cnt > 0u ? cnt : 1u;
}

__device__ __forceinline__ void xcd_barrier(const XcdBarrier& b) {
    asm volatile("s_waitcnt vmcnt(0)" ::: "memory");
    __syncthreads();
    if (threadIdx.x == 0) {
        unsigned* bar = b.bar;
        __builtin_amdgcn_s_waitcnt(0);
        unsigned nloc = b.st[0], nx = b.st[1];
        if (nloc == 0u) { xcd_barrier_complete(bar, b.x, nloc, nx); b.st[0] = nloc; b.st[1] = nx; }
        const unsigned old = xb_add(&bar[XB_XSUB(b.x)], 1u);
        const unsigned gen = old / nloc;
        if (old + 1u == (gen + 1u) * nloc) {
            __builtin_amdgcn_fence(__ATOMIC_RELEASE, "agent");
            asm volatile("s_waitcnt vmcnt(0)" ::: "memory");
            const unsigned og = xb_add(&bar[XB_TOP], 1u);
            const unsigned tg = og / nx;
            if (og + 1u == (tg + 1u) * nx) xb_add(&bar[XB_TOPGEN], 1u);
            else XB_SPIN(xb_ld(&bar[XB_TOPGEN]) == tg, bar);
            __builtin_amdgcn_fence(__ATOMIC_ACQUIRE, "agent");
            xb_add(&bar[XB_XGEN(b.x)], 1u);
            asm volatile("s_waitcnt vmcnt(0)" ::: "memory");
        } else {
            XB_SPIN(xb_ld(&bar[XB_XGEN(b.x)]) == gen, bar);
            __builtin_amdgcn_fence(__ATOMIC_ACQUIRE, "agent");
            asm volatile("s_waitcnt vmcnt(0)" ::: "memory");
        }
    }
    __syncthreads();
}
namespace pg8 {
constexpr int BM = 256, BK = 64, HALF = 128, HTB = HALF * BK * 2  , STAGE_BYTES = 8 * HTB;
__host__ __device__ __forceinline__ int lds_byte(int r, int c) { const int st = (r >> 4) * 2 + (c >> 5), rr = r & 15, cc = c & 31, ob = rr * 64 + cc * 2; return st * 1024 + (ob ^ (((ob >> 9) & 1) << 5)); }
__host__ __device__ __forceinline__ void stage_rc(int b, int& R, int& C) { const int st = b / 1024, sb = b % 1024, swz = sb ^ (((sb >> 9) & 1) << 5); R = (st >> 1) * 16 + swz / 64; C = (st & 1) * 32 + (swz % 64) / 2; }
__host__ __device__ __forceinline__ int perm32(int rho) { const int n = rho >> 4, i = rho & 15; return 8 * (i >> 2) + 4 * n + (i & 3); }

enum { GU_LAST = 1 };
struct GU {
    const char* A;
    const char* B;
    char* C;
    const char* P;
    int lda, ldb;
    int nt;
    int pm, pn;
    int seg;
    int flags;
    int rows;
    int aux;
    int f8;
};
typedef f32x4 Acc[2][2][4][2];
typedef int i32x4 __attribute__((ext_vector_type(4)));
typedef int i32x8 __attribute__((ext_vector_type(8)));

#if !NAIVE_GEMM
template <class Epi, class Sched, bool HAS_F8 = false>
__device__ __forceinline__ void gemm_phase(LAS unsigned char* lds, const Sched& S, const Epi& E, const int tid) {
    const int wid = __builtin_amdgcn_readfirstlane(tid >> 6), lane = tid & 63, wr = wid >> 2, wc = wid & 3, fr = lane & 15, fq = lane >> 4;
    const unsigned ldsw = (unsigned)wid * 1024u;
    const int aoff = lds_byte(wr * 64 + fr, fq * 8), boff = lds_byte(wc * 32 + fr, fq * 8);
#define PG8_SA(b, h) (((b) * 2 + (h)) * HTB)
#define PG8_SB(b, h) ((4 + (b) * 2 + (h)) * HTB)
#define PG8_STAGE(bufoff, gbase, voff) do { _Pragma("unroll") for (int _i = 0; _i < 2; ++_i) { unsigned o_ = (voff)[_i]; asm volatile("" : "+v"(o_));     \
        __builtin_amdgcn_global_load_lds((const unsigned*)((const char*)(gbase) + o_), (LAS unsigned*)(lds + (bufoff) + ldsw + _i * 8192), 16, 0, 0); } } while (0)
#define PG8_LDA(dst, b, h) do { _Pragma("unroll") for (int m = 0; m < 4; ++m) _Pragma("unroll") for (int k = 0; k < 2; ++k) dst[m][k] = *(const LAS bf16x8*)(lds + PG8_SA(b, h) + aoff + m * 2048 + k * 1024); } while (0)
#define PG8_LDB(dst, b, h) do { _Pragma("unroll") for (int n = 0; n < 2; ++n) _Pragma("unroll") for (int k = 0; k < 2; ++k) dst[n][k] = *(const LAS bf16x8*)(lds + PG8_SB(b, h) + boff + n * 2048 + k * 1024); } while (0)
#define PG8_MFMA8(c, a, b) do { const i32x8 a_ = (a), b_ = (b); asm volatile("s_nop 4\n\tv_mfma_scale_f32_16x16x128_f8f6f4 %0, %1, %2, %0, %3, %3 op_sel_hi:[0,0,0]" : "+v"(c) : "v"(a_), "v"(b_), "v"(f8scale)); } while (0)
#define PG8_MFMA_DRAIN() do { if (HAS_F8) asm volatile("s_nop 15\n\ts_nop 15\n\ts_nop 15" ::: "memory"); } while (0)
#define PG8_CAT8(x) __builtin_shufflevector(__builtin_bit_cast(i32x4, (x)[0]), __builtin_bit_cast(i32x4, (x)[1]), 0, 1, 2, 3, 4, 5, 6, 7)
#define PG8_MMA(ai, bj, At, Bt) do { __builtin_amdgcn_s_setprio(1); if (HAS_F8) { _Pragma("unroll") for (int m = 0; m < 4; ++m) _Pragma("unroll") for (int n = 0; n < 2; ++n) \
        PG8_MFMA8(acc[ai][bj][m][n], PG8_CAT8(Bt[n]), PG8_CAT8(At[m])); } \
    else { _Pragma("unroll") for (int m = 0; m < 4; ++m) _Pragma("unroll") for (int n = 0; n < 2; ++n) _Pragma("unroll") for (int k = 0; k < 2; ++k) \
        acc[ai][bj][m][n] = __builtin_amdgcn_mfma_f32_16x16x32_bf16(Bt[n][k], At[m][k], acc[ai][bj][m][n], 0, 0, 0); } __builtin_amdgcn_s_setprio(0); } while (0)
#define PG8_WAIT_V(n) asm volatile("s_waitcnt vmcnt(" #n ")" ::: "memory")
#define PG8_WAIT_L(n) asm volatile("s_waitcnt lgkmcnt(" #n ")" ::: "memory")
#define PG8_BAR __builtin_amdgcn_s_barrier()
#define PG8_SCHED __builtin_amdgcn_sched_barrier(0)
#define PG8_MKV(u, va, vb) do { _Pragma("unroll") for (int _i = 0; _i < 2; ++_i) { int R_, C_; stage_rc(tid * 16 + _i * 8192, R_, C_); const int Rb_ = (R_ & ~31) + perm32(R_ & 31);     \
        vb[_i] = (unsigned)(Rb_ * (u).ldb + C_ * 2); va[0][_i] = S.arow((u), R_) + (unsigned)(C_ * 2); if (Sched::GATHER) va[1][_i] = S.arow((u), 128 + R_) + (unsigned)(C_ * 2); } } while (0)
    GU cur, nxt; int ui = 0;
    if (!S.next(0, cur)) return;
    Acc acc;
#pragma unroll
    for (int a = 0; a < 2; ++a)
#pragma unroll
        for (int b = 0; b < 2; ++b)
#pragma unroll
            for (int m = 0; m < 4; ++m)
#pragma unroll
                for (int n = 0; n < 2; ++n) acc[a][b][m][n] = (f32x4){0.f, 0.f, 0.f, 0.f};
    bf16x8 At[4][2], B0[2][2], B1[2][2];
    int f8scale = 0x7f7f7f7f; asm volatile("" : "+v"(f8scale));
    constexpr int NH = Sched::GATHER ? 2 : 1;
    unsigned vA[NH][2], vB[2], nvA[NH][2], nvB[2];
    PG8_MKV(cur, vA, vB);
    const size_t kstep = (size_t)(BK * 2);
    {
        const char* cA = cur.A; const char* cB = cur.B; const size_t hsB = (size_t)HALF * cur.ldb;
        const char* cBh = cB + hsB; const char* cAk = cA + kstep; const char* cBk = cB + kstep; const char* cBhk = cB + hsB + kstep; const char* cAh = Sched::GATHER ? cA : cA + (size_t)HALF * cur.lda;
        asm volatile("" : "+s"(cA), "+s"(cB), "+s"(cBh), "+s"(cAk), "+s"(cBk), "+s"(cBhk), "+s"(cAh));
        PG8_STAGE(PG8_SB(0, 0), cB, vB); PG8_STAGE(PG8_SB(0, 1), cBh, vB); PG8_STAGE(PG8_SA(0, 0), cA, vA[0]); PG8_STAGE(PG8_SA(0, 1), cAh, vA[NH - 1]);
        if (wr == 1) PG8_BAR;
        PG8_WAIT_V(2); PG8_BAR;
        PG8_STAGE(PG8_SB(1, 0), cBk, vB); PG8_STAGE(PG8_SA(1, 0), cAk, vA[0]); PG8_STAGE(PG8_SB(1, 1), cBhk, vB);
        PG8_WAIT_V(6); PG8_BAR;
    }
    for (;;) {
        const bool has_next = S.next(ui + 1, nxt);
        if (has_next) { PG8_MKV(nxt, nvA, nvB); }
        else {
#pragma unroll
            for (int i = 0; i < 2; ++i) { nvB[i] = vB[i]; nvA[0][i] = vA[0][i]; nvA[NH - 1][i] = vA[NH - 1][i]; }
        }
        const char* cA = cur.A; const char* cB = cur.B; const size_t hsB = (size_t)HALF * cur.ldb;
        const char* nA = has_next ? nxt.A : cA; const char* nB = has_next ? nxt.B : cB; const size_t nhsB = has_next ? (size_t)HALF * nxt.ldb : hsB;
        const size_t hsA = Sched::GATHER ? 0 : (size_t)HALF * cur.lda, nhsA = Sched::GATHER ? 0 : (has_next ? (size_t)HALF * nxt.lda : hsA);
        const int nt = cur.nt;
        for (int t = 0; t < nt; t += 2) {
            const bool last = (t == nt - 2);
            const char* a1 = cA + (size_t)(t + 1) * kstep;
            const char* a2 = last ? nA : cA + (size_t)(t + 2) * kstep; const char* b2 = last ? nB : cB + (size_t)(t + 2) * kstep;
            const char* a3 = a2 + kstep; const char* b3 = b2 + kstep;
            const size_t xhsB = last ? nhsB : hsB, xhsA = last ? nhsA : hsA;
            const char* b2h = b2 + xhsB; const char* b3h = b3 + xhsB; const char* a1h = a1 + hsA; const char* a2h = a2 + xhsA;
            asm volatile("" : "+s"(a1h), "+s"(a2), "+s"(a3), "+s"(b2), "+s"(b3), "+s"(b2h), "+s"(b3h), "+s"(a2h));
            unsigned xA[NH][2], xB[2];
#pragma unroll
            for (int i = 0; i < 2; ++i) { xB[i] = last ? nvB[i] : vB[i]; xA[0][i] = last ? nvA[0][i] : vA[0][i]; xA[NH - 1][i] = last ? nvA[NH - 1][i] : vA[NH - 1][i]; }
            PG8_LDB(B0, 0, 0); PG8_LDB(B1, 0, 1); PG8_SCHED; PG8_LDA(At, 0, 0); PG8_STAGE(PG8_SA(1, 1), a1h, vA[NH - 1]);
            PG8_WAIT_V(8); PG8_WAIT_L(0); PG8_BAR; PG8_MMA(0, 0, At, B0); PG8_MMA(0, 1, At, B1); PG8_BAR; PG8_SCHED;
            PG8_LDA(At, 0, 1); PG8_STAGE(PG8_SB(0, 0), b2, xB); PG8_STAGE(PG8_SB(0, 1), b2h, xB); PG8_STAGE(PG8_SA(0, 0), a2, xA[0]);
            PG8_WAIT_V(8); PG8_WAIT_L(0); PG8_BAR; PG8_MMA(1, 0, At, B0); PG8_MMA(1, 1, At, B1); PG8_BAR; PG8_SCHED;
            PG8_LDB(B0, 1, 0); PG8_LDB(B1, 1, 1); PG8_SCHED; PG8_LDA(At, 1, 0); PG8_STAGE(PG8_SA(0, 1), a2h, xA[NH - 1]);
            PG8_WAIT_V(8); PG8_WAIT_L(0); PG8_BAR; PG8_MMA(0, 0, At, B0); PG8_MMA(0, 1, At, B1); PG8_BAR; PG8_SCHED;
            PG8_LDA(At, 1, 1); PG8_STAGE(PG8_SB(1, 0), b3, xB); PG8_STAGE(PG8_SB(1, 1), b3h, xB); PG8_STAGE(PG8_SA(1, 0), a3, xA[0]);
            PG8_WAIT_V(8); PG8_WAIT_L(0); PG8_BAR; PG8_MMA(1, 0, At, B0); PG8_MMA(1, 1, At, B1); PG8_BAR; PG8_SCHED;
        }
        if (wr == 0) PG8_BAR;
        PG8_MFMA_DRAIN();
        { int fr_e = fr, fq_e = fq; asm volatile("" : "+v"(fr_e), "+v"(fq_e));
          E(acc, cur, wr, wc, fr_e, fq_e); }
        if (!has_next) break;
        if (cur.flags & GU_LAST) {
#pragma unroll
            for (int a = 0; a < 2; ++a)
#pragma unroll
                for (int b = 0; b < 2; ++b)
#pragma unroll
                    for (int m = 0; m < 4; ++m)
#pragma unroll
                        for (int n = 0; n < 2; ++n) acc[a][b][m][n] = (f32x4){0.f, 0.f, 0.f, 0.f};
        }
        cur = nxt; ++ui;
#pragma unroll
        for (int i = 0; i < 2; ++i) { vB[i] = nvB[i]; vA[0][i] = nvA[0][i]; vA[NH - 1][i] = nvA[NH - 1][i]; }
        if (wr == 1) PG8_BAR;
    }
    PG8_WAIT_V(0);
    PG8_BAR;
#undef PG8_SA
#undef PG8_SB
#undef PG8_STAGE
#undef PG8_LDA
#undef PG8_LDB
#undef PG8_MMA
#undef PG8_WAIT_V
#undef PG8_WAIT_L
#undef PG8_BAR
#undef PG8_SCHED
#undef PG8_MKV
#undef PG8_CAT8
}
#else
template <class Epi, class Sched>
__device__ __forceinline__ void gemm_phase(LAS unsigned char* lds, const Sched& S, const Epi& E, const int tid) {
    const int wid = __builtin_amdgcn_readfirstlane(tid >> 6), lane = tid & 63, wr = wid >> 2, wc = wid & 3, fr = lane & 15, fq = lane >> 4;
    GU cur; Acc acc;
#pragma unroll
    for (int a = 0; a < 2; ++a)
#pragma unroll
        for (int b = 0; b < 2; ++b)
#pragma unroll
            for (int m = 0; m < 4; ++m)
#pragma unroll
                for (int n = 0; n < 2; ++n) acc[a][b][m][n] = (f32x4){0.f, 0.f, 0.f, 0.f};
    for (int ui = 0; S.next(ui, cur); ++ui) {
        const int K = cur.nt * 64;
#pragma unroll 1
        for (int ai = 0; ai < 2; ++ai)
#pragma unroll 1
            for (int m = 0; m < 4; ++m) {
                const char* ap = cur.A + S.arow(cur, ai * 128 + wr * 64 + m * 16 + fr);
#pragma unroll 1
                for (int bj = 0; bj < 2; ++bj) {
                    float s[8];
#pragma unroll
                    for (int j = 0; j < 8; ++j) s[j] = 0.f;
                    const char* bp = cur.B + (size_t)(bj * 128 + wc * 32 + 8 * fq) * cur.ldb;
#pragma unroll 1
                    for (int k = 0; k < K; k += 8) {
                        const u32x4 av = *(const u32x4*)(ap + k * 2);
                        const float a0 = bflo(av.x), a1 = bfhi(av.x), a2 = bflo(av.y), a3 = bfhi(av.y), a4 = bflo(av.z), a5 = bfhi(av.z), a6 = bflo(av.w), a7 = bfhi(av.w);
#pragma unroll
                        for (int j = 0; j < 8; ++j) { const u32x4 bv = *(const u32x4*)(bp + (size_t)j * cur.ldb + k * 2);
                            s[j] += a0 * bflo(bv.x) + a1 * bfhi(bv.x) + a2 * bflo(bv.y) + a3 * bfhi(bv.y) + a4 * bflo(bv.z) + a5 * bfhi(bv.z) + a6 * bflo(bv.w) + a7 * bfhi(bv.w); }
                    }
#pragma unroll
                    for (int a_ = 0; a_ < 2; ++a_)
#pragma unroll
                        for (int m_ = 0; m_ < 4; ++m_)
#pragma unroll
                            for (int b_ = 0; b_ < 2; ++b_) if (a_ == ai && m_ == m && b_ == bj) {
                                acc[a_][b_][m_][0] += (f32x4){s[0], s[1], s[2], s[3]}; acc[a_][b_][m_][1] += (f32x4){s[4], s[5], s[6], s[7]}; }
                }
            }
        E(acc, cur, wr, wc, fr, fq);
        if (cur.flags & GU_LAST) {
#pragma unroll
            for (int a = 0; a < 2; ++a)
#pragma unroll
                for (int b = 0; b < 2; ++b)
#pragma unroll
                    for (int m = 0; m < 4; ++m)
#pragma unroll
                        for (int n = 0; n < 2; ++n) acc[a][b][m][n] = (f32x4){0.f, 0.f, 0.f, 0.f};
        }
    }
    __syncthreads();
}
#endif
}
namespace pg8 {
__device__ __forceinline__ unsigned cvt_pk_bf16(float lo, float hi) { unsigned r; asm volatile("v_cvt_pk_bf16_f32 %0, %1, %2" : "=v"(r) : "v"(lo), "v"(hi)); return r; }
__device__ __forceinline__ void st8(char* p, const f32x4 v0, const f32x4 v1) { u32x4 w; w.x = cvt_pk_bf16(v0[0], v0[1]); w.y = cvt_pk_bf16(v0[2], v0[3]); w.z = cvt_pk_bf16(v1[0], v1[1]); w.w = cvt_pk_bf16(v1[2], v1[3]); *(u32x4*)p = w; }
__device__ __forceinline__ void ld8(const char* p, f32x4& v0, f32x4& v1) { const u32x4 w = *(const u32x4*)p; v0 = (f32x4){bflo(w.x), bfhi(w.x), bflo(w.y), bfhi(w.y)}; v1 = (f32x4){bflo(w.z), bfhi(w.z), bflo(w.w), bfhi(w.w)}; }
__device__ __forceinline__ void tile_of(int L, int nM, int nN, int& pm, int& pn) {
    const int nwg = nM * nN; int wgid = L; { const int q = nwg / 8, r = nwg % 8, xcd = wgid % 8, off = wgid / 8; wgid = (xcd < r ? xcd * (q + 1) : r * (q + 1) + (xcd - r) * q) + off; }
    const int nig = 8 * nN, gid = wgid / nig, fm = gid * 8, gsz = (nM - fm) < 8 ? (nM - fm) : 8;
    pm = fm + ((wgid % nig) % gsz); pn = (wgid % nig) / gsz;
}
#define EPI_ROWS(...) _Pragma("unroll") for (int ai = 0; ai < 2; ++ai) _Pragma("unroll") for (int m = 0; m < 4; ++m) { const int lrow = ai * 128 + wr * 64 + m * 16 + fr; __VA_ARGS__ }
#define EPI_COLS(...) _Pragma("unroll") for (int bj = 0; bj < 2; ++bj) { const int lcol = bj * 128 + wc * 32 + 8 * fq; f32x4& v0 = acc[ai][bj][m][0]; f32x4& v1 = acc[ai][bj][m][1]; __VA_ARGS__ }

struct SchedDense {
    const char* A; const char* B; int lda, ldb, nt, nM, nN, G, c;
    static constexpr bool GATHER = false;
    __device__ __forceinline__ bool next(int i, GU& u) const {
        const int L = i * G + c; if (L >= nM * nN) return false;
        int pm, pn; tile_of(L, nM, nN, pm, pn);
        u.A = A + (size_t)pm * 256 * lda; u.B = B + (size_t)pn * 256 * ldb; u.C = nullptr; u.P = nullptr; u.lda = lda; u.ldb = ldb; u.nt = nt; u.pm = pm; u.pn = pn; u.seg = 0; u.flags = GU_LAST; u.rows = 256; u.aux = 0; u.f8 = 0;
        return true;
    }
    __device__ __forceinline__ unsigned arow(const GU& u, int r) const { return (unsigned)(r * u.lda); }
};
template <bool HALF> struct SchedProj {
    unsigned char* ws; unsigned char* lw; int G, c;
    static constexpr bool GATHER = false;
    __device__ __forceinline__ bool next(int i, GU& u) const {
        int id = -1;
        if (G == 256) {
            if (!HALF) { if (i == 0) id = c; else if (i == 1 && c < 192) id = c + 256; }
            else { if (c < 192) { if (i < 3) id = c * 3 + i; } else { if (i < 5) id = 576 + (c - 192) * 5 + i; } } }
        else { const int L = i * G + c; if (L < (HALF ? 896 : 448)) id = L; }
        if (id < 0) return false;
        int pm, pn;
        if (!HALF) { int t14; tile_of(id, 32, 14, pm, t14); u.A = (const char*)ws + WS_X + (size_t)pm * 256 * 4096; u.lda = 4096; u.B = (const char*)lw + LW_WIN + (size_t)t14 * 256 * 4096; u.ldb = 4096; u.nt = 32; u.f8 = 0;
            pn = t14 < 12 ? t14 : 16 + (t14 - 12); }
        else { int t28; tile_of(id, 32, 28, pm, t28); u.A = (const char*)ws + WS_H8 + (size_t)pm * 256 * 2048; u.lda = 2048; u.B = (const char*)lw + LW_WG8 + (size_t)t28 * 256 * 2048; u.ldb = 2048; u.nt = 16; u.f8 = 1;
            pn = t28 < 24 ? 18 + t28 : 12 + (t28 - 24); }
        u.C = nullptr; u.P = nullptr; u.pm = pm; u.pn = pn; u.seg = 0; u.flags = GU_LAST; u.rows = 256; u.aux = 0;
        return true;
    }
    __device__ __forceinline__ unsigned arow(const GU& u, int r) const { return (unsigned)(r * u.lda); }
};
template <int MODE> struct SchedSeg {
    unsigned char* ws; unsigned char* lw; int G, c;
    static constexpr bool GATHER = false; static constexpr int NS = MODE == 0 ? 3 : 4;
    __device__ __forceinline__ bool next(int i, GU& u) const {
        const int ti = i / NS, sg = i % NS; const int L = ti * G + c; if (L >= 256) return false;
        int pm, pn; tile_of(L, 32, 8, pm, pn);
        if (MODE == 0) { const size_t ao = sg == 0 ? WS_OAN : sg == 1 ? WS_CVO : WS_GLUO; const int la = sg == 0 ? 2048 : 1024; const size_t bo = sg == 0 ? 0 : sg == 1 ? 2048 : 3072;
            u.A = (const char*)ws + ao + (size_t)pm * 256 * la; u.lda = la; u.nt = sg == 0 ? 16 : 8; u.B = (const char*)lw + LW_WCAT + bo + (size_t)pn * 256 * 4096; u.ldb = 4096; }
        else if (XAO_FP8) { int two = 2; asm volatile("" : "+s"(two)); u.A = (const char*)ws + WS_P + sg * 256 + (size_t)pm * 256 * 1024; u.lda = 1024; u.nt = two; u.B = (const char*)lw + LW_VW + sg * 256 + (size_t)pn * 256 * 1024; u.ldb = 1024; }
        else { u.A = (const char*)ws + WS_P + sg * 512 + (size_t)pm * 256 * 2048; u.lda = 2048; u.nt = 4; u.B = (const char*)lw + LW_VW + sg * 512 + (size_t)pn * 256 * 2048; u.ldb = 2048; }
        u.C = nullptr; u.P = nullptr; u.pm = pm; u.pn = pn; u.seg = sg; u.flags = (sg == NS - 1) ? GU_LAST : 0; u.rows = 256; u.aux = 0; u.f8 = 0;
        return true;
    }
    __device__ __forceinline__ unsigned arow(const GU& u, int r) const { return (unsigned)(r * u.lda); }
};
struct EpiStore { int ldc; int ncolh;
    __device__ __forceinline__ void operator()(Acc& acc, const GU& u, int wr, int wc, int fr, int fq) const {
        const float sc = __builtin_bit_cast(float, u.aux);
        EPI_ROWS( if (lrow < u.rows) { char* rp = u.C + (unsigned)(lrow * ldc); EPI_COLS( if (bj < ncolh) st8(rp + lcol * 2, v0 * sc, v1 * sc); ) } )
    }
};
struct EpiStoreF32 { int ldc;
    __device__ __forceinline__ void operator()(Acc& acc, const GU& u, int wr, int wc, int fr, int fq) const {
        EPI_ROWS( { char* rp = u.C + (unsigned)(lrow * ldc); const int lcol = wc * 32 + 8 * fq; *(f32x4*)(rp + lcol * 4) = acc[ai][0][m][0]; *(f32x4*)(rp + lcol * 4 + 16) = acc[ai][0][m][1]; } )
    }
};
struct EpiProj { char* ws; const float* ropeC; const float* ropeS; const float* rstd;
    __device__ __forceinline__ void operator()(Acc& acc, const GU& u, int wr, int wc, int fr, int fq) const {
        const int pn = u.pn;
        if (pn < 8) {
            char* dst = ws + (pn < 4 ? WS_Q : WS_K) + (size_t)(pn & 3) * 512; const float sc0 = pn < 4 ? C2Q : 1.f;
            EPI_ROWS( { const int tok = u.pm * 256 + lrow; char* rp = dst + (unsigned)(tok * 2048); const float sc = sc0 * rstd[tok];
                EPI_COLS( { const int i0 = (lcol & 63) >> 1; const f32x4 c4 = *(const f32x4*)(ropeC + tok * 32 + i0), s4 = *(const f32x4*)(ropeS + tok * 32 + i0);
                    const f32x4 o0 = (f32x4){v0[0] * c4[0] - v0[1] * s4[0], v0[1] * c4[0] + v0[0] * s4[0], v0[2] * c4[1] - v0[3] * s4[1], v0[3] * c4[1] + v0[2] * s4[1]};
                    const f32x4 o1 = (f32x4){v1[0] * c4[2] - v1[1] * s4[2], v1[1] * c4[2] + v1[0] * s4[2], v1[2] * c4[3] - v1[3] * s4[3], v1[3] * c4[3] + v1[2] * s4[3]};
                    st8(rp + lcol * 2, o0 * sc, o1 * sc); } ) } )
        } else if (pn < 12) {
            char* dst = ws + WS_V + (size_t)(pn - 8) * 512;
            EPI_ROWS( { const int tok = u.pm * 256 + lrow; char* rp = dst + (unsigned)(tok * 2048); const float rs = rstd[tok]; EPI_COLS( st8(rp + lcol * 2, v0 * rs, v1 * rs); ) } )
        } else if (pn < 16) {
            char* dst = ws + WS_Z + (size_t)(pn - 12) * 256;
            EPI_ROWS( { const int tok = u.pm * 256 + lrow; char* rp = dst + (unsigned)(tok * 1024); const float is = rstd[tok] * (1.f / GATE_WSCALE);
                EPI_COLS( { u32x2 w; w.x = cvt_pk_bf16(v0[0] * is * sigmoidf_(v0[1] * is), v0[2] * is * sigmoidf_(v0[3] * is)); w.y = cvt_pk_bf16(v1[0] * is * sigmoidf_(v1[1] * is), v1[2] * is * sigmoidf_(v1[3] * is)); *(u32x2*)(rp + lcol) = w; } ) } )
        } else if (pn < 18) {
            EPI_ROWS( { const int tok = u.pm * 256 + lrow; const float rs = rstd[tok];
                EPI_COLS( { const int ch = (pn - 16) * 256 + lcol, g = ch >> 4, h = ch & 15; st8((ws + WS_UC) + (unsigned)(((g * 256 + (tok >> 5)) * 512 + (tok & 31) * 16 + h) * 2), v0 * rs, v1 * rs); } ) } )
        } else {
            char* dst = ws + WS_GATES + (size_t)(pn - 18) * 256;
            EPI_ROWS( { const int tok = u.pm * 256 + lrow; char* rp = dst + (unsigned)(tok * 6144); const float is = rstd[tok] * (1.f / GATE_WSCALE);
                EPI_COLS( { unsigned qa[4], qb[4];
                    _Pragma("unroll") for (int j = 0; j < 4; ++j) { qa[j] = (unsigned)fminf(sigmoidf_(v0[j] * is) * 256.f, 255.f); qb[j] = (unsigned)fminf(sigmoidf_(v1[j] * is) * 256.f, 255.f); }
                    u32x2 w; w.x = qa[0] | (qa[1] << 8) | (qa[2] << 16) | (qa[3] << 24); w.y = qb[0] | (qb[1] << 8) | (qb[2] << 16) | (qb[3] << 24);
                    *(u32x2*)(rp + lcol) = w; } ) } )
        }
    }
};
struct EpiSsm3 { char* ys;
    __device__ __forceinline__ void operator()(Acc& acc, const GU& u, int wr, int wc, int fr, int fq) const {
        if (!(u.flags & GU_LAST)) return;
        const int g = u.pm;
        EPI_ROWS( { const int chunk = lrow;
            EPI_COLS( { const int jh = u.pn * 256 + lcol, j = jh >> 4, h = jh & 15; st8(ys + (unsigned)(((chunk * 32 + j) * 512 + g * 16 + h) * 2), v0, v1); } ) } )
    }
};
struct EpiGlu { char* dst; const float* bias;
    __device__ __forceinline__ void operator()(Acc& acc, const GU& u, int wr, int wc, int fr, int fq) const {
        EPI_ROWS( { const int tok = u.pm * 256 + lrow; char* rp = (dst + (size_t)u.pn * 256) + (unsigned)(tok * 1024);
            EPI_COLS( { const int j0 = u.pn * 128 + (lcol >> 1); const f32x4 ba = *(const f32x4*)(bias + j0), bb = *(const f32x4*)(bias + 512 + j0);
                u32x2 w; w.x = cvt_pk_bf16((v0[0] + ba[0]) * sigmoidf_(v0[1] + bb[0]), (v0[2] + ba[1]) * sigmoidf_(v0[3] + bb[1]));
                w.y = cvt_pk_bf16((v1[0] + ba[2]) * sigmoidf_(v1[1] + bb[2]), (v1[2] + ba[3]) * sigmoidf_(v1[3] + bb[3])); *(u32x2*)(rp + lcol) = w; } ) } )
    }
};
struct EpiGated { const char* gates; char* merged;
    __device__ __forceinline__ void operator()(Acc& acc, const GU& u, int wr, int wc, int fr, int fq) const {
        const int sg = u.seg;
        EPI_ROWS( { const int tok = u.pm * 256 + lrow; const char* gp = (gates + (size_t)u.pn * 256) + (unsigned)(tok * 6144); char* mp = (merged + (size_t)u.pn * 512) + (unsigned)(tok * 4096);
            EPI_COLS( { const u32x2 nq = *(const u32x2*)(gp + (size_t)sg * 2048 + lcol);
                if (sg < 2) { const u32x2 dq = *(const u32x2*)(gp + (size_t)(sg + 1) * 2048 + lcol);
                    _Pragma("unroll") for (int j = 0; j < 4; ++j) { v0[j] *= ((float)((nq.x >> (8 * j)) & 255u) + 0.5f) * __builtin_amdgcn_rcpf((float)((dq.x >> (8 * j)) & 255u) + 0.5f); v1[j] *= ((float)((nq.y >> (8 * j)) & 255u) + 0.5f) * __builtin_amdgcn_rcpf((float)((dq.y >> (8 * j)) & 255u) + 0.5f); } }
                else { _Pragma("unroll") for (int j = 0; j < 4; ++j) { v0[j] *= fmaf((float)((nq.x >> (8 * j)) & 255u), 1.f / 256.f, 0.5f / 256.f); v1[j] *= fmaf((float)((nq.y >> (8 * j)) & 255u), 1.f / 256.f, 0.5f / 256.f); }
                    st8(mp + lcol * 2, v0, v1); } } ) } )
    }
};
struct EpiResid { char* x; char* h8; float* rsq;
    __device__ __forceinline__ void operator()(Acc& acc, const GU& u, int wr, int wc, int fr, int fq) const {
        EPI_ROWS( { const int tok = u.pm * 256 + lrow; char* rp = (x + (size_t)u.pn * 512) + (unsigned)(tok * 4096); char* hp = (h8 + (size_t)u.pn * (S_FP8 ? 256 : 512)) + (unsigned)(tok * (S_FP8 ? 2048 : 4096)); float s = 0.f;
            EPI_COLS( { f32x4 a, b; ld8(rp + lcol * 2, a, b); a = a + v0; b = b + v1; st8(rp + lcol * 2, a, b);
                s += (a[0] * a[0] + a[1] * a[1]) + (a[2] * a[2] + a[3] * a[3]) + (b[0] * b[0] + b[1] * b[1]) + (b[2] * b[2] + b[3] * b[3]);
#if S_FP8
                int q0 = __builtin_amdgcn_cvt_pk_fp8_f32(a[0], a[1], 0, false); q0 = __builtin_amdgcn_cvt_pk_fp8_f32(a[2], a[3], q0, true);
                int q1 = __builtin_amdgcn_cvt_pk_fp8_f32(b[0], b[1], 0, false); q1 = __builtin_amdgcn_cvt_pk_fp8_f32(b[2], b[3], q1, true); *(u32x2*)(hp + lcol) = (u32x2){(unsigned)q0, (unsigned)q1};
#elif !defined(DBG_NO_HST)
                st8(hp + lcol * 2, a, b);
#endif
                } )
#ifndef DBG_NO_RSQ
            s += xor_lane<16>(s); s += xor_lane<32>(s);
            if (fq == 0) rsq[(u.pn * T + tok) * 4 + wc] = s;
#endif
            } )
    }
};
struct EpiSexp { char* P; float* rs; const float* rsq;
    __device__ __forceinline__ void operator()(Acc& acc, const GU& u, int wr, int wc, int fr, int fq) const {
        EPI_ROWS( { const int tok = u.pm * 256 + lrow; char* rp = (P + (size_t)u.pn * 512) + (unsigned)(tok * 2048); char* rp8 = (P + (size_t)u.pn * 256) + (unsigned)(tok * 1024); (void)rp; (void)rp8; float s = 0.f;
            float sq = 0.f;
#ifdef DBG_READ_RS
            _Pragma("unroll") for (int q = 0; q < 8; ++q) { const f32x4 t4 = *(const f32x4*)(rs + 262144 + tok * 32 + q * 4); sq += (t4[0] + t4[1]) + (t4[2] + t4[3]); }
#elif defined(DBG_RSQ_ATOMIC_LD)
            _Pragma("unroll") for (int q = 0; q < 32; ++q) sq += __hip_atomic_load(rsq + tok * 32 + q, __ATOMIC_RELAXED, __HIP_MEMORY_SCOPE_AGENT);
#else
            _Pragma("unroll") for (int q = 0; q < 8; ++q) { const f32x4 t4 = *(const f32x4*)(rsq + (q * T + tok) * 4); sq += (t4[0] + t4[1]) + (t4[2] + t4[3]); }
#endif
#ifdef DBG_RN1
            const float rn = 1.f;
#elif defined(DBG_RN1_KEEP)
            asm volatile("" :: "v"(sq)); const float rn = 1.f;
#else
            const float rn = FUSE_N2 ? rsqrtf(sq * (1.f / DM) + RMS_EPS) * (1.f / SQK_SCALE) : 1.f + 0.f * sq;
#endif
#if XAO_FP8
            EPI_COLS( { v0 = v0 * rn - 2.f; v1 = v1 * rn - 2.f;
                const float e0 = __builtin_amdgcn_exp2f(v0[0]), e1 = __builtin_amdgcn_exp2f(v0[1]), e2 = __builtin_amdgcn_exp2f(v0[2]), e3 = __builtin_amdgcn_exp2f(v0[3]);
                const float e4 = __builtin_amdgcn_exp2f(v1[0]), e5 = __builtin_amdgcn_exp2f(v1[1]), e6 = __builtin_amdgcn_exp2f(v1[2]), e7 = __builtin_amdgcn_exp2f(v1[3]);
                int q0 = __builtin_amdgcn_cvt_pk_fp8_f32(e0, e1, 0, false); q0 = __builtin_amdgcn_cvt_pk_fp8_f32(e2, e3, q0, true);
                int q1 = __builtin_amdgcn_cvt_pk_fp8_f32(e4, e5, 0, false); q1 = __builtin_amdgcn_cvt_pk_fp8_f32(e6, e7, q1, true);
                *(u32x2*)(rp8 + lcol) = (u32x2){(unsigned)q0, (unsigned)q1};
                const f32x2 a0 = __builtin_amdgcn_cvt_pk_f32_fp8(q0, false), a1 = __builtin_amdgcn_cvt_pk_f32_fp8(q0, true), a2 = __builtin_amdgcn_cvt_pk_f32_fp8(q1, false), a3 = __builtin_amdgcn_cvt_pk_f32_fp8(q1, true);
                s += ((a0[0] + a0[1]) + (a1[0] + a1[1])) + ((a2[0] + a2[1]) + (a3[0] + a3[1])); } )
#else
            EPI_COLS( { v0 = v0 * rn; v1 = v1 * rn; u32x4 w; w.x = cvt_pk_bf16(__builtin_amdgcn_exp2f(v0[0]), __builtin_amdgcn_exp2f(v0[1])); w.y = cvt_pk_bf16(__builtin_amdgcn_exp2f(v0[2]), __builtin_amdgcn_exp2f(v0[3]));
                w.z = cvt_pk_bf16(__builtin_amdgcn_exp2f(v1[0]), __builtin_amdgcn_exp2f(v1[1])); w.w = cvt_pk_bf16(__builtin_amdgcn_exp2f(v1[2]), __builtin_amdgcn_exp2f(v1[3]));
                *(u32x4*)(rp + lcol * 2) = w; s += ((bflo(w.x) + bfhi(w.x)) + (bflo(w.y) + bfhi(w.y))) + ((bflo(w.z) + bfhi(w.z)) + (bflo(w.w) + bfhi(w.w))); } )
#endif
            s += xor_lane<16>(s); s += xor_lane<32>(s);
            if (fq == 0) rs[(u.pn * T + tok) * 4 + wc] = s; } )
    }
};
#ifdef DBG_NO_XA
#define XA_DBG_COND && false
#else
#define XA_DBG_COND
#endif
struct EpiXao { const float* rs; char* x;
    __device__ __forceinline__ void operator()(Acc& acc, const GU& u, int wr, int wc, int fr, int fq) const {
        const int sg = u.seg;
        EPI_ROWS( { const int tok = u.pm * 256 + lrow; const f32x4 a = *(const f32x4*)(rs + (sg * T + tok) * 4); const float lh = (a[0] + a[1]) + (a[2] + a[3]);
            float f = __builtin_amdgcn_rcpf(lh) * (sg == 3 ? 1.f / VW_SCALE : 1.f);
            if (sg < 3) { const f32x4 b = *(const f32x4*)(rs + ((sg + 1) * T + tok) * 4); f *= (b[0] + b[1]) + (b[2] + b[3]); }
            char* rp = (x + (size_t)u.pn * 512) + (unsigned)(tok * 4096);
            EPI_COLS( { v0 = v0 * f; v1 = v1 * f; if (sg == 3 XA_DBG_COND) { f32x4 a, b; ld8(rp + lcol * 2, a, b); st8(rp + lcol * 2, a + v0, b + v1); } } ) } )
    }
};
template <bool DOWN> struct SchedMoE {
    const volatile LAS int* cnt;
    unsigned char* ws; unsigned char* lw; int G, c;
    static constexpr bool GATHER = !DOWN;
    static constexpr int nN = DOWN ? 8 : 4;
    __device__ __forceinline__ bool next(int i, GU& u) const {
        const int L = i * G + c; const int tile = L / nN, pn = L % nN;
        int e = -1, mt = 0, off = 0, tacc = 0, ce = 0;
#pragma unroll 1
        for (int k = 0; k < NEXP; ++k) { const int ck = __builtin_amdgcn_readfirstlane(cnt[k]); const int tk = (ck + 255) >> 8;
            if (e < 0 && tile < tacc + tk) { e = k; mt = tile - tacc; ce = ck; }
            if (e < 0) { off += ck; tacc += tk; } }
        if (e < 0) return false;
        u.pm = mt; u.pn = pn; u.seg = 0; u.flags = GU_LAST; u.aux = e; u.f8 = 1;
        u.rows = (ce - mt * 256) < 256 ? (ce - mt * 256) : 256;
        int ntd = 4, ntg = 16; asm volatile("" : "+s"(ntd), "+s"(ntg));
        if (DOWN) { u.nt = ntd; u.lda = 512; u.ldb = 512; u.B = (const char*)lw + LW_WD + (size_t)e * DM * FFE + (size_t)pn * 256 * 512;
            u.A = (const char*)ws + WS_HE + (size_t)(off + mt * 256) * 512; u.C = (char*)ws + WS_Y + (size_t)(off + mt * 256) * 2048; u.P = nullptr; }
        else { u.nt = ntg; u.lda = 2048; u.ldb = 2048; u.B = (const char*)lw + LW_WGU + (size_t)e * 1024 * DM + (size_t)pn * 256 * 2048;
            u.A = (const char*)ws + WS_H8; u.C = (char*)ws + WS_HE + (size_t)(off + mt * 256) * 512; u.P = (const char*)ws + WS_WL + ((size_t)e * T + mt * 256) * 4; }
        return true;
    }
    __device__ __forceinline__ unsigned arow(const GU& u, int r) const {
        if (DOWN) return (unsigned)(r * u.lda);
        const int tok = (r < u.rows) ? ((const int*)(ws + WS_LIST))[u.aux * T + u.pm * 256 + r] : 0;
        return (unsigned)tok * (unsigned)u.lda;
    }
};
struct EpiGu {
    __device__ __forceinline__ void operator()(Acc& acc, const GU& u, int wr, int wc, int fr, int fq) const {
        constexpr float is = 1.f / GATE_WSCALE;
        EPI_ROWS( if (lrow < u.rows) { const float w = *(const float*)(u.P + lrow * 4) * is; char* rp = (u.C + (size_t)u.pn * 128) + (unsigned)(lrow * 512);
            EPI_COLS( { const float g0 = v0[0] * is, g1 = v0[2] * is, g2 = v1[0] * is, g3 = v1[2] * is;
                int p8 = __builtin_amdgcn_cvt_pk_fp8_f32(g0 * sigmoidf_(g0) * v0[1] * w, g1 * sigmoidf_(g1) * v0[3] * w, 0, false);
                p8 = __builtin_amdgcn_cvt_pk_fp8_f32(g2 * sigmoidf_(g2) * v1[1] * w, g3 * sigmoidf_(g3) * v1[3] * w, p8, true); *(unsigned*)(rp + (lcol >> 1)) = (unsigned)p8; } ) } )
    }
};
struct EpiDown {
    __device__ __forceinline__ void operator()(Acc& acc, const GU& u, int wr, int wc, int fr, int fq) const {
        constexpr float ys = 16.f / GATE_WSCALE;
        EPI_ROWS( if (lrow < u.rows) { char* rp = (u.C + (size_t)u.pn * 256) + (unsigned)(lrow * 2048);
            EPI_COLS( { int q0 = __builtin_amdgcn_cvt_pk_fp8_f32(v0[0] * ys, v0[1] * ys, 0, false); q0 = __builtin_amdgcn_cvt_pk_fp8_f32(v0[2] * ys, v0[3] * ys, q0, true);
                int q1 = __builtin_amdgcn_cvt_pk_fp8_f32(v1[0] * ys, v1[1] * ys, 0, false); q1 = __builtin_amdgcn_cvt_pk_fp8_f32(v1[2] * ys, v1[3] * ys, q1, true); *(u32x2*)(rp + lcol) = (u32x2){(unsigned)q0, (unsigned)q1}; } ) } )
    }
};
}
#include <hip/hip_bf16.h>
#include <cmath>
namespace attn_body {
using bf16=__hip_bfloat16;
using bf16x8=__attribute__((ext_vector_type(8)))short;
using s16x4=__attribute__((ext_vector_type(4)))short;
using f32x16=__attribute__((ext_vector_type(16)))float;
using u32x4=__attribute__((ext_vector_type(4)))unsigned;
constexpr int BATCH=1,NHEAD=16,SEQ=8192,D=64,DM=NHEAD*D;
constexpr int NW=8,QBLK=32,QB=QBLK*NW,KVBLK=64,NQB=SEQ/QB;
constexpr int ATTN_PITCH=DM, ATTN_UNIT_ROWS=QB;
__device__ __forceinline__ int crow(int r,int hi){return (r&3)+8*(r>>2)+4*hi;}
#define SBAR() __builtin_amdgcn_sched_barrier(0)
__device__ __forceinline__ void cmask(f32x16&p0,f32x16&p1,int jb,int qrel,int hi){
  const float NEG=-INFINITY; int kb=64*jb+4*hi;
  #pragma unroll
  for(int r=0;r<16;++r){int kv=kb+(r&3)+8*(r>>2); if(kv>qrel)p0[r]=NEG; if(kv+32>qrel)p1[r]=NEG;}
}

constexpr int NSLOT=3, SLOTB=8192;
constexpr int LDS_K=0, LDS_V=NSLOT*SLOTB, LDS_WS=2*NSLOT*SLOTB, LDS_OST=LDS_WS+NW*64*4, LDS_BYTES=LDS_OST+NW*4096;
constexpr float C2=0.125f*1.4426950408889634f;
__device__ __forceinline__ void glds16(const void*gsrc,unsigned lds_dst){unsigned keep;
  asm volatile("s_mov_b32 %0, m0\n\ts_mov_b32 m0, %2\n\ts_nop 0\n\tglobal_load_lds_dwordx4 %1, off\n\ts_mov_b32 m0, %0":"=&s"(keep):"v"(gsrc),"s"(lds_dst):"memory");}
__device__ __forceinline__ float max3f(float a,float b,float c){float r;asm("v_max3_f32 %0, %1, %2, %3":"=v"(r):"v"(a),"v"(b),"v"(c));return r;}
__device__ __forceinline__ float max2f(float a,float b){float r;asm("v_max_f32_e32 %0, %1, %2":"=v"(r):"v"(a),"v"(b));return r;}
__device__ __forceinline__ float fadd_s(float a,float b){float r;asm("v_add_f32_e32 %0, %1, %2":"=v"(r):"v"(a),"v"(b));return r;}
__device__ __forceinline__ float fsub_s(float a,float b){float r;asm("v_sub_f32_e32 %0, %1, %2":"=v"(r):"v"(a),"v"(b));return r;}
typedef float f32x2_t __attribute__((ext_vector_type(2))); typedef __bf16 bf16x2_t __attribute__((ext_vector_type(2)));
__device__ __forceinline__ unsigned cvtpk_s(float lo,float hi){f32x2_t v={lo,hi};bf16x2_t b=__builtin_convertvector(v,bf16x2_t);return __builtin_bit_cast(unsigned,b);}
#define WAIT_BAR(N) asm volatile("s_waitcnt vmcnt(" #N ") lgkmcnt(0)\n\ts_barrier":::"memory")

__device__ __forceinline__ void qkt(f32x16&p0,f32x16&p1,const char*Kslot,const bf16x8*qr,const f32x16&negm,int r32,int hi){
  const char*kb=Kslot+hi*1024+r32*16;
  #pragma unroll
  for(int d0=0;d0<4;++d0){
    const bf16x8 b0=*reinterpret_cast<const bf16x8*>(kb+d0*2048);
    const bf16x8 b1=*reinterpret_cast<const bf16x8*>(kb+d0*2048+512);
    if(d0==0){p0=__builtin_amdgcn_mfma_f32_32x32x16_bf16(b0,qr[0],negm,0,0,0);p1=__builtin_amdgcn_mfma_f32_32x32x16_bf16(b1,qr[0],negm,0,0,0);}
    else{p0=__builtin_amdgcn_mfma_f32_32x32x16_bf16(b0,qr[d0],p0,0,0,0);p1=__builtin_amdgcn_mfma_f32_32x32x16_bf16(b1,qr[d0],p1,0,0,0);}}
}
typedef __attribute__((address_space(3))) const char* lds_cptr;
typedef short v4i16_t __attribute__((ext_vector_type(4)));
__device__ __forceinline__ void kload8(bf16x8*kf,lds_cptr kp){
  kf[0]=*(const __attribute__((address_space(3))) bf16x8*)(kp);      kf[1]=*(const __attribute__((address_space(3))) bf16x8*)(kp+512);
  kf[2]=*(const __attribute__((address_space(3))) bf16x8*)(kp+2048); kf[3]=*(const __attribute__((address_space(3))) bf16x8*)(kp+2560);
  kf[4]=*(const __attribute__((address_space(3))) bf16x8*)(kp+4096); kf[5]=*(const __attribute__((address_space(3))) bf16x8*)(kp+4608);
  kf[6]=*(const __attribute__((address_space(3))) bf16x8*)(kp+6144); kf[7]=*(const __attribute__((address_space(3))) bf16x8*)(kp+6656);
}
__device__ __forceinline__ void kload2(bf16x8*kf,lds_cptr kp,int j){ kf[2*j]=*(const __attribute__((address_space(3))) bf16x8*)(kp+j*2048); kf[2*j+1]=*(const __attribute__((address_space(3))) bf16x8*)(kp+j*2048+512); }
__device__ __forceinline__ s16x4 vtr(lds_cptr p){ return __builtin_bit_cast(s16x4,__builtin_amdgcn_ds_read_tr16_b64_v4i16((__attribute__((address_space(3))) v4i16_t*)p)); }
__device__ __forceinline__ float rowmax(const f32x16&p0,const f32x16&p1){
  float a=max3f(p0[0],p0[1],p1[0]),b=max3f(p0[2],p0[3],p1[1]);a=max3f(a,p1[2],p1[3]);
  #pragma unroll
  for(int r=4;r<16;r+=4){a=max3f(a,p0[r],p0[r+1]);b=max3f(b,p0[r+2],p0[r+3]);a=max3f(a,p1[r],p1[r+1]);b=max3f(b,p1[r+2],p1[r+3]);}
  const float m=max2f(a,b);
  auto rr=__builtin_amdgcn_permlane32_swap(__float_as_uint(m),__float_as_uint(m),false,false);
  return max2f(__uint_as_float(rr[0]),__uint_as_float(rr[1]));
}
__device__ __forceinline__ void pv(f32x16*o,int vb,bf16x8 pa0,bf16x8 pa1,bf16x8 pa2,bf16x8 pa3){
  #pragma unroll
  for(int d0=0;d0<2;++d0){s16x4 lo[4],hi[4];
    #pragma unroll
    for(int ks=0;ks<4;++ks){
      asm volatile("ds_read_b64_tr_b16 %0,%1 offset:%c2":"=&v"(lo[ks]):"v"(vb),"i"(d0*4096+ks*1024):"memory");
      asm volatile("ds_read_b64_tr_b16 %0,%1 offset:%c2":"=&v"(hi[ks]):"v"(vb),"i"(d0*4096+ks*1024+512):"memory");}
    asm volatile("s_waitcnt lgkmcnt(0)":::"memory");SBAR();
    #define PK(k) (bf16x8){lo[k][0],lo[k][1],lo[k][2],lo[k][3],hi[k][0],hi[k][1],hi[k][2],hi[k][3]}
    o[d0]=__builtin_amdgcn_mfma_f32_32x32x16_bf16(pa0,PK(0),o[d0],0,0,0);
    o[d0]=__builtin_amdgcn_mfma_f32_32x32x16_bf16(pa1,PK(1),o[d0],0,0,0);
    o[d0]=__builtin_amdgcn_mfma_f32_32x32x16_bf16(pa2,PK(2),o[d0],0,0,0);
    o[d0]=__builtin_amdgcn_mfma_f32_32x32x16_bf16(pa3,PK(3),o[d0],0,0,0);
    #undef PK
  }
}

#ifndef ATTN_STORE16
#define ATTN_STORE16(p,v) (*(u32x4*)(p)=(v))
#endif
template<int THRL> __device__ __forceinline__ void attn_unit(int hq,int hv,int qb,const bf16*Q,const bf16*__restrict__ K,const bf16*__restrict__ V,bf16*O,char*shm,const int tid){
  const int lane=tid&63,r32=lane&31,hi=lane>>5; const int wid=__builtin_amdgcn_readfirstlane(tid>>6);
  const long rowbase=0; const int q0=qb*QB;
  const bf16*Qw=Q+(rowbase+q0+wid*QBLK)*DM+hq*D;
  const bf16*Kh=K+rowbase*DM+hq*D,*Vh=V+rowbase*DM+hv*D;
  const unsigned lds0=(unsigned)(uintptr_t)shm;
  float*wsf=(float*)(shm+LDS_WS)+wid*64;
  const bf16*ksrc=Kh+(long)lane*DM+wid*8;
  const bf16*vsrc=Vh+(long)(16*(wid&3)+(lane>>2))*DM+(wid>>2)*32+(lane&3)*8;
  const unsigned kdst=lds0+LDS_K+wid*1024, vdst=lds0+LDS_V+wid*1024;
  #define DMA_K(t,slot) glds16(ksrc+(long)(t)*KVBLK*DM,(unsigned)__builtin_amdgcn_readfirstlane(kdst+(slot)))
  #define DMA_V(t,slot) glds16(vsrc+(long)(t)*KVBLK*DM,(unsigned)__builtin_amdgcn_readfirstlane(vdst+(slot)))
  const int vb0=(int)(lds0+LDS_V)+((lane>>4)&1)*32+(lane&3)*8+(4*hi+((lane&15)>>2))*64;
  const char*Kbase=shm+LDS_K; bf16x8 kf[8];
  const lds_cptr shm3=(lds_cptr)shm; const lds_cptr kp0=shm3+LDS_K+hi*1024+r32*16; const lds_cptr vp0=shm3+LDS_V+((lane>>4)&1)*32+(lane&3)*8+(4*hi+((lane&15)>>2))*64;
  const int NT=(q0+QB)/KVBLK;
  DMA_K(0,0);DMA_V(0,0);DMA_K(1,SLOTB);
  bf16x8 qr[4];
  #pragma unroll
  for(int d0=0;d0<4;++d0)qr[d0]=*reinterpret_cast<const bf16x8*>(&Qw[(long)r32*DM+d0*16+hi*8]);
  float mhat=0.f,l_reg=0.f;f32x16 o[2];o[0]=f32x16{};o[1]=f32x16{};f32x16 negm=f32x16{};asm volatile("":"+v"(negm));
  const int qrel=wid*QBLK+r32;
  #define CMASK(P0,P1,t) do{int jb_=(t)-(NT-4); if(jb_>=0)cmask(P0,P1,jb_,qrel,hi);}while(0)
  bool resc=false;
  #define START(P0,P1) do{ const float rm=rowmax(P0,P1); resc=false; \
    { const float dl=rm; mhat=fadd_s(mhat,dl); \
      _Pragma("unroll") for(int r=0;r<16;++r){P0[r]=fsub_s(P0[r],dl);P1[r]=fsub_s(P1[r],dl);} \
      _Pragma("unroll") for(int r=0;r<16;++r)negm[r]=-mhat; asm volatile("":"+v"(negm)); } \
    _Pragma("unroll") for(int r=0;r<16;++r)P0[r]=__builtin_amdgcn_exp2f(P0[r]); }while(0)
  #define RESC() do{ if(resc){ asm volatile("s_waitcnt lgkmcnt(0)":::"memory"); \
      _Pragma("unroll") for(int d_=0;d_<2;++d_) _Pragma("unroll") for(int r=0;r<16;++r)o[d_][r]*=wsf[crow(r,hi)]; } }while(0)
  f32x16 pA0,pA1,pB0,pB1;
  int sl_prev=0,sl_cur=0,sl_next=SLOTB;
  #define ROT() do{sl_prev=sl_cur;sl_cur=sl_next;sl_next=(sl_next==(NSLOT-1)*SLOTB)?0:sl_next+SLOTB;}while(0)
  DMA_K(2,2*SLOTB);
  WAIT_BAR(3);
  qkt(pA0,pA1,Kbase,qr,negm,r32,hi);asm volatile("s_nop 15\n\ts_nop 7":"+v"(pA0),"+v"(pA1));CMASK(pA0,pA1,0);
  START(pA0,pA1);
  _Pragma("unroll") for(int r=0;r<16;++r)pA1[r]=__builtin_amdgcn_exp2f(pA1[r]);
  WAIT_BAR(0);
  DMA_K(3,0);DMA_V(1,SLOTB);
  ROT();
  kload8(kf,kp0+sl_cur);
  WAIT_BAR(2);
  s16x4 vlo[8],vhi[8]; u32x4 pw0,pw1,pw2,pw3;
  #define PKW(P,B) cvtpk_s(P[B],P[B+1])
  #define PAF(k) __builtin_bit_cast(bf16x8,pw##k)
  #define VFR(i) (bf16x8){vlo[i][0],vlo[i][1],vlo[i][2],vlo[i][3],vhi[i][0],vhi[i][1],vhi[i][2],vhi[i][3]}
  #define PIN(x) asm volatile("":"+v"(x))
  #define MX3(a,b,c) __builtin_fmaxf(__builtin_fmaxf((a),(b)),(c))
  #define GAPA(MF,A0,A1,A2,A3,W0,W1,PW) do{ MF; sacc+=A0; sacc+=A1; sacc+=A2; sacc+=A3; PIN(sacc); W0; W1; PIN(PW); SBAR(); }while(0)
  #define EX(v) __builtin_amdgcn_exp2f(v)
  #define GAPB(MF,X,B) do{ MF; X[B]=EX(X[B]); X[B+1]=EX(X[B+1]); X[B+2]=EX(X[B+2]); X[B+3]=EX(X[B+3]); PIN(X); SBAR(); }while(0)
  #define VRD(i) do{ vlo[i]=vtr(vp_+(((i)>>2)*4096+((i)&3)*1024)); vhi[i]=vtr(vp_+(((i)>>2)*4096+((i)&3)*1024+512)); }while(0)
  #define KRD(G,j) do{ if(G){ kload2(kf,kp0+sl_next,j); SBAR(); } }while(0)
  #define STEP(C0,C1,P0,P1,t,GK,GV,GL) do{ SBAR(); \
    const lds_cptr vp_=vp0+sl_prev; \
    VRD(0); SBAR(); float sacc=(P0[0]+P0[1]); \
    GAPA(C0=__builtin_amdgcn_mfma_f32_32x32x16_bf16(kf[0],qr[0],negm,0,0,0), P0[2],P0[3],P0[4],P0[5],     pw0[0]=PKW(P0,0), pw0[1]=PKW(P0,2), pw0); \
    VRD(4); SBAR(); GAPA(C1=__builtin_amdgcn_mfma_f32_32x32x16_bf16(kf[1],qr[0],negm,0,0,0), P0[6],P0[7],P0[8],P0[9],     pw0[2]=PKW(P0,4), pw0[3]=PKW(P0,6), pw0); \
    VRD(1); SBAR(); GAPA(C0=__builtin_amdgcn_mfma_f32_32x32x16_bf16(kf[2],qr[1],C0,0,0,0),   P0[10],P0[11],P0[12],P0[13], pw1[0]=PKW(P0,8), pw1[1]=PKW(P0,10), pw1); \
    VRD(5); SBAR(); GAPA(C1=__builtin_amdgcn_mfma_f32_32x32x16_bf16(kf[3],qr[1],C1,0,0,0),   P0[14],P0[15],P1[0],P1[1],   pw1[2]=PKW(P0,12),pw1[3]=PKW(P0,14), pw1); \
    VRD(2); SBAR(); GAPA(C0=__builtin_amdgcn_mfma_f32_32x32x16_bf16(kf[4],qr[2],C0,0,0,0),   P1[2],P1[3],P1[4],P1[5],     pw2[0]=PKW(P1,0), pw2[1]=PKW(P1,2), pw2); \
    VRD(6); SBAR(); GAPA(C1=__builtin_amdgcn_mfma_f32_32x32x16_bf16(kf[5],qr[2],C1,0,0,0),   P1[6],P1[7],P1[8],P1[9],     pw2[2]=PKW(P1,4), pw2[3]=PKW(P1,6), pw2); \
    VRD(3); SBAR(); GAPA(C0=__builtin_amdgcn_mfma_f32_32x32x16_bf16(kf[6],qr[3],C0,0,0,0),   P1[10],P1[11],P1[12],P1[13], pw3[0]=PKW(P1,8), pw3[1]=PKW(P1,10), pw3); \
    VRD(7); SBAR(); GAPA(C1=__builtin_amdgcn_mfma_f32_32x32x16_bf16(kf[7],qr[3],C1,0,0,0),   P1[14],P1[15],0.f,0.f,       pw3[2]=PKW(P1,12),pw3[3]=PKW(P1,14), pw3); \
    l_reg+=sacc; \
    if(GK){DMA_K((t)+3,sl_cur);} if(GV){DMA_V((t)+1,sl_next);} \
    CMASK(C0,C1,t); \
    { float a=MX3(C0[0],C0[1],C1[0]),b=MX3(C0[2],C0[3],C1[1]); a=MX3(a,C1[2],C1[3]); \
      _Pragma("unroll") for(int r=4;r<16;r+=4){a=MX3(a,C0[r],C0[r+1]);b=MX3(b,C0[r+2],C0[r+3]);a=MX3(a,C1[r],C1[r+1]);b=MX3(b,C1[r+2],C1[r+3]);} \
      float rm=__builtin_fmaxf(a,b); { auto rr=__builtin_amdgcn_permlane32_swap(__float_as_uint(rm),__float_as_uint(rm),false,false); rm=__builtin_fmaxf(__uint_as_float(rr[0]),__uint_as_float(rr[1])); } \
      resc=false; \
      if(__builtin_expect(__any(rm>(float)THRL),0)){ const float dl=__builtin_fmaxf(rm,0.f); mhat+=dl; \
        _Pragma("unroll") for(int r=0;r<16;++r){C0[r]-=dl;C1[r]-=dl;} \
        _Pragma("unroll") for(int r=0;r<16;++r)negm[r]=-mhat; asm volatile("":"+v"(negm)); \
        const float f=__builtin_amdgcn_exp2f(-dl); l_reg*=f; if(hi==0)wsf[r32]=f; resc=true; } } \
    SBAR(); \
    GAPB(o[0]=__builtin_amdgcn_mfma_f32_32x32x16_bf16(PAF(0),VFR(0),o[0],0,0,0), C0,0); \
    GAPB(o[1]=__builtin_amdgcn_mfma_f32_32x32x16_bf16(PAF(0),VFR(4),o[1],0,0,0), C0,4); \
    KRD(GL,0); GAPB(o[0]=__builtin_amdgcn_mfma_f32_32x32x16_bf16(PAF(1),VFR(1),o[0],0,0,0), C0,8); \
    KRD(GL,1); GAPB(o[1]=__builtin_amdgcn_mfma_f32_32x32x16_bf16(PAF(1),VFR(5),o[1],0,0,0), C0,12); \
    KRD(GL,2); GAPB(o[0]=__builtin_amdgcn_mfma_f32_32x32x16_bf16(PAF(2),VFR(2),o[0],0,0,0), C1,0); \
    KRD(GL,3); GAPB(o[1]=__builtin_amdgcn_mfma_f32_32x32x16_bf16(PAF(2),VFR(6),o[1],0,0,0), C1,4); \
    GAPB(o[0]=__builtin_amdgcn_mfma_f32_32x32x16_bf16(PAF(3),VFR(3),o[0],0,0,0), C1,8); \
    GAPB(o[1]=__builtin_amdgcn_mfma_f32_32x32x16_bf16(PAF(3),VFR(7),o[1],0,0,0), C1,12); \
    }while(0)
  int t=1;
  #undef CMASK
  #define CMASK(P0,P1,t) do{}while(0)
  for(;t+5<NT;t+=2){
    STEP(pB0,pB1,pA0,pA1,t,true,true,true);     WAIT_BAR(2); RESC(); ROT();
    STEP(pA0,pA1,pB0,pB1,t+1,true,true,true);   WAIT_BAR(2); RESC(); ROT();
  }
  #undef CMASK
  #define CMASK(P0,P1,t) do{int jb_=(t)-(NT-4); if(jb_>=0)cmask(P0,P1,jb_,qrel,hi);}while(0)
  #define ENDW(tt) do{ if((tt)+3<NT){WAIT_BAR(2);} else if((tt)+2<NT){WAIT_BAR(1);} else {WAIT_BAR(0);} }while(0)
  for(;t+1<NT;t+=2){
    STEP(pB0,pB1,pA0,pA1,t,(t+3<NT),(t+1<NT),(t+1<NT));       ENDW(t);   RESC(); ROT();
    STEP(pA0,pA1,pB0,pB1,t+1,(t+4<NT),(t+2<NT),(t+2<NT));     ENDW(t+1); RESC(); ROT();
  }
  STEP(pB0,pB1,pA0,pA1,NT-1,false,false,false); RESC();
  { float sacc=pB0[0]+pB0[1]; _Pragma("unroll") for(int r=2;r<16;++r)sacc+=pB0[r]; _Pragma("unroll") for(int r=0;r<16;++r)sacc+=pB1[r]; l_reg+=sacc;
    pw0=(u32x4){PKW(pB0,0),PKW(pB0,2),PKW(pB0,4),PKW(pB0,6)};pw1=(u32x4){PKW(pB0,8),PKW(pB0,10),PKW(pB0,12),PKW(pB0,14)};pw2=(u32x4){PKW(pB1,0),PKW(pB1,2),PKW(pB1,4),PKW(pB1,6)};pw3=(u32x4){PKW(pB1,8),PKW(pB1,10),PKW(pB1,12),PKW(pB1,14)};
    SBAR(); pv(o,vb0+sl_cur,PAF(0),PAF(1),PAF(2),PAF(3)); }
  #undef PKW
  #undef PAF
  #undef VFR
  #undef PIN
  #undef MX3
  #undef GAPA
  #undef GAPB
  #undef EX
  #undef VRD
  #undef KRD
  #undef STEP
  #undef ENDW
  {auto rr=__builtin_amdgcn_permlane32_swap(__float_as_uint(l_reg),__float_as_uint(l_reg),false,false);l_reg=__uint_as_float(rr[0])+__uint_as_float(rr[1]);}
  if(hi==0)wsf[32+r32]=l_reg;asm volatile("s_waitcnt lgkmcnt(0)":::"memory");
  float rli[16];
  #pragma unroll
  for(int r=0;r<16;++r)rli[r]=__builtin_amdgcn_rcpf(wsf[32+crow(r,hi)]);
  bf16*Ow=O+(rowbase+q0+wid*QBLK)*DM+hv*D;
  { bf16*stg=(bf16*)(shm+LDS_OST)+wid*2048;
    #pragma unroll
    for(int r=0;r<16;++r){const int orow=crow(r,hi);
      #pragma unroll
      for(int d0=0;d0<2;++d0)stg[orow*64+d0*32+r32]=__float2bfloat16(o[d0][r]*rli[r]);}
    asm volatile("s_waitcnt lgkmcnt(0)":::"memory");
    #pragma unroll
    for(int i=0;i<4;++i){const int row=i*8+(lane>>3),ch=lane&7; const u32x4 v=*(const u32x4*)(stg+row*64+ch*8); ATTN_STORE16(Ow+(long)row*DM+ch*8,v);} }
  asm volatile("s_waitcnt lgkmcnt(0)\n\ts_barrier":::"memory");
  #undef DMA_K
  #undef DMA_V
  #undef CMASK
  #undef START
  #undef RESC
  #undef ROT
}

constexpr int ATTN_LDS_BYTES=LDS_BYTES;
#undef SBAR
#undef WAIT_BAR
}
namespace attn_body {
#if NAIVE_ATTN
__device__ __forceinline__ void attn_unit_naive(int hq,int hv,int qb,const bf16_t*Q,const bf16_t*K,const bf16_t*V,bf16_t*O,const int tid_){
  const int lane=tid_&63, wid=tid_>>6;
#pragma unroll 1
  for(int r=0;r<32;++r){ const int row=qb*256+wid*32+r;
    float q[64];
#pragma unroll
    for(int c=0;c<8;++c){ const ::u32x4 w=*(const ::u32x4*)(Q+(size_t)row*1024+hq*64+c*8); q[c*8+0]=bflo(w.x);q[c*8+1]=bfhi(w.x);q[c*8+2]=bflo(w.y);q[c*8+3]=bfhi(w.y);q[c*8+4]=bflo(w.z);q[c*8+5]=bfhi(w.z);q[c*8+6]=bflo(w.w);q[c*8+7]=bfhi(w.w); }
    float m=-INFINITY,l=0.f,o=0.f;
#pragma unroll 1
    for(int j0=0;j0<=row;j0+=64){ const int j=j0+lane; float s=-INFINITY;
      if(j<=row){ float a=0.f;
#pragma unroll
        for(int c=0;c<8;++c){ const ::u32x4 w=*(const ::u32x4*)(K+(size_t)j*1024+hq*64+c*8); a+=q[c*8+0]*bflo(w.x)+q[c*8+1]*bfhi(w.x)+q[c*8+2]*bflo(w.y)+q[c*8+3]*bfhi(w.y)+q[c*8+4]*bflo(w.z)+q[c*8+5]*bfhi(w.z)+q[c*8+6]*bflo(w.w)+q[c*8+7]*bfhi(w.w); }
        s=a; }
      const float mb=wave_max(s);
      const float mn=fmaxf(m,mb), alpha=exp2f(m-mn); const float p=(j<=row)?exp2f(s-mn):0.f;
      l=l*alpha+wave_sum(p); o*=alpha;
      const int nj=(row-j0+1)<64?(row-j0+1):64;
#pragma unroll 1
      for(int jj=0;jj<nj;++jj){ const float pj=__builtin_bit_cast(float,__builtin_amdgcn_readlane(__builtin_bit_cast(int,p),jj)); o+=pj*bf2f(V[(size_t)(j0+jj)*1024+hv*64+lane]); }
      m=mn; }
    O[(size_t)row*1024+hv*64+lane]=(bf16_t)f2bf(o/l);
  }
}
#endif
__device__ __forceinline__ void attn_phase(char* lds, const bf16_t* Q, const bf16_t* K, const bf16_t* V, bf16_t* O1, bf16_t* O2, int vcu, int G, const int tid) {
  const int nu = (G == 256) ? 4 : (1024 - vcu + G - 1) / G;
#pragma unroll 1
  for (int i = 0; i < nu; ++i) {
    int bh, qb;
    if (G == 256) { const int s = vcu & 7; bh = vcu >> 3; qb = (i == 0) ? s : (i == 1) ? 15 - s : (i == 2) ? 16 + s : 31 - s; }
    else { const int L = vcu + i * G; bh = L >> 5; qb = L & 31; }
    const int h = bh >> 2, c = (bh >> 1) & 1, vh = bh & 1;
    int tid_u = tid; asm volatile("" : "+v"(tid_u));
#if NAIVE_ATTN
    attn_unit_naive(h * 2 + c, h * 2 + vh, qb, Q, K, V, c ? O2 : O1, tid_u);
#else
    attn_unit<8>(h * 2 + c, h * 2 + vh, qb, (const bf16*)Q, (const bf16*)K, (const bf16*)V, (bf16*)(c ? O2 : O1), lds, tid_u);
#endif
  }
}
}
namespace attn128 {
using bf16=__hip_bfloat16;
using bf16x8=__attribute__((ext_vector_type(8)))short;
using s16x4=__attribute__((ext_vector_type(4)))short;
using f32x16=__attribute__((ext_vector_type(16)))float;
using u32x4=__attribute__((ext_vector_type(4)))unsigned;
constexpr int BATCH=1,NHEAD=16,SEQ=8192,D=64,DM=NHEAD*D;
constexpr int NW=8,QBLK=32,QB=QBLK*NW,KVBLK=64,NQB=SEQ/QB;
constexpr int ATTN_PITCH=DM, ATTN_UNIT_ROWS=QB;
__device__ __forceinline__ int crow(int r,int hi){return (r&3)+8*(r>>2)+4*hi;}
#define SBAR() __builtin_amdgcn_sched_barrier(0)
__device__ __forceinline__ void cmask(f32x16&p0,f32x16&p1,int jb,int qrel,int hi){
  const float NEG=-INFINITY; int kb=64*jb+4*hi;
  #pragma unroll
  for(int r=0;r<16;++r){int kv=kb+(r&3)+8*(r>>2); if(kv>qrel)p0[r]=NEG; if(kv+32>qrel)p1[r]=NEG;}
}

constexpr int NSLOT=3, SLOTB=8192;
constexpr int VSLOTB=2*SLOTB;
constexpr int LDS_K=0, LDS_V=NSLOT*SLOTB, LDS_WS=LDS_V+NSLOT*VSLOTB, LDS_OST=LDS_WS+NW*64*4, LDS_BYTES=LDS_OST+NW*4096;
constexpr float C2=0.125f*1.4426950408889634f;
__device__ __forceinline__ void glds16(const void*gsrc,unsigned lds_dst){unsigned keep;
  asm volatile("s_mov_b32 %0, m0\n\ts_mov_b32 m0, %2\n\ts_nop 0\n\tglobal_load_lds_dwordx4 %1, off\n\ts_mov_b32 m0, %0":"=&s"(keep):"v"(gsrc),"s"(lds_dst):"memory");}
__device__ __forceinline__ float max3f(float a,float b,float c){float r;asm("v_max3_f32 %0, %1, %2, %3":"=v"(r):"v"(a),"v"(b),"v"(c));return r;}
__device__ __forceinline__ float max2f(float a,float b){float r;asm("v_max_f32_e32 %0, %1, %2":"=v"(r):"v"(a),"v"(b));return r;}
__device__ __forceinline__ float fadd_s(float a,float b){float r;asm("v_add_f32_e32 %0, %1, %2":"=v"(r):"v"(a),"v"(b));return r;}
__device__ __forceinline__ float fsub_s(float a,float b){float r;asm("v_sub_f32_e32 %0, %1, %2":"=v"(r):"v"(a),"v"(b));return r;}
typedef float f32x2_t __attribute__((ext_vector_type(2))); typedef __bf16 bf16x2_t __attribute__((ext_vector_type(2)));
__device__ __forceinline__ unsigned cvtpk_s(float lo,float hi){f32x2_t v={lo,hi};bf16x2_t b=__builtin_convertvector(v,bf16x2_t);return __builtin_bit_cast(unsigned,b);}
#define WAIT_BAR(N) asm volatile("s_waitcnt vmcnt(" #N ") lgkmcnt(0)\n\ts_barrier":::"memory")

__device__ __forceinline__ void qkt(f32x16&p0,f32x16&p1,const char*Kslot,const bf16x8*qr,const f32x16&negm,int r32,int hi){
  const char*kb=Kslot+hi*1024+r32*16;
  #pragma unroll
  for(int d0=0;d0<4;++d0){
    const bf16x8 b0=*reinterpret_cast<const bf16x8*>(kb+d0*2048);
    const bf16x8 b1=*reinterpret_cast<const bf16x8*>(kb+d0*2048+512);
    if(d0==0){p0=__builtin_amdgcn_mfma_f32_32x32x16_bf16(b0,qr[0],negm,0,0,0);p1=__builtin_amdgcn_mfma_f32_32x32x16_bf16(b1,qr[0],negm,0,0,0);}
    else{p0=__builtin_amdgcn_mfma_f32_32x32x16_bf16(b0,qr[d0],p0,0,0,0);p1=__builtin_amdgcn_mfma_f32_32x32x16_bf16(b1,qr[d0],p1,0,0,0);}}
}
typedef __attribute__((address_space(3))) const char* lds_cptr;
typedef short v4i16_t __attribute__((ext_vector_type(4)));
__device__ __forceinline__ void kload8(bf16x8*kf,lds_cptr kp){
  kf[0]=*(const __attribute__((address_space(3))) bf16x8*)(kp);      kf[1]=*(const __attribute__((address_space(3))) bf16x8*)(kp+512);
  kf[2]=*(const __attribute__((address_space(3))) bf16x8*)(kp+2048); kf[3]=*(const __attribute__((address_space(3))) bf16x8*)(kp+2560);
  kf[4]=*(const __attribute__((address_space(3))) bf16x8*)(kp+4096); kf[5]=*(const __attribute__((address_space(3))) bf16x8*)(kp+4608);
  kf[6]=*(const __attribute__((address_space(3))) bf16x8*)(kp+6144); kf[7]=*(const __attribute__((address_space(3))) bf16x8*)(kp+6656);
}
__device__ __forceinline__ void kload2(bf16x8*kf,lds_cptr kp,int j){ kf[2*j]=*(const __attribute__((address_space(3))) bf16x8*)(kp+j*2048); kf[2*j+1]=*(const __attribute__((address_space(3))) bf16x8*)(kp+j*2048+512); }
__device__ __forceinline__ s16x4 vtr(lds_cptr p){ return __builtin_bit_cast(s16x4,__builtin_amdgcn_ds_read_tr16_b64_v4i16((__attribute__((address_space(3))) v4i16_t*)p)); }
__device__ __forceinline__ float rowmax(const f32x16&p0,const f32x16&p1){
  float a=max3f(p0[0],p0[1],p1[0]),b=max3f(p0[2],p0[3],p1[1]);a=max3f(a,p1[2],p1[3]);
  #pragma unroll
  for(int r=4;r<16;r+=4){a=max3f(a,p0[r],p0[r+1]);b=max3f(b,p0[r+2],p0[r+3]);a=max3f(a,p1[r],p1[r+1]);b=max3f(b,p1[r+2],p1[r+3]);}
  const float m=max2f(a,b);
  auto rr=__builtin_amdgcn_permlane32_swap(__float_as_uint(m),__float_as_uint(m),false,false);
  return max2f(__uint_as_float(rr[0]),__uint_as_float(rr[1]));
}
__device__ __forceinline__ void pv(f32x16*o,int vb,bf16x8 pa0,bf16x8 pa1,bf16x8 pa2,bf16x8 pa3){
  #pragma unroll
  for(int d0=0;d0<4;++d0){s16x4 lo[4],hi[4];
    #pragma unroll
    for(int ks=0;ks<4;++ks){
      asm volatile("ds_read_b64_tr_b16 %0,%1 offset:%c2":"=&v"(lo[ks]):"v"(vb),"i"(d0*4096+ks*1024):"memory");
      asm volatile("ds_read_b64_tr_b16 %0,%1 offset:%c2":"=&v"(hi[ks]):"v"(vb),"i"(d0*4096+ks*1024+512):"memory");}
    asm volatile("s_waitcnt lgkmcnt(0)":::"memory");SBAR();
    #define PK(k) (bf16x8){lo[k][0],lo[k][1],lo[k][2],lo[k][3],hi[k][0],hi[k][1],hi[k][2],hi[k][3]}
    o[d0]=__builtin_amdgcn_mfma_f32_32x32x16_bf16(pa0,PK(0),o[d0],0,0,0);
    o[d0]=__builtin_amdgcn_mfma_f32_32x32x16_bf16(pa1,PK(1),o[d0],0,0,0);
    o[d0]=__builtin_amdgcn_mfma_f32_32x32x16_bf16(pa2,PK(2),o[d0],0,0,0);
    o[d0]=__builtin_amdgcn_mfma_f32_32x32x16_bf16(pa3,PK(3),o[d0],0,0,0);
    #undef PK
  }
}

#ifndef ATTN_STORE16
#define ATTN_STORE16(p,v) (*(u32x4*)(p)=(v))
#endif
template<int THRL> __device__ __forceinline__ void attn_unit(int hq,int hv,int qb,const bf16*Q,const bf16*__restrict__ K,const bf16*__restrict__ V,bf16*O,char*shm,const int tid){
  const int lane=tid&63,r32=lane&31,hi=lane>>5; const int wid=__builtin_amdgcn_readfirstlane(tid>>6);
  const long rowbase=0; const int q0=qb*QB;
  const bf16*Qw=Q+(rowbase+q0+wid*QBLK)*DM+hq*D;
  const bf16*Kh=K+rowbase*DM+hq*D,*Vh=V+rowbase*DM+hv*128;
  const unsigned lds0=(unsigned)(uintptr_t)shm;
  float*wsf=(float*)(shm+LDS_WS)+wid*64;
  const bf16*ksrc=Kh+(long)lane*DM+wid*8;
  const bf16*vsrc=Vh+(long)(16*(wid&3)+(lane>>2))*DM+(wid>>2)*32+(lane&3)*8;
  const unsigned kdst=lds0+LDS_K+wid*1024, vdst=lds0+LDS_V+wid*1024;
  #define DMA_K(t,slot) glds16(ksrc+(long)(t)*KVBLK*DM,(unsigned)__builtin_amdgcn_readfirstlane(kdst+(slot)))
  #define DMA_V(t,slot) do{ glds16(vsrc+(long)(t)*KVBLK*DM,(unsigned)__builtin_amdgcn_readfirstlane(vdst+2*(slot))); glds16(vsrc+(long)(t)*KVBLK*DM+64,(unsigned)__builtin_amdgcn_readfirstlane(vdst+2*(slot)+8192)); }while(0)
  const int vb0=(int)(lds0+LDS_V)+((lane>>4)&1)*32+(lane&3)*8+(4*hi+((lane&15)>>2))*64;
  const char*Kbase=shm+LDS_K; bf16x8 kf[8];
  const lds_cptr shm3=(lds_cptr)shm; const lds_cptr kp0=shm3+LDS_K+hi*1024+r32*16; const lds_cptr vp0=shm3+LDS_V+((lane>>4)&1)*32+(lane&3)*8+(4*hi+((lane&15)>>2))*64;
  const int NT=(q0+QB)/KVBLK;
  DMA_K(0,0);DMA_V(0,0);DMA_K(1,SLOTB);
  bf16x8 qr[4];
  #pragma unroll
  for(int d0=0;d0<4;++d0)qr[d0]=*reinterpret_cast<const bf16x8*>(&Qw[(long)r32*DM+d0*16+hi*8]);
  float mhat=0.f,l_reg=0.f;f32x16 o[4];o[0]=f32x16{};o[1]=f32x16{};o[2]=f32x16{};o[3]=f32x16{};
  const int qrel=wid*QBLK+r32;
  #define CMASK(P0,P1,t) do{int jb_=(t)-(NT-4); if(jb_>=0)cmask(P0,P1,jb_,qrel,hi);}while(0)
  bool resc=false;
  #define START(P0,P1) do{ const float rm=rowmax(P0,P1); resc=false; \
    { const float dl=rm; mhat=fadd_s(mhat,dl); \
      _Pragma("unroll") for(int r=0;r<16;++r){P0[r]=fsub_s(P0[r],dl);P1[r]=fsub_s(P1[r],dl);} \
      } \
    _Pragma("unroll") for(int r=0;r<16;++r)P0[r]=__builtin_amdgcn_exp2f(P0[r]); }while(0)
  #define RESC() do{ if(resc){ asm volatile("s_waitcnt lgkmcnt(0)":::"memory"); \
      _Pragma("unroll") for(int d_=0;d_<4;++d_) _Pragma("unroll") for(int r=0;r<16;++r)o[d_][r]*=wsf[crow(r,hi)]; } }while(0)
  f32x16 pA0,pA1,pB0,pB1;
  int sl_prev=0,sl_cur=0,sl_next=SLOTB;
  #define ROT() do{sl_prev=sl_cur;sl_cur=sl_next;sl_next=(sl_next==(NSLOT-1)*SLOTB)?0:sl_next+SLOTB;}while(0)
  DMA_K(2,2*SLOTB);
  WAIT_BAR(4);
  { const f32x16 zero16=f32x16{}; qkt(pA0,pA1,Kbase,qr,zero16,r32,hi); }asm volatile("s_nop 15\n\ts_nop 7":"+v"(pA0),"+v"(pA1));CMASK(pA0,pA1,0);
  START(pA0,pA1);
  _Pragma("unroll") for(int r=0;r<16;++r)pA1[r]=__builtin_amdgcn_exp2f(pA1[r]);
  WAIT_BAR(0);
  DMA_K(3,0);DMA_V(1,SLOTB);
  ROT();
  kload8(kf,kp0+sl_cur);
  WAIT_BAR(3);
  s16x4 vlo[8],vhi[8]; u32x4 pw0,pw1,pw2,pw3;
  #define PKW(P,B) cvtpk_s(P[B],P[B+1])
  #define PAF(k) __builtin_bit_cast(bf16x8,pw##k)
  #define VFR(i) (bf16x8){vlo[i][0],vlo[i][1],vlo[i][2],vlo[i][3],vhi[i][0],vhi[i][1],vhi[i][2],vhi[i][3]}
  #define PIN(x) asm volatile("":"+v"(x))
  #define MX3(a,b,c) __builtin_fmaxf(__builtin_fmaxf((a),(b)),(c))
  #define GAPA(MF,A0,A1,A2,A3,W0,W1,PW) do{ MF; sacc+=A0; sacc+=A1; sacc+=A2; sacc+=A3; PIN(sacc); W0; W1; PIN(PW); SBAR(); }while(0)
  #define EX(v) __builtin_amdgcn_exp2f(v)
  #define GAPB(MF,X,B) do{ MF; X[B]=EX(X[B]); X[B+1]=EX(X[B+1]); X[B+2]=EX(X[B+2]); X[B+3]=EX(X[B+3]); PIN(X); SBAR(); }while(0)
  #define GAPB2(MF,RD,X,B) do{ MF; RD; X[B]=EX(X[B]); X[B+1]=EX(X[B+1]); PIN(X); SBAR(); }while(0)
  #define VRD2(i) do{ vlo[i]=vtr(vp_+((((i)>>2)+2)*4096+((i)&3)*1024)); vhi[i]=vtr(vp_+((((i)>>2)+2)*4096+((i)&3)*1024+512)); }while(0)
  #define VRD(i) do{ vlo[i]=vtr(vp_+(((i)>>2)*4096+((i)&3)*1024)); vhi[i]=vtr(vp_+(((i)>>2)*4096+((i)&3)*1024+512)); }while(0)
  #define KRD(G,j) do{ if(G){ kload2(kf,kp0+sl_next,j); SBAR(); } }while(0)
  #define STEP(C0,C1,P0,P1,t,GK,GV,GL) do{ SBAR(); \
    const lds_cptr vp_=vp0+2*sl_prev; \
    { const float nm_=-mhat; _Pragma("unroll") for(int r=0;r<16;++r){C0[r]=nm_;C1[r]=nm_;} }     \
    VRD(0); SBAR(); float sacc=(P0[0]+P0[1]); \
    GAPA(C0=__builtin_amdgcn_mfma_f32_32x32x16_bf16(kf[0],qr[0],C0,0,0,0), P0[2],P0[3],P0[4],P0[5],     pw0[0]=PKW(P0,0), pw0[1]=PKW(P0,2), pw0); \
    VRD(4); SBAR(); GAPA(C1=__builtin_amdgcn_mfma_f32_32x32x16_bf16(kf[1],qr[0],C1,0,0,0), P0[6],P0[7],P0[8],P0[9],     pw0[2]=PKW(P0,4), pw0[3]=PKW(P0,6), pw0); \
    VRD(1); SBAR(); GAPA(C0=__builtin_amdgcn_mfma_f32_32x32x16_bf16(kf[2],qr[1],C0,0,0,0),   P0[10],P0[11],P0[12],P0[13], pw1[0]=PKW(P0,8), pw1[1]=PKW(P0,10), pw1); \
    VRD(5); SBAR(); GAPA(C1=__builtin_amdgcn_mfma_f32_32x32x16_bf16(kf[3],qr[1],C1,0,0,0),   P0[14],P0[15],P1[0],P1[1],   pw1[2]=PKW(P0,12),pw1[3]=PKW(P0,14), pw1); \
    VRD(2); SBAR(); GAPA(C0=__builtin_amdgcn_mfma_f32_32x32x16_bf16(kf[4],qr[2],C0,0,0,0),   P1[2],P1[3],P1[4],P1[5],     pw2[0]=PKW(P1,0), pw2[1]=PKW(P1,2), pw2); \
    VRD(6); SBAR(); GAPA(C1=__builtin_amdgcn_mfma_f32_32x32x16_bf16(kf[5],qr[2],C1,0,0,0),   P1[6],P1[7],P1[8],P1[9],     pw2[2]=PKW(P1,4), pw2[3]=PKW(P1,6), pw2); \
    VRD(3); SBAR(); GAPA(C0=__builtin_amdgcn_mfma_f32_32x32x16_bf16(kf[6],qr[3],C0,0,0,0),   P1[10],P1[11],P1[12],P1[13], pw3[0]=PKW(P1,8), pw3[1]=PKW(P1,10), pw3); \
    VRD(7); SBAR(); GAPA(C1=__builtin_amdgcn_mfma_f32_32x32x16_bf16(kf[7],qr[3],C1,0,0,0),   P1[14],P1[15],0.f,0.f,       pw3[2]=PKW(P1,12),pw3[3]=PKW(P1,14), pw3); \
    l_reg+=sacc; \
    if(GK){DMA_K((t)+3,sl_cur);} if(GV){DMA_V((t)+1,sl_next);} \
    CMASK(C0,C1,t); \
    { float a=MX3(C0[0],C0[1],C1[0]),b=MX3(C0[2],C0[3],C1[1]); a=MX3(a,C1[2],C1[3]); \
      _Pragma("unroll") for(int r=4;r<16;r+=4){a=MX3(a,C0[r],C0[r+1]);b=MX3(b,C0[r+2],C0[r+3]);a=MX3(a,C1[r],C1[r+1]);b=MX3(b,C1[r+2],C1[r+3]);} \
      float rm=__builtin_fmaxf(a,b); { auto rr=__builtin_amdgcn_permlane32_swap(__float_as_uint(rm),__float_as_uint(rm),false,false); rm=__builtin_fmaxf(__uint_as_float(rr[0]),__uint_as_float(rr[1])); } \
      resc=false; \
      if(__builtin_expect(__any(rm>(float)THRL),0)){ const float dl=__builtin_fmaxf(rm,0.f); mhat+=dl; \
        _Pragma("unroll") for(int r=0;r<16;++r){C0[r]-=dl;C1[r]-=dl;} \
        const float f=__builtin_amdgcn_exp2f(-dl); l_reg*=f; if(hi==0)wsf[r32]=f; resc=true; } } \
    SBAR(); \
    GAPB2(o[0]=__builtin_amdgcn_mfma_f32_32x32x16_bf16(PAF(0),VFR(0),o[0],0,0,0), VRD2(0), C0,0); \
    GAPB2(o[1]=__builtin_amdgcn_mfma_f32_32x32x16_bf16(PAF(0),VFR(4),o[1],0,0,0), VRD2(4), C0,2); \
    GAPB2(o[0]=__builtin_amdgcn_mfma_f32_32x32x16_bf16(PAF(1),VFR(1),o[0],0,0,0), VRD2(1), C0,4); \
    GAPB2(o[1]=__builtin_amdgcn_mfma_f32_32x32x16_bf16(PAF(1),VFR(5),o[1],0,0,0), VRD2(5), C0,6); \
    GAPB2(o[0]=__builtin_amdgcn_mfma_f32_32x32x16_bf16(PAF(2),VFR(2),o[0],0,0,0), VRD2(2), C0,8); \
    GAPB2(o[1]=__builtin_amdgcn_mfma_f32_32x32x16_bf16(PAF(2),VFR(6),o[1],0,0,0), VRD2(6), C0,10); \
    GAPB2(o[0]=__builtin_amdgcn_mfma_f32_32x32x16_bf16(PAF(3),VFR(3),o[0],0,0,0), VRD2(3), C0,12); \
    GAPB2(o[1]=__builtin_amdgcn_mfma_f32_32x32x16_bf16(PAF(3),VFR(7),o[1],0,0,0), VRD2(7), C0,14); \
    KRD(GL,0); GAPB2(o[2]=__builtin_amdgcn_mfma_f32_32x32x16_bf16(PAF(0),VFR(0),o[2],0,0,0), (void)0, C1,0); \
    KRD(GL,1); GAPB2(o[3]=__builtin_amdgcn_mfma_f32_32x32x16_bf16(PAF(0),VFR(4),o[3],0,0,0), (void)0, C1,2); \
    KRD(GL,2); GAPB2(o[2]=__builtin_amdgcn_mfma_f32_32x32x16_bf16(PAF(1),VFR(1),o[2],0,0,0), (void)0, C1,4); \
    KRD(GL,3); GAPB2(o[3]=__builtin_amdgcn_mfma_f32_32x32x16_bf16(PAF(1),VFR(5),o[3],0,0,0), (void)0, C1,6); \
    GAPB2(o[2]=__builtin_amdgcn_mfma_f32_32x32x16_bf16(PAF(2),VFR(2),o[2],0,0,0), (void)0, C1,8); \
    GAPB2(o[3]=__builtin_amdgcn_mfma_f32_32x32x16_bf16(PAF(2),VFR(6),o[3],0,0,0), (void)0, C1,10); \
    GAPB2(o[2]=__builtin_amdgcn_mfma_f32_32x32x16_bf16(PAF(3),VFR(3),o[2],0,0,0), (void)0, C1,12); \
    GAPB2(o[3]=__builtin_amdgcn_mfma_f32_32x32x16_bf16(PAF(3),VFR(7),o[3],0,0,0), (void)0, C1,14); \
    }while(0)
  int t=1;
  #undef CMASK
  #define CMASK(P0,P1,t) do{}while(0)
  for(;t+5<NT;t+=2){
    STEP(pB0,pB1,pA0,pA1,t,true,true,true);     WAIT_BAR(3); RESC(); ROT();
    STEP(pA0,pA1,pB0,pB1,t+1,true,true,true);   WAIT_BAR(3); RESC(); ROT();
  }
  #undef CMASK
  #define CMASK(P0,P1,t) do{int jb_=(t)-(NT-4); if(jb_>=0)cmask(P0,P1,jb_,qrel,hi);}while(0)
  #define ENDW(tt) do{ if((tt)+3<NT){WAIT_BAR(3);} else if((tt)+2<NT){WAIT_BAR(2);} else {WAIT_BAR(0);} }while(0)
  for(;t+1<NT;t+=2){
    STEP(pB0,pB1,pA0,pA1,t,(t+3<NT),(t+1<NT),(t+1<NT));       ENDW(t);   RESC(); ROT();
    STEP(pA0,pA1,pB0,pB1,t+1,(t+4<NT),(t+2<NT),(t+2<NT));     ENDW(t+1); RESC(); ROT();
  }
  STEP(pB0,pB1,pA0,pA1,NT-1,false,false,false); RESC();
  { float sacc=pB0[0]+pB0[1]; _Pragma("unroll") for(int r=2;r<16;++r)sacc+=pB0[r]; _Pragma("unroll") for(int r=0;r<16;++r)sacc+=pB1[r]; l_reg+=sacc;
    pw0=(u32x4){PKW(pB0,0),PKW(pB0,2),PKW(pB0,4),PKW(pB0,6)};pw1=(u32x4){PKW(pB0,8),PKW(pB0,10),PKW(pB0,12),PKW(pB0,14)};pw2=(u32x4){PKW(pB1,0),PKW(pB1,2),PKW(pB1,4),PKW(pB1,6)};pw3=(u32x4){PKW(pB1,8),PKW(pB1,10),PKW(pB1,12),PKW(pB1,14)};
    SBAR(); pv(o,vb0+2*sl_cur,PAF(0),PAF(1),PAF(2),PAF(3)); }
  #undef PKW
  #undef PAF
  #undef VFR
  #undef PIN
  #undef MX3
  #undef GAPA
  #undef GAPB
  #undef GAPB2
  #undef VRD2
  #undef EX
  #undef VRD
  #undef KRD
  #undef STEP
  #undef ENDW
  {auto rr=__builtin_amdgcn_permlane32_swap(__float_as_uint(l_reg),__float_as_uint(l_reg),false,false);l_reg=__uint_as_float(rr[0])+__uint_as_float(rr[1]);}
  if(hi==0)wsf[32+r32]=l_reg;asm volatile("s_waitcnt lgkmcnt(0)":::"memory");
  float rli[16];
  #pragma unroll
  for(int r=0;r<16;++r)rli[r]=__builtin_amdgcn_rcpf(wsf[32+crow(r,hi)]);
  bf16*Ow=O+(rowbase+q0+wid*QBLK)*DM+hv*128;
  { bf16*stg=(bf16*)(shm+LDS_OST)+wid*2048;
    #pragma unroll
    for(int p=0;p<2;++p){
      #pragma unroll
      for(int r=0;r<16;++r){const int orow=crow(r,hi);
        #pragma unroll
        for(int d0=0;d0<2;++d0)stg[orow*64+d0*32+r32]=__float2bfloat16(o[2*p+d0][r]*rli[r]);}
      asm volatile("s_waitcnt lgkmcnt(0)":::"memory");
      #pragma unroll
      for(int i=0;i<4;++i){const int row=i*8+(lane>>3),ch=lane&7; const u32x4 v=*(const u32x4*)(stg+row*64+ch*8); ATTN_STORE16(Ow+(long)row*DM+p*64+ch*8,v);}
      asm volatile("s_waitcnt lgkmcnt(0)":::"memory"); } }
  asm volatile("s_waitcnt lgkmcnt(0)\n\ts_barrier":::"memory");
  #undef DMA_K
  #undef DMA_V
  #undef CMASK
  #undef START
  #undef RESC
  #undef ROT
}

constexpr int ATTN_LDS_BYTES=LDS_BYTES;
#undef SBAR
#undef WAIT_BAR
}

#ifndef ATTN128
#define ATTN128 1
#endif
namespace attn128 {
__device__ __forceinline__ void attn_phase(char* lds, const bf16_t* Q, const bf16_t* K, const bf16_t* V, bf16_t* O1, bf16_t* O2, int vcu, int G, const int tid) {
  const int nu = (G == 256) ? 2 : (512 - vcu + G - 1) / G;
#pragma unroll 1
  for (int i = 0; i < nu; ++i) {
    int hc, qb;
    if (G == 256) { const int s = vcu & 15; hc = vcu >> 4; qb = (i == 0) ? s : 31 - s; }
    else { const int L = vcu + i * G; hc = L >> 5; qb = L & 31; }
    int tid_u = tid; asm volatile("" : "+v"(tid_u));
    attn_unit<8>(hc, hc >> 1, qb, (const bf16*)Q, (const bf16*)K, (const bf16*)V, (bf16*)((hc & 1) ? O2 : O1), lds, tid_u);
  }
}
}
struct Ctx { unsigned char* ws; LAS unsigned char* lds; gu32* ctl; int tid, lane, wave, vcu, G, gw, NGW; };
__device__ __forceinline__ unsigned char* lwp(const Ctx& F, int l, size_t off) { return F.ws + WS_LW + (size_t)l * LW_SIZE + off; }

__device__ __forceinline__ int rowmap(int kind, int n, int H) {
    if (kind == 1) { const int d = n & 63; return (n & ~63) | (d < 32 ? 2 * d : 2 * (d - 32) + 1); }
    if (kind == 2) return n < H ? 2 * n : 2 * (n - H) + 1;
    if (kind == 3) return 2 * n;
    if (kind == 4) return 2 * n + 1;
    return n;
}
__device__ __forceinline__ void xpose_item(const float* W, int N, bf16_t* WT, int dpitch, int koff, int kind, int nbase, int H, int rbase, int k0, int n0, int lane, const float* gk = nullptr) {
    const int q = lane >> 4, c = lane & 15;
    const float* src = W + (size_t)(k0 + 16 * q) * N + n0 + 4 * c;
    f32x4 v[16];
#pragma unroll
    for (int i = 0; i < 16; ++i) v[i] = __builtin_nontemporal_load((const f32x4*)(src + (size_t)i * N));
    if (gk) { const f32x4* g4 = (const f32x4*)(gk + k0 + 16 * q); const f32x4 ga = g4[0], gb = g4[1], gc = g4[2], gd = g4[3];
#pragma unroll
        for (int i = 0; i < 4; ++i) { v[i] = v[i] * ga[i]; v[4 + i] = v[4 + i] * gb[i]; v[8 + i] = v[8 + i] * gc[i]; v[12 + i] = v[12 + i] * gd[i]; } }
#pragma unroll
    for (int j = 0; j < 4; ++j) { const int drow = rbase + rowmap(kind, n0 + 4 * c + j - nbase, H);
        u32x4 o0, o1; o0.x = pk2(v[0][j], v[1][j]); o0.y = pk2(v[2][j], v[3][j]); o0.z = pk2(v[4][j], v[5][j]); o0.w = pk2(v[6][j], v[7][j]);
        o1.x = pk2(v[8][j], v[9][j]); o1.y = pk2(v[10][j], v[11][j]); o1.z = pk2(v[12][j], v[13][j]); o1.w = pk2(v[14][j], v[15][j]);
        u32x4* dp = (u32x4*)(WT + (size_t)drow * dpitch + koff + k0 + 16 * q); dp[0] = o0; dp[1] = o1; }
}
__device__ __forceinline__ void xpose_item8(const float* W, int N, unsigned char* WT, int dpitch, int kind, int nbase, int k0, int n0, int lane, float scale, int H = 0, int rbase = 0, const float* gk = nullptr) {
    const int q = lane >> 4, c = lane & 15;
    const float* src = W + (size_t)(k0 + 16 * q) * N + n0 + 4 * c;
    f32x4 v[16];
#pragma unroll
    for (int i = 0; i < 16; ++i) v[i] = __builtin_nontemporal_load((const f32x4*)(src + (size_t)i * N)) * scale;
    if (gk) { const f32x4* g4 = (const f32x4*)(gk + k0 + 16 * q); const f32x4 ga = g4[0], gb = g4[1], gc = g4[2], gd = g4[3];
#pragma unroll
        for (int i = 0; i < 4; ++i) { v[i] = v[i] * ga[i]; v[4 + i] = v[4 + i] * gb[i]; v[8 + i] = v[8 + i] * gc[i]; v[12 + i] = v[12 + i] * gd[i]; } }
#pragma unroll
    for (int j = 0; j < 4; ++j) { const int drow = rbase + rowmap(kind, n0 + 4 * c + j - nbase, H); int w[4];
#pragma unroll
        for (int t = 0; t < 4; ++t) { int p8 = __builtin_amdgcn_cvt_pk_fp8_f32(v[4 * t][j], v[4 * t + 1][j], 0, false); w[t] = __builtin_amdgcn_cvt_pk_fp8_f32(v[4 * t + 2][j], v[4 * t + 3][j], p8, true); }
        *(u32x4*)(WT + (size_t)drow * dpitch + k0 + 16 * q) = (u32x4){(unsigned)w[0], (unsigned)w[1], (unsigned)w[2], (unsigned)w[3]}; }
}
#define XP_MAT(W_, K_, N_, WT_, DP_, KOFF_, KIND_, NBASE_, H_, RBASE_, NLO_, NHI_) { const int nb_ = ((NHI_) - (NLO_)) / 64, items_ = ((K_) / 64) * nb_; \
    if (r < items_) { xpose_item((W_), (N_), (bf16_t*)(WT_), (DP_), (KOFF_), (KIND_), (NBASE_), (H_), (RBASE_), 64 * (r / nb_), (NLO_) + 64 * (r % nb_), F.lane); continue; } r -= items_; }

#define XP_MATG(W_, K_, N_, WT_, DP_, KOFF_, KIND_, NBASE_, H_, RBASE_, NLO_, NHI_, GK_) { const int nb_ = ((NHI_) - (NLO_)) / 64, items_ = ((K_) / 64) * nb_; \
    if (r < items_) { xpose_item((W_), (N_), (bf16_t*)(WT_), (DP_), (KOFF_), (KIND_), (NBASE_), (H_), (RBASE_), 64 * (r / nb_), (NLO_) + 64 * (r % nb_), F.lane, (GK_)); continue; } r -= items_; }

__device__ __forceinline__ void sincos_d(double a, float& s, float& c) {
    const double k = rint(a * 0.15915494309189535); const double rr = a - k * 6.283185307179586476925; const float rf = (float)rr; s = sinf(rf); c = cosf(rf);
}

struct Inputs { const LAS unsigned* tab;
    __device__ __forceinline__ const float* ptr(int i) const { const unsigned lo = __builtin_amdgcn_readfirstlane(tab[2 * i]), hi = __builtin_amdgcn_readfirstlane(tab[2 * i + 1]);
        return (const float*)(((unsigned long long)hi << 32) | lo); } };

#ifndef DEFER_CONV
#define DEFER_CONV 1
#endif
constexpr int IT_WIN = 32 * (NPROJ / 64), IT_DA = 16 * 32, IT_CV = 8 * 32, IT_SO = 8 * 32, IT_GLU = 8 * 16, IT_MIX = 32 * 32, IT_KV = 32 * 16, IT_XO = 8 * 32, IT_G = 16 * 32 * 8, IT_D = 16 * 8 * 32;
constexpr int IT_BIG = IT_WIN + IT_DA + IT_CV + IT_SO + IT_GLU + IT_MIX + 2 * IT_G + IT_D;
__device__ __forceinline__ void conv_item(const Ctx& F, const Inputs& I, const int l, int r) {
    do {
        const float* win = I.ptr(4) + (size_t)l * DM * NPROJ;
        const float* gmix = I.ptr(3) + (size_t)l * DM;
        XP_MATG(win, DM, NPROJ, lwp(F, l, LW_WIN), DM, 0, 1, 0, 0, 0, 0, 2048, gmix)
        XP_MATG(win, DM, NPROJ, lwp(F, l, LW_WIN), DM, 0, 0, 0, 0, 0, 2048, 3072, gmix)
        { const int nb_ = 1024 / 64, items_ = (DM / 64) * nb_;
            if (r < items_) { xpose_item8(win, NPROJ, lwp(F, l, LW_WG8), DM, 2, 3072, 64 * (r / nb_), 3072 + 64 * (r % nb_), F.lane, GATE_WSCALE, 512, 6144, gmix); continue; } r -= items_; }
        XP_MATG(win, DM, NPROJ, lwp(F, l, LW_WIN), DM, 0, 0, 4096, 0, 3072, 4096, 4608, gmix)
        { const int nb_ = (NPROJ - 4608) / 64, items_ = (DM / 64) * nb_;
            if (r < items_) { xpose_item8(win, NPROJ, lwp(F, l, LW_WG8), DM, 0, 4608, 64 * (r / nb_), 4608 + 64 * (r % nb_), F.lane, GATE_WSCALE, 0, 0, gmix); continue; } r -= items_; }
        XP_MAT(I.ptr(10) + (size_t)l * 1024 * DM, 1024, DM, lwp(F, l, LW_WCAT), DM, 0, 0, 0, 0, 0, 0, DM)
        XP_MAT(I.ptr(15) + (size_t)l * 512 * DM, 512, DM, lwp(F, l, LW_WCAT), DM, 1024, 0, 0, 0, 0, 0, DM)
        XP_MAT(I.ptr(26) + (size_t)l * 512 * DM, 512, DM, lwp(F, l, LW_WCAT), DM, 1536, 0, 0, 0, 0, 0, DM)
        XP_MAT(I.ptr(24) + (size_t)l * 512 * 1024, 512, 1024, lwp(F, l, LW_WGLU), 512, 0, 2, 0, 512, 0, 0, 1024)
        XP_MAT(I.ptr(27) + (size_t)l * DM * DM, DM, DM, lwp(F, l, LW_WMIX), DM, 0, 0, 0, 0, 0, 0, DM)
        if (r < 2 * IT_G) { const int up = r >= IT_G; if (up) r -= IT_G; const int e = r / (32 * 8); r %= (32 * 8);
            const float* w = I.ptr(up ? 39 : 38) + ((size_t)l * NEXP + e) * DM * FFE;
            xpose_item8(w, FFE, lwp(F, l, LW_WGU) + (size_t)e * 1024 * DM, DM, up ? 4 : 3, 0, 64 * (r / 8), 64 * (r % 8), F.lane, GATE_WSCALE); continue; }
        r -= 2 * IT_G;
        { const int e = r / (8 * 32); r %= (8 * 32); const float* w = I.ptr(40) + ((size_t)l * NEXP + e) * FFE * DM;
            xpose_item8(w, DM, lwp(F, l, LW_WD) + (size_t)e * DM * FFE, FFE, 0, 0, 64 * (r / 32), 64 * (r % 32), F.lane, GATE_WSCALE); }
    } while (0);
}
__device__ __forceinline__ void conv_item_xa(const Ctx& F, const Inputs& I, const int l, int r) {
    do {
        XP_MAT(I.ptr(31) + (size_t)l * DM * 1024, DM, 1024, F.ws + WS_WKVT + (size_t)l * 1024 * DM * 2, DM, 0, 0, 0, 0, 0, 0, 1024)
        XP_MAT(I.ptr(32) + (size_t)l * 512 * DM, 512, DM, F.ws + WS_WXOT + (size_t)l * DM * 512 * 2, 512, 0, 0, 0, 0, 0, 0, DM)
    } while (0);
}
__device__ __forceinline__ void conv_window(const Ctx& F, const Inputs& I, const int l, const int base, const int wave_rank, const int nper) {
#pragma unroll 1
    for (int k = 0; k < nper; ++k) { const int r = base + wave_rank * nper + k; if (r < IT_BIG) conv_item(F, I, l, r); }
}
constexpr int IT_EXP = 2 * IT_G + IT_D, IT_EARLY = IT_BIG - IT_EXP;
__device__ __forceinline__ void ph_prologue_a(const Ctx& F, const Inputs& I) {
#pragma unroll 1
  for (int pass = 0; pass < 2; ++pass) {
   if ((pass == 0) == ((F.vcu & 1) == 0)) {
    if (DEFER_CONV && F.G == 256) { for (int it = F.gw; it < IT_EARLY; it += F.NGW) conv_item(F, I, 0, it); }
    else for (int it = F.gw; it < NL * IT_BIG; it += F.NGW) conv_item(F, I, it / IT_BIG, it % IT_BIG);
    for (int it = F.gw; it < NL * (IT_KV + IT_XO); it += F.NGW) conv_item_xa(F, I, it / (IT_KV + IT_XO), it % (IT_KV + IT_XO));
    for (size_t i = (size_t)F.gw * 64 + F.lane; i < (size_t)NL * DM * 512 / 8; i += (size_t)F.NGW * 64) {
        const f32x4 a = *(const f32x4*)(I.ptr(30) + i * 8), b = *(const f32x4*)(I.ptr(30) + i * 8 + 4); const float g = FUSE_N2 ? I.ptr(28)[(i * 8) / 512] : 1.f;
        u32x4 o; o.x = pk2(a[0] * g, a[1] * g); o.y = pk2(a[2] * g, a[3] * g); o.z = pk2(b[0] * g, b[1] * g); o.w = pk2(b[2] * g, b[3] * g); *(u32x4*)(F.ws + WS_WQB + i * 16) = o; }
    for (int i = F.gw * 64 + F.lane; i < NL * 20 * DM; i += F.NGW * 64) { const int l = i / (20 * DM), j = (i / DM) % 20, k = i % DM;
        const float g = I.ptr(33)[l * DM + k]; const float w = j < 4 ? I.ptr(34)[((size_t)l * DM + k) * 4 + j] : I.ptr(36)[((size_t)l * DM + k) * 16 + (j - 4)];
        const float p = g * w; const unsigned hb = pk2(p, 0.f) & 0xffffu; const unsigned lb = pk2(p - bflo(hb), 0.f) & 0xffffu;
        ((unsigned short*)lwp(F, l, LW_RT))[j * DM + k] = (unsigned short)hb; ((unsigned short*)lwp(F, l, LW_RT))[(20 + j) * DM + k] = (unsigned short)lb; }
    for (int i = F.gw * 64 + F.lane; i < T * 32; i += F.NGW * 64) { const int t = i >> 5, d = i & 31;
        const double inv = exp(-(double)d * (1.0 / 32.0) * 9.210340371976184); float s, c; sincos_d((double)((const int*)I.ptr(2))[t] * inv, s, c);
        ((float*)(F.ws + WS_ROPE))[i] = c; ((float*)(F.ws + WS_ROPE))[T * 32 + i] = s; }
    for (int rw = F.gw; rw < NL * MEML; rw += F.NGW) { const int l = rw / MEML, m = rw % MEML;
        const f32x4* xr = (const f32x4*)(I.ptr(1) + (size_t)m * DM) + F.lane; f32x4 v[8]; float s = 0.f;
#pragma unroll
        for (int j = 0; j < 8; ++j) { v[j] = xr[64 * j]; s += (v[j][0] * v[j][0] + v[j][1] * v[j][1]) + (v[j][2] * v[j][2] + v[j][3] * v[j][3]); }
        const float rstd = rsqrtf(wave_sum(s) * (1.f / DM) + RMS_EPS);
        const f32x4* gr = (const f32x4*)(I.ptr(29) + (size_t)l * DM) + F.lane; u32x2* o = (u32x2*)(F.ws + WS_MNORM + (size_t)rw * DM * 2) + F.lane;
#pragma unroll
        for (int j = 0; j < 8; ++j) { const f32x4 g = gr[64 * j]; u32x2 w; w.x = pk2(v[j][0] * rstd * g[0], v[j][1] * rstd * g[1]); w.y = pk2(v[j][2] * rstd * g[2], v[j][3] * rstd * g[3]); o[64 * j] = w; } }
   } else {
    __syncthreads();
    for (int it2 = F.vcu; it2 < NL * 32 * 2; it2 += F.G) {
        const int it = it2 >> 1, hs = it2 & 1, l = it >> 5, g = it & 31;
        LAS f32x2* lamP = (LAS f32x2*)(F.lds + RING_OFF);
        LAS f32x2* Bb = lamP + 33 * 64;
        LAS f32x2* Cc = Bb + 64 * 16;
        LAS float* Kt = (LAS float*)(Cc + 16 * 64);
        LAS f32x2* fz = (LAS f32x2*)(Kt + 32 * 256);
        for (int i = F.tid; i < 33 * 64; i += NWAVES * 64) { const int tau = i >> 6, p = i & 63; const float lr = I.ptr(16)[(l * 32 + g) * 64 + p], li = I.ptr(17)[(l * 32 + g) * 64 + p]; const float dt = expf(I.ptr(18)[l * 32 + g]);
            float s, c; sincos_d((double)tau * (double)li * (double)dt, s, c); const float mg = expf((float)tau * lr * dt); lamP[tau * 64 + p] = (f32x2){mg * c, mg * s}; }
        if (F.tid < 64) { const int p = F.tid; const float lr = I.ptr(16)[(l * 32 + g) * 64 + p], li = I.ptr(17)[(l * 32 + g) * 64 + p]; const float dt = expf(I.ptr(18)[l * 32 + g]);
            float s1, c1; sincos_d((double)li * (double)dt, s1, c1); const float mg1 = expf(lr * dt), abr = mg1 * c1, abi = mg1 * s1, den = lr * lr + li * li;
            fz[p] = (f32x2){((abr - 1.f) * lr + abi * li) / den, (abi * lr - (abr - 1.f) * li) / den}; }
        __syncthreads();
        if (hs == 0 && F.tid < 64) ((f32x2*)lwp(F, l, LW_LAM))[g * 64 + F.tid] = lamP[32 * 64 + F.tid];
        for (int i = F.tid; i < 1024; i += 512) { const int p = i >> 4, h = i & 15; const float br = I.ptr(19)[((size_t)(l * 32 + g) * 64 + p) * 16 + h], bi = I.ptr(20)[((size_t)(l * 32 + g) * 64 + p) * 16 + h]; const f32x2 f = fz[p];
            Bb[i] = (f32x2){f[0] * br - f[1] * bi, f[0] * bi + f[1] * br};
            const int hh = i >> 6, pp = i & 63; Cc[i] = (f32x2){I.ptr(21)[((size_t)(l * 32 + g) * 16 + hh) * 64 + pp], I.ptr(22)[((size_t)(l * 32 + g) * 16 + hh) * 64 + pp]}; }
        __syncthreads();
        for (int i = F.tid; i < 32 * 128; i += 512) { const int tau = i >> 7, h = hs * 8 + ((i >> 4) & 7), h2 = i & 15; float a = 0.f;
            for (int p = 0; p < 64; ++p) { const f32x2 lm = lamP[tau * 64 + p], b = Bb[p * 16 + h2], c = Cc[h * 64 + p]; const float wr_ = lm[0] * b[0] - lm[1] * b[1], wi_ = lm[0] * b[1] + lm[1] * b[0]; a += c[0] * wr_ - c[1] * wi_; }
            if (tau == 0 && h == h2) a += I.ptr(23)[(l * 32 + g) * 16 + h];
            Kt[tau * 256 + h * 16 + h2] = a; }
        __syncthreads();
        bf16_t* bke = (bf16_t*)(lwp(F, l, LW_BKE) + (size_t)g * 512 * 640 * 2);
        for (int i = F.tid; i < 256 * 80; i += 512) { const int nn = i / 80, k8 = i % 80, j = nn >> 3, h = hs * 8 + (nn & 7), n = j * 16 + h; float v[8];
            if (k8 < 64) { const int ii = k8 >> 1, h0 = (k8 & 1) * 8;
#pragma unroll
                for (int q = 0; q < 8; ++q) v[q] = (ii <= j) ? Kt[(j - ii) * 256 + h * 16 + h0 + q] : 0.f; }
            else { const int p0 = (k8 - 64) * 4;
#pragma unroll
                for (int q = 0; q < 4; ++q) { const f32x2 c = Cc[h * 64 + p0 + q], lm = lamP[(j + 1) * 64 + p0 + q]; v[2 * q] = c[0] * lm[0] - c[1] * lm[1]; v[2 * q + 1] = -(c[0] * lm[1] + c[1] * lm[0]); } }
            u32x4 o; o.x = pk2(v[0], v[1]); o.y = pk2(v[2], v[3]); o.z = pk2(v[4], v[5]); o.w = pk2(v[6], v[7]); *(u32x4*)(bke + (size_t)n * 640 + k8 * 8) = o; }
        bf16_t* fm = (bf16_t*)(lwp(F, l, LW_F) + (size_t)g * 128 * 512 * 2);
        for (int i = F.tid; i < 64 * 64; i += 512) { const int n = hs * 64 + (i >> 6), k8 = i & 63, p = n >> 1, im = n & 1, ii = k8 >> 1, h0 = (k8 & 1) * 8; float v[8]; const f32x2 lm = lamP[(31 - ii) * 64 + p];
#pragma unroll
            for (int q = 0; q < 8; ++q) { const f32x2 b = Bb[p * 16 + h0 + q]; v[q] = im ? (lm[0] * b[1] + lm[1] * b[0]) : (lm[0] * b[0] - lm[1] * b[1]); }
            u32x4 o; o.x = pk2(v[0], v[1]); o.y = pk2(v[2], v[3]); o.z = pk2(v[4], v[5]); o.w = pk2(v[6], v[7]); *(u32x4*)(fm + (size_t)n * 512 + k8 * 8) = o; }
        __syncthreads();
    }
   }
  }
}

__device__ __forceinline__ void ph_norm1(const Ctx& F, int l, const float* xin, const float* gain, float* fout) {
    char* X = (char*)(F.ws + WS_X);
    for (int rowb = F.gw; rowb < T; rowb += 2 * F.NGW) {
        f32x4 v[2][8];
        if (l == 0) {
#pragma unroll
            for (int r = 0; r < 2; ++r) { const int row = rowb + r * F.NGW; if (row < T) { const f32x4* xr = (const f32x4*)(xin + (size_t)row * DM) + F.lane;
#pragma unroll
                for (int j = 0; j < 8; ++j) v[r][j] = xr[64 * j]; } } }
        else {
            const int cv = (F.lane < 16) ? (int)__hip_atomic_load(F.ctl + CW_CNT + ((l - 1) * 16 + F.lane) * 16, RLX_AGENT) : 0;
            int4 tk[2];
#pragma unroll
            for (int r = 0; r < 2; ++r) { const int row = rowb + r * F.NGW; tk[r] = (row < T) ? *(const int4*)(F.ws + WS_TOK + (size_t)row * 16) : make_int4(0, 0, 0, 0); }
            unsigned ya[2][8], yb[2][8]; u32x2 xq[2][8];
#pragma unroll
            for (int r = 0; r < 2; ++r) { const int row = rowb + r * F.NGW; if (row < T) {
                int o0 = 0, o1 = 0;
#pragma unroll
                for (int k = 0; k < 16; ++k) { const int ck = __builtin_amdgcn_readlane(cv, k); o0 += (k < tk[r].x) ? ck : 0; o1 += (k < tk[r].z) ? ck : 0; }
                const unsigned* y0 = (const unsigned*)(F.ws + WS_Y + (size_t)(o0 + tk[r].y) * 2048) + F.lane; const unsigned* y1 = (const unsigned*)(F.ws + WS_Y + (size_t)(o1 + tk[r].w) * 2048) + F.lane;
                const u32x2* xr = (const u32x2*)(X + (size_t)row * DM * 2) + F.lane;
#pragma unroll
                for (int j = 0; j < 8; ++j) { ya[r][j] = y0[64 * j]; yb[r][j] = y1[64 * j]; xq[r][j] = xr[64 * j]; } } }
#pragma unroll
            for (int r = 0; r < 2; ++r)
#pragma unroll
                for (int j = 0; j < 8; ++j) { const int a = (int)ya[r][j], b = (int)yb[r][j]; const u32x2 xb = xq[r][j]; f32x4 x = (f32x4){bflo(xb.x), bfhi(xb.x), bflo(xb.y), bfhi(xb.y)};
#ifndef DBG_NO_MOE
                    const f32x2 a0 = __builtin_amdgcn_cvt_pk_f32_fp8(a, false), a1 = __builtin_amdgcn_cvt_pk_f32_fp8(a, true), b0 = __builtin_amdgcn_cvt_pk_f32_fp8(b, false), b1 = __builtin_amdgcn_cvt_pk_f32_fp8(b, true);
                    x[0] += (a0[0] + b0[0]) * (1.f / 16.f); x[1] += (a0[1] + b0[1]) * (1.f / 16.f); x[2] += (a1[0] + b1[0]) * (1.f / 16.f); x[3] += (a1[1] + b1[1]) * (1.f / 16.f);
#endif
                    v[r][j] = x; } }
        const f32x4* gr = (const f32x4*)gain + F.lane;
#pragma unroll
        for (int r = 0; r < 2; ++r) { const int row = rowb + r * F.NGW; if (row < T) {
            float s = 0.f;
#pragma unroll
            for (int j = 0; j < 8; ++j) s += (v[r][j][0] * v[r][j][0] + v[r][j][1] * v[r][j][1]) + (v[r][j][2] * v[r][j][2] + v[r][j][3] * v[r][j][3]);
            const float rstd = rsqrtf(wave_sum(s) * (1.f / DM) + RMS_EPS);
            if (fout) { f32x4* o = (f32x4*)(fout + (size_t)row * DM) + F.lane;
#pragma unroll
                for (int j = 0; j < 8; ++j) { const f32x4 g = gr[64 * j]; o[64 * j] = (f32x4){v[r][j][0] * rstd * g[0], v[r][j][1] * rstd * g[1], v[r][j][2] * rstd * g[2], v[r][j][3] * rstd * g[3]}; } }
            else { u32x2* xo = (u32x2*)(X + (size_t)row * DM * 2) + F.lane; unsigned* o8 = (unsigned*)(F.ws + WS_H8 + (size_t)row * DM) + F.lane;
                if (F.lane == 0) ((float*)(F.ws + WS_RSTD))[row] = rstd;
#pragma unroll
                for (int j = 0; j < 8; ++j) { u32x2 xw; xw.x = pk2(v[r][j][0], v[r][j][1]); xw.y = pk2(v[r][j][2], v[r][j][3]); xo[64 * j] = xw;
                    int p8 = __builtin_amdgcn_cvt_pk_fp8_f32(v[r][j][0], v[r][j][1], 0, false); p8 = __builtin_amdgcn_cvt_pk_fp8_f32(v[r][j][2], v[r][j][3], p8, true); o8[64 * j] = (unsigned)p8; } } } }
    }
}
__device__ __forceinline__ void ph_norm2(const Ctx& F, const float* gain) {
    const float* X = (const float*)(F.ws + WS_X);
    for (int row = F.gw; row < T; row += F.NGW) {
        const f32x4* xr = (const f32x4*)(X + (size_t)row * DM) + F.lane; f32x4 v[8]; float s = 0.f;
#pragma unroll
        for (int j = 0; j < 8; ++j) { v[j] = xr[64 * j]; s += (v[j][0] * v[j][0] + v[j][1] * v[j][1]) + (v[j][2] * v[j][2] + v[j][3] * v[j][3]); }
        const float rstd = rsqrtf(wave_sum(s) * (1.f / DM) + RMS_EPS);
        const f32x4* gr = (const f32x4*)gain + F.lane; u32x2* o = (u32x2*)(F.ws + WS_H + (size_t)row * DM * 2) + F.lane;
#pragma unroll
        for (int j = 0; j < 8; ++j) { const f32x4 g = gr[64 * j]; u32x2 w; w.x = pk2(v[j][0] * rstd * g[0], v[j][1] * rstd * g[1]); w.y = pk2(v[j][2] * rstd * g[2], v[j][3] * rstd * g[3]); o[64 * j] = w; }
    }
}
__device__ __forceinline__ void ph_conv(const Ctx& F, const float* dww, const float* dwb, const float* lng, const float* lnb) {
    LAS float* cs = (LAS float*)(F.lds + RING_OFF);
    const bf16_t* Z = (const bf16_t*)(F.ws + WS_Z);
    for (int run = F.vcu; run < T / 32; run += F.G) {
        const int t0 = run * 32, c = F.tid;
        float w[31];
#pragma unroll
        for (int k = 0; k < 31; ++k) w[k] = dww[k * 512 + c];
        const float b = dwb[c];
        float zz[62];
#pragma unroll
        for (int i = 0; i < 62; ++i) { const int t = t0 - 30 + i; zz[i] = (t >= 0) ? bf2f(Z[(size_t)t * 512 + c]) : 0.f; }
#pragma unroll
        for (int j = 0; j < 32; ++j) { float a = b;
#pragma unroll
            for (int k = 0; k < 31; ++k) a += w[k] * zz[j + k];
            cs[j * 512 + c] = a; }
        __syncthreads();
#pragma unroll
        for (int q = 0; q < 4; ++q) { const int j = F.wave * 4 + q; const f32x4 a0 = *(const LAS f32x4*)(cs + j * 512 + F.lane * 8), a1 = *(const LAS f32x4*)(cs + j * 512 + F.lane * 8 + 4);
            const float mu = wave_sum((a0[0] + a0[1]) + (a0[2] + a0[3]) + (a1[0] + a1[1]) + (a1[2] + a1[3])) * (1.f / 512.f);
            const f32x4 d0 = a0 - mu, d1 = a1 - mu;
            const float var = wave_sum((d0[0] * d0[0] + d0[1] * d0[1]) + (d0[2] * d0[2] + d0[3] * d0[3]) + (d1[0] * d1[0] + d1[1] * d1[1]) + (d1[2] * d1[2] + d1[3] * d1[3])) * (1.f / 512.f);
            const float rstd = rsqrtf(var + LN_EPS);
            const f32x4 g0 = *(const f32x4*)(lng + F.lane * 8), g1 = *(const f32x4*)(lng + F.lane * 8 + 4), b0 = *(const f32x4*)(lnb + F.lane * 8), b1 = *(const f32x4*)(lnb + F.lane * 8 + 4);
            f32x4 y0 = d0 * rstd * g0 + b0, y1 = d1 * rstd * g1 + b1;
#pragma unroll
            for (int i = 0; i < 4; ++i) { y0[i] = y0[i] * sigmoidf_(y0[i]); y1[i] = y1[i] * sigmoidf_(y1[i]); }
            u32x4 o; o.x = pk2(y0[0], y0[1]); o.y = pk2(y0[2], y0[3]); o.z = pk2(y1[0], y1[1]); o.w = pk2(y1[2], y1[3]);
            *(u32x4*)(F.ws + WS_CVO + ((size_t)(t0 + j) * 512 + F.lane * 8) * 2) = o; }
        __syncthreads();
    }
}
__device__ __forceinline__ void ph_ssm2(const Ctx& F, int l) {
    if (F.vcu < 64) { const int g = F.vcu >> 1, p = (F.vcu & 1) * 32 + (F.tid & 31), q = F.tid >> 5; const f32x2 lm = ((const f32x2*)lwp(F, l, LW_LAM))[g * 64 + p];
        LAS f32x2* Tq = (LAS f32x2*)(F.lds + RING_OFF);
        const float* S = (const float*)(F.ws + WS_SS) + g * 128 + 2 * p + (size_t)(16 * q) * 4096;
        f32x2 sv[16];
#pragma unroll
        for (int i = 0; i < 16; ++i) sv[i] = *(const f32x2*)(S + (size_t)i * 4096);
        f32x2 loc[16]; float xr = 0.f, xi = 0.f;
#pragma unroll
        for (int i = 0; i < 16; ++i) { const float nr = lm[0] * xr - lm[1] * xi + sv[i][0], ni = lm[0] * xi + lm[1] * xr + sv[i][1]; xr = nr; xi = ni; loc[i] = (f32x2){xr, xi}; }
        Tq[q * 32 + (F.tid & 31)] = loc[15];
        float pr = lm[0], pi = lm[1];
#pragma unroll
        for (int k = 0; k < 4; ++k) { const float nr = pr * pr - pi * pi, ni = 2.f * pr * pi; pr = nr; pi = ni; }
        __syncthreads();
        float cr = 0.f, ci = 0.f;
        for (int qq = 0; qq < q; ++qq) { const f32x2 t = Tq[qq * 32 + (F.tid & 31)]; const float nr = pr * cr - pi * ci + t[0], ni = pr * ci + pi * cr + t[1]; cr = nr; ci = ni; }
        unsigned* xp = (unsigned*)(F.ws + WS_XP) + ((size_t)g * 256 + 16 * q) * 64 + p;
        xp[0] = pk2(cr, ci);
#pragma unroll
        for (int i = 1; i < 16; ++i) { const float nr = lm[0] * cr - lm[1] * ci, ni = lm[0] * ci + lm[1] * cr; cr = nr; ci = ni; xp[i * 64] = pk2(cr + loc[i - 1][0], ci + loc[i - 1][1]); }
    }
    __syncthreads();
}
#if NAIVE_SSM
__device__ __forceinline__ void ph_ssm_naive(const Ctx& F, int l, const Inputs& I) {
    if (F.vcu < 32) { const int g = F.vcu; LAS f32x2* xs = (LAS f32x2*)(F.lds + RING_OFF); LAS float* us = (LAS float*)(xs + 64);
        float br[16], bi[16], abr = 0.f, abi = 0.f, xr = 0.f, xi = 0.f, cr[64], ci[64], dsk = 0.f;
        if (F.tid < 64) { const int p = F.tid; const float lr = I.ptr(16)[(l * 32 + g) * 64 + p], li = I.ptr(17)[(l * 32 + g) * 64 + p]; const float dt = expf(I.ptr(18)[l * 32 + g]);
            float s1, c1; sincos_d((double)li * (double)dt, s1, c1); const float mg1 = expf(lr * dt); abr = mg1 * c1; abi = mg1 * s1; const float den = lr * lr + li * li;
            const float fr_ = ((abr - 1.f) * lr + abi * li) / den, fi_ = (abi * lr - (abr - 1.f) * li) / den;
#pragma unroll
            for (int h = 0; h < 16; ++h) { const float b_r = I.ptr(19)[((size_t)(l * 32 + g) * 64 + p) * 16 + h], b_i = I.ptr(20)[((size_t)(l * 32 + g) * 64 + p) * 16 + h]; br[h] = fr_ * b_r - fi_ * b_i; bi[h] = fr_ * b_i + fi_ * b_r; } }
        if (F.tid < 16) { const int h = F.tid;
#pragma unroll
            for (int p = 0; p < 64; ++p) { cr[p] = I.ptr(21)[((size_t)(l * 32 + g) * 16 + h) * 64 + p]; ci[p] = I.ptr(22)[((size_t)(l * 32 + g) * 16 + h) * 64 + p]; }
            dsk = I.ptr(23)[(l * 32 + g) * 16 + h]; }
        const bf16_t* UC = (const bf16_t*)(F.ws + WS_UC) + (size_t)g * 256 * 512;
#pragma unroll 1
        for (int t = 0; t < T; ++t) {
            if (F.tid < 16) us[F.tid] = bf2f(UC[(size_t)(t >> 5) * 512 + (t & 31) * 16 + F.tid]);
            __syncthreads();
            if (F.tid < 64) { float ar = 0.f, ai = 0.f;
#pragma unroll
                for (int h = 0; h < 16; ++h) { ar += br[h] * us[h]; ai += bi[h] * us[h]; }
                const float nr = abr * xr - abi * xi + ar, ni = abr * xi + abi * xr + ai; xr = nr; xi = ni; xs[F.tid] = (f32x2){xr, xi}; }
            __syncthreads();
            if (F.tid < 16) { float y = dsk * us[F.tid];
#pragma unroll
                for (int p = 0; p < 64; ++p) { const f32x2 x = xs[p]; y += cr[p] * x[0] - ci[p] * x[1]; }
                ((bf16_t*)(F.ws + WS_YS))[(size_t)t * 512 + g * 16 + F.tid] = (bf16_t)f2bf(y); }
        }
        __syncthreads();
    }
}
#endif
__device__ __forceinline__ void ph_diff(const Ctx& F, int l, const Inputs& I) {
    const float lam_init = 0.8f - 0.6f * expf(-0.3f * (float)l);
    const float d1 = wave_sum(I.ptr(5)[l * 64 + F.lane] * I.ptr(6)[l * 64 + F.lane]), d2 = wave_sum(I.ptr(7)[l * 64 + F.lane] * I.ptr(8)[l * 64 + F.lane]);
    const float lam = expf(d1) - expf(d2) + lam_init, post = 1.f - lam_init;
    float hn[16];
#pragma unroll
    for (int i = 0; i < 16; ++i) hn[i] = I.ptr(9)[l * 128 + (F.lane & 7) * 16 + i] * post;
    for (int row = F.gw; row < T; row += F.NGW) {
        const u32x4* a = (const u32x4*)(F.ws + WS_O1 + (size_t)row * 2048) + F.lane * 2; const u32x4* b = (const u32x4*)(F.ws + WS_O2 + (size_t)row * 2048) + F.lane * 2;
        float d[16]; float ss = 0.f;
#pragma unroll
        for (int q = 0; q < 2; ++q) { const u32x4 x = a[q], y = b[q];
            d[q * 8 + 0] = bflo(x.x) - lam * bflo(y.x); d[q * 8 + 1] = bfhi(x.x) - lam * bfhi(y.x); d[q * 8 + 2] = bflo(x.y) - lam * bflo(y.y); d[q * 8 + 3] = bfhi(x.y) - lam * bfhi(y.y);
            d[q * 8 + 4] = bflo(x.z) - lam * bflo(y.z); d[q * 8 + 5] = bfhi(x.z) - lam * bfhi(y.z); d[q * 8 + 6] = bflo(x.w) - lam * bflo(y.w); d[q * 8 + 7] = bfhi(x.w) - lam * bfhi(y.w); }
#pragma unroll
        for (int i = 0; i < 16; ++i) ss += d[i] * d[i];
        ss += xor_lane<1>(ss); ss += xor_lane<2>(ss); ss += xor_lane<4>(ss);
        const float rstd = rsqrtf(ss * (1.f / 128.f) + HEAD_EPS);
        u32x4* o = (u32x4*)(F.ws + WS_OAN + (size_t)row * 2048) + F.lane * 2;
#pragma unroll
        for (int q = 0; q < 2; ++q) { u32x4 w; w.x = pk2(d[q * 8 + 0] * rstd * hn[q * 8 + 0], d[q * 8 + 1] * rstd * hn[q * 8 + 1]); w.y = pk2(d[q * 8 + 2] * rstd * hn[q * 8 + 2], d[q * 8 + 3] * rstd * hn[q * 8 + 3]);
            w.z = pk2(d[q * 8 + 4] * rstd * hn[q * 8 + 4], d[q * 8 + 5] * rstd * hn[q * 8 + 5]); w.w = pk2(d[q * 8 + 6] * rstd * hn[q * 8 + 6], d[q * 8 + 7] * rstd * hn[q * 8 + 7]); o[q] = w; }
    }
}
__device__ __forceinline__ void ph_norm3_router(const Ctx& F, int l, const Inputs& I, const bool commit = true) {
    const char* X = (const char*)(F.ws + WS_X); LAS float* part = (LAS float*)(F.lds + RING_OFF);
    const char* RT = (const char*)lwp(F, l, LW_RT);
    for (int run = F.vcu; run < T / 32; run += F.G) {
        const int r0 = run * 32;
        int ln = F.lane; asm volatile("" : "+v"(ln));
        const int fr = ln & 15, fq = ln >> 4;
        const unsigned lo16 = (unsigned)ln * 16u;
        f32x4 acc[2][2];
#pragma unroll
        for (int m = 0; m < 2; ++m)
#pragma unroll
            for (int n = 0; n < 2; ++n) acc[m][n] = (f32x4){0.f, 0.f, 0.f, 0.f};
        {
            const char* xa = X + (size_t)(r0 + fr) * (DM * 2) + (unsigned)((F.wave * 256 + fq * 8) * 2);
            const char* wa = RT + (size_t)fr * (DM * 2) + (unsigned)((F.wave * 256 + fq * 8) * 2);
            const char* wb = RT + (size_t)(16 + (fr & 3)) * (DM * 2) + (unsigned)((F.wave * 256 + fq * 8) * 2);
#pragma unroll 4
            for (int ks = 0; ks < 8; ++ks) {
                const bf16x8 x0 = *(const bf16x8*)(xa + ks * 64), x1 = *(const bf16x8*)(xa + 16 * DM * 2 + ks * 64);
                const bf16x8 ha = *(const bf16x8*)(wa + ks * 64), la = *(const bf16x8*)(wa + 20 * DM * 2 + ks * 64), hb = *(const bf16x8*)(wb + ks * 64), lb = *(const bf16x8*)(wb + 20 * DM * 2 + ks * 64);
                acc[0][0] = __builtin_amdgcn_mfma_f32_16x16x32_bf16(ha, x0, acc[0][0], 0, 0, 0); acc[1][0] = __builtin_amdgcn_mfma_f32_16x16x32_bf16(ha, x1, acc[1][0], 0, 0, 0);
                acc[0][1] = __builtin_amdgcn_mfma_f32_16x16x32_bf16(hb, x0, acc[0][1], 0, 0, 0); acc[1][1] = __builtin_amdgcn_mfma_f32_16x16x32_bf16(hb, x1, acc[1][1], 0, 0, 0);
                acc[0][0] = __builtin_amdgcn_mfma_f32_16x16x32_bf16(la, x0, acc[0][0], 0, 0, 0); acc[1][0] = __builtin_amdgcn_mfma_f32_16x16x32_bf16(la, x1, acc[1][0], 0, 0, 0);
                acc[0][1] = __builtin_amdgcn_mfma_f32_16x16x32_bf16(lb, x0, acc[0][1], 0, 0, 0); acc[1][1] = __builtin_amdgcn_mfma_f32_16x16x32_bf16(lb, x1, acc[1][1], 0, 0, 0);
            }
        }
        __syncthreads();
#pragma unroll
        for (int m = 0; m < 2; ++m) { LAS float* pw = part + ((F.wave * 32 + 16 * m + fr) * 24);
            *(LAS f32x4*)(pw + 4 * fq) = acc[m][0]; if (fq == 0) *(LAS f32x4*)(pw + 16) = acc[m][1]; }
        __syncthreads();
        u32x2 xb[4][8];
#pragma unroll
        for (int rr = 0; rr < 4; ++rr)
#pragma unroll
            for (int j = 0; j < 8; ++j) xb[rr][j] = *(const u32x2*)(X + (size_t)(r0 + F.wave * 4 + rr) * (DM * 2) + 512 * j + (lo16 >> 1));
#pragma unroll
        for (int rr = 0; rr < 4; ++rr) { const int rl = F.wave * 4 + rr, row = r0 + rl;
            float lgv = 0.f;
            if (ln < 20) {
#pragma unroll
                for (int w = 0; w < 8; ++w) lgv += part[(w * 32 + rl) * 24 + ln]; }
            f32x4 v[8]; float ss = 0.f;
#pragma unroll
            for (int j = 0; j < 8; ++j) { v[j] = (f32x4){bflo(xb[rr][j].x), bfhi(xb[rr][j].x), bflo(xb[rr][j].y), bfhi(xb[rr][j].y)}; ss += (v[j][0] * v[j][0] + v[j][1] * v[j][1]) + (v[j][2] * v[j][2] + v[j][3] * v[j][3]); }
            const float rstd = rsqrtf(wave_sum(ss) * (1.f / DM) + RMS_EPS);
            float lg[20];
#pragma unroll
            for (int j = 0; j < 20; ++j) lg[j] = __builtin_bit_cast(float, __builtin_amdgcn_readlane(__builtin_bit_cast(int, lgv), j));
            float gl[4], el[16];
#pragma unroll
            for (int i = 0; i < 4; ++i) gl[i] = lg[i] * rstd + I.ptr(35)[l * 4 + i];
#pragma unroll
            for (int i = 0; i < 16; ++i) el[i] = lg[4 + i] * rstd + I.ptr(37)[l * 16 + i];
            int gi = 0; float gm = gl[0];
#pragma unroll
            for (int i = 1; i < 4; ++i) if (gl[i] > gm) { gm = gl[i]; gi = i; }
            float gs = 0.f;
#pragma unroll
            for (int i = 0; i < 4; ++i) gs += expf(gl[i] - gm);
            const float gw_ = 1.f / gs;
            float sel[4];
#pragma unroll
            for (int i = 0; i < 4; ++i) sel[i] = gi == 0 ? el[i] : gi == 1 ? el[4 + i] : gi == 2 ? el[8 + i] : el[12 + i];
            int i0 = 0; float v0 = sel[0];
#pragma unroll
            for (int i = 1; i < 4; ++i) if (sel[i] > v0) { v0 = sel[i]; i0 = i; }
            int i1 = -1; float v1 = -INFINITY;
#pragma unroll
            for (int i = 0; i < 4; ++i) if (i != i0 && sel[i] > v1) { v1 = sel[i]; i1 = i; }
            const float w0 = gw_ / (1.f + expf(v1 - v0)), w1 = gw_ - w0;
            const int e0 = gi * 4 + i0, e1 = gi * 4 + i1;
            if (F.lane == 0 && commit) {
                const int s0 = (int)__hip_atomic_fetch_add(F.ctl + CW_CNT + (l * 16 + e0) * 16, 1u, RLX_AGENT), s1 = (int)__hip_atomic_fetch_add(F.ctl + CW_CNT + (l * 16 + e1) * 16, 1u, RLX_AGENT);
                ((int*)(F.ws + WS_LIST))[e0 * T + s0] = row; ((float*)(F.ws + WS_WL))[e0 * T + s0] = w0;
                ((int*)(F.ws + WS_LIST))[e1 * T + s1] = row; ((float*)(F.ws + WS_WL))[e1 * T + s1] = w1;
                *(int4*)(F.ws + WS_TOK + (size_t)row * 16) = make_int4(e0, s0, e1, s1); }
            const char* gr = (const char*)(I.ptr(33) + (size_t)l * DM); char* o = (char*)(F.ws + WS_H8 + (size_t)row * DM);
#pragma unroll
            for (int j = 0; j < 8; ++j) { const f32x4 g = *(const f32x4*)(gr + 1024 * j + lo16);
                int p8 = __builtin_amdgcn_cvt_pk_fp8_f32(v[j][0] * rstd * g[0], v[j][1] * rstd * g[1], 0, false); p8 = __builtin_amdgcn_cvt_pk_fp8_f32(v[j][2] * rstd * g[2], v[j][3] * rstd * g[3], p8, true); *(unsigned*)(o + 256 * j + (lo16 >> 2)) = (unsigned)p8; }
        }
    }
    __syncthreads();
}
namespace pg8 {
struct SchedKV { unsigned char* ws; int G, c; static constexpr bool GATHER = false;
    __device__ __forceinline__ bool next(int i, GU& u) const { const int L = i * G + c; if (L >= 16) return false; const int l = L >> 2, pn = L & 3;
        u.A = (const char*)ws + WS_MNORM + (size_t)l * MEML * DM * 2; u.B = (const char*)ws + WS_WKVT + (size_t)l * 1024 * DM * 2 + (size_t)pn * 256 * 4096; u.C = (char*)ws + WS_KVB + (size_t)l * MEML * 2048 + pn * 512; u.P = nullptr;
        u.lda = 4096; u.ldb = 4096; u.nt = 32; u.pm = 0; u.pn = pn; u.seg = 0; u.flags = GU_LAST; u.rows = 256; u.aux = __builtin_bit_cast(int, 1.0f); u.f8 = 0; return true; }
    __device__ __forceinline__ unsigned arow(const GU& u, int r) const { return (unsigned)(r * u.lda); } };
struct SchedAbsorb { unsigned char* ws; int G, c; static constexpr bool GATHER = false;
    __device__ __forceinline__ bool next(int i, GU& u) const { const int L = i * G + c; if (L >= 256) return false; const int w = L & 127, l = w >> 5, h = (w >> 3) & 3, t = w & 7;
        unsigned char* lw = ws + WS_LW + (size_t)l * LW_SIZE; const char* kvb = (const char*)ws + WS_KVB + (size_t)l * MEML * 2048;
        int two = 2; asm volatile("" : "+s"(two));
        u.P = nullptr; u.nt = two; u.pm = 0; u.pn = 0; u.seg = 0; u.flags = GU_LAST; u.rows = 256;
        if (L < 128) { u.A = kvb + h * 256; u.lda = 2048; u.B = (const char*)ws + WS_WQB + (size_t)l * DM * 1024 + (size_t)t * 256 * 1024 + h * 256; u.ldb = 1024;
            u.C = (char*)lw + LW_WQK + (size_t)(h * 256) * (S_FP8 ? 2048 : 4096) + t * (S_FP8 ? 256 : 512); u.aux = __builtin_bit_cast(int, C2X * SQK_SCALE); u.f8 = 0; u.seg = S_FP8; }
        else { u.A = (const char*)ws + WS_WXOT + (size_t)l * DM * 1024 + (size_t)t * 256 * 1024 + h * 256; u.lda = 1024; u.B = kvb + 1024 + h * 256; u.ldb = 2048;
            u.C = (char*)lw + LW_VW + (size_t)(t * 256) * (XAO_FP8 ? 1024 : 2048) + h * (XAO_FP8 ? 256 : 512); u.aux = __builtin_bit_cast(int, VW_SCALE); u.f8 = 0; u.seg = XAO_FP8; }
        u.pm = (L < 128) ? (S_FP8 ? 2048 : 4096) : (XAO_FP8 ? 1024 : 2048);
        return true; }
    __device__ __forceinline__ unsigned arow(const GU& u, int r) const { return (unsigned)(r * u.lda); } };
struct EpiStoreP {
    __device__ __forceinline__ void operator()(Acc& acc, const GU& u, int wr, int wc, int fr, int fq) const {
        const float sc = __builtin_bit_cast(float, u.aux);
        if (u.seg) { EPI_ROWS( { char* rp = u.C + (unsigned)(lrow * u.pm); EPI_COLS( { int q0 = __builtin_amdgcn_cvt_pk_fp8_f32(v0[0] * sc, v0[1] * sc, 0, false); q0 = __builtin_amdgcn_cvt_pk_fp8_f32(v0[2] * sc, v0[3] * sc, q0, true);
                int q1 = __builtin_amdgcn_cvt_pk_fp8_f32(v1[0] * sc, v1[1] * sc, 0, false); q1 = __builtin_amdgcn_cvt_pk_fp8_f32(v1[2] * sc, v1[3] * sc, q1, true); *(u32x2*)(rp + lcol) = (u32x2){(unsigned)q0, (unsigned)q1}; } ) } ) }
        else { EPI_ROWS( { char* rp = u.C + (unsigned)(lrow * u.pm); EPI_COLS( st8(rp + lcol * 2, v0 * sc, v1 * sc); ) } ) }
    } };
struct SchedSsm1 { unsigned char* ws; unsigned char* lw; int G, c; static constexpr bool GATHER = false;
    __device__ __forceinline__ bool next(int i, GU& u) const { const int g = i * G + c; if (g >= 32) return false;
        u.A = (const char*)ws + WS_UC + (size_t)g * 256 * 1024; u.lda = 1024; u.B = (const char*)lw + LW_F + (size_t)g * 128 * 1024; u.ldb = 1024; u.C = (char*)ws + WS_SS + g * 512; u.P = nullptr;
        u.nt = 8; u.pm = 0; u.pn = g; u.seg = 0; u.flags = GU_LAST; u.rows = 256; u.aux = 0; u.f8 = 0; return true; }
    __device__ __forceinline__ unsigned arow(const GU& u, int r) const { return (unsigned)(r * u.lda); } };
struct SchedSsm3 { unsigned char* ws; unsigned char* lw; int G, c; static constexpr bool GATHER = false;
    __device__ __forceinline__ bool next(int i, GU& u) const { const int ti = i >> 1, sg = i & 1, L = ti * G + c; if (L >= 64) return false; const int g = L >> 1, pn = L & 1;
        const char* b = (const char*)lw + LW_BKE + (size_t)g * 512 * 1280 + (size_t)pn * 256 * 1280;
        if (sg == 0) { u.A = (const char*)ws + WS_UC + (size_t)g * 256 * 1024; u.lda = 1024; u.B = b; u.nt = 8; }
        else { u.A = (const char*)ws + WS_XP + (size_t)g * 256 * 256; u.lda = 256; u.B = b + 1024; u.nt = 2; }
        u.ldb = 1280; u.C = nullptr; u.P = nullptr; u.pm = g; u.pn = pn; u.seg = sg; u.flags = sg ? GU_LAST : 0; u.rows = 256; u.aux = 0; u.f8 = 0; return true; }
    __device__ __forceinline__ unsigned arow(const GU& u, int r) const { return (unsigned)(r * u.lda); } };
}

constexpr int PH_PRO_A = 0, PH_PRO_B = 1, PH_PRO_C = 2, PH_L0 = 3, NPL = 15, PH_FINAL = PH_L0 + NL * NPL, NPHASES = PH_FINAL + 1;
constexpr int INTAB_OFF = LDSCTL_OFF + 1024;
struct Args { const float* in[42]; float* out; unsigned char* ws; int ph_lo, ph_hi; };
#define LAUNDER_S(x) asm volatile("" : "+s"(x))
#define MKCTX() Ctx F; { unsigned char* w_ = args.ws; LAUNDER_S(w_); F.ws = w_; F.lds = (LAS unsigned char*)lds_raw; F.ctl = (gu32*)(w_ + WS_CTL); \
    F.tid = tid_of(wave_s); F.lane = F.tid & 63; F.wave = __builtin_amdgcn_readfirstlane(F.tid >> 6); \
    int g_ = gridDim.x; LAUNDER_S(g_); F.G = g_; { int bx_ = blockIdx.x; LAUNDER_S(bx_); F.vcu = (g_ % 8 == 0) ? (bx_ % 8) * (g_ / 8) + bx_ / 8 : bx_; } \
    F.gw = F.vcu * NWAVES + F.wave; F.NGW = F.G * NWAVES; } \
    unsigned char* const ws = F.ws; (void)ws; const Inputs I{(const LAS unsigned*)(F.lds + INTAB_OFF)}; (void)I; int bx = blockIdx.x; LAUNDER_S(bx);
#if MK_PER_PHASE
#define GRID_BAR() do { } while (0)
#else
#define GRID_BAR() do { unsigned char* w_ = args.ws; LAUNDER_S(w_); XcdBarrier bar_; bar_.bar = (unsigned*)((gu32*)(w_ + WS_CTL) + CW_BAR); bar_.x = xb_xcc_id(); \
        bar_.st = (volatile LAS unsigned*)((LAS unsigned char*)lds_raw + MISC_OFF) + 8; xcd_barrier(bar_); } while (0)
#endif
#define IN(k) (lo <= (k) && (k) < hi)
#define SEAM(k) do { if (IN(k) && IN((k) + 1)) GRID_BAR(); } while (0)
#ifndef ONLY_LPH
#define ONLY_LPH -1
#endif
#define LPH_ON(j) (ONLY_LPH < 0 || ONLY_LPH == (j))
#ifndef DBG_DUP_MASK
#define DBG_DUP_MASK 0
#endif
#define NREP(j) (1 + ((DBG_DUP_MASK >> (j)) & 1))
#define INL(j) (LPH_ON(j) && lo <= (P0 + (j)) && (P0 + (j)) < hi)
#define SEAML(j) do { if ((lo <= (P0 + (j)) && (P0 + (j)) < hi) && (lo <= (P0 + (j) + 1) && (P0 + (j) + 1) < hi)) GRID_BAR(); } while (0)
template <int l> __device__ __forceinline__ void run_layer(const Args& args, unsigned char* lds_raw, const int lo, const int hi, const int wave_s) {
        const int P0 = PH_L0 + l * NPL;
#define LW() (ws + WS_LW + (size_t)l * LW_SIZE)
        if (INL(0)) for (int rep_ = 0; rep_ < NREP(0); ++rep_) { MKCTX(); ph_norm1(F, l, I.ptr(0), I.ptr(3) + (size_t)l * DM, nullptr); } SEAML(0);
        if (INL(1)) for (int rep_ = 0; rep_ < NREP(1); ++rep_) { MKCTX(); pg8::EpiProj E{(char*)ws, (const float*)(ws + WS_ROPE), (const float*)(ws + WS_ROPE) + T * 32, (const float*)(ws + WS_RSTD)};
            { pg8::SchedProj<false> S{ws, LW(), F.G, bx}; pg8::gemm_phase<pg8::EpiProj, pg8::SchedProj<false>, false>(F.lds + RING_OFF, S, E, F.tid); }
            { pg8::SchedProj<true> S{ws, LW(), F.G, bx}; pg8::gemm_phase<pg8::EpiProj, pg8::SchedProj<true>, true>(F.lds + RING_OFF, S, E, F.tid); } } SEAML(1);
#if NAIVE_SSM
        if (INL(2)) for (int rep_ = 0; rep_ < NREP(2); ++rep_) { MKCTX(); ph_conv(F, I.ptr(11) + (size_t)l * 31 * 512, I.ptr(12) + l * 512, I.ptr(13) + l * 512, I.ptr(14) + l * 512); ph_ssm_naive(F, l, I); } SEAML(2);
        SEAML(3); SEAML(4);
#else
        if (INL(2)) for (int rep_ = 0; rep_ < NREP(2); ++rep_) { MKCTX(); ph_conv(F, I.ptr(11) + (size_t)l * 31 * 512, I.ptr(12) + l * 512, I.ptr(13) + l * 512, I.ptr(14) + l * 512);
            pg8::SchedSsm1 S{ws, LW(), F.G, bx}; pg8::EpiStoreF32 E{16384}; pg8::gemm_phase(F.lds + RING_OFF, S, E, F.tid);
            if (DEFER_CONV && l + 1 < NL && F.G == 256 && bx >= 32) conv_window(F, I, l + 1, 0, (bx - 32) * NWAVES + F.wave, 2); } SEAML(2);
        if (INL(3)) for (int rep_ = 0; rep_ < NREP(3); ++rep_) { MKCTX(); ph_ssm2(F, l);
            if (DEFER_CONV && l + 1 < NL && F.G == 256 && F.vcu >= 64) conv_window(F, I, l + 1, 3584, (F.vcu - 64) * NWAVES + F.wave, 1); } SEAML(3);
#endif
        if (INL(5)) for (int rep_ = 0; rep_ < NREP(5); ++rep_) { MKCTX(); { pg8::SchedSsm3 S{ws, LW(), F.G, bx}; pg8::EpiSsm3 E{(char*)ws + WS_YS}; pg8::gemm_phase(F.lds + RING_OFF, S, E, F.tid);
            if (DEFER_CONV && l + 1 < NL && F.G == 256 && bx >= 64) conv_window(F, I, l + 1, 5120, (bx - 64) * NWAVES + F.wave, 2); }
            (ATTN128 && !NAIVE_ATTN ? attn128::attn_phase : attn_body::attn_phase)((char*)lds_raw + RING_OFF, (const bf16_t*)(ws + WS_Q), (const bf16_t*)(ws + WS_K), (const bf16_t*)(ws + WS_V), (bf16_t*)(ws + WS_O1), (bf16_t*)(ws + WS_O2), F.vcu, F.G, F.tid); } SEAML(5);
        if (INL(6)) for (int rep_ = 0; rep_ < NREP(6); ++rep_) { MKCTX(); ph_diff(F, l, I); __syncthreads();
            pg8::SchedDense S{(const char*)ws + WS_YS, (const char*)LW() + LW_WGLU, 1024, 1024, 8, 32, 4, F.G, bx}; pg8::EpiGlu E{(char*)ws + WS_GLUO, I.ptr(25) + (size_t)l * 1024}; pg8::gemm_phase(F.lds + RING_OFF, S, E, F.tid);
            if (DEFER_CONV && l + 1 < NL && F.G == 256 && bx >= 128) conv_window(F, I, l + 1, 8192, (bx - 128) * NWAVES + F.wave, 2); } SEAML(6);
        if (INL(7)) for (int rep_ = 0; rep_ < NREP(7); ++rep_) { MKCTX(); pg8::SchedSeg<0> S{ws, LW(), F.G, bx}; pg8::EpiGated E{(const char*)ws + WS_GATES, (char*)ws + WS_MERGED}; pg8::gemm_phase(F.lds + RING_OFF, S, E, F.tid); } SEAML(7);
        if (INL(8)) for (int rep_ = 0; rep_ < NREP(8); ++rep_) { MKCTX(); pg8::SchedDense S{(const char*)ws + WS_MERGED, (const char*)LW() + LW_WMIX, 4096, 4096, 32, 32, 8, F.G, bx}; pg8::EpiResid E{(char*)ws + WS_X, (char*)ws + ((S_FP8 || !FUSE_N2) ? WS_H8 : WS_H), (float*)(ws + WS_RSQ)}; pg8::gemm_phase(F.lds + RING_OFF, S, E, F.tid); } SEAML(8);
#ifdef DBG_EXTRA_BAR
        if (INL(9)) GRID_BAR();
#endif
#if !FUSE_N2
        if (INL(9)) for (int rep_ = 0; rep_ < NREP(9); ++rep_) { MKCTX(); ph_norm2(F, I.ptr(28) + (size_t)l * DM); } SEAML(9);
#endif
        if (INL(10)) for (int rep_ = 0; rep_ < NREP(10); ++rep_) { MKCTX(); pg8::SchedDense S{(const char*)ws + (S_FP8 ? WS_H8 : WS_H), (const char*)LW() + LW_WQK, S_FP8 ? 2048 : 4096, S_FP8 ? 2048 : 4096, S_FP8 ? 16 : 32, 32, 4, F.G, bx}; pg8::EpiSexp E{(char*)ws + WS_P, (float*)(ws + WS_RS), (const float*)(ws + WS_RSQ)}; pg8::gemm_phase<pg8::EpiSexp, pg8::SchedDense, S_FP8 != 0>(F.lds + RING_OFF, S, E, F.tid);
            if (DEFER_CONV && l + 1 < NL && F.G == 256 && bx >= 128) conv_window(F, I, l + 1, 10240, (bx - 128) * NWAVES + F.wave, 6); } SEAML(10);
        if (INL(11)) for (int rep_ = 0; rep_ < NREP(11); ++rep_) { MKCTX(); pg8::SchedSeg<1> S{ws, LW(), F.G, bx}; pg8::EpiXao E{(const float*)(ws + WS_RS), (char*)ws + WS_X}; pg8::gemm_phase<pg8::EpiXao, pg8::SchedSeg<1>, XAO_FP8 != 0>(F.lds + RING_OFF, S, E, F.tid); } SEAML(11);
        if (INL(12)) for (int rep_ = 0; rep_ < NREP(12); ++rep_) { MKCTX(); ph_norm3_router(F, l, I, rep_ == NREP(12) - 1); } SEAML(12);
        if (INL(13)) for (int rep_ = 0; rep_ < NREP(13); ++rep_) { MKCTX(); volatile LAS unsigned* MISC = (volatile LAS unsigned*)(F.lds + MISC_OFF);
            if (F.tid < 16) MISC[16 + F.tid] = __hip_atomic_load(F.ctl + CW_CNT + (l * 16 + F.tid) * 16, RLX_AGENT);
            __syncthreads();
            pg8::SchedMoE<false> S{(const volatile LAS int*)(MISC + 16), ws, LW(), F.G, bx}; pg8::EpiGu E{}; pg8::gemm_phase<pg8::EpiGu, pg8::SchedMoE<false>, true>(F.lds + RING_OFF, S, E, F.tid);
            if (DEFER_CONV && l + 1 < NL && F.G == 256 && bx >= 64) conv_window(F, I, l + 1, 16384, (bx - 64) * NWAVES + F.wave, 3); } SEAML(13);
        if (INL(14)) for (int rep_ = 0; rep_ < NREP(14); ++rep_) { MKCTX(); volatile LAS unsigned* MISC = (volatile LAS unsigned*)(F.lds + MISC_OFF);
            if (F.tid < 16) MISC[16 + F.tid] = __hip_atomic_load(F.ctl + CW_CNT + (l * 16 + F.tid) * 16, RLX_AGENT);
            __syncthreads();
            pg8::SchedMoE<true> S{(const volatile LAS int*)(MISC + 16), ws, LW(), F.G, bx}; pg8::EpiDown E{}; pg8::gemm_phase<pg8::EpiDown, pg8::SchedMoE<true>, true>(F.lds + RING_OFF, S, E, F.tid); } SEAML(14);
#undef LW
}
__global__ void __launch_bounds__(NWAVES * 64, 2) mk_fwd(Args args) {
    extern __shared__ __attribute__((aligned(16))) unsigned char lds_raw[];
    const int wave_s = __builtin_amdgcn_readfirstlane((int)threadIdx.x >> 6);
    {   LAS unsigned char* l0 = (LAS unsigned char*)lds_raw;
        for (int u = threadIdx.x; u < (LDS_BYTES - LDSCTL_OFF) / 4; u += NWAVES * 64) ((LAS unsigned*)(l0 + LDSCTL_OFF))[u] = 0u;
        __syncthreads();
        if (threadIdx.x < 84) { const unsigned* ka = (const unsigned*)__builtin_amdgcn_kernarg_segment_ptr(); ((LAS unsigned*)(l0 + INTAB_OFF))[threadIdx.x] = ka[threadIdx.x]; }
        __syncthreads(); }
#if !MK_PER_PHASE
    {   unsigned char* w_ = args.ws; LAUNDER_S(w_); (void)xcd_barrier_post((unsigned*)((gu32*)(w_ + WS_CTL) + CW_BAR), (volatile LAS unsigned*)((LAS unsigned char*)lds_raw + MISC_OFF) + 8); }
#endif
    const int lo = args.ph_lo, hi = args.ph_hi;

    if ((ONLY_LPH < 0 || ONLY_LPH == 100) && IN(PH_PRO_A)) for (int rep_ = 0; rep_ < NREP(20); ++rep_) { MKCTX(); ph_prologue_a(F, I); } SEAM(PH_PRO_A);
    if ((ONLY_LPH < 0 || ONLY_LPH == 101) && IN(PH_PRO_B)) { MKCTX(); pg8::SchedKV S{ws, F.G, bx}; pg8::EpiStore E{2048, 2}; pg8::gemm_phase(F.lds + RING_OFF, S, E, F.tid);
        if (DEFER_CONV && F.G == 256 && bx >= 16) { for (int it = (bx - 16) * NWAVES + F.wave; it < IT_EXP; it += 240 * NWAVES) conv_item(F, I, 0, IT_EARLY + it); } } SEAM(PH_PRO_B);
    if ((ONLY_LPH < 0 || ONLY_LPH == 102) && IN(PH_PRO_C)) { MKCTX(); pg8::SchedAbsorb S{ws, F.G, bx}; pg8::EpiStoreP E{}; pg8::gemm_phase(F.lds + RING_OFF, S, E, F.tid); } SEAM(PH_PRO_C);

    run_layer<0>(args, lds_raw, lo, hi, wave_s); run_layer<1>(args, lds_raw, lo, hi, wave_s); run_layer<2>(args, lds_raw, lo, hi, wave_s); run_layer<3>(args, lds_raw, lo, hi, wave_s);
    if ((ONLY_LPH < 0 || ONLY_LPH == 103) && IN(PH_FINAL)) { MKCTX(); float* outp = args.out; ph_norm1(F, NL, I.ptr(0), I.ptr(41), outp); }
}

extern "C" void kernel_launch(void* const* d_in, const int* in_sizes, int n_in, void* d_out, int out_size, void* d_ws, size_t ws_size, hipStream_t stream) {
    static int grid = 0;
    if (grid == 0) {
        if (n_in != 42 || out_size != T * DM || ws_size < WS_END) { fprintf(stderr, "kernel_launch: unexpected problem shape / workspace (%d inputs, out %d, ws %zu < %zu); nothing launched\n", n_in, out_size, ws_size, (size_t)WS_END); grid = -1; return; }
        int dev = 0, cus = 0, per_cu = 0;
        if (hipGetDevice(&dev) != hipSuccess || hipDeviceGetAttribute(&cus, hipDeviceAttributeMultiprocessorCount, dev) != hipSuccess) { grid = -1; return; }
        if (hipFuncSetAttribute((const void*)mk_fwd, hipFuncAttributeMaxDynamicSharedMemorySize, LDS_BYTES) != hipSuccess) { fprintf(stderr, "kernel_launch: hipFuncSetAttribute failed\n"); grid = -1; return; }
        if (hipOccupancyMaxActiveBlocksPerMultiprocessor(&per_cu, (const void*)mk_fwd, NWAVES * 64, LDS_BYTES) != hipSuccess || per_cu < 1) { fprintf(stderr, "kernel_launch: occupancy query says %d workgroups per CU\n", per_cu); }
        (void)hipGetLastError();
        grid = cus;
    }
    if (grid < 0) return;
    if (hipMemsetAsync((char*)d_ws + WS_CTL, 0, CTL_ZERO_BYTES, stream) != hipSuccess) return;
    Args a{};
    for (int i = 0; i < 42; ++i) a.in[i] = (const float*)d_in[i];
    a.out = (float*)d_out; a.ws = (unsigned char*)d_ws;
#if MK_PER_PHASE
    for (int ph = 0; ph < NPHASES; ++ph) { a.ph_lo = ph; a.ph_hi = ph + 1; hipLaunchKernelGGL(mk_fwd, dim3(grid), dim3(NWAVES * 64), LDS_BYTES, stream, a); }
#else
    a.ph_lo = 0; a.ph_hi = NPHASES;
    hipLaunchKernelGGL(mk_fwd, dim3(grid), dim3(NWAVES * 64), LDS_BYTES, stream, a);
#endif
}
```
